# Optimizing an MI355X kernel written in HIP

```python
import jax, jax.numpy as jnp
from jax import lax
import numpy as np

D_MODEL = 2048
BATCH = 4
SEQ = 4096
DEPTH = 4

PLE_DIM = 256
D_FF = 4 * D_MODEL
EPS = 1e-6
NEG = -1e30
FORCE_BONUS = 1e6

LRU_WIDTH = D_MODEL // 2
LRU_HEADS = 16
LRU_HEAD_DIM = LRU_WIDTH // LRU_HEADS
CONV_WIDTH = 4
LRU_C = 8.0
POOL_WIDTH = D_MODEL // 2
POOL_WINDOWS = (2, 4, 8, 16)
POOL_GROUPS = len(POOL_WINDOWS)
POOL_GROUP_DIM = POOL_WIDTH // POOL_GROUPS
AB_IN = 2 * LRU_WIDTH + POOL_WIDTH
AB_MIX = LRU_WIDTH + POOL_WIDTH

N_HEADS = 16
HEAD_DIM = D_MODEL // N_HEADS
N_KV = 4
HPG = N_HEADS // N_KV
KV_WIDTH = N_KV * HEAD_DIM
CMP_LEN = 32
CMP_STRIDE = 16
CMP_HIDDEN = 512
SEL_LEN = 64
SEL_TOPN = 16
WINDOW = 512
N_BRANCH = 3
Q_BLOCK = 32
C_MIX = N_HEADS * HEAD_DIM
C_IN = C_MIX + 6 * KV_WIDTH + N_BRANCH * N_HEADS

N_EVEN = (DEPTH + 1) // 2
N_ODD = DEPTH // 2

kernel_name = 'hybrid_rglru_pool_nsa'


def rmsnorm(x, g):
    xf = x.astype(jnp.float32)
    y = xf * lax.rsqrt(jnp.mean(xf * xf, axis=-1, keepdims=True) + EPS)
    return (y * g.astype(jnp.float32)).astype(x.dtype)


def alibi_slopes():
    h = jnp.arange(1, N_HEADS + 1, dtype=jnp.float32)
    return jnp.exp2(-8.0 * h / N_HEADS).reshape(N_KV, HPG)


def causal_conv(x, w, b):
    S = x.shape[1]
    xp = jnp.pad(x, ((0, 0), (CONV_WIDTH - 1, 0), (0, 0)))
    out = b
    for k in range(CONV_WIDTH):
        out = out + xp[:, k:k + S] * w[k]
    return out


def _lin_combine(c1, c2):
    a1, b1 = c1
    a2, b2 = c2
    return a1 * a2, a2 * b1 + b2


def rg_lru(x, w_r, b_r, w_i, b_i, lam):
    B, S, W = x.shape
    xf = x.astype(jnp.float32)
    xh = xf.reshape(B, S, LRU_HEADS, LRU_HEAD_DIM)
    r = jax.nn.sigmoid(jnp.einsum('bshi,hij->bshj', xh, w_r.astype(jnp.float32)).reshape(B, S, W) + b_r.astype(jnp.float32))
    i = jax.nn.sigmoid(jnp.einsum('bshi,hij->bshj', xh, w_i.astype(jnp.float32)).reshape(B, S, W) + b_i.astype(jnp.float32))
    log_a = -LRU_C * r * jax.nn.softplus(-lam.astype(jnp.float32))
    a = jnp.exp(log_a)
    bvals = jnp.sqrt(-jnp.expm1(2.0 * log_a)) * (i * xf)
    _, h = lax.associative_scan(_lin_combine, (a, bvals), axis=1)
    return h.astype(x.dtype)


def pool_mixer(u, w, scale):
    B, S, _ = u.shape
    ug = u.astype(jnp.float32).reshape(B, S, POOL_GROUPS, POOL_GROUP_DIM)
    cs = jnp.cumsum(ug, axis=1)
    t = jnp.arange(S)
    outs = []
    for g, win in enumerate(POOL_WINDOWS):
        c = cs[:, :, g]
        prev = jnp.pad(c, ((0, 0), (win, 0), (0, 0)))[:, :S]
        cnt = jnp.minimum(t + 1, win).astype(jnp.float32)[None, :, None]
        outs.append((c - prev) / cnt - ug[:, :, g])
    d = jnp.stack(outs, axis=2)
    y = jnp.einsum('bsgi,gij->bsgj', d, w.astype(jnp.float32)).reshape(B, S, POOL_WIDTH)
    return (y * scale.astype(jnp.float32)).astype(u.dtype)


def ab_mixer(hn, w_in, conv_w, conv_b, w_r, b_r, w_i, b_i, lam, pool_w, pool_scale, w_out):
    z = hn @ w_in
    xr, gate, u = jnp.split(z, [LRU_WIDTH, 2 * LRU_WIDTH], axis=-1)
    xr = causal_conv(xr, conv_w, conv_b)
    y_lru = rg_lru(xr, w_r, b_r, w_i, b_i, lam) * jax.nn.gelu(gate)
    y_pool = pool_mixer(u, pool_w, pool_scale)
    return jnp.concatenate([y_lru, y_pool], axis=-1) @ w_out


def compress(kv, pos, w1, w2):
    S = kv.shape[1]
    n_cmp = (S - CMP_LEN) // CMP_STRIDE + 1
    idx = jnp.arange(n_cmp)[:, None] * CMP_STRIDE + jnp.arange(CMP_LEN)[None, :]
    blocks = kv[:, idx] + pos[None, None, :, None, :]
    hid = jax.nn.gelu(jnp.einsum('bnlgd,ldf->bngf', blocks, w1))
    return jnp.einsum('bngf,fd->bngd', hid, w2)


def nsa_mixer(hn, w_in, pos_k, w1_k, w2_k, pos_v, w1_v, w2_v, w_out):
    B, S, _ = hn.shape
    z = hn @ w_in
    splits = np.cumsum([C_MIX] + [KV_WIDTH] * 6).tolist()
    q, kc, vc, ks, vs, kw, vw, gl = jnp.split(z, splits, axis=-1)
    q = q.reshape(B, S, N_KV, HPG, HEAD_DIM) * (HEAD_DIM ** -0.5)
    kv_shape = (B, S, N_KV, HEAD_DIM)
    kc, vc, ks, vs, kw, vw = [a.reshape(kv_shape) for a in (kc, vc, ks, vs, kw, vw)]
    gates = jax.nn.sigmoid(gl.astype(jnp.float32)).reshape(B, S, N_BRANCH, N_KV, HPG)

    k_cmp = compress(kc, pos_k, w1_k, w2_k).astype(jnp.float32)
    v_cmp = compress(vc, pos_v, w1_v, w2_v).astype(jnp.float32)
    n_cmp = k_cmp.shape[1]
    n_sel = S // SEL_LEN
    top_n = min(SEL_TOPN, n_sel)
    cmp_start = jnp.arange(n_cmp) * CMP_STRIDE
    cmp_end = cmp_start + CMP_LEN - 1
    sel_start = jnp.arange(n_sel) * SEL_LEN
    ov = ((cmp_start[:, None] < sel_start[None, :] + SEL_LEN) & (cmp_start[:, None] + CMP_LEN > sel_start[None, :])).astype(jnp.float32)
    ks_blocks = ks.reshape(B, n_sel, SEL_LEN, N_KV, HEAD_DIM).transpose(0, 3, 1, 2, 4)
    vs_blocks = vs.reshape(B, n_sel, SEL_LEN, N_KV, HEAD_DIM).transpose(0, 3, 1, 2, 4)
    kw_pad = jnp.pad(kw, ((0, 0), (WINDOW, 0), (0, 0), (0, 0)))
    vw_pad = jnp.pad(vw, ((0, 0), (WINDOW, 0), (0, 0), (0, 0)))
    slopes = alibi_slopes()
    n_qblk = S // Q_BLOCK
    q_blocks = q.reshape(B, n_qblk, Q_BLOCK, N_KV, HPG, HEAD_DIM).swapaxes(0, 1)
    g_blocks = gates.reshape(B, n_qblk, Q_BLOCK, N_BRANCH, N_KV, HPG).swapaxes(0, 1)
    bi = jnp.arange(B)[:, None, None, None]
    gi = jnp.arange(N_KV)[None, :, None, None]
    jj = jnp.arange(n_sel)

    def one_block(args):
        blk, qb, gb = args
        t0 = blk * Q_BLOCK
        t = t0 + jnp.arange(Q_BLOCK)
        qf = qb.astype(jnp.float32)
        dist_c = (t[:, None] - cmp_end[None, :]).astype(jnp.float32)
        valid_c = dist_c >= 0
        s_c = jnp.einsum('bqghd,bngd->bghqn', qf, k_cmp) - slopes[None, :, :, None, None] * dist_c
        s_c = jnp.where(valid_c, s_c, NEG)
        p_c = jnp.where(valid_c, jax.nn.softmax(s_c, axis=-1), 0.0)
        o_c = jnp.einsum('bghqn,bngd->bqghd', p_c, v_cmp)
        imp = jnp.einsum('bghqn,nm->bgqm', p_c, ov)
        cur = t // SEL_LEN
        forced = (jj[None, :] == 0) | (jj[None, :] == cur[:, None]) | (jj[None, :] == cur[:, None] - 1)
        causal_s = sel_start[None, :] <= t[:, None]
        imp = jnp.where(forced, imp + FORCE_BONUS, imp)
        imp = jnp.where(causal_s, imp, NEG)
        _, idx = lax.top_k(imp, top_n)
        k_g = ks_blocks[bi, gi, idx].astype(jnp.float32)
        v_g = vs_blocks[bi, gi, idx].astype(jnp.float32)
        pos = idx[..., None] * SEL_LEN + jnp.arange(SEL_LEN)
        dist_s = (t[None, None, :, None, None] - pos).astype(jnp.float32)[:, :, None]
        s_s = jnp.einsum('bqghd,bgqnkd->bghqnk', qf, k_g) - slopes[None, :, :, None, None, None] * dist_s
        s_s = jnp.where(dist_s >= 0, s_s, NEG).reshape(B, N_KV, HPG, Q_BLOCK, top_n * SEL_LEN)
        p_s = jax.nn.softmax(s_s, axis=-1).reshape(B, N_KV, HPG, Q_BLOCK, top_n, SEL_LEN)
        o_s = jnp.einsum('bghqnk,bgqnkd->bqghd', p_s, v_g)
        kwb = lax.dynamic_slice_in_dim(kw_pad, t0, WINDOW + Q_BLOCK, axis=1).astype(jnp.float32)
        vwb = lax.dynamic_slice_in_dim(vw_pad, t0, WINDOW + Q_BLOCK, axis=1).astype(jnp.float32)
        s_pos = t0 - WINDOW + jnp.arange(WINDOW + Q_BLOCK)
        dist_w = t[:, None] - s_pos[None, :]
        valid_w = (dist_w >= 0) & (dist_w < WINDOW) & (s_pos[None, :] >= 0)
        s_w = jnp.einsum('bqghd,bkgd->bghqk', qf, kwb) - slopes[None, :, :, None, None] * dist_w.astype(jnp.float32)
        p_w = jax.nn.softmax(jnp.where(valid_w, s_w, NEG), axis=-1)
        o_w = jnp.einsum('bghqk,bkgd->bqghd', p_w, vwb)
        o = gb[:, :, 0, :, :, None] * o_c + gb[:, :, 1, :, :, None] * o_s + gb[:, :, 2, :, :, None] * o_w
        return o.astype(hn.dtype)

    o = lax.map(one_block, (jnp.arange(n_qblk), q_blocks, g_blocks))
    o = o.swapaxes(0, 1).reshape(B, S, C_MIX)
    return o @ w_out


def setup_inputs(seed: int = 0) -> dict:
    key = jax.random.key(seed)
    keys = iter(jax.random.split(key, 48))

    def nrm(shape, scale):
        return jax.random.normal(next(keys), shape, jnp.float32) * scale

    def gain(shape):
        return 1.0 + nrm(shape, 0.05)

    u = jax.random.uniform(next(keys), (N_EVEN, LRU_WIDTH), jnp.float32, 0.9, 0.999)
    s = u ** (1.0 / LRU_C)
    lam = jnp.log(s) - jnp.log1p(-s)
    return {
        'x': nrm((BATCH, SEQ, D_MODEL), 1.0),
        'p': nrm((DEPTH, BATCH, SEQ, PLE_DIM), 1.0),
        'ln_mix_g': gain((DEPTH, D_MODEL)),
        'ab_w_in': nrm((N_EVEN, D_MODEL, AB_IN), D_MODEL ** -0.5),
        'ab_conv_w': nrm((N_EVEN, CONV_WIDTH, LRU_WIDTH), CONV_WIDTH ** -0.5),
        'ab_conv_b': nrm((N_EVEN, LRU_WIDTH), 0.01),
        'ab_w_rgate': nrm((N_EVEN, LRU_HEADS, LRU_HEAD_DIM, LRU_HEAD_DIM), LRU_HEAD_DIM ** -0.5),
        'ab_b_rgate': nrm((N_EVEN, LRU_WIDTH), 0.1),
        'ab_w_igate': nrm((N_EVEN, LRU_HEADS, LRU_HEAD_DIM, LRU_HEAD_DIM), LRU_HEAD_DIM ** -0.5),
        'ab_b_igate': nrm((N_EVEN, LRU_WIDTH), 0.1),
        'ab_lambda': lam,
        'ab_pool_w': nrm((N_EVEN, POOL_GROUPS, POOL_GROUP_DIM, POOL_GROUP_DIM), POOL_GROUP_DIM ** -0.5),
        'ab_pool_scale': gain((N_EVEN, POOL_WIDTH)),
        'ab_w_out': nrm((N_EVEN, AB_MIX, D_MODEL), AB_MIX ** -0.5),
        'c_w_in': nrm((N_ODD, D_MODEL, C_IN), D_MODEL ** -0.5),
        'c_cmp_pos_k': nrm((N_ODD, CMP_LEN, HEAD_DIM), 0.02),
        'c_cmp_w1_k': nrm((N_ODD, CMP_LEN, HEAD_DIM, CMP_HIDDEN), (CMP_LEN * HEAD_DIM) ** -0.5),
        'c_cmp_w2_k': nrm((N_ODD, CMP_HIDDEN, HEAD_DIM), CMP_HIDDEN ** -0.5),
        'c_cmp_pos_v': nrm((N_ODD, CMP_LEN, HEAD_DIM), 0.02),
        'c_cmp_w1_v': nrm((N_ODD, CMP_LEN, HEAD_DIM, CMP_HIDDEN), (CMP_LEN * HEAD_DIM) ** -0.5),
        'c_cmp_w2_v': nrm((N_ODD, CMP_HIDDEN, HEAD_DIM), CMP_HIDDEN ** -0.5),
        'c_w_out': nrm((N_ODD, C_MIX, D_MODEL), C_MIX ** -0.5),
        'ln_mlp_g': gain((DEPTH, D_MODEL)),
        'mlp_w_up': nrm((DEPTH, D_MODEL, D_FF), D_MODEL ** -0.5),
        'mlp_w_down': nrm((DEPTH, D_FF, D_MODEL), D_FF ** -0.5),
        'ln_ple_g': gain((DEPTH, D_MODEL)),
        'ple_w_gate': nrm((DEPTH, D_MODEL, D_MODEL), D_MODEL ** -0.5),
        'ple_w_proj': nrm((DEPTH, PLE_DIM, D_MODEL), PLE_DIM ** -0.5),
        'ln_final_g': gain((D_MODEL,)),
    }


def reference(x, p, ln_mix_g, ab_w_in, ab_conv_w, ab_conv_b, ab_w_rgate, ab_b_rgate, ab_w_igate, ab_b_igate, ab_lambda, ab_pool_w, ab_pool_scale, ab_w_out, c_w_in, c_cmp_pos_k, c_cmp_w1_k, c_cmp_w2_k, c_cmp_pos_v, c_cmp_w1_v, c_cmp_w2_v, c_w_out, ln_mlp_g, mlp_w_up, mlp_w_down, ln_ple_g, ple_w_gate, ple_w_proj, ln_final_g):
    h = x
    for i in range(DEPTH):
        j = i // 2
        hn = rmsnorm(h, ln_mix_g[i])
        if i % 2 == 0:
            h = h + ab_mixer(hn, ab_w_in[j], ab_conv_w[j], ab_conv_b[j], ab_w_rgate[j], ab_b_rgate[j], ab_w_igate[j], ab_b_igate[j], ab_lambda[j], ab_pool_w[j], ab_pool_scale[j], ab_w_out[j])
        else:
            h = h + nsa_mixer(hn, c_w_in[j], c_cmp_pos_k[j], c_cmp_w1_k[j], c_cmp_w2_k[j], c_cmp_pos_v[j], c_cmp_w1_v[j], c_cmp_w2_v[j], c_w_out[j])
        hn = rmsnorm(h, ln_mlp_g[i])
        h = h + jnp.square(jax.nn.relu(hn @ mlp_w_up[i])) @ mlp_w_down[i]
        gate = jax.nn.sigmoid(rmsnorm(h, ln_ple_g[i]) @ ple_w_gate[i])
        h = h + gate * (p[i] @ ple_w_proj[i])
    return rmsnorm(h, ln_final_g)
```

```cpp
#include <hip/hip_runtime.h>
#include <hip/hip_cooperative_groups.h>
#include <cstdio>
namespace cg = cooperative_groups;

#ifndef MK_ONE_LAUNCH
#define MK_ONE_LAUNCH 1
#endif

#define LAS __attribute__((address_space(3)))
typedef unsigned short bf16_t;
typedef short bf16x8 __attribute__((ext_vector_type(8)));
typedef float f32x4 __attribute__((ext_vector_type(4)));
typedef float f32x2 __attribute__((ext_vector_type(2)));
typedef unsigned u32x4 __attribute__((ext_vector_type(4)));
typedef unsigned u32x2 __attribute__((ext_vector_type(2)));

constexpr int T_TOK = 16384, DM = 2048, SEQ = 4096, NB = 4, DFF = 8192, PLE = 256;
constexpr int AB_IN = 3072, C_IN = 5168, C_INP = 5376;
constexpr float EPSV = 1e-6f;
constexpr float LOG2E = 1.4426950408889634f;

__device__ __forceinline__ unsigned f2bf(float f) { unsigned u = __builtin_bit_cast(unsigned, f); return (u + 0x7fffu + ((u >> 16) & 1u)) >> 16; }
__device__ __forceinline__ unsigned pk2(float lo, float hi) { unsigned r; asm volatile("v_cvt_pk_bf16_f32 %0, %1, %2" : "=v"(r) : "v"(lo), "v"(hi)); return r; }
__device__ __forceinline__ float bf2f(unsigned short b) { return __builtin_bit_cast(float, ((unsigned)b) << 16); }
__device__ __forceinline__ float bflo(unsigned w) { return __builtin_bit_cast(float, w << 16); }
__device__ __forceinline__ float bfhi(unsigned w) { return __builtin_bit_cast(float, w & 0xffff0000u); }
__device__ __forceinline__ float shx(float v, int lane, int o) { return __builtin_bit_cast(float, __builtin_amdgcn_ds_bpermute((lane ^ o) << 2, __builtin_bit_cast(int, v))); }
__device__ __forceinline__ float wave_sum(float v, int lane) {
#pragma unroll
    for (int o = 1; o < 64; o <<= 1) v += shx(v, lane, o);
    return v;
}
__device__ __forceinline__ float sigmoidf_(float x) { return 1.0f / (1.0f + __expf(-x)); }
__device__ __forceinline__ float gelu_tanh(float x) {
    const float u = 0.7978845608028654f * (x + 0.044715f * x * x * x);
    const float e = __expf(2.0f * u);
    const float th = 1.0f - 2.0f / (e + 1.0f);
    return 0.5f * x * (1.0f + th);
}

__device__ __forceinline__ unsigned char* opqp(unsigned char* p) { asm volatile("" : "+s"(p)); return p; }
__device__ __forceinline__ int opq(int v) { asm volatile("" : "+s"(v)); return v; }
__device__ __forceinline__ int opaque_tid() { int t = threadIdx.x; asm volatile("" : "+v"(t)); return t; }
namespace pg8 {
constexpr int BM = 256, BK = 64, HALF = 128, HTB = HALF * BK * 2, STAGE_BYTES = 8 * HTB, NXCD = 8, WGM = 8;
__host__ __device__ __forceinline__ int lds_byte(int r, int c) { const int st = (r >> 4) * 2 + (c >> 5), rr = r & 15, cc = c & 31, ob = rr * 64 + cc * 2; return st * 1024 + (ob ^ (((ob >> 9) & 1) << 5)); }
__host__ __device__ __forceinline__ void stage_rc(int b, int& R, int& C) { const int st = b / 1024, sb = b % 1024, swz = sb ^ (((sb >> 9) & 1) << 5); R = (st >> 1) * 16 + swz / 64; C = (st & 1) * 32 + (swz % 64) / 2; }
__host__ __device__ __forceinline__ int perm32(int rho) { const int n = rho >> 4, i = rho & 15; return 8 * (i >> 2) + 4 * n + (i & 3); }

struct Unit { int pm, pn; };
struct Gemm { const bf16_t* A; const bf16_t* Bt; int M, N, K, lda, ldb; };

struct StaticOrder {
    int nM, nN, nwg, G, c;
    __device__ void init(int M, int N, int G_, int c_) { nM = M / BM; nN = N / BM; nwg = nM * nN; G = G_; c = c_; }
    __device__ bool next(int i, Unit& u) const {
        const long L = (long)i * G + c; if (L >= nwg || c < 0) return false;
        int wgid = (int)L; { const int q = nwg / NXCD, r = nwg % NXCD, xcd = wgid % NXCD, off = wgid / NXCD; wgid = (xcd < r ? xcd * (q + 1) : r * (q + 1) + (xcd - r) * q) + off; }
        const int nig = WGM * nN, gid = wgid / nig, fm = gid * WGM, gsz = (nM - fm) < WGM ? (nM - fm) : WGM;
        u.pm = fm + ((wgid % nig) % gsz); u.pn = (wgid % nig) / gsz; return true;
    }
};

template <class Epi, class Sched>
__device__ __forceinline__ void gemm_phase(LAS unsigned char* lds, const Gemm g, const Sched& S, const Epi& E) {
    const int tid = opaque_tid(), wid = __builtin_amdgcn_readfirstlane(tid >> 6), lane = tid & 63, wr = wid >> 2, wc = wid & 3, fr = lane & 15, fq = lane >> 4;
    const int K = g.K, nt = K / BK;
    unsigned voffA[2], voffB[2];
#pragma unroll
    for (int i = 0; i < 2; ++i) { int R, C; stage_rc(tid * 16 + i * 8192, R, C); const int Rb = Epi::PERM ? ((R & ~31) + perm32(R & 31)) : R;
        voffA[i] = (unsigned)(R * g.lda + C) * 2u; voffB[i] = (unsigned)(Rb * g.ldb + C) * 2u; }
    const size_t kstep = (size_t)(BK * 2);
    const size_t hstepA = (size_t)HALF * g.lda * 2, hstepB = (size_t)HALF * g.ldb * 2;
    const size_t tstepA = 2 * hstepA, tstepB = 2 * hstepB;
    const unsigned ldsw = (unsigned)wid * 1024u;
    const int aoff = lds_byte(wr * 64 + fr, fq * 8), boff = lds_byte(wc * 32 + fr, fq * 8);
#define PG8_SA(b, h) (((b) * 2 + (h)) * HTB)
#define PG8_SB(b, h) ((4 + (b) * 2 + (h)) * HTB)
#define PG8_STAGE(bufoff, gbase, voff) do { _Pragma("unroll") for (int _i = 0; _i < 2; ++_i) \
        __builtin_amdgcn_global_load_lds((const unsigned*)((const char*)(gbase) + (voff)[_i]), (LAS unsigned*)(lds + (bufoff) + ldsw + _i * 8192), 16, 0, 0); } while (0)
#define PG8_LDA(dst, b, h) do { _Pragma("unroll") for (int m = 0; m < 4; ++m) _Pragma("unroll") for (int k = 0; k < 2; ++k) dst[m][k] = *(const LAS bf16x8*)(lds + PG8_SA(b, h) + aoff + m * 2048 + k * 1024); } while (0)
#define PG8_LDB(dst, b, h) do { _Pragma("unroll") for (int n = 0; n < 2; ++n) _Pragma("unroll") for (int k = 0; k < 2; ++k) dst[n][k] = *(const LAS bf16x8*)(lds + PG8_SB(b, h) + boff + n * 2048 + k * 1024); } while (0)
#define PG8_MMA(ai, bj, At, Bt) do { __builtin_amdgcn_s_setprio(1); _Pragma("unroll") for (int m = 0; m < 4; ++m) _Pragma("unroll") for (int n = 0; n < 2; ++n) _Pragma("unroll") for (int k = 0; k < 2; ++k) \
        acc[ai][bj][m][n] = __builtin_amdgcn_mfma_f32_16x16x32_bf16(Bt[n][k], At[m][k], acc[ai][bj][m][n], 0, 0, 0); __builtin_amdgcn_s_setprio(0); } while (0)
#define PG8_WAIT_V(n) asm volatile("s_waitcnt vmcnt(" #n ")" ::: "memory")
#define PG8_WAIT_L(n) asm volatile("s_waitcnt lgkmcnt(" #n ")" ::: "memory")
#define PG8_BAR __builtin_amdgcn_s_barrier()
#define PG8_SCHED __builtin_amdgcn_sched_barrier(0)
    Unit cur, nxt; int ui = 0;
    if (!S.next(0, cur)) return;
    f32x4 acc[2][2][4][2];
#pragma unroll
    for (int a = 0; a < 2; ++a)
#pragma unroll
        for (int b = 0; b < 2; ++b)
#pragma unroll
            for (int m = 0; m < 4; ++m)
#pragma unroll
                for (int n = 0; n < 2; ++n) acc[a][b][m][n] = (f32x4){0.f, 0.f, 0.f, 0.f};
    bf16x8 At[4][2], B0[2][2], B1[2][2];
    const char* cA = (const char*)g.A + (size_t)cur.pm * tstepA; const char* cB = (const char*)g.Bt + (size_t)cur.pn * tstepB;
    PG8_STAGE(PG8_SB(0, 0), cB, voffB); PG8_STAGE(PG8_SB(0, 1), cB + hstepB, voffB); PG8_STAGE(PG8_SA(0, 0), cA, voffA); PG8_STAGE(PG8_SA(0, 1), cA + hstepA, voffA);
    if (wr == 1) PG8_BAR;
    PG8_WAIT_V(2); PG8_BAR;
    PG8_STAGE(PG8_SB(1, 0), cB + kstep, voffB); PG8_STAGE(PG8_SA(1, 0), cA + kstep, voffA); PG8_STAGE(PG8_SB(1, 1), cB + hstepB + kstep, voffB);
    PG8_WAIT_V(6); PG8_BAR;
    for (;;) {
        const bool has_next = S.next(ui + 1, nxt);
        const char* nA = has_next ? (const char*)g.A + (size_t)nxt.pm * tstepA : cA; const char* nB = has_next ? (const char*)g.Bt + (size_t)nxt.pn * tstepB : cB;
        for (int t = 0; t < nt; t += 2) {
            const bool last = (t == nt - 2);
            const char* a1 = cA + (size_t)(t + 1) * kstep;
            const char* a2 = last ? nA : cA + (size_t)(t + 2) * kstep; const char* b2 = last ? nB : cB + (size_t)(t + 2) * kstep;
            const char* a3 = a2 + kstep; const char* b3 = b2 + kstep;
            PG8_LDB(B0, 0, 0); PG8_LDB(B1, 0, 1); PG8_SCHED; PG8_LDA(At, 0, 0); PG8_STAGE(PG8_SA(1, 1), a1 + hstepA, voffA);
            PG8_WAIT_V(8); PG8_WAIT_L(0); PG8_BAR; PG8_MMA(0, 0, At, B0); PG8_MMA(0, 1, At, B1); PG8_BAR; PG8_SCHED;
            PG8_LDA(At, 0, 1); PG8_STAGE(PG8_SB(0, 0), b2, voffB); PG8_STAGE(PG8_SB(0, 1), b2 + hstepB, voffB); PG8_STAGE(PG8_SA(0, 0), a2, voffA);
            PG8_WAIT_V(8); PG8_WAIT_L(0); PG8_BAR; PG8_MMA(1, 0, At, B0); PG8_MMA(1, 1, At, B1); PG8_BAR; PG8_SCHED;
            PG8_LDB(B0, 1, 0); PG8_LDB(B1, 1, 1); PG8_SCHED; PG8_LDA(At, 1, 0); PG8_STAGE(PG8_SA(0, 1), a2 + hstepA, voffA);
            PG8_WAIT_V(8); PG8_WAIT_L(0); PG8_BAR; PG8_MMA(0, 0, At, B0); PG8_MMA(0, 1, At, B1); PG8_BAR; PG8_SCHED;
            PG8_LDA(At, 1, 1); PG8_STAGE(PG8_SB(1, 0), b3, voffB); PG8_STAGE(PG8_SB(1, 1), b3 + hstepB, voffB); PG8_STAGE(PG8_SA(1, 0), a3, voffA);
            PG8_WAIT_V(8); PG8_WAIT_L(0); PG8_BAR; PG8_MMA(1, 0, At, B0); PG8_MMA(1, 1, At, B1); PG8_BAR; PG8_SCHED;
        }
        if (wr == 0) PG8_BAR;
        E(acc, cur, wr, wc, fr, fq);
        if (!has_next) break;
#pragma unroll
        for (int a = 0; a < 2; ++a)
#pragma unroll
            for (int b = 0; b < 2; ++b)
#pragma unroll
                for (int m = 0; m < 4; ++m)
#pragma unroll
                    for (int n = 0; n < 2; ++n) acc[a][b][m][n] = (f32x4){0.f, 0.f, 0.f, 0.f};
        cur = nxt; cA = nA; cB = nB; ++ui;
        if (wr == 1) PG8_BAR;
    }
    PG8_WAIT_V(0);
    PG8_BAR;
#undef PG8_SA
#undef PG8_SB
#undef PG8_STAGE
#undef PG8_LDA
#undef PG8_LDB
#undef PG8_MMA
#undef PG8_WAIT_V
#undef PG8_WAIT_L
#undef PG8_BAR
#undef PG8_SCHED
}
}
using pg8::Unit; using pg8::HALF; using pg8::BM;

template <int ACT  > struct EpiBf16 {
    static constexpr bool PERM = true;
    bf16_t* O; int ldc; const float* bias;
    __device__ __forceinline__ void operator()(const f32x4 (&acc)[2][2][4][2], const Unit& u, int wr, int wc, int fr, int fq) const {
        const int row0 = u.pm * BM + wr * 64 + fr, col0 = u.pn * BM + wc * 32 + 8 * fq;
        f32x4 bv[2][2];
#pragma unroll
        for (int bj = 0; bj < 2; ++bj)
#pragma unroll
            for (int n = 0; n < 2; ++n) bv[bj][n] = (ACT == 2) ? *(const f32x4*)(bias + col0 + bj * HALF + 4 * n) : (f32x4){0.f, 0.f, 0.f, 0.f};
#pragma unroll
        for (int ai = 0; ai < 2; ++ai)
#pragma unroll
            for (int m = 0; m < 4; ++m) { bf16_t* rowp = O + (size_t)(row0 + ai * HALF + m * 16) * ldc + col0;
#pragma unroll
                for (int bj = 0; bj < 2; ++bj) { f32x4 v0 = acc[ai][bj][m][0] + bv[bj][0], v1 = acc[ai][bj][m][1] + bv[bj][1];
                    if (ACT == 1) {
#pragma unroll
                        for (int j = 0; j < 4; ++j) { const float a = fmaxf(v0[j], 0.f), b = fmaxf(v1[j], 0.f); v0[j] = a * a; v1[j] = b * b; } }
                    if (ACT == 2) {
#pragma unroll
                        for (int j = 0; j < 4; ++j) { v0[j] = gelu_tanh(v0[j]); v1[j] = gelu_tanh(v1[j]); } }
                    u32x4 w; w.x = pk2(v0[0], v0[1]); w.y = pk2(v0[2], v0[3]); w.z = pk2(v1[0], v1[1]); w.w = pk2(v1[2], v1[3]);
                    *(u32x4*)(rowp + bj * HALF) = w; } }
    }
};
template <int MODE> struct EpiF32 {
    static constexpr bool PERM = false;
    const float* base; float* out; const float* pp; int ldc;
    __device__ __forceinline__ void operator()(const f32x4 (&acc)[2][2][4][2], const Unit& u, int wr, int wc, int fr, int fq) const {
        const int row0 = u.pm * BM + wr * 64 + fr, col0 = u.pn * BM + wc * 32 + 4 * fq;
#pragma unroll
        for (int ai = 0; ai < 2; ++ai)
#pragma unroll
            for (int m = 0; m < 4; ++m) { const size_t off = (size_t)(row0 + ai * HALF + m * 16) * ldc + col0;
#pragma unroll
                for (int bj = 0; bj < 2; ++bj)
#pragma unroll
                    for (int n = 0; n < 2; ++n) { const size_t o2 = off + bj * HALF + n * 16; f32x4 a = acc[ai][bj][m][n];
                        if (MODE == 0) { a = a + *(const f32x4*)(base + o2); }
                        if (MODE == 1) { const f32x4 b = *(const f32x4*)(base + o2), p = *(const f32x4*)(pp + o2);
#pragma unroll
                            for (int j = 0; j < 4; ++j) a[j] = b[j] + sigmoidf_(a[j]) * p[j]; }
                        *(f32x4*)(out + o2) = a; }
                asm volatile("" ::: "memory"); }
    }
};
struct EpiNsa {
    static constexpr bool PERM = true;
    bf16_t *Q, *KC, *VC, *KS, *VST, *KW, *VWT; float* GL;
    __device__ __forceinline__ void operator()(const f32x4 (&acc)[2][2][4][2], const Unit& u, int wr, int wc, int fr, int fq) const {
        const int row0 = u.pm * BM + wr * 64 + fr; const int pn = u.pn;
#pragma unroll
        for (int ai = 0; ai < 2; ++ai)
#pragma unroll
            for (int m = 0; m < 4; ++m) { const int row = row0 + ai * HALF + m * 16; const int b = row >> 12, s = row & 4095;
#pragma unroll
                for (int bj = 0; bj < 2; ++bj) { const f32x4 v0 = acc[ai][bj][m][0], v1 = acc[ai][bj][m][1];
                    const int cl = bj * HALF + wc * 32 + 8 * fq;
                    if (pn < 8) { u32x4 w; w.x = pk2(v0[0], v0[1]); w.y = pk2(v0[2], v0[3]); w.z = pk2(v1[0], v1[1]); w.w = pk2(v1[2], v1[3]);
                        *(u32x4*)(Q + (size_t)row * 2048 + pn * 256 + cl) = w; }
                    else if (pn < 20) { const int k = (pn - 8) >> 1; const int c = ((pn - 8) & 1) * 256 + cl; const int g = c >> 7, d = c & 127;
                        if (k == 3 || k == 5) { bf16_t* dst = (k == 3 ? VST : VWT) + ((size_t)((b * 4 + g) * 128 + d)) * 4096 + s;
#pragma unroll
                            for (int j = 0; j < 4; ++j) { dst[(size_t)j * 4096] = (bf16_t)f2bf(v0[j]); dst[(size_t)(4 + j) * 4096] = (bf16_t)f2bf(v1[j]); } }
                        else { bf16_t* dst = (k == 0 ? KC : k == 1 ? VC : k == 2 ? KS : KW) + ((size_t)((b * 4 + g) * 4096 + s)) * 128 + d;
                            u32x4 w; w.x = pk2(v0[0], v0[1]); w.y = pk2(v0[2], v0[3]); w.z = pk2(v1[0], v1[1]); w.w = pk2(v1[2], v1[3]);
                            *(u32x4*)dst = w; } }
                    else { if (cl < 48) { float* dst = GL + (size_t)row * 48 + cl;
                            f32x4 a, c2;
#pragma unroll
                            for (int j = 0; j < 4; ++j) { a[j] = sigmoidf_(v0[j]); c2[j] = sigmoidf_(v1[j]); }
                            *(f32x4*)dst = a; *(f32x4*)(dst + 4) = c2; } } } }
    }
};
template <int TR> struct EpiCmp2 {
    static constexpr bool PERM = true;
    bf16_t* O;
    __device__ __forceinline__ void operator()(const f32x4 (&acc)[2][2][4][2], const Unit& u, int wr, int wc, int fr, int fq) const {
        const int row0 = u.pm * BM + wr * 64 + fr; const int cl = wc * 32 + 8 * fq;
#pragma unroll
        for (int ai = 0; ai < 2; ++ai)
#pragma unroll
            for (int m = 0; m < 4; ++m) { const int row = row0 + ai * HALF + m * 16; const f32x4 v0 = acc[ai][0][m][0], v1 = acc[ai][0][m][1];
                if (TR == 0) { u32x4 w; w.x = pk2(v0[0], v0[1]); w.y = pk2(v0[2], v0[3]); w.z = pk2(v1[0], v1[1]); w.w = pk2(v1[2], v1[3]);
                    *(u32x4*)(O + (size_t)row * 128 + cl) = w; }
                else { bf16_t* dst = O + ((size_t)((row >> 8) * 128 + cl)) * 256 + (row & 255);
#pragma unroll
                    for (int j = 0; j < 4; ++j) { dst[(size_t)j * 256] = (bf16_t)f2bf(v0[j]); dst[(size_t)(4 + j) * 256] = (bf16_t)f2bf(v1[j]); } } }
    }
};

constexpr size_t al256(size_t x) { return (x + 255) & ~(size_t)255; }
constexpr size_t SZ_WIN = (size_t)AB_IN * DM * 2, SZ_SQ = (size_t)DM * DM * 2, SZ_CIN = (size_t)C_INP * DM * 2, SZ_W1 = (size_t)512 * 4096 * 2, SZ_W2 = (size_t)256 * 512 * 2;
constexpr size_t SZ_UP = (size_t)DFF * DM * 2, SZ_WP = (size_t)DM * PLE * 2, SZ_WRI = (size_t)16 * 64 * 64 * 2, SZ_POOLT = (size_t)4 * 256 * 256 * 2, SZ_WU = (size_t)DM * 1024 * 2;
constexpr size_t WS_WIN = 0;
constexpr size_t WS_WOUT = WS_WIN + 2 * SZ_WIN;
constexpr size_t WS_CIN = WS_WOUT + 2 * SZ_SQ;
constexpr size_t WS_COUT = WS_CIN + 2 * SZ_CIN;
constexpr size_t WS_W1K = WS_COUT + 2 * SZ_SQ;
constexpr size_t WS_W1V = WS_W1K + 2 * SZ_W1;
constexpr size_t WS_W2K = WS_W1V + 2 * SZ_W1;
constexpr size_t WS_W2V = WS_W2K + 2 * SZ_W2;
constexpr size_t WS_WUP = WS_W2V + 2 * SZ_W2;
constexpr size_t WS_WDN = WS_WUP + 4 * SZ_UP;
constexpr size_t WS_WG = WS_WDN + 4 * SZ_UP;
constexpr size_t WS_WP = WS_WG + 4 * SZ_SQ;
constexpr size_t WS_WR = WS_WP + 4 * SZ_WP;
constexpr size_t WS_WI = WS_WR + 2 * SZ_WRI;
constexpr size_t WS_POOLT = WS_WI + 2 * SZ_WRI;
constexpr size_t WS_WU = WS_POOLT + 2 * SZ_POOLT;
constexpr size_t WS_PB = WS_WU + 2 * SZ_WU;
constexpr size_t WS_POSB = WS_PB + (size_t)4 * T_TOK * PLE * 2;
constexpr size_t WS_XN = WS_POSB + 8192;
constexpr size_t WS_YB = WS_XN + (size_t)T_TOK * DM * 2;
constexpr size_t WS_Z = WS_YB + (size_t)T_TOK * DM * 2;
constexpr size_t SZ_KV = (size_t)16 * 4096 * 128 * 2;
constexpr size_t Z_Q = 0, Z_KC = (size_t)T_TOK * DM * 2, Z_VC = Z_KC + SZ_KV, Z_KS = Z_VC + SZ_KV, Z_VST = Z_KS + SZ_KV, Z_KW = Z_VST + SZ_KV, Z_VWT = Z_KW + SZ_KV;
constexpr size_t Z_GL = Z_VWT + SZ_KV, Z_HIDK = Z_GL + (size_t)T_TOK * 48 * 4, Z_HIDV = Z_HIDK + (size_t)4096 * 512 * 2, Z_KCMP = Z_HIDV + (size_t)4096 * 512 * 2, Z_VCMPT = Z_KCMP + (size_t)4096 * 128 * 2;
constexpr size_t WS_END = WS_Z + (size_t)T_TOK * DFF * 2;
static_assert(Z_VCMPT + 4096 * 128 * 2 <= (size_t)T_TOK * DFF * 2, "z region");
static_assert(WS_END <= (size_t)1 << 30, "workspace");
constexpr int LDS_BYTES = pg8::STAGE_BYTES;

struct Args { const float* in[29]; float* out; unsigned char* ws; int lo, hi, one, pad; };

__device__ __forceinline__ void transpose_item(const float* W, int N, int ldw, bf16_t* WT, int ldt, LAS float* scr, int item, int lane) {
    const int nblk = (N + 31) / 32, kb = item / nblk, nb = item % nblk, k0 = 64 * kb, n0 = 32 * nb;
    const int nn = n0 + (lane & 31); const bool ok = nn < N;
#pragma unroll 8
    for (int i = 0; i < 32; ++i) { const int kk = 2 * i + (lane >> 5); scr[kk * 33 + (lane & 31)] = ok ? W[(size_t)(k0 + kk) * ldw + nn] : 0.f; }
    asm volatile("s_waitcnt lgkmcnt(0)" ::: "memory");
    const int c = lane & 7;
#pragma unroll
    for (int j = 0; j < 4; ++j) { const int n = (lane >> 3) + 8 * j; const LAS float* s = scr + (8 * c) * 33 + n;
        u32x4 o; o.x = f2bf(s[0 * 33]) | (f2bf(s[1 * 33]) << 16); o.y = f2bf(s[2 * 33]) | (f2bf(s[3 * 33]) << 16); o.z = f2bf(s[4 * 33]) | (f2bf(s[5 * 33]) << 16); o.w = f2bf(s[6 * 33]) | (f2bf(s[7 * 33]) << 16);
        if (n0 + n < N) *(u32x4*)(WT + (size_t)(n0 + n) * ldt + k0 + 8 * c) = o; }
    asm volatile("s_waitcnt lgkmcnt(0)" ::: "memory");
}
__device__ __forceinline__ void conv_mat(const float* W, int K, int N, int ldw, bf16_t* WT, int ldt, LAS float* scr, int gw, int NGW, int lane, int& rot) {
    const int nitems = (K / 64) * ((N + 31) / 32);
    int start = gw - rot; if (start < 0) start += NGW;
    for (int it = start; it < nitems; it += NGW) transpose_item(W, N, ldw, WT, ldt, scr, it, lane);
    rot = (rot + nitems) % NGW;
}
__device__ __forceinline__ void conv_plain(const float* src, int rows, int ncols, int lds_, bf16_t* dst, int ldd, int gt, int NGT) {
    const int cpr = ncols / 8; const long total = (long)rows * cpr;
    for (long i = gt; i < total; i += NGT) { const int r = (int)(i / cpr), c = (int)(i % cpr) * 8;
        const f32x4 a = *(const f32x4*)(src + (size_t)r * lds_ + c), b = *(const f32x4*)(src + (size_t)r * lds_ + c + 4);
        u32x4 o; o.x = f2bf(a[0]) | (f2bf(a[1]) << 16); o.y = f2bf(a[2]) | (f2bf(a[3]) << 16); o.z = f2bf(b[0]) | (f2bf(b[1]) << 16); o.w = f2bf(b[2]) | (f2bf(b[3]) << 16);
        *(u32x4*)(dst + (size_t)r * ldd + c) = o; }
}
__device__ __forceinline__ void zero_fill16(unsigned char* p, size_t bytes, int gt, int NGT) {
    const u32x4 z = (u32x4){0u, 0u, 0u, 0u};
    for (size_t i = (size_t)gt * 16; i < bytes; i += (size_t)NGT * 16) *(u32x4*)(p + i) = z;
}

template <bool F32OUT>
__device__ __forceinline__ void rmsnorm_rows(const float* X, const float* g, bf16_t* O, float* OF, int bx, int NGW) {
    asm volatile("" ::: "memory"); const int tid = opaque_tid(), lane = tid & 63; const int gw = opq(bx) * 8 + __builtin_amdgcn_readfirstlane(tid >> 6);
    f32x4 gv[8];
#pragma unroll
    for (int j = 0; j < 8; ++j) gv[j] = *(const f32x4*)(g + (lane + 64 * j) * 4);
    for (int r = gw; r < T_TOK; r += NGW) {
        const float* xr = X + (size_t)r * DM; f32x4 v[8]; float s = 0.f;
#pragma unroll
        for (int j = 0; j < 8; ++j) { v[j] = *(const f32x4*)(xr + (lane + 64 * j) * 4); s += (v[j][0] * v[j][0] + v[j][1] * v[j][1]) + (v[j][2] * v[j][2] + v[j][3] * v[j][3]); }
        const float rstd = rsqrtf(wave_sum(s, lane) * (1.f / DM) + EPSV);
#pragma unroll
        for (int j = 0; j < 8; ++j) { const f32x4 y = v[j] * rstd * gv[j];
            if (F32OUT) *(f32x4*)(OF + (size_t)r * DM + (lane + 64 * j) * 4) = y;
            else { u32x2 w; w.x = pk2(y[0], y[1]); w.y = pk2(y[2], y[3]); *(u32x2*)(O + (size_t)r * DM + (lane + 64 * j) * 4) = w; } }
    }
}

__device__ __forceinline__ void lru_item(LAS unsigned char* lds, int item, const bf16_t* ZE, const float* conv_w, const float* conv_b,
                                         const bf16_t* WrT, const bf16_t* WiT, const float* b_r, const float* b_i, const float* lam, bf16_t* YB) {
    const int tid = opaque_tid(), w = __builtin_amdgcn_readfirstlane(tid >> 6), lane = tid & 63, fr = lane & 15, fq = lane >> 4;
    const int b = item >> 6, hh = (item >> 2) & 15, qq = item & 3;
    LAS unsigned char* XC = lds;
    LAS float* SEGA = (LAS float*)(lds + 36864);
    LAS float* SEGB = SEGA + 1024;
    LAS float* HIN = SEGB + 1024;
    const int co = tid & 7, tr = tid >> 3;
    float cw[4][8], cb[8];
#pragma unroll
    for (int k = 0; k < 4; ++k)
#pragma unroll
        for (int e = 0; e < 8; ++e) cw[k][e] = conv_w[k * 1024 + hh * 64 + co * 8 + e];
#pragma unroll
    for (int e = 0; e < 8; ++e) cb[e] = conv_b[hh * 64 + co * 8 + e];
    bf16x8 wrf[2], wif[2];
#pragma unroll
    for (int kk = 0; kk < 2; ++kk) { wrf[kk] = *(const bf16x8*)(WrT + ((size_t)hh * 64 + qq * 16 + fr) * 64 + kk * 32 + fq * 8); wif[kk] = *(const bf16x8*)(WiT + ((size_t)hh * 64 + qq * 16 + fr) * 64 + kk * 32 + fq * 8); }
    const int ch = hh * 64 + qq * 16 + fr;
    const float br = b_r[ch], bi = b_i[ch];
    const float lm = lam[ch]; float sp8; { const float e = __expf(-lm); const float ser = e * (1.f - e * (0.5f - e * (0.33333333f - e * 0.25f)));
        sp8 = 8.0f * ((-lm > 20.f) ? -lm : (e < 0.03f ? ser : __logf(1.0f + e))); }
    float carry = 0.f;
    const bf16_t* zb = ZE + (size_t)b * SEQ * AB_IN;
    for (int sc = 0; sc < 16; ++sc) {
        const int t0 = sc * 256;
        {
            float xin[7][8];
#pragma unroll
            for (int r = 0; r < 7; ++r) { const int t = t0 + tr * 4 - 3 + r;
                if (t >= 0) { const u32x4 v = *(const u32x4*)(zb + (size_t)t * AB_IN + hh * 64 + co * 8);
                    xin[r][0] = bflo(v.x); xin[r][1] = bfhi(v.x); xin[r][2] = bflo(v.y); xin[r][3] = bfhi(v.y); xin[r][4] = bflo(v.z); xin[r][5] = bfhi(v.z); xin[r][6] = bflo(v.w); xin[r][7] = bfhi(v.w); }
                else {
#pragma unroll
                    for (int e = 0; e < 8; ++e) xin[r][e] = 0.f; } }
#pragma unroll
            for (int q = 0; q < 4; ++q) { float o[8];
#pragma unroll
                for (int e = 0; e < 8; ++e) o[e] = cb[e] + cw[0][e] * xin[q][e] + cw[1][e] * xin[q + 1][e] + cw[2][e] * xin[q + 2][e] + cw[3][e] * xin[q + 3][e];
                u32x4 wv; wv.x = pk2(o[0], o[1]); wv.y = pk2(o[2], o[3]); wv.z = pk2(o[4], o[5]); wv.w = pk2(o[6], o[7]);
                *(LAS u32x4*)(XC + (tr * 4 + q) * 144 + co * 16) = wv; }
        }
        __syncthreads();
        float av[2][4], bv[2][4];
#pragma unroll
        for (int ml = 0; ml < 2; ++ml) { const int mt = w * 2 + ml;
            f32x4 ar = (f32x4){0.f, 0.f, 0.f, 0.f}, ai = ar;
#pragma unroll
            for (int kk = 0; kk < 2; ++kk) { const bf16x8 xa = *(const LAS bf16x8*)(XC + (mt * 16 + fr) * 144 + kk * 64 + fq * 16);
                ar = __builtin_amdgcn_mfma_f32_16x16x32_bf16(xa, wrf[kk], ar, 0, 0, 0); ai = __builtin_amdgcn_mfma_f32_16x16x32_bf16(xa, wif[kk], ai, 0, 0, 0); }
            float A = 1.f, Bc = 0.f;
#pragma unroll
            for (int r = 0; r < 4; ++r) { const int tok = mt * 16 + fq * 4 + r;
                const float xcv = bf2f(*(const LAS unsigned short*)(XC + tok * 144 + (qq * 16 + fr) * 2));
                const float rg = sigmoidf_(ar[r] + br), ig = sigmoidf_(ai[r] + bi);
                const float la = -rg * sp8; const float a = __expf(la); const float x2 = 2.f * la; const float em = (x2 > -0.3f) ? -x2 * (1.f + x2 * 0.5f * (1.f + x2 * 0.33333333f * (1.f + x2 * 0.25f * (1.f + x2 * 0.2f * (1.f + x2 * 0.16666667f))))) : 1.f - __expf(x2);
                const float mult = sqrtf(fmaxf(em, 0.f));
                av[ml][r] = a; bv[ml][r] = mult * ig * xcv;
                Bc = a * Bc + bv[ml][r]; A = A * a; }
            const int sg = mt * 4 + fq; SEGA[sg * 16 + fr] = A; SEGB[sg * 16 + fr] = Bc; }
        __syncthreads();
        if (w == 0 && lane < 16) { float h = carry;
#pragma unroll 8
            for (int sg = 0; sg < 64; ++sg) { HIN[sg * 16 + lane] = h; h = SEGA[sg * 16 + lane] * h + SEGB[sg * 16 + lane]; }
            carry = h; }
        __syncthreads();
#pragma unroll
        for (int ml = 0; ml < 2; ++ml) { const int mt = w * 2 + ml; float h = HIN[(mt * 4 + fq) * 16 + fr];
#pragma unroll
            for (int r = 0; r < 4; ++r) { const int t = t0 + mt * 16 + fq * 4 + r; h = av[ml][r] * h + bv[ml][r];
                const float gt = bf2f(zb[(size_t)t * AB_IN + 1024 + ch]);
                YB[((size_t)b * SEQ + t) * DM + ch] = (bf16_t)f2bf(h * gelu_tanh(gt)); } }
    }
    __syncthreads();
}
__device__ __forceinline__ void pool_item(int item, const bf16_t* ZE, const float* scale, bf16_t* YB) {
    const int tid = opaque_tid(), b = item >> 6, tch = item & 63, co = tid & 127, seg = tid >> 7;
    const int win = 2 << (co >> 5);
    float sc[8];
#pragma unroll
    for (int e = 0; e < 8; ++e) sc[e] = scale[co * 8 + e];
    const bf16_t* zb = ZE + (size_t)b * SEQ * AB_IN + 2048 + co * 8;
    const int ts = tch * 64 + seg * 16;
    float sum[8];
#pragma unroll
    for (int e = 0; e < 8; ++e) sum[e] = 0.f;
    for (int s = ts - win + 1; s < ts; ++s) if (s >= 0) { const u32x4 v = *(const u32x4*)(zb + (size_t)s * AB_IN);
        sum[0] += bflo(v.x); sum[1] += bfhi(v.x); sum[2] += bflo(v.y); sum[3] += bfhi(v.y); sum[4] += bflo(v.z); sum[5] += bfhi(v.z); sum[6] += bflo(v.w); sum[7] += bfhi(v.w); }
    for (int t = ts; t < ts + 16; ++t) {
        const u32x4 v = *(const u32x4*)(zb + (size_t)t * AB_IN);
        float x[8] = {bflo(v.x), bfhi(v.x), bflo(v.y), bfhi(v.y), bflo(v.z), bfhi(v.z), bflo(v.w), bfhi(v.w)};
        const float inv = 1.0f / (float)((t + 1) < win ? (t + 1) : win);
        float o[8];
#pragma unroll
        for (int e = 0; e < 8; ++e) { sum[e] += x[e]; o[e] = (sum[e] * inv - x[e]) * sc[e]; }
        u32x4 wv; wv.x = pk2(o[0], o[1]); wv.y = pk2(o[2], o[3]); wv.z = pk2(o[4], o[5]); wv.w = pk2(o[6], o[7]);
        *(u32x4*)(YB + ((size_t)b * SEQ + t) * DM + 1024 + co * 8) = wv;
        const int so = t - win + 1;
        if (so >= 0) { const u32x4 q = *(const u32x4*)(zb + (size_t)so * AB_IN);
            sum[0] -= bflo(q.x); sum[1] -= bfhi(q.x); sum[2] -= bflo(q.y); sum[3] -= bfhi(q.y); sum[4] -= bflo(q.z); sum[5] -= bfhi(q.z); sum[6] -= bflo(q.w); sum[7] -= bfhi(q.w); }
    }
}

constexpr int KT_PITCH = 272, VT_PITCH = 144;
constexpr int AL_KT = 0, AL_VT = 64 * KT_PITCH, AL_IMPA = 36864, AL_IMPB = AL_IMPA + 64 * 65 * 4, AL_SEL = AL_IMPB + 64 * 65 * 4, AL_UNI = AL_SEL + 512;
constexpr float QSCALE2 = 0.08838834764831845f * LOG2E;
constexpr float NEGB = -1e30f;

struct StageRegs { u32x4 k[2], v[2]; };
__device__ __forceinline__ void stage_load(StageRegs& R, const bf16_t* kbase, const bf16_t* vbase, int vpitch, int tid) {
    const int kr = tid >> 3, kc = tid & 7, vr = tid >> 2, vc = tid & 3;
    R.k[0] = *(const u32x4*)(kbase + kr * 128 + kc * 8); R.k[1] = *(const u32x4*)(kbase + kr * 128 + 64 + kc * 8);
    R.v[0] = *(const u32x4*)(vbase + (size_t)vr * vpitch + vc * 8); R.v[1] = *(const u32x4*)(vbase + (size_t)vr * vpitch + 32 + vc * 8);
}
__device__ __forceinline__ void stage_store(const StageRegs& R, LAS unsigned char* lds, int tid) {
    const int kr = tid >> 3, kc = tid & 7, vr = tid >> 2, vc = tid & 3;
    *(LAS u32x4*)(lds + AL_KT + kr * KT_PITCH + kc * 16) = R.k[0]; *(LAS u32x4*)(lds + AL_KT + kr * KT_PITCH + 128 + kc * 16) = R.k[1];
    *(LAS u32x4*)(lds + AL_VT + vr * VT_PITCH + vc * 16) = R.v[0]; *(LAS u32x4*)(lds + AL_VT + vr * VT_PITCH + 64 + vc * 16) = R.v[1];
}
template <int MODE>
__device__ __forceinline__ void attn_tile(LAS unsigned char* lds, const bf16x8 (&qf)[2][4], f32x4 (&O)[2][8], float (&m)[2], float (&l)[2], const int (&tpos)[2], float slope2,
                                          int kp0, int kstride, const bool (&selbit)[2], int fr, int fq, int wv, int tile64, int lane) {
    f32x4 s[2][4];
#pragma unroll
    for (int ci = 0; ci < 2; ++ci)
#pragma unroll
        for (int k4 = 0; k4 < 4; ++k4) s[ci][k4] = (f32x4){0.f, 0.f, 0.f, 0.f};
#pragma unroll
    for (int k4 = 0; k4 < 4; ++k4)
#pragma unroll
        for (int kk = 0; kk < 4; ++kk) { const bf16x8 kf = *(const LAS bf16x8*)(lds + AL_KT + (k4 * 16 + fr) * KT_PITCH + kk * 64 + fq * 16);
            s[0][k4] = __builtin_amdgcn_mfma_f32_16x16x32_bf16(kf, qf[0][kk], s[0][k4], 0, 0, 0);
            s[1][k4] = __builtin_amdgcn_mfma_f32_16x16x32_bf16(kf, qf[1][kk], s[1][k4], 0, 0, 0); }
#pragma unroll
    for (int ci = 0; ci < 2; ++ci) {
        float mx = NEGB;
#pragma unroll
        for (int k4 = 0; k4 < 4; ++k4)
#pragma unroll
            for (int j = 0; j < 4; ++j) { const int kidx = k4 * 16 + fq * 4 + j; const int dist = tpos[ci] - (kp0 + kstride * kidx);
                bool ok = dist >= 0; if (MODE == 3) ok = ok && dist < 512; if (MODE == 2) ok = ok && selbit[ci];
                const float sv = ok ? (s[ci][k4][j] * QSCALE2 - slope2 * (float)dist) : 2.0f * NEGB;
                s[ci][k4][j] = sv; mx = fmaxf(mx, sv); }
        if (MODE != 1) {
            mx = fmaxf(mx, shx(mx, lane, 16)); mx = fmaxf(mx, shx(mx, lane, 32));
            const float mn = fmaxf(m[ci], mx); const float alpha = exp2f(m[ci] - mn); m[ci] = mn;
            float ps = 0.f;
#pragma unroll
            for (int k4 = 0; k4 < 4; ++k4)
#pragma unroll
                for (int j = 0; j < 4; ++j) { const float p = exp2f(s[ci][k4][j] - mn); s[ci][k4][j] = p; ps += p; }
            l[ci] = l[ci] * alpha + ps;
            if (MODE != 0) {
#pragma unroll
                for (int dt = 0; dt < 8; ++dt) O[ci][dt] = O[ci][dt] * alpha; }
        } else {
#pragma unroll
            for (int k4 = 0; k4 < 4; ++k4) {
#pragma unroll
                for (int j = 0; j < 4; ++j) s[ci][k4][j] = exp2f(s[ci][k4][j] - m[ci]) * l[ci];
                float a = (s[ci][k4][0] + s[ci][k4][1]) + (s[ci][k4][2] + s[ci][k4][3]); float b3 = s[ci][k4][3];
                a += shx(a, lane, 1); a += shx(a, lane, 2); b3 += shx(b3, lane, 1); b3 += shx(b3, lane, 2);
                if ((fr & 3) == 0) { const int tl = wv * 8 + ci * 4 + (fr >> 2); const int ms = tile64 * 16 + k4 * 4 + fq;
                    ((LAS float*)(lds + AL_IMPA))[tl * 65 + ms] = a; ((LAS float*)(lds + AL_IMPB))[tl * 65 + ms + 1] = b3; } }
        }
    }
    if (MODE != 0) {
#pragma unroll
        for (int ks = 0; ks < 2; ++ks) {
            bf16x8 pf[2];
#pragma unroll
            for (int ci = 0; ci < 2; ++ci) { u32x4 w; w.x = pk2(s[ci][2 * ks][0], s[ci][2 * ks][1]); w.y = pk2(s[ci][2 * ks][2], s[ci][2 * ks][3]); w.z = pk2(s[ci][2 * ks + 1][0], s[ci][2 * ks + 1][1]); w.w = pk2(s[ci][2 * ks + 1][2], s[ci][2 * ks + 1][3]);
                pf[ci] = __builtin_bit_cast(bf16x8, w); }
#pragma unroll
            for (int dt = 0; dt < 8; ++dt) { const LAS unsigned char* vp = lds + AL_VT + (dt * 16 + fr) * VT_PITCH + (ks * 32 + fq * 4) * 2;
                const u32x2 lo = *(const LAS u32x2*)vp, hi = *(const LAS u32x2*)(vp + 32);
                const bf16x8 vf = __builtin_bit_cast(bf16x8, (u32x4){lo.x, lo.y, hi.x, hi.y});
                O[0][dt] = __builtin_amdgcn_mfma_f32_16x16x32_bf16(vf, pf[0], O[0][dt], 0, 0, 0);
                O[1][dt] = __builtin_amdgcn_mfma_f32_16x16x32_bf16(vf, pf[1], O[1][dt], 0, 0, 0); }
        }
    }
}

__device__ __forceinline__ void nsa_item(LAS unsigned char* lds, int b, int g, int tq, const bf16_t* Q, const bf16_t* KS, const bf16_t* VST, const bf16_t* KW, const bf16_t* VWT,
                                         const bf16_t* KCMP, const bf16_t* VCMPT, const float* GL, bf16_t* YB) {
    const int tid = opaque_tid(), wv = __builtin_amdgcn_readfirstlane(tid >> 6), lane = tid & 63, fr = lane & 15, fq = lane >> 4;
    const int t0 = tq * 64, bg = b * 4 + g, head = g * 4 + (fr & 3);
    LAS float* IMPA = (LAS float*)(lds + AL_IMPA);
    LAS unsigned long long* SEL = (LAS unsigned long long*)(lds + AL_SEL);
    LAS unsigned long long* UNI = (LAS unsigned long long*)(lds + AL_UNI);
    __syncthreads();
    for (int i = tid; i < 2 * 64 * 65; i += 512) IMPA[i] = 0.f;
    int tpos[2]; bf16x8 qf[2][4];
#pragma unroll
    for (int ci = 0; ci < 2; ++ci) { tpos[ci] = t0 + wv * 8 + ci * 4 + (fr >> 2);
        const bf16_t* qp = Q + ((size_t)(b * SEQ + tpos[ci])) * DM + head * 128 + fq * 8;
#pragma unroll
        for (int kk = 0; kk < 4; ++kk) qf[ci][kk] = *(const bf16x8*)(qp + kk * 32);
    }
    const float slope2 = exp2f(-0.5f * (float)(head + 1)) * LOG2E;
    f32x4 O[2][8]; float m[2], l[2]; bool selbit[2] = {true, true};
#pragma unroll
    for (int ci = 0; ci < 2; ++ci)
#pragma unroll
        for (int dt = 0; dt < 8; ++dt) { O[ci][dt] = (f32x4){0.f, 0.f, 0.f, 0.f}; }
    StageRegs R;
    const int ncmp = ((t0 + 32) >> 4) + 1, nct = (ncmp + 63) >> 6;
    const bf16_t* kcb = KCMP + (size_t)bg * 256 * 128; const bf16_t* vcb = VCMPT + (size_t)bg * 128 * 256;
    m[0] = m[1] = NEGB; l[0] = l[1] = 0.f;
    stage_load(R, kcb, vcb, 256, tid);
    for (int ct = 0; ct < nct; ++ct) {
        __syncthreads(); stage_store(R, lds, tid); __syncthreads();
        if (ct + 1 < nct) stage_load(R, kcb + (size_t)(ct + 1) * 64 * 128, vcb + (ct + 1) * 64, 256, tid);
        attn_tile<0>(lds, qf, O, m, l, tpos, slope2, 16 * (ct * 64) + 31, 16, selbit, fr, fq, wv, ct, lane);
    }
#pragma unroll
    for (int ci = 0; ci < 2; ++ci) { float lt = l[ci]; lt += shx(lt, lane, 16); lt += shx(lt, lane, 32); l[ci] = lt > 0.f ? 1.0f / lt : 0.f; }
    stage_load(R, kcb, vcb, 256, tid);
    for (int ct = 0; ct < nct; ++ct) {
        __syncthreads(); stage_store(R, lds, tid); __syncthreads();
        if (ct + 1 < nct) stage_load(R, kcb + (size_t)(ct + 1) * 64 * 128, vcb + (ct + 1) * 64, 256, tid);
        attn_tile<1>(lds, qf, O, m, l, tpos, slope2, 16 * (ct * 64) + 31, 16, selbit, fr, fq, wv, ct, lane);
    }
#pragma unroll
    for (int ci = 0; ci < 2; ++ci) { const float gc = GL[((size_t)(b * SEQ + tpos[ci])) * 48 + head];
        bf16_t* op = YB + ((size_t)(b * SEQ + tpos[ci])) * DM + head * 128 + fq * 4;
#pragma unroll
        for (int dt = 0; dt < 8; ++dt) { const f32x4 o = O[ci][dt] * gc; u32x2 w; w.x = pk2(o[0], o[1]); w.y = pk2(o[2], o[3]); *(u32x2*)(op + dt * 16) = w; O[ci][dt] = (f32x4){0.f, 0.f, 0.f, 0.f}; } }
    __syncthreads();
    {
        const int cur = tq; unsigned long long wun = 0ull;
#pragma unroll 1
        for (int tk = 0; tk < 8; ++tk) { const int tl = wv * 8 + tk;
            float v = IMPA[tl * 65 + lane] + IMPA[64 * 65 + tl * 65 + lane];
            if (lane == 0 || lane == cur || lane == cur - 1) v += 1e6f;
            if (lane > cur) v = NEGB;
            int rank = 0; const int vi = __builtin_bit_cast(int, v);
#pragma unroll
            for (int mm = 0; mm < 64; ++mm) { const float vm = __builtin_bit_cast(float, __builtin_amdgcn_readlane(vi, mm)); rank += ((vm > v) || (vm == v && mm < lane)) ? 1 : 0; }
            const unsigned long long mk = __ballot(rank < 16 && lane <= cur);
            wun |= mk;
            if (lane == 0) SEL[tl] = mk; }
        if (lane == 0) UNI[wv] = wun;
    }
    __syncthreads();
    unsigned long long selm[2], wun, bun = 0ull;
#pragma unroll
    for (int ci = 0; ci < 2; ++ci) selm[ci] = SEL[wv * 8 + ci * 4 + (fr >> 2)];
    wun = UNI[wv];
#pragma unroll
    for (int i = 0; i < 8; ++i) bun |= UNI[i];
    { const unsigned lo = __builtin_amdgcn_readfirstlane((unsigned)bun), hi = __builtin_amdgcn_readfirstlane((unsigned)(bun >> 32)); bun = ((unsigned long long)hi << 32) | lo;
      const unsigned lo2 = __builtin_amdgcn_readfirstlane((unsigned)wun), hi2 = __builtin_amdgcn_readfirstlane((unsigned)(wun >> 32)); wun = ((unsigned long long)hi2 << 32) | lo2; }
    const bf16_t* ksb = KS + (size_t)bg * SEQ * 128; const bf16_t* vsb = VST + (size_t)bg * 128 * SEQ;
    m[0] = m[1] = NEGB; l[0] = l[1] = 0.f;
    {
        unsigned long long rem = bun; int j = __builtin_ctzll(rem); rem &= rem - 1;
        stage_load(R, ksb + (size_t)j * 64 * 128, vsb + j * 64, SEQ, tid);
        for (;;) {
            __syncthreads(); stage_store(R, lds, tid); __syncthreads();
            const int jn = rem ? __builtin_ctzll(rem) : -1; if (jn >= 0) { rem &= rem - 1; stage_load(R, ksb + (size_t)jn * 64 * 128, vsb + jn * 64, SEQ, tid); }
            if ((wun >> j) & 1ull) { selbit[0] = (selm[0] >> j) & 1ull; selbit[1] = (selm[1] >> j) & 1ull;
                attn_tile<2>(lds, qf, O, m, l, tpos, slope2, j * 64, 1, selbit, fr, fq, wv, 0, lane); }
            if (jn < 0) break; j = jn;
        }
    }
#pragma unroll
    for (int ci = 0; ci < 2; ++ci) { float lt = l[ci]; lt += shx(lt, lane, 16); lt += shx(lt, lane, 32); const float gs = GL[((size_t)(b * SEQ + tpos[ci])) * 48 + 16 + head]; const float sc = lt > 0.f ? gs / lt : 0.f;
        bf16_t* op = YB + ((size_t)(b * SEQ + tpos[ci])) * DM + head * 128 + fq * 4;
#pragma unroll
        for (int dt = 0; dt < 8; ++dt) { const f32x4 o = O[ci][dt] * sc; const u32x2 pv = *(const u32x2*)(op + dt * 16); u32x2 w; w.x = pk2(bflo(pv.x) + o[0], bfhi(pv.x) + o[1]); w.y = pk2(bflo(pv.y) + o[2], bfhi(pv.y) + o[3]); *(u32x2*)(op + dt * 16) = w; O[ci][dt] = (f32x4){0.f, 0.f, 0.f, 0.f}; } }
    const bf16_t* kwb = KW + (size_t)bg * SEQ * 128; const bf16_t* vwb = VWT + (size_t)bg * 128 * SEQ;
    m[0] = m[1] = NEGB; l[0] = l[1] = 0.f; selbit[0] = selbit[1] = true;
    {
        const int j0 = tq >= 8 ? tq - 8 : 0;
        stage_load(R, kwb + (size_t)j0 * 64 * 128, vwb + j0 * 64, SEQ, tid);
        for (int j = j0; j <= tq; ++j) {
            __syncthreads(); stage_store(R, lds, tid); __syncthreads();
            if (j < tq) stage_load(R, kwb + (size_t)(j + 1) * 64 * 128, vwb + (j + 1) * 64, SEQ, tid);
            attn_tile<3>(lds, qf, O, m, l, tpos, slope2, j * 64, 1, selbit, fr, fq, wv, 0, lane);
        }
    }
#pragma unroll
    for (int ci = 0; ci < 2; ++ci) { float lt = l[ci]; lt += shx(lt, lane, 16); lt += shx(lt, lane, 32); const float gwv = GL[((size_t)(b * SEQ + tpos[ci])) * 48 + 32 + head]; const float sc = lt > 0.f ? gwv / lt : 0.f;
        bf16_t* op = YB + ((size_t)(b * SEQ + tpos[ci])) * DM + head * 128 + fq * 4;
#pragma unroll
        for (int dt = 0; dt < 8; ++dt) { const f32x4 o = O[ci][dt] * sc; const u32x2 pv = *(const u32x2*)(op + dt * 16); u32x2 w; w.x = pk2(bflo(pv.x) + o[0], bfhi(pv.x) + o[1]); w.y = pk2(bflo(pv.y) + o[2], bfhi(pv.y) + o[3]); *(u32x2*)(op + dt * 16) = w; } }
}

__global__ void __launch_bounds__(512) fwd_kernel(Args a) {
    extern __shared__ __attribute__((aligned(16))) unsigned char lds_raw[];
    LAS unsigned char* lds = (LAS unsigned char*)lds_raw;
    const int G = gridDim.x, bx = blockIdx.x;
    const int NGW = G * 8, NGT = G * 512;
#define GW() (opq(bx) * 8 + __builtin_amdgcn_readfirstlane(opaque_tid() >> 6))
    unsigned char* ws = a.ws;
    int ph = 0;
#ifndef ONLY
#define ONLY -1
#endif
#define EN(id) (ONLY < 0 || ONLY == (id))
#define ON() (ph >= a.lo && ph < a.hi)
#define SEAM() do { ++ph; if (a.one) cg::this_grid().sync(); } while (0)

    bf16_t* XN = (bf16_t*)(ws + WS_XN); bf16_t* YB = (bf16_t*)(ws + WS_YB); unsigned char* Z = ws + WS_Z;
    float* posb = (float*)(ws + WS_POSB);

    if (EN(0) && ON()) {
        const int tid = opaque_tid(), lane = tid & 63, wave = __builtin_amdgcn_readfirstlane(tid >> 6), gw = bx * 8 + wave, gt = bx * 512 + tid;
        LAS float* scr = (LAS float*)(lds + wave * 8448);
        int rot = 0;
        for (int i = 0; i < 4; ++i) {
            conv_mat(a.in[23] + (size_t)i * DM * DFF, DM, DFF, DFF, (bf16_t*)(ws + WS_WUP + i * SZ_UP), DM, scr, gw, NGW, lane, rot);
            conv_mat(a.in[24] + (size_t)i * DFF * DM, DFF, DM, DM, (bf16_t*)(ws + WS_WDN + i * SZ_UP), DFF, scr, gw, NGW, lane, rot);
            conv_mat(a.in[26] + (size_t)i * DM * DM, DM, DM, DM, (bf16_t*)(ws + WS_WG + i * SZ_SQ), DM, scr, gw, NGW, lane, rot);
            conv_mat(a.in[27] + (size_t)i * PLE * DM, PLE, DM, DM, (bf16_t*)(ws + WS_WP + i * SZ_WP), PLE, scr, gw, NGW, lane, rot);
        }
        for (int j = 0; j < 2; ++j) {
            conv_mat(a.in[3] + (size_t)j * DM * AB_IN, DM, 2048, AB_IN, (bf16_t*)(ws + WS_WIN + j * SZ_WIN), DM, scr, gw, NGW, lane, rot);
            conv_mat(a.in[13] + (size_t)j * DM * DM, DM, DM, DM, (bf16_t*)(ws + WS_WOUT + j * SZ_SQ), DM, scr, gw, NGW, lane, rot);
            conv_mat(a.in[14] + (size_t)j * DM * C_IN, DM, C_IN, C_IN, (bf16_t*)(ws + WS_CIN + j * SZ_CIN), DM, scr, gw, NGW, lane, rot);
            conv_mat(a.in[21] + (size_t)j * DM * DM, DM, DM, DM, (bf16_t*)(ws + WS_COUT + j * SZ_SQ), DM, scr, gw, NGW, lane, rot);
            conv_mat(a.in[16] + (size_t)j * 4096 * 512, 4096, 512, 512, (bf16_t*)(ws + WS_W1K + j * SZ_W1), 4096, scr, gw, NGW, lane, rot);
            conv_mat(a.in[19] + (size_t)j * 4096 * 512, 4096, 512, 512, (bf16_t*)(ws + WS_W1V + j * SZ_W1), 4096, scr, gw, NGW, lane, rot);
            conv_mat(a.in[17] + (size_t)j * 512 * 128, 512, 128, 128, (bf16_t*)(ws + WS_W2K + j * SZ_W2), 512, scr, gw, NGW, lane, rot);
            conv_mat(a.in[20] + (size_t)j * 512 * 128, 512, 128, 128, (bf16_t*)(ws + WS_W2V + j * SZ_W2), 512, scr, gw, NGW, lane, rot);
            for (int h = 0; h < 16; ++h) {
                conv_mat(a.in[6] + ((size_t)j * 16 + h) * 4096, 64, 64, 64, (bf16_t*)(ws + WS_WR + j * SZ_WRI) + h * 4096, 64, scr, gw, NGW, lane, rot);
                conv_mat(a.in[8] + ((size_t)j * 16 + h) * 4096, 64, 64, 64, (bf16_t*)(ws + WS_WI + j * SZ_WRI) + h * 4096, 64, scr, gw, NGW, lane, rot);
            }
            for (int gI = 0; gI < 4; ++gI)
                conv_mat(a.in[11] + ((size_t)j * 4 + gI) * 65536, 256, 256, 256, (bf16_t*)(ws + WS_POOLT + j * SZ_POOLT) + gI * 65536, 256, scr, gw, NGW, lane, rot);
            conv_plain(a.in[3] + (size_t)j * DM * AB_IN + 2048, DM, 1024, AB_IN, (bf16_t*)(ws + WS_WU + j * SZ_WU), 1024, gt, NGT);
            zero_fill16(ws + WS_CIN + j * SZ_CIN + (size_t)C_IN * DM * 2, (size_t)(C_INP - C_IN) * DM * 2, gt, NGT);
            zero_fill16(ws + WS_W2K + j * SZ_W2 + (size_t)128 * 512 * 2, (size_t)128 * 512 * 2, gt, NGT);
            zero_fill16(ws + WS_W2V + j * SZ_W2 + (size_t)128 * 512 * 2, (size_t)128 * 512 * 2, gt, NGT);
        }
        conv_plain(a.in[1], 4 * T_TOK, PLE, PLE, (bf16_t*)(ws + WS_PB), PLE, gt, NGT);
        __syncthreads();
        for (int it = gw; it < 4 * 8; it += NGW) { const int q = it >> 3, fc = it & 7, j = q >> 1;
            const float* pos = a.in[(q & 1) ? 18 : 15] + (size_t)j * 4096; const float* w1 = a.in[(q & 1) ? 19 : 16] + (size_t)j * 4096 * 512 + fc * 64 + lane;
            float acc0 = 0.f, acc1 = 0.f, acc2 = 0.f, acc3 = 0.f;
            for (int k = 0; k < 4096; k += 4) { acc0 += pos[k] * w1[(size_t)k * 512]; acc1 += pos[k + 1] * w1[(size_t)(k + 1) * 512]; acc2 += pos[k + 2] * w1[(size_t)(k + 2) * 512]; acc3 += pos[k + 3] * w1[(size_t)(k + 3) * 512]; }
            posb[q * 512 + fc * 64 + lane] = (acc0 + acc1) + (acc2 + acc3); }
    }
    SEAM();
    if (EN(1) && ON()) {
        if (bx < 64) { const int j = bx >> 5, gI = (bx >> 3) & 3, pn = bx & 7;
            pg8::Gemm gm{(const bf16_t*)(ws + WS_POOLT + j * SZ_POOLT) + gI * 65536, (const bf16_t*)(ws + WS_WU + j * SZ_WU) + gI * 256, 256, 2048, 256, 256, 1024};
            pg8::StaticOrder S; S.init(256, 2048, G, pn);
            EpiBf16<0> E{(bf16_t*)(ws + WS_WIN + j * SZ_WIN) + (size_t)(2048 + gI * 256) * DM, DM, nullptr};
            pg8::gemm_phase(lds, gm, S, E); }
    }
#pragma unroll 1
    for (int layer = 0; layer < 4; ++layer) {
        const int j = layer >> 1; const bool even = (layer & 1) == 0;
        unsigned char* wsl = opqp(ws); unsigned char* Zl = wsl + WS_Z; bf16_t* XNl = (bf16_t*)(wsl + WS_XN); bf16_t* YBl = (bf16_t*)(wsl + WS_YB); float* posbl = (float*)(wsl + WS_POSB);
        const float* hin = (layer == 0) ? a.in[0] : a.out;
        if (EN(2) && ON()) rmsnorm_rows<false>(hin, a.in[2] + layer * DM, XNl, nullptr, bx, NGW);
        SEAM();
        if (EN(3) && ON()) {
            if (even) { pg8::Gemm gm{XNl, (const bf16_t*)(wsl + WS_WIN + j * SZ_WIN), T_TOK, AB_IN, DM, DM, DM};
                pg8::StaticOrder S; S.init(T_TOK, AB_IN, opq(G), opq(bx)); EpiBf16<0> E{(bf16_t*)Zl, AB_IN, nullptr}; pg8::gemm_phase(lds, gm, S, E); }
            else { pg8::Gemm gm{XNl, (const bf16_t*)(wsl + WS_CIN + j * SZ_CIN), T_TOK, C_INP, DM, DM, DM};
                pg8::StaticOrder S; S.init(T_TOK, C_INP, opq(G), opq(bx));
                EpiNsa E{(bf16_t*)(Zl + Z_Q), (bf16_t*)(Zl + Z_KC), (bf16_t*)(Zl + Z_VC), (bf16_t*)(Zl + Z_KS), (bf16_t*)(Zl + Z_VST), (bf16_t*)(Zl + Z_KW), (bf16_t*)(Zl + Z_VWT), (float*)(Zl + Z_GL)};
                pg8::gemm_phase(lds, gm, S, E); }
        }
        SEAM();
        if (even) {
            if (EN(4) && ON()) {
#ifndef NO_LRU
                for (int it = opq(bx); it < 256; it += G)
                    lru_item(lds, it, (const bf16_t*)Zl, a.in[4] + (size_t)j * 4096, a.in[5] + j * 1024, (const bf16_t*)(wsl + WS_WR + j * SZ_WRI), (const bf16_t*)(wsl + WS_WI + j * SZ_WRI),
                             a.in[7] + j * 1024, a.in[9] + j * 1024, a.in[10] + j * 1024, YBl);
#endif
                for (int it = opq(bx); it < 256; it += G) pool_item(it, (const bf16_t*)Zl, a.in[12] + j * 1024, YBl);
            }
            SEAM();
        } else {
            if (EN(5) && ON()) {
                if (bx < 64) { const int kv = bx >> 5;
                    pg8::Gemm gm{(const bf16_t*)(Zl + (kv ? Z_VC : Z_KC)), (const bf16_t*)(wsl + (kv ? WS_W1V : WS_W1K) + j * SZ_W1), 4096, 512, 4096, 2048, 4096};
                    pg8::StaticOrder S; S.init(4096, 512, opq(G), opq(bx) & 31);
                    EpiBf16<2> E{(bf16_t*)(Zl + (kv ? Z_HIDV : Z_HIDK)), 512, posbl + (j * 2 + kv) * 512}; pg8::gemm_phase(lds, gm, S, E); }
            }
            SEAM();
            if (EN(6) && ON()) {
                if (bx < 16) { pg8::Gemm gm{(const bf16_t*)(Zl + Z_HIDK), (const bf16_t*)(wsl + WS_W2K + j * SZ_W2), 4096, 256, 512, 512, 512};
                    pg8::StaticOrder S; S.init(4096, 256, opq(G), opq(bx)); EpiCmp2<0> E{(bf16_t*)(Zl + Z_KCMP)}; pg8::gemm_phase(lds, gm, S, E); }
                else if (bx < 32) { pg8::Gemm gm{(const bf16_t*)(Zl + Z_HIDV), (const bf16_t*)(wsl + WS_W2V + j * SZ_W2), 4096, 256, 512, 512, 512};
                    pg8::StaticOrder S; S.init(4096, 256, opq(G), opq(bx) - 16); EpiCmp2<1> E{(bf16_t*)(Zl + Z_VCMPT)}; pg8::gemm_phase(lds, gm, S, E); }
            }
            SEAM();
            if (EN(7) && ON()) {
                for (int it = opq(bx), r = 0; it < 1024; it += G, ++r) { const int c = it % 256, rr = it / 256; const int cp = (rr & 1) ? 255 - c : c;
                    const int tq = 63 - (rr * 16 + (cp >> 4)), bgi = cp & 15;
#ifndef NO_ATTN
                    nsa_item(lds, bgi >> 2, bgi & 3, tq, (const bf16_t*)(Zl + Z_Q), (const bf16_t*)(Zl + Z_KS), (const bf16_t*)(Zl + Z_VST), (const bf16_t*)(Zl + Z_KW), (const bf16_t*)(Zl + Z_VWT),
                             (const bf16_t*)(Zl + Z_KCMP), (const bf16_t*)(Zl + Z_VCMPT), (const float*)(Zl + Z_GL), YBl);
#endif
                }
                __syncthreads();
            }
            SEAM();
        }
        if (EN(8) && ON()) { pg8::Gemm gm{YBl, (const bf16_t*)(wsl + (even ? WS_WOUT : WS_COUT) + j * SZ_SQ), T_TOK, DM, DM, DM, DM};
            pg8::StaticOrder S; S.init(T_TOK, DM, opq(G), opq(bx)); EpiF32<0> E{hin, a.out, nullptr, DM}; pg8::gemm_phase(lds, gm, S, E); }
        SEAM();
        if (EN(9) && ON()) rmsnorm_rows<false>(a.out, a.in[22] + layer * DM, XNl, nullptr, bx, NGW);
        SEAM();
        if (EN(10) && ON()) { pg8::Gemm gm{XNl, (const bf16_t*)(wsl + WS_WUP + layer * SZ_UP), T_TOK, DFF, DM, DM, DM};
            pg8::StaticOrder S; S.init(T_TOK, DFF, opq(G), opq(bx)); EpiBf16<1> E{(bf16_t*)Zl, DFF, nullptr}; pg8::gemm_phase(lds, gm, S, E); }
        SEAM();
        if (EN(11) && ON()) { pg8::Gemm gm{(const bf16_t*)Zl, (const bf16_t*)(wsl + WS_WDN + layer * SZ_UP), T_TOK, DM, DFF, DFF, DFF};
            pg8::StaticOrder S; S.init(T_TOK, DM, opq(G), opq(bx)); EpiF32<0> E{a.out, a.out, nullptr, DM}; pg8::gemm_phase(lds, gm, S, E); }
        SEAM();
        if (EN(12) && ON()) {
            { pg8::Gemm gm{(const bf16_t*)(wsl + WS_PB) + (size_t)layer * T_TOK * PLE, (const bf16_t*)(wsl + WS_WP + layer * SZ_WP), T_TOK, DM, PLE, PLE, PLE};
              pg8::StaticOrder S; S.init(T_TOK, DM, opq(G), opq(bx)); EpiF32<2> E{nullptr, (float*)Zl, nullptr, DM}; pg8::gemm_phase(lds, gm, S, E); }
            asm volatile("" ::: "memory");
            rmsnorm_rows<false>(a.out, a.in[25] + layer * DM, XNl, nullptr, bx, NGW);
        }
        SEAM();
        if (EN(13) && ON()) { pg8::Gemm gm{XNl, (const bf16_t*)(wsl + WS_WG + layer * SZ_SQ), T_TOK, DM, DM, DM, DM};
            pg8::StaticOrder S; S.init(T_TOK, DM, opq(G), opq(bx)); EpiF32<1> E{a.out, a.out, (const float*)Zl, DM}; pg8::gemm_phase(lds, gm, S, E); }
        SEAM();
    }
    if (EN(14) && ON()) rmsnorm_rows<true>(a.out, a.in[28], nullptr, a.out, bx, NGW);
#undef ON
#undef SEAM
}
constexpr int N_PHASES = 1 + 2 * 9 + 2 * 11 + 1;

extern "C" void kernel_launch(void* const* d_in, const int* in_sizes, int n_in, void* d_out, int out_size, void* d_ws, size_t ws_size, hipStream_t stream) {
    static int grid = 0;
    if (grid == 0) {
        if (n_in != 29 || ws_size < WS_END) { fprintf(stderr, "kernel_launch: unexpected n_in %d / ws %zu (need %zu)\n", n_in, ws_size, (size_t)WS_END); grid = -1; return; }
        int dev = 0, cus = 0, per_cu = 0;
        hipGetDevice(&dev); hipDeviceGetAttribute(&cus, hipDeviceAttributeMultiprocessorCount, dev);
        if (hipFuncSetAttribute((const void*)fwd_kernel, hipFuncAttributeMaxDynamicSharedMemorySize, LDS_BYTES) != hipSuccess) { fprintf(stderr, "hipFuncSetAttribute failed\n"); grid = -1; return; }
        if (hipOccupancyMaxActiveBlocksPerMultiprocessor(&per_cu, (const void*)fwd_kernel, 512, LDS_BYTES) != hipSuccess || per_cu < 1) { fprintf(stderr, "occupancy query: %d\n", per_cu); per_cu = 1; }
        (void)hipGetLastError();
        grid = cus;
    }
    if (grid < 0) return;
    Args a{};
    for (int i = 0; i < 29; ++i) a.in[i] = (const float*)d_in[i];
    a.out = (float*)d_out; a.ws = (unsigned char*)d_ws;
#if MK_ONE_LAUNCH
    a.lo = 0; a.hi = 1 << 30; a.one = 1; a.pad = 0;
    void* args[] = {&a};
    hipError_t e = hipLaunchCooperativeKernel((const void*)fwd_kernel, dim3(grid), dim3(512), args, LDS_BYTES, stream);
    if (e != hipSuccess) fprintf(stderr, "cooperative launch failed: %s (grid %d)\n", hipGetErrorString(e), grid);
#else
    for (int p = 0; p < N_PHASES; ++p) { a.lo = p; a.hi = p + 1; a.one = 0; a.pad = 0;
        hipLaunchKernelGGL(fwd_kernel, dim3(grid), dim3(512), LDS_BYTES, stream, a); }
#endif
}
```

```cpp
#include <hip/hip_runtime.h>
#include <hip/hip_cooperative_groups.h>
#include <cstdio>
namespace cg = cooperative_groups;

#ifndef REP_ATTN
#define REP_ATTN 1
#endif
#ifndef REP_LRU
#define REP_LRU 1
#endif
#ifndef REP_P0
#define REP_P0 1
#endif
#ifndef REP_UP
#define REP_UP 1
#endif
#ifndef MK_ONE_LAUNCH
#define MK_ONE_LAUNCH 1
#endif

#define LAS __attribute__((address_space(3)))
typedef unsigned short bf16_t;
typedef short bf16x8 __attribute__((ext_vector_type(8)));
typedef float f32x4 __attribute__((ext_vector_type(4)));
typedef float f32x2 __attribute__((ext_vector_type(2)));
typedef unsigned u32x4 __attribute__((ext_vector_type(4)));
typedef unsigned u32x2 __attribute__((ext_vector_type(2)));

constexpr int T_TOK = 16384, DM = 2048, SEQ = 4096, NB = 4, DFF = 8192, PLE = 256;
constexpr int AB_IN = 3072, C_IN = 5168, C_INP = 5376;
constexpr float EPSV = 1e-6f;
constexpr float LOG2E = 1.4426950408889634f;

__device__ __forceinline__ unsigned f2bf(float f) { unsigned u = __builtin_bit_cast(unsigned, f); return (u + 0x7fffu + ((u >> 16) & 1u)) >> 16; }
__device__ __forceinline__ unsigned pk2(float lo, float hi) { unsigned r; asm volatile("v_cvt_pk_bf16_f32 %0, %1, %2" : "=v"(r) : "v"(lo), "v"(hi)); return r; }
__device__ __forceinline__ float bf2f(unsigned short b) { return __builtin_bit_cast(float, ((unsigned)b) << 16); }
__device__ __forceinline__ float bflo(unsigned w) { return __builtin_bit_cast(float, w << 16); }
__device__ __forceinline__ float bfhi(unsigned w) { return __builtin_bit_cast(float, w & 0xffff0000u); }
__device__ __forceinline__ float shx(float v, int lane, int o) { return __builtin_bit_cast(float, __builtin_amdgcn_ds_bpermute((lane ^ o) << 2, __builtin_bit_cast(int, v))); }
__device__ __forceinline__ float wave_sum(float v, int lane) {
#pragma unroll
    for (int o = 1; o < 64; o <<= 1) v += shx(v, lane, o);
    return v;
}
__device__ __forceinline__ float sigmoidf_(float x) { return 1.0f / (1.0f + __expf(-x)); }
__device__ __forceinline__ float gelu_tanh(float x) {
    const float u = 0.7978845608028654f * (x + 0.044715f * x * x * x);
    const float e = __expf(2.0f * u);
    const float th = 1.0f - 2.0f / (e + 1.0f);
    return 0.5f * x * (1.0f + th);
}

__device__ __forceinline__ unsigned char* opqp(unsigned char* p) { asm volatile("" : "+s"(p)); return p; }
__device__ __forceinline__ int opq(int v) { asm volatile("" : "+s"(v)); return v; }
__device__ __forceinline__ int opaque_tid() { int t = threadIdx.x; asm volatile("" : "+v"(t)); return t; }
namespace pg8 {
constexpr int BM = 256, BK = 64, HALF = 128, HTB = HALF * BK * 2, STAGE_BYTES = 8 * HTB, NXCD = 8, WGM = 8;
__host__ __device__ __forceinline__ int lds_byte(int r, int c) { const int st = (r >> 4) * 2 + (c >> 5), rr = r & 15, cc = c & 31, ob = rr * 64 + cc * 2; return st * 1024 + (ob ^ (((ob >> 9) & 1) << 5)); }
__host__ __device__ __forceinline__ void stage_rc(int b, int& R, int& C) { const int st = b / 1024, sb = b % 1024, swz = sb ^ (((sb >> 9) & 1) << 5); R = (st >> 1) * 16 + swz / 64; C = (st & 1) * 32 + (swz % 64) / 2; }
__host__ __device__ __forceinline__ int perm32(int rho) { const int n = rho >> 4, i = rho & 15; return 8 * (i >> 2) + 4 * n + (i & 3); }

struct Unit { int pm, pn; };
struct Gemm { const bf16_t* A; const bf16_t* Bt; int M, N, K, lda, ldb; };

struct StaticOrder {
    int nM, nN, nwg, G, c;
    __device__ void init(int M, int N, int G_, int c_) { nM = M / BM; nN = N / BM; nwg = nM * nN; G = G_; c = c_; }
    __device__ bool next(int i, Unit& u) const {
        const long L = (long)i * G + c; if (L >= nwg || c < 0) return false;
        int wgid = (int)L; { const int q = nwg / NXCD, r = nwg % NXCD, xcd = wgid % NXCD, off = wgid / NXCD; wgid = (xcd < r ? xcd * (q + 1) : r * (q + 1) + (xcd - r) * q) + off; }
        const int nig = WGM * nN, gid = wgid / nig, fm = gid * WGM, gsz = (nM - fm) < WGM ? (nM - fm) : WGM;
        u.pm = fm + ((wgid % nig) % gsz); u.pn = (wgid % nig) / gsz; return true;
    }
};

template <class Epi, class Sched>
__device__ __forceinline__ void gemm_phase(LAS unsigned char* lds, const Gemm g, const Sched& S, const Epi& E) {
    const int tid = opaque_tid(), wid = __builtin_amdgcn_readfirstlane(tid >> 6), lane = tid & 63, wr = wid >> 2, wc = wid & 3, fr = lane & 15, fq = lane >> 4;
    const int K = g.K, nt = K / BK;
    unsigned voffA[2], voffB[2];
#pragma unroll
    for (int i = 0; i < 2; ++i) { int R, C; stage_rc(tid * 16 + i * 8192, R, C); const int Rb = Epi::PERM ? ((R & ~31) + perm32(R & 31)) : R;
        voffA[i] = (unsigned)(R * g.lda + C) * 2u; voffB[i] = (unsigned)(Rb * g.ldb + C) * 2u; }
    const size_t kstep = (size_t)(BK * 2);
    const size_t hstepA = (size_t)HALF * g.lda * 2, hstepB = (size_t)HALF * g.ldb * 2;
    const size_t tstepA = 2 * hstepA, tstepB = 2 * hstepB;
    const unsigned ldsw = (unsigned)wid * 1024u;
    const int aoff = lds_byte(wr * 64 + fr, fq * 8), boff = lds_byte(wc * 32 + fr, fq * 8);
#define PG8_SA(b, h) (((b) * 2 + (h)) * HTB)
#define PG8_SB(b, h) ((4 + (b) * 2 + (h)) * HTB)
#define PG8_STAGE(bufoff, gbase, voff) do { _Pragma("unroll") for (int _i = 0; _i < 2; ++_i) \
        __builtin_amdgcn_global_load_lds((const unsigned*)((const char*)(gbase) + (voff)[_i]), (LAS unsigned*)(lds + (bufoff) + ldsw + _i * 8192), 16, 0, 0); } while (0)
#define PG8_LDA(dst, b, h) do { _Pragma("unroll") for (int m = 0; m < 4; ++m) _Pragma("unroll") for (int k = 0; k < 2; ++k) dst[m][k] = *(const LAS bf16x8*)(lds + PG8_SA(b, h) + aoff + m * 2048 + k * 1024); } while (0)
#define PG8_LDB(dst, b, h) do { _Pragma("unroll") for (int n = 0; n < 2; ++n) _Pragma("unroll") for (int k = 0; k < 2; ++k) dst[n][k] = *(const LAS bf16x8*)(lds + PG8_SB(b, h) + boff + n * 2048 + k * 1024); } while (0)
#define PG8_MMA(ai, bj, At, Bt) do { __builtin_amdgcn_s_setprio(1); _Pragma("unroll") for (int m = 0; m < 4; ++m) _Pragma("unroll") for (int n = 0; n < 2; ++n) _Pragma("unroll") for (int k = 0; k < 2; ++k) \
        acc[ai][bj][m][n] = __builtin_amdgcn_mfma_f32_16x16x32_bf16(Bt[n][k], At[m][k], acc[ai][bj][m][n], 0, 0, 0); __builtin_amdgcn_s_setprio(0); } while (0)
#define PG8_WAIT_V(n) asm volatile("s_waitcnt vmcnt(" #n ")" ::: "memory")
#define PG8_WAIT_L(n) asm volatile("s_waitcnt lgkmcnt(" #n ")" ::: "memory")
#define PG8_BAR __builtin_amdgcn_s_barrier()
#define PG8_SCHED __builtin_amdgcn_sched_barrier(0)
    Unit cur, nxt; int ui = 0;
    if (!S.next(0, cur)) return;
    f32x4 acc[2][2][4][2];
#pragma unroll
    for (int a = 0; a < 2; ++a)
#pragma unroll
        for (int b = 0; b < 2; ++b)
#pragma unroll
            for (int m = 0; m < 4; ++m)
#pragma unroll
                for (int n = 0; n < 2; ++n) acc[a][b][m][n] = (f32x4){0.f, 0.f, 0.f, 0.f};
    bf16x8 At[4][2], B0[2][2], B1[2][2];
    const char* cA = (const char*)g.A + (size_t)cur.pm * tstepA; const char* cB = (const char*)g.Bt + (size_t)cur.pn * tstepB;
    PG8_STAGE(PG8_SB(0, 0), cB, voffB); PG8_STAGE(PG8_SB(0, 1), cB + hstepB, voffB); PG8_STAGE(PG8_SA(0, 0), cA, voffA); PG8_STAGE(PG8_SA(0, 1), cA + hstepA, voffA);
    if (wr == 1) PG8_BAR;
    PG8_WAIT_V(2); PG8_BAR;
    PG8_STAGE(PG8_SB(1, 0), cB + kstep, voffB); PG8_STAGE(PG8_SA(1, 0), cA + kstep, voffA); PG8_STAGE(PG8_SB(1, 1), cB + hstepB + kstep, voffB);
    PG8_WAIT_V(6); PG8_BAR;
    for (;;) {
        const bool has_next = S.next(ui + 1, nxt);
        const char* nA = has_next ? (const char*)g.A + (size_t)nxt.pm * tstepA : cA; const char* nB = has_next ? (const char*)g.Bt + (size_t)nxt.pn * tstepB : cB;
        for (int t = 0; t < nt; t += 2) {
            const bool last = (t == nt - 2);
            const char* a1 = cA + (size_t)(t + 1) * kstep;
            const char* a2 = last ? nA : cA + (size_t)(t + 2) * kstep; const char* b2 = last ? nB : cB + (size_t)(t + 2) * kstep;
            const char* a3 = a2 + kstep; const char* b3 = b2 + kstep;
            PG8_LDB(B0, 0, 0); PG8_LDB(B1, 0, 1); PG8_SCHED; PG8_LDA(At, 0, 0); PG8_STAGE(PG8_SA(1, 1), a1 + hstepA, voffA);
            PG8_WAIT_V(8); PG8_WAIT_L(0); PG8_BAR; PG8_MMA(0, 0, At, B0); PG8_MMA(0, 1, At, B1); PG8_BAR; PG8_SCHED;
            PG8_LDA(At, 0, 1); PG8_STAGE(PG8_SB(0, 0), b2, voffB); PG8_STAGE(PG8_SB(0, 1), b2 + hstepB, voffB); PG8_STAGE(PG8_SA(0, 0), a2, voffA);
            PG8_WAIT_V(8); PG8_WAIT_L(0); PG8_BAR; PG8_MMA(1, 0, At, B0); PG8_MMA(1, 1, At, B1); PG8_BAR; PG8_SCHED;
            PG8_LDB(B0, 1, 0); PG8_LDB(B1, 1, 1); PG8_SCHED; PG8_LDA(At, 1, 0); PG8_STAGE(PG8_SA(0, 1), a2 + hstepA, voffA);
            PG8_WAIT_V(8); PG8_WAIT_L(0); PG8_BAR; PG8_MMA(0, 0, At, B0); PG8_MMA(0, 1, At, B1); PG8_BAR; PG8_SCHED;
            PG8_LDA(At, 1, 1); PG8_STAGE(PG8_SB(1, 0), b3, voffB); PG8_STAGE(PG8_SB(1, 1), b3 + hstepB, voffB); PG8_STAGE(PG8_SA(1, 0), a3, voffA);
            PG8_WAIT_V(8); PG8_WAIT_L(0); PG8_BAR; PG8_MMA(1, 0, At, B0); PG8_MMA(1, 1, At, B1); PG8_BAR; PG8_SCHED;
        }
        if (wr == 0) PG8_BAR;
        { const int tl = opaque_tid() & 63; E(acc, cur, wr, wc, tl & 15, tl >> 4); }
        if (!has_next) break;
#pragma unroll
        for (int a = 0; a < 2; ++a)
#pragma unroll
            for (int b = 0; b < 2; ++b)
#pragma unroll
                for (int m = 0; m < 4; ++m)
#pragma unroll
                    for (int n = 0; n < 2; ++n) acc[a][b][m][n] = (f32x4){0.f, 0.f, 0.f, 0.f};
        cur = nxt; cA = nA; cB = nB; ++ui;
        if (wr == 1) PG8_BAR;
    }
    PG8_WAIT_V(0);
    PG8_BAR;
#undef PG8_SA
#undef PG8_SB
#undef PG8_STAGE
#undef PG8_LDA
#undef PG8_LDB
#undef PG8_MMA
#undef PG8_WAIT_V
#undef PG8_WAIT_L
#undef PG8_BAR
#undef PG8_SCHED
}
}
using pg8::Unit; using pg8::HALF; using pg8::BM;


#define XB_TMO      128
#define XB_XCNT(j)  (256  + 64 * (j))
#define XB_XSUB(j)  (1280 + 64 * (j))
#define XB_XGEN(j)  (2304 + 64 * (j))
#define XB_TOP      3328
#define XB_TOPGEN   3392
#define XCD_BAR_WORDS 3456
#define XB_SPIN_CAP (1u << 18)
__device__ __forceinline__ unsigned xb_ld(unsigned* p)              { return __hip_atomic_load(p, __ATOMIC_RELAXED, __HIP_MEMORY_SCOPE_AGENT); }
__device__ __forceinline__ unsigned xb_add(unsigned* p, unsigned v) { return __hip_atomic_fetch_add(p, v, __ATOMIC_RELAXED, __HIP_MEMORY_SCOPE_AGENT); }
__device__ __forceinline__ unsigned xb_xcc_id() { return (unsigned)__builtin_amdgcn_s_getreg((3 << 11) | 20) & 0xFu; }
#define XB_SPIN(cond, bar) do { unsigned _sp = 0; while (cond) { __builtin_amdgcn_s_sleep(1); \
    if ((++_sp & 255u) == 0u) { if (xb_ld(&(bar)[XB_TMO])) break; if (_sp > XB_SPIN_CAP) { atomicAdd(&(bar)[XB_TMO], 1u); break; } } } } while (0)
struct XcdBarrier { unsigned* bar; unsigned x; volatile LAS unsigned* st; };
__device__ __forceinline__ XcdBarrier xcd_barrier_post(unsigned* bar, volatile LAS unsigned* st) {
    XcdBarrier b; b.bar = bar; b.x = xb_xcc_id(); b.st = st;
    if (threadIdx.x == 0) (void)xb_add(&bar[XB_XCNT(b.x)], 1u);
    return b;
}
__device__ __forceinline__ void xcd_barrier_complete(unsigned* bar, unsigned x, unsigned& nloc, unsigned& nx) {
    const unsigned G = gridDim.x * gridDim.y * gridDim.z;
    unsigned sum, cnt, mine, sp = 0u;
    for (;;) {
        sum = 0u; cnt = 0u; mine = 0u;
#pragma unroll
        for (unsigned j = 0; j < 16; ++j) { const unsigned c = xb_ld(&bar[XB_XCNT(j)]); sum += c; cnt += (c > 0u) ? 1u : 0u; mine = (j == x) ? c : mine; }
        if (sum == G) break;
        __builtin_amdgcn_s_sleep(1);
        if ((++sp & 255u) == 0u) { if (xb_ld(&bar[XB_TMO])) break; if (sp > XB_SPIN_CAP) { atomicAdd(&bar[XB_TMO], 1u); break; } }
    }
    nloc = mine > 0u ? mine : 1u; nx = cnt > 0u ? cnt : 1u;
}
__device__ __forceinline__ void xcd_barrier(const XcdBarrier& b) {
    asm volatile("s_waitcnt vmcnt(0)" ::: "memory");
    __syncthreads();
    if (threadIdx.x == 0) {
        unsigned* bar = b.bar;
        __builtin_amdgcn_s_waitcnt(0);
        unsigned nloc = b.st[0], nx = b.st[1];
        if (nloc == 0u) { xcd_barrier_complete(bar, b.x, nloc, nx); b.st[0] = nloc; b.st[1] = nx; }
        const unsigned old = xb_add(&bar[XB_XSUB(b.x)], 1u);
        const unsigned gen = old / nloc;
        if (old + 1u == (gen + 1u) * nloc) {
            __builtin_amdgcn_fence(__ATOMIC_RELEASE, "agent");
            asm volatile("s_waitcnt vmcnt(0)" ::: "memory");
            const unsigned og = xb_add(&bar[XB_TOP], 1u);
            const unsigned tg = og / nx;
            if (og + 1u == (tg + 1u) * nx) xb_add(&bar[XB_TOPGEN], 1u);
            else XB_SPIN(xb_ld(&bar[XB_TOPGEN]) == tg, bar);
            __builtin_amdgcn_fence(__ATOMIC_ACQUIRE, "agent");
            xb_add(&bar[XB_XGEN(b.x)], 1u);
            asm volatile("s_waitcnt vmcnt(0)" ::: "memory");
        } else {
            XB_SPIN(xb_ld(&bar[XB_XGEN(b.x)]) == gen, bar);
            __builtin_amdgcn_fence(__ATOMIC_ACQUIRE, "agent");
            asm volatile("s_waitcnt vmcnt(0)" ::: "memory");
        }
    }
    __syncthreads();
}

template <int ACT  > struct EpiBf16 {
    static constexpr bool PERM = true;
    bf16_t* O; int ldc; const float* bias;
    __device__ __forceinline__ void operator()(const f32x4 (&acc)[2][2][4][2], const Unit& u, int wr, int wc, int fr, int fq) const {
        const int row0 = u.pm * BM + wr * 64 + fr, col0 = u.pn * BM + wc * 32 + 8 * fq;
        f32x4 bv[2][2];
#pragma unroll
        for (int bj = 0; bj < 2; ++bj)
#pragma unroll
            for (int n = 0; n < 2; ++n) bv[bj][n] = (ACT == 2) ? *(const f32x4*)(bias + col0 + bj * HALF + 4 * n) : (f32x4){0.f, 0.f, 0.f, 0.f};
#pragma unroll
        for (int ai = 0; ai < 2; ++ai)
#pragma unroll
            for (int m = 0; m < 4; ++m) { bf16_t* rowp = O + (size_t)(row0 + ai * HALF + m * 16) * ldc + col0;
#pragma unroll
                for (int bj = 0; bj < 2; ++bj) { f32x4 v0 = acc[ai][bj][m][0] + bv[bj][0], v1 = acc[ai][bj][m][1] + bv[bj][1];
                    if (ACT == 1) {
#pragma unroll
                        for (int j = 0; j < 4; ++j) { const float a = fmaxf(v0[j], 0.f), b = fmaxf(v1[j], 0.f); v0[j] = a * a; v1[j] = b * b; } }
                    if (ACT == 2) {
#pragma unroll
                        for (int j = 0; j < 4; ++j) { v0[j] = gelu_tanh(v0[j]); v1[j] = gelu_tanh(v1[j]); } }
                    u32x4 w; w.x = pk2(v0[0], v0[1]); w.y = pk2(v0[2], v0[3]); w.z = pk2(v1[0], v1[1]); w.w = pk2(v1[2], v1[3]);
                    *(u32x4*)(rowp + bj * HALF) = w; } }
    }
};
template <int MODE> struct EpiF32 {
    static constexpr bool PERM = false;
    const float* base; float* out; const float* pp; int ldc;
    __device__ __forceinline__ void operator()(const f32x4 (&acc)[2][2][4][2], const Unit& u, int wr, int wc, int fr, int fq) const {
        const int row0 = u.pm * BM + wr * 64 + fr, col0 = u.pn * BM + wc * 32 + 4 * fq;
#pragma unroll
        for (int ai = 0; ai < 2; ++ai)
#pragma unroll
            for (int m = 0; m < 4; ++m) { const size_t off = (size_t)(row0 + ai * HALF + m * 16) * ldc + col0;
#pragma unroll
                for (int bj = 0; bj < 2; ++bj)
#pragma unroll
                    for (int n = 0; n < 2; ++n) { const size_t o2 = off + bj * HALF + n * 16; f32x4 a = acc[ai][bj][m][n];
                        if (MODE == 0) { a = a + *(const f32x4*)(base + o2); }
                        if (MODE == 1) { const f32x4 b = *(const f32x4*)(base + o2), p = *(const f32x4*)(pp + o2);
#pragma unroll
                            for (int j = 0; j < 4; ++j) a[j] = b[j] + sigmoidf_(a[j]) * p[j]; }
                        *(f32x4*)(out + o2) = a; }
                asm volatile("" ::: "memory"); }
    }
};
struct EpiNsa {
    static constexpr bool PERM = true;
    bf16_t *Q, *KC, *VC, *KS, *VST, *KW, *VWT; float* GL;
    __device__ __forceinline__ void operator()(const f32x4 (&acc)[2][2][4][2], const Unit& u, int wr, int wc, int fr, int fq) const {
        const int row0 = u.pm * BM + wr * 64 + fr; const int pn = u.pn;
#pragma unroll
        for (int ai = 0; ai < 2; ++ai)
#pragma unroll
            for (int m = 0; m < 4; ++m) { const int row = row0 + ai * HALF + m * 16; const int b = row >> 12, s = row & 4095;
#pragma unroll
                for (int bj = 0; bj < 2; ++bj) { const f32x4 v0 = acc[ai][bj][m][0], v1 = acc[ai][bj][m][1];
                    const int cl = bj * HALF + wc * 32 + 8 * fq;
                    if (pn < 8) { u32x4 w; w.x = pk2(v0[0], v0[1]); w.y = pk2(v0[2], v0[3]); w.z = pk2(v1[0], v1[1]); w.w = pk2(v1[2], v1[3]);
                        *(u32x4*)(Q + (size_t)row * 2048 + pn * 256 + cl) = w; }
                    else if (pn < 20) { const int k = (pn - 8) >> 1; const int c = ((pn - 8) & 1) * 256 + cl; const int g = c >> 7, d = c & 127;
                        if (k == 3 || k == 5) { bf16_t* dst = (k == 3 ? VST : VWT) + ((size_t)((b * 4 + g) * 128 + d)) * 4096 + s;
#pragma unroll
                            for (int j = 0; j < 4; ++j) { dst[(size_t)j * 4096] = (bf16_t)f2bf(v0[j]); dst[(size_t)(4 + j) * 4096] = (bf16_t)f2bf(v1[j]); } }
                        else { bf16_t* dst = (k == 0 ? KC : k == 1 ? VC : k == 2 ? KS : KW) + ((size_t)((b * 4 + g) * 4096 + s)) * 128 + d;
                            u32x4 w; w.x = pk2(v0[0], v0[1]); w.y = pk2(v0[2], v0[3]); w.z = pk2(v1[0], v1[1]); w.w = pk2(v1[2], v1[3]);
                            *(u32x4*)dst = w; } }
                    else { if (cl < 48) { float* dst = GL + (size_t)row * 48 + cl;
                            f32x4 a, c2;
#pragma unroll
                            for (int j = 0; j < 4; ++j) { a[j] = sigmoidf_(v0[j]); c2[j] = sigmoidf_(v1[j]); }
                            *(f32x4*)dst = a; *(f32x4*)(dst + 4) = c2; } } } }
    }
};
template <int TR> struct EpiCmp2 {
    static constexpr bool PERM = true;
    bf16_t* O;
    __device__ __forceinline__ void operator()(const f32x4 (&acc)[2][2][4][2], const Unit& u, int wr, int wc, int fr, int fq) const {
        const int row0 = u.pm * BM + wr * 64 + fr; const int cl = wc * 32 + 8 * fq;
#pragma unroll
        for (int ai = 0; ai < 2; ++ai)
#pragma unroll
            for (int m = 0; m < 4; ++m) { const int row = row0 + ai * HALF + m * 16; const f32x4 v0 = acc[ai][0][m][0], v1 = acc[ai][0][m][1];
                if (TR == 0) { u32x4 w; w.x = pk2(v0[0], v0[1]); w.y = pk2(v0[2], v0[3]); w.z = pk2(v1[0], v1[1]); w.w = pk2(v1[2], v1[3]);
                    *(u32x4*)(O + (size_t)row * 128 + cl) = w; }
                else { bf16_t* dst = O + ((size_t)((row >> 8) * 128 + cl)) * 256 + (row & 255);
#pragma unroll
                    for (int j = 0; j < 4; ++j) { dst[(size_t)j * 256] = (bf16_t)f2bf(v0[j]); dst[(size_t)(4 + j) * 256] = (bf16_t)f2bf(v1[j]); } } }
    }
};

constexpr size_t al256(size_t x) { return (x + 255) & ~(size_t)255; }
constexpr size_t SZ_WIN = (size_t)AB_IN * DM * 2, SZ_SQ = (size_t)DM * DM * 2, SZ_CIN = (size_t)C_INP * DM * 2, SZ_W1 = (size_t)512 * 4096 * 2, SZ_W2 = (size_t)256 * 512 * 2;
constexpr size_t SZ_UP = (size_t)DFF * DM * 2, SZ_WP = (size_t)DM * PLE * 2, SZ_WRI = (size_t)16 * 64 * 64 * 2, SZ_POOLT = (size_t)4 * 256 * 256 * 2, SZ_WU = (size_t)DM * 1024 * 2;
constexpr size_t WS_WIN = 0;
constexpr size_t WS_WOUT = WS_WIN + 2 * SZ_WIN;
constexpr size_t WS_CIN = WS_WOUT + 2 * SZ_SQ;
constexpr size_t WS_COUT = WS_CIN + 2 * SZ_CIN;
constexpr size_t WS_W1K = WS_COUT + 2 * SZ_SQ;
constexpr size_t WS_W1V = WS_W1K + 2 * SZ_W1;
constexpr size_t WS_W2K = WS_W1V + 2 * SZ_W1;
constexpr size_t WS_W2V = WS_W2K + 2 * SZ_W2;
constexpr size_t WS_WUP = WS_W2V + 2 * SZ_W2;
constexpr size_t WS_WDN = WS_WUP + 4 * SZ_UP;
constexpr size_t WS_WG = WS_WDN + 4 * SZ_UP;
constexpr size_t WS_WP = WS_WG + 4 * SZ_SQ;
constexpr size_t WS_WR = WS_WP + 4 * SZ_WP;
constexpr size_t WS_WI = WS_WR + 2 * SZ_WRI;
constexpr size_t WS_POOLT = WS_WI + 2 * SZ_WRI;
constexpr size_t WS_WU = WS_POOLT + 2 * SZ_POOLT;
constexpr size_t WS_PB = WS_WU + 2 * SZ_WU;
constexpr size_t WS_POSB = WS_PB + (size_t)4 * T_TOK * PLE * 2;
constexpr size_t WS_XN = WS_POSB + 8192;
constexpr size_t WS_YB = WS_XN + (size_t)T_TOK * DM * 2;
constexpr size_t WS_Z = WS_YB + (size_t)T_TOK * DM * 2;
constexpr size_t SZ_KV = (size_t)16 * 4096 * 128 * 2;
constexpr size_t Z_Q = 0, Z_KC = (size_t)T_TOK * DM * 2, Z_VC = Z_KC + SZ_KV, Z_KS = Z_VC + SZ_KV, Z_VST = Z_KS + SZ_KV, Z_KW = Z_VST + SZ_KV, Z_VWT = Z_KW + SZ_KV;
constexpr size_t Z_GL = Z_VWT + SZ_KV, Z_HIDK = Z_GL + (size_t)T_TOK * 48 * 4, Z_HIDV = Z_HIDK + (size_t)4096 * 512 * 2, Z_KCMP = Z_HIDV + (size_t)4096 * 512 * 2, Z_VCMPT = Z_KCMP + (size_t)4096 * 128 * 2;
constexpr size_t WS_BAR = WS_Z + (size_t)T_TOK * DFF * 2;
constexpr size_t WS_END = WS_BAR + XCD_BAR_WORDS * 4 + 256;
static_assert(Z_VCMPT + 4096 * 128 * 2 <= (size_t)T_TOK * DFF * 2, "z region");
static_assert(WS_END <= (size_t)1 << 30, "workspace");
constexpr int LDS_BYTES = pg8::STAGE_BYTES + 64;

struct Args { const float* in[29]; float* out; unsigned char* ws; int lo, hi, one, pad; };

__device__ __forceinline__ void titem_load(float (&v)[32], const float* W, int N, int ldw, int item, int lane) {
    const int nblk = (N + 31) / 32, kb = item / nblk, nb = item % nblk, k0 = 64 * kb, n0 = 32 * nb;
    const int nn = n0 + (lane & 31); const bool ok = nn < N;
    const float* p = W + (size_t)(k0 + (lane >> 5)) * ldw + nn;
#pragma unroll
    for (int i = 0; i < 32; ++i) v[i] = ok ? p[(size_t)(2 * i) * ldw] : 0.f;
}
__device__ __forceinline__ void titem_store(const float (&v)[32], int N, bf16_t* WT, int ldt, LAS float* scr, int item, int lane) {
    const int nblk = (N + 31) / 32, kb = item / nblk, nb = item % nblk, k0 = 64 * kb, n0 = 32 * nb;
#pragma unroll
    for (int i = 0; i < 32; ++i) scr[(2 * i + (lane >> 5)) * 33 + (lane & 31)] = v[i];
    asm volatile("s_waitcnt lgkmcnt(0)" ::: "memory");
    const int c = lane & 7;
#pragma unroll
    for (int j = 0; j < 4; ++j) { const int n = (lane >> 3) + 8 * j; const LAS float* s = scr + (8 * c) * 33 + n;
        u32x4 o; o.x = pk2(s[0 * 33], s[1 * 33]); o.y = pk2(s[2 * 33], s[3 * 33]); o.z = pk2(s[4 * 33], s[5 * 33]); o.w = pk2(s[6 * 33], s[7 * 33]);
        if (n0 + n < N) *(u32x4*)(WT + (size_t)(n0 + n) * ldt + k0 + 8 * c) = o; }
    asm volatile("s_waitcnt lgkmcnt(0)" ::: "memory");
}
__device__ __forceinline__ void conv_mat(const float* W, int K, int N, int ldw, bf16_t* WT, int ldt, LAS float* scr, int gw, int NGW, int lane, int& rot) {
    const int nitems = (K / 64) * ((N + 31) / 32);
    int it = gw - rot; if (it < 0) it += NGW;
    rot = (rot + nitems) % NGW;
    if (it >= nitems) return;
    float va[32], vb[32];
    titem_load(va, W, N, ldw, it, lane);
    for (;;) {
        const int n1 = it + NGW; if (n1 < nitems) titem_load(vb, W, N, ldw, n1, lane);
        titem_store(va, N, WT, ldt, scr, it, lane);
        if (n1 >= nitems) break;
        const int n2 = n1 + NGW; if (n2 < nitems) titem_load(va, W, N, ldw, n2, lane);
        titem_store(vb, N, WT, ldt, scr, n1, lane);
        if (n2 >= nitems) break;
        it = n2;
    }
}
__device__ __forceinline__ void conv_plain(const float* src, int rows, int ncols, int lds_, bf16_t* dst, int ldd, int gt, int NGT) {
    const int cpr = ncols / 8; const long total = (long)rows * cpr;
    for (long i = gt; i < total; i += NGT) { const int r = (int)(i / cpr), c = (int)(i % cpr) * 8;
        const f32x4 a = *(const f32x4*)(src + (size_t)r * lds_ + c), b = *(const f32x4*)(src + (size_t)r * lds_ + c + 4);
        u32x4 o; o.x = f2bf(a[0]) | (f2bf(a[1]) << 16); o.y = f2bf(a[2]) | (f2bf(a[3]) << 16); o.z = f2bf(b[0]) | (f2bf(b[1]) << 16); o.w = f2bf(b[2]) | (f2bf(b[3]) << 16);
        *(u32x4*)(dst + (size_t)r * ldd + c) = o; }
}
__device__ __forceinline__ void zero_fill16(unsigned char* p, size_t bytes, int gt, int NGT) {
    const u32x4 z = (u32x4){0u, 0u, 0u, 0u};
    for (size_t i = (size_t)gt * 16; i < bytes; i += (size_t)NGT * 16) *(u32x4*)(p + i) = z;
}

template <bool F32OUT>
__device__ __forceinline__ void rmsnorm_rows(const float* X, const float* g, bf16_t* O, float* OF, int bx, int NGW) {
    asm volatile("" ::: "memory"); const int tid = opaque_tid(), lane = tid & 63; const int gw = opq(bx) * 8 + __builtin_amdgcn_readfirstlane(tid >> 6);
    f32x4 gv[8];
#pragma unroll
    for (int j = 0; j < 8; ++j) gv[j] = *(const f32x4*)(g + (lane + 64 * j) * 4);
    for (int r = gw; r < T_TOK; r += NGW) {
        const float* xr = X + (size_t)r * DM; f32x4 v[8]; float s = 0.f;
#pragma unroll
        for (int j = 0; j < 8; ++j) { v[j] = *(const f32x4*)(xr + (lane + 64 * j) * 4); s += (v[j][0] * v[j][0] + v[j][1] * v[j][1]) + (v[j][2] * v[j][2] + v[j][3] * v[j][3]); }
        const float rstd = rsqrtf(wave_sum(s, lane) * (1.f / DM) + EPSV);
#pragma unroll
        for (int j = 0; j < 8; ++j) { const f32x4 y = v[j] * rstd * gv[j];
            if (F32OUT) *(f32x4*)(OF + (size_t)r * DM + (lane + 64 * j) * 4) = y;
            else { u32x2 w; w.x = pk2(y[0], y[1]); w.y = pk2(y[2], y[3]); *(u32x2*)(O + (size_t)r * DM + (lane + 64 * j) * 4) = w; } }
    }
}

__device__ __forceinline__ void lru_item(LAS unsigned char* lds, int item, const bf16_t* ZE, const float* conv_w, const float* conv_b,
                                         const bf16_t* WrT, const bf16_t* WiT, const float* b_r, const float* b_i, const float* lam, bf16_t* YB) {
    const int tid = opaque_tid(), w = __builtin_amdgcn_readfirstlane(tid >> 6), lane = tid & 63, fr = lane & 15, fq = lane >> 4;
    const int b = item >> 6, hh = (item >> 2) & 15, qq = item & 3;
    LAS unsigned char* XC = lds;
    LAS float* SEGA = (LAS float*)(lds + 36864);
    LAS float* SEGB = SEGA + 1024;
    LAS float* HIN = SEGB + 1024;
    const int co = tid & 7, tr = tid >> 3;
    float cw[4][8], cb[8];
#pragma unroll
    for (int k = 0; k < 4; ++k)
#pragma unroll
        for (int e = 0; e < 8; ++e) cw[k][e] = conv_w[k * 1024 + hh * 64 + co * 8 + e];
#pragma unroll
    for (int e = 0; e < 8; ++e) cb[e] = conv_b[hh * 64 + co * 8 + e];
    bf16x8 wrf[2], wif[2];
#pragma unroll
    for (int kk = 0; kk < 2; ++kk) { wrf[kk] = *(const bf16x8*)(WrT + ((size_t)hh * 64 + qq * 16 + fr) * 64 + kk * 32 + fq * 8); wif[kk] = *(const bf16x8*)(WiT + ((size_t)hh * 64 + qq * 16 + fr) * 64 + kk * 32 + fq * 8); }
    const int ch = hh * 64 + qq * 16 + fr;
    const float br = b_r[ch], bi = b_i[ch];
    const float lm = lam[ch]; float sp8; { const float e = __expf(-lm); const float ser = e * (1.f - e * (0.5f - e * (0.33333333f - e * 0.25f)));
        sp8 = 8.0f * ((-lm > 20.f) ? -lm : (e < 0.03f ? ser : __logf(1.0f + e))); }
    float carry = 0.f;
    const bf16_t* zb = ZE + (size_t)b * SEQ * AB_IN;
    for (int sc = 0; sc < 16; ++sc) {
        const int t0 = sc * 256;
        {
            float xin[7][8];
#pragma unroll
            for (int r = 0; r < 7; ++r) { const int t = t0 + tr * 4 - 3 + r;
                if (t >= 0) { const u32x4 v = *(const u32x4*)(zb + (size_t)t * AB_IN + hh * 64 + co * 8);
                    xin[r][0] = bflo(v.x); xin[r][1] = bfhi(v.x); xin[r][2] = bflo(v.y); xin[r][3] = bfhi(v.y); xin[r][4] = bflo(v.z); xin[r][5] = bfhi(v.z); xin[r][6] = bflo(v.w); xin[r][7] = bfhi(v.w); }
                else {
#pragma unroll
                    for (int e = 0; e < 8; ++e) xin[r][e] = 0.f; } }
#pragma unroll
            for (int q = 0; q < 4; ++q) { float o[8];
#pragma unroll
                for (int e = 0; e < 8; ++e) o[e] = cb[e] + cw[0][e] * xin[q][e] + cw[1][e] * xin[q + 1][e] + cw[2][e] * xin[q + 2][e] + cw[3][e] * xin[q + 3][e];
                u32x4 wv; wv.x = pk2(o[0], o[1]); wv.y = pk2(o[2], o[3]); wv.z = pk2(o[4], o[5]); wv.w = pk2(o[6], o[7]);
                *(LAS u32x4*)(XC + (tr * 4 + q) * 144 + co * 16) = wv; }
        }
        __syncthreads();
        float av[2][4], bv[2][4];
#pragma unroll
        for (int ml = 0; ml < 2; ++ml) { const int mt = w * 2 + ml;
            f32x4 ar = (f32x4){0.f, 0.f, 0.f, 0.f}, ai = ar;
#pragma unroll
            for (int kk = 0; kk < 2; ++kk) { const bf16x8 xa = *(const LAS bf16x8*)(XC + (mt * 16 + fr) * 144 + kk * 64 + fq * 16);
                ar = __builtin_amdgcn_mfma_f32_16x16x32_bf16(xa, wrf[kk], ar, 0, 0, 0); ai = __builtin_amdgcn_mfma_f32_16x16x32_bf16(xa, wif[kk], ai, 0, 0, 0); }
            float A = 1.f, Bc = 0.f;
#pragma unroll
            for (int r = 0; r < 4; ++r) { const int tok = mt * 16 + fq * 4 + r;
                const float xcv = bf2f(*(const LAS unsigned short*)(XC + tok * 144 + (qq * 16 + fr) * 2));
                const float rg = sigmoidf_(ar[r] + br), ig = sigmoidf_(ai[r] + bi);
                const float la = -rg * sp8; const float a = __expf(la); const float x2 = 2.f * la; const float em = (x2 > -0.3f) ? -x2 * (1.f + x2 * 0.5f * (1.f + x2 * 0.33333333f * (1.f + x2 * 0.25f * (1.f + x2 * 0.2f * (1.f + x2 * 0.16666667f))))) : 1.f - __expf(x2);
                const float mult = sqrtf(fmaxf(em, 0.f));
                av[ml][r] = a; bv[ml][r] = mult * ig * xcv;
                Bc = a * Bc + bv[ml][r]; A = A * a; }
            const int sg = mt * 4 + fq; SEGA[sg * 16 + fr] = A; SEGB[sg * 16 + fr] = Bc; }
        __syncthreads();
        if (w == 0 && lane < 16) { float h = carry;
#pragma unroll 8
            for (int sg = 0; sg < 64; ++sg) { HIN[sg * 16 + lane] = h; h = SEGA[sg * 16 + lane] * h + SEGB[sg * 16 + lane]; }
            carry = h; }
        __syncthreads();
#pragma unroll
        for (int ml = 0; ml < 2; ++ml) { const int mt = w * 2 + ml; float h = HIN[(mt * 4 + fq) * 16 + fr];
#pragma unroll
            for (int r = 0; r < 4; ++r) { const int t = t0 + mt * 16 + fq * 4 + r; h = av[ml][r] * h + bv[ml][r];
                const float gt = bf2f(zb[(size_t)t * AB_IN + 1024 + ch]);
                YB[((size_t)b * SEQ + t) * DM + ch] = (bf16_t)f2bf(h * gelu_tanh(gt)); } }
    }
    __syncthreads();
}
__device__ __forceinline__ void pool_item(int item, const bf16_t* ZE, const float* scale, bf16_t* YB) {
    const int tid = opaque_tid(), b = item >> 6, tch = item & 63, co = tid & 127, seg = tid >> 7;
    const int win = 2 << (co >> 5);
    float sc[8];
#pragma unroll
    for (int e = 0; e < 8; ++e) sc[e] = scale[co * 8 + e];
    const bf16_t* zb = ZE + (size_t)b * SEQ * AB_IN + 2048 + co * 8;
    const int ts = tch * 64 + seg * 16;
    float sum[8];
#pragma unroll
    for (int e = 0; e < 8; ++e) sum[e] = 0.f;
    for (int s = ts - win + 1; s < ts; ++s) if (s >= 0) { const u32x4 v = *(const u32x4*)(zb + (size_t)s * AB_IN);
        sum[0] += bflo(v.x); sum[1] += bfhi(v.x); sum[2] += bflo(v.y); sum[3] += bfhi(v.y); sum[4] += bflo(v.z); sum[5] += bfhi(v.z); sum[6] += bflo(v.w); sum[7] += bfhi(v.w); }
    for (int t = ts; t < ts + 16; ++t) {
        const u32x4 v = *(const u32x4*)(zb + (size_t)t * AB_IN);
        float x[8] = {bflo(v.x), bfhi(v.x), bflo(v.y), bfhi(v.y), bflo(v.z), bfhi(v.z), bflo(v.w), bfhi(v.w)};
        const float inv = 1.0f / (float)((t + 1) < win ? (t + 1) : win);
        float o[8];
#pragma unroll
        for (int e = 0; e < 8; ++e) { sum[e] += x[e]; o[e] = (sum[e] * inv - x[e]) * sc[e]; }
        u32x4 wv; wv.x = pk2(o[0], o[1]); wv.y = pk2(o[2], o[3]); wv.z = pk2(o[4], o[5]); wv.w = pk2(o[6], o[7]);
        *(u32x4*)(YB + ((size_t)b * SEQ + t) * DM + 1024 + co * 8) = wv;
        const int so = t - win + 1;
        if (so >= 0) { const u32x4 q = *(const u32x4*)(zb + (size_t)so * AB_IN);
            sum[0] -= bflo(q.x); sum[1] -= bfhi(q.x); sum[2] -= bflo(q.y); sum[3] -= bfhi(q.y); sum[4] -= bflo(q.z); sum[5] -= bfhi(q.z); sum[6] -= bflo(q.w); sum[7] -= bfhi(q.w); }
    }
}

constexpr int KT_PITCH = 272, VT_PITCH = 144;
constexpr int AL_KT = 0, AL_VT = 64 * KT_PITCH, AL_IMPA = 36864, AL_IMPB = AL_IMPA + 64 * 65 * 4, AL_SEL = AL_IMPB + 64 * 65 * 4, AL_UNI = AL_SEL + 512;
constexpr float QSCALE2 = 0.08838834764831845f * LOG2E;
constexpr float NEGB = -1e30f;

struct StageRegs { u32x4 k[2], v[2]; };
__device__ __forceinline__ void stage_load(StageRegs& R, const bf16_t* kbase, const bf16_t* vbase, int vpitch, int tid) {
    const int kr = tid >> 3, kc = tid & 7, vr = tid >> 2, vc = tid & 3;
    R.k[0] = *(const u32x4*)(kbase + kr * 128 + kc * 8); R.k[1] = *(const u32x4*)(kbase + kr * 128 + 64 + kc * 8);
    R.v[0] = *(const u32x4*)(vbase + (size_t)vr * vpitch + vc * 8); R.v[1] = *(const u32x4*)(vbase + (size_t)vr * vpitch + 32 + vc * 8);
}
__device__ __forceinline__ void stage_store(const StageRegs& R, LAS unsigned char* lds, int tid) {
    const int kr = tid >> 3, kc = tid & 7, vr = tid >> 2, vc = tid & 3;
    *(LAS u32x4*)(lds + AL_KT + kr * KT_PITCH + kc * 16) = R.k[0]; *(LAS u32x4*)(lds + AL_KT + kr * KT_PITCH + 128 + kc * 16) = R.k[1];
    *(LAS u32x4*)(lds + AL_VT + vr * VT_PITCH + vc * 16) = R.v[0]; *(LAS u32x4*)(lds + AL_VT + vr * VT_PITCH + 64 + vc * 16) = R.v[1];
}
template <int MODE>
__device__ __forceinline__ void attn_tile(LAS unsigned char* lds, const bf16x8 (&qf)[2][4], f32x4 (&O)[2][8], float (&m)[2], float (&l)[2], const int (&tpos)[2], float slope2,
                                          int kp0, int kstride, const bool (&selbit)[2], int fr, int fq, int wv, int tile64, int lane) {
    f32x4 s[2][4];
#pragma unroll
    for (int ci = 0; ci < 2; ++ci)
#pragma unroll
        for (int k4 = 0; k4 < 4; ++k4) s[ci][k4] = (f32x4){0.f, 0.f, 0.f, 0.f};
#pragma unroll
    for (int k4 = 0; k4 < 4; ++k4)
#pragma unroll
        for (int kk = 0; kk < 4; ++kk) { const bf16x8 kf = *(const LAS bf16x8*)(lds + AL_KT + (k4 * 16 + fr) * KT_PITCH + kk * 64 + fq * 16);
            s[0][k4] = __builtin_amdgcn_mfma_f32_16x16x32_bf16(kf, qf[0][kk], s[0][k4], 0, 0, 0);
            s[1][k4] = __builtin_amdgcn_mfma_f32_16x16x32_bf16(kf, qf[1][kk], s[1][k4], 0, 0, 0); }
#pragma unroll
    for (int ci = 0; ci < 2; ++ci) {
        float mx = NEGB;
#pragma unroll
        for (int k4 = 0; k4 < 4; ++k4)
#pragma unroll
            for (int j = 0; j < 4; ++j) { const int kidx = k4 * 16 + fq * 4 + j; const int dist = tpos[ci] - (kp0 + kstride * kidx);
                bool ok = dist >= 0; if (MODE == 3) ok = ok && dist < 512; if (MODE == 2) ok = ok && selbit[ci];
                const float sv = ok ? (s[ci][k4][j] * QSCALE2 - slope2 * (float)dist) : 2.0f * NEGB;
                s[ci][k4][j] = sv; mx = fmaxf(mx, sv); }
        if (MODE != 1) {
            mx = fmaxf(mx, shx(mx, lane, 16)); mx = fmaxf(mx, shx(mx, lane, 32));
            const float mn = fmaxf(m[ci], mx); const float alpha = exp2f(m[ci] - mn); m[ci] = mn;
            float ps = 0.f;
#pragma unroll
            for (int k4 = 0; k4 < 4; ++k4)
#pragma unroll
                for (int j = 0; j < 4; ++j) { const float p = exp2f(s[ci][k4][j] - mn); s[ci][k4][j] = p; ps += p; }
            l[ci] = l[ci] * alpha + ps;
            if (MODE != 0) {
#pragma unroll
                for (int dt = 0; dt < 8; ++dt) O[ci][dt] = O[ci][dt] * alpha; }
        } else {
#pragma unroll
            for (int k4 = 0; k4 < 4; ++k4) {
#pragma unroll
                for (int j = 0; j < 4; ++j) s[ci][k4][j] = exp2f(s[ci][k4][j] - m[ci]) * l[ci];
                float a = (s[ci][k4][0] + s[ci][k4][1]) + (s[ci][k4][2] + s[ci][k4][3]); float b3 = s[ci][k4][3];
                a += shx(a, lane, 1); a += shx(a, lane, 2); b3 += shx(b3, lane, 1); b3 += shx(b3, lane, 2);
                if ((fr & 3) == 0) { const int tl = wv * 8 + ci * 4 + (fr >> 2); const int ms = tile64 * 16 + k4 * 4 + fq;
                    ((LAS float*)(lds + AL_IMPA))[tl * 65 + ms] = a; ((LAS float*)(lds + AL_IMPB))[tl * 65 + ms + 1] = b3; } }
        }
    }
    if (MODE != 0) {
#pragma unroll
        for (int ks = 0; ks < 2; ++ks) {
            bf16x8 pf[2];
#pragma unroll
            for (int ci = 0; ci < 2; ++ci) { u32x4 w; w.x = pk2(s[ci][2 * ks][0], s[ci][2 * ks][1]); w.y = pk2(s[ci][2 * ks][2], s[ci][2 * ks][3]); w.z = pk2(s[ci][2 * ks + 1][0], s[ci][2 * ks + 1][1]); w.w = pk2(s[ci][2 * ks + 1][2], s[ci][2 * ks + 1][3]);
                pf[ci] = __builtin_bit_cast(bf16x8, w); }
#pragma unroll
            for (int dt = 0; dt < 8; ++dt) { const LAS unsigned char* vp = lds + AL_VT + (dt * 16 + fr) * VT_PITCH + (ks * 32 + fq * 4) * 2;
                const u32x2 lo = *(const LAS u32x2*)vp, hi = *(const LAS u32x2*)(vp + 32);
                const bf16x8 vf = __builtin_bit_cast(bf16x8, (u32x4){lo.x, lo.y, hi.x, hi.y});
                O[0][dt] = __builtin_amdgcn_mfma_f32_16x16x32_bf16(vf, pf[0], O[0][dt], 0, 0, 0);
                O[1][dt] = __builtin_amdgcn_mfma_f32_16x16x32_bf16(vf, pf[1], O[1][dt], 0, 0, 0); }
        }
    }
}

__device__ __forceinline__ void nsa_item(LAS unsigned char* lds, int b, int g, int tq, const bf16_t* Q, const bf16_t* KS, const bf16_t* VST, const bf16_t* KW, const bf16_t* VWT,
                                         const bf16_t* KCMP, const bf16_t* VCMPT, const float* GL, bf16_t* YB) {
    const int tid = opaque_tid(), wv = __builtin_amdgcn_readfirstlane(tid >> 6), lane = tid & 63, fr = lane & 15, fq = lane >> 4;
    const int t0 = tq * 64, bg = b * 4 + g, head = g * 4 + (fr & 3);
    LAS float* IMPA = (LAS float*)(lds + AL_IMPA);
    LAS unsigned long long* SEL = (LAS unsigned long long*)(lds + AL_SEL);
    LAS unsigned long long* UNI = (LAS unsigned long long*)(lds + AL_UNI);
    __syncthreads();
    for (int i = tid; i < 2 * 64 * 65; i += 512) IMPA[i] = 0.f;
    int tpos[2]; bf16x8 qf[2][4];
#pragma unroll
    for (int ci = 0; ci < 2; ++ci) { tpos[ci] = t0 + wv * 8 + ci * 4 + (fr >> 2);
        const bf16_t* qp = Q + ((size_t)(b * SEQ + tpos[ci])) * DM + head * 128 + fq * 8;
#pragma unroll
        for (int kk = 0; kk < 4; ++kk) qf[ci][kk] = *(const bf16x8*)(qp + kk * 32);
    }
    const float slope2 = exp2f(-0.5f * (float)(head + 1)) * LOG2E;
    f32x4 O[2][8]; float m[2], l[2]; bool selbit[2] = {true, true};
#pragma unroll
    for (int ci = 0; ci < 2; ++ci)
#pragma unroll
        for (int dt = 0; dt < 8; ++dt) { O[ci][dt] = (f32x4){0.f, 0.f, 0.f, 0.f}; }
    StageRegs R;
    const int ncmp = ((t0 + 32) >> 4) + 1, nct = (ncmp + 63) >> 6;
    const bf16_t* kcb = KCMP + (size_t)bg * 256 * 128; const bf16_t* vcb = VCMPT + (size_t)bg * 128 * 256;
    m[0] = m[1] = NEGB; l[0] = l[1] = 0.f;
    stage_load(R, kcb, vcb, 256, tid);
    for (int ct = 0; ct < nct; ++ct) {
        __syncthreads(); stage_store(R, lds, tid); __syncthreads();
        if (ct + 1 < nct) stage_load(R, kcb + (size_t)(ct + 1) * 64 * 128, vcb + (ct + 1) * 64, 256, tid);
        attn_tile<0>(lds, qf, O, m, l, tpos, slope2, 16 * (ct * 64) + 31, 16, selbit, fr, fq, wv, ct, lane);
    }
#pragma unroll
    for (int ci = 0; ci < 2; ++ci) { float lt = l[ci]; lt += shx(lt, lane, 16); lt += shx(lt, lane, 32); l[ci] = lt > 0.f ? 1.0f / lt : 0.f; }
    stage_load(R, kcb, vcb, 256, tid);
    for (int ct = 0; ct < nct; ++ct) {
        __syncthreads(); stage_store(R, lds, tid); __syncthreads();
        if (ct + 1 < nct) stage_load(R, kcb + (size_t)(ct + 1) * 64 * 128, vcb + (ct + 1) * 64, 256, tid);
        attn_tile<1>(lds, qf, O, m, l, tpos, slope2, 16 * (ct * 64) + 31, 16, selbit, fr, fq, wv, ct, lane);
    }
#pragma unroll
    for (int ci = 0; ci < 2; ++ci) { const float gc = GL[((size_t)(b * SEQ + tpos[ci])) * 48 + head];
        bf16_t* op = YB + ((size_t)(b * SEQ + tpos[ci])) * DM + head * 128 + fq * 4;
#pragma unroll
        for (int dt = 0; dt < 8; ++dt) { const f32x4 o = O[ci][dt] * gc; u32x2 w; w.x = pk2(o[0], o[1]); w.y = pk2(o[2], o[3]); *(u32x2*)(op + dt * 16) = w; O[ci][dt] = (f32x4){0.f, 0.f, 0.f, 0.f}; } }
    __syncthreads();
    {
        const int cur = tq; unsigned long long wun = 0ull;
#pragma unroll 1
        for (int tk = 0; tk < 8; ++tk) { const int tl = wv * 8 + tk;
            float v = IMPA[tl * 65 + lane] + IMPA[64 * 65 + tl * 65 + lane];
            if (lane == 0 || lane == cur || lane == cur - 1) v += 1e6f;
            if (lane > cur) v = NEGB;
            int rank = 0; const int vi = __builtin_bit_cast(int, v);
#pragma unroll
            for (int mm = 0; mm < 64; ++mm) { const float vm = __builtin_bit_cast(float, __builtin_amdgcn_readlane(vi, mm)); rank += ((vm > v) || (vm == v && mm < lane)) ? 1 : 0; }
            const unsigned long long mk = __ballot(rank < 16 && lane <= cur);
            wun |= mk;
            if (lane == 0) SEL[tl] = mk; }
        if (lane == 0) UNI[wv] = wun;
    }
    __syncthreads();
    unsigned long long selm[2], wun, bun = 0ull;
#pragma unroll
    for (int ci = 0; ci < 2; ++ci) selm[ci] = SEL[wv * 8 + ci * 4 + (fr >> 2)];
    wun = UNI[wv];
#pragma unroll
    for (int i = 0; i < 8; ++i) bun |= UNI[i];
    { const unsigned lo = __builtin_amdgcn_readfirstlane((unsigned)bun), hi = __builtin_amdgcn_readfirstlane((unsigned)(bun >> 32)); bun = ((unsigned long long)hi << 32) | lo;
      const unsigned lo2 = __builtin_amdgcn_readfirstlane((unsigned)wun), hi2 = __builtin_amdgcn_readfirstlane((unsigned)(wun >> 32)); wun = ((unsigned long long)hi2 << 32) | lo2; }
    const bf16_t* ksb = KS + (size_t)bg * SEQ * 128; const bf16_t* vsb = VST + (size_t)bg * 128 * SEQ;
    m[0] = m[1] = NEGB; l[0] = l[1] = 0.f;
    {
        unsigned long long rem = bun; int j = __builtin_ctzll(rem); rem &= rem - 1;
        stage_load(R, ksb + (size_t)j * 64 * 128, vsb + j * 64, SEQ, tid);
        for (;;) {
            __syncthreads(); stage_store(R, lds, tid); __syncthreads();
            const int jn = rem ? __builtin_ctzll(rem) : -1; if (jn >= 0) { rem &= rem - 1; stage_load(R, ksb + (size_t)jn * 64 * 128, vsb + jn * 64, SEQ, tid); }
            if ((wun >> j) & 1ull) { selbit[0] = (selm[0] >> j) & 1ull; selbit[1] = (selm[1] >> j) & 1ull;
                attn_tile<2>(lds, qf, O, m, l, tpos, slope2, j * 64, 1, selbit, fr, fq, wv, 0, lane); }
            if (jn < 0) break; j = jn;
        }
    }
#pragma unroll
    for (int ci = 0; ci < 2; ++ci) { float lt = l[ci]; lt += shx(lt, lane, 16); lt += shx(lt, lane, 32); const float gs = GL[((size_t)(b * SEQ + tpos[ci])) * 48 + 16 + head]; const float sc = lt > 0.f ? gs / lt : 0.f;
        bf16_t* op = YB + ((size_t)(b * SEQ + tpos[ci])) * DM + head * 128 + fq * 4;
#pragma unroll
        for (int dt = 0; dt < 8; ++dt) { const f32x4 o = O[ci][dt] * sc; const u32x2 pv = *(const u32x2*)(op + dt * 16); u32x2 w; w.x = pk2(bflo(pv.x) + o[0], bfhi(pv.x) + o[1]); w.y = pk2(bflo(pv.y) + o[2], bfhi(pv.y) + o[3]); *(u32x2*)(op + dt * 16) = w; O[ci][dt] = (f32x4){0.f, 0.f, 0.f, 0.f}; } }
    const bf16_t* kwb = KW + (size_t)bg * SEQ * 128; const bf16_t* vwb = VWT + (size_t)bg * 128 * SEQ;
    m[0] = m[1] = NEGB; l[0] = l[1] = 0.f; selbit[0] = selbit[1] = true;
    {
        const int j0 = tq >= 8 ? tq - 8 : 0;
        stage_load(R, kwb + (size_t)j0 * 64 * 128, vwb + j0 * 64, SEQ, tid);
        for (int j = j0; j <= tq; ++j) {
            __syncthreads(); stage_store(R, lds, tid); __syncthreads();
            if (j < tq) stage_load(R, kwb + (size_t)(j + 1) * 64 * 128, vwb + (j + 1) * 64, SEQ, tid);
            attn_tile<3>(lds, qf, O, m, l, tpos, slope2, j * 64, 1, selbit, fr, fq, wv, 0, lane);
        }
    }
#pragma unroll
    for (int ci = 0; ci < 2; ++ci) { float lt = l[ci]; lt += shx(lt, lane, 16); lt += shx(lt, lane, 32); const float gwv = GL[((size_t)(b * SEQ + tpos[ci])) * 48 + 32 + head]; const float sc = lt > 0.f ? gwv / lt : 0.f;
        bf16_t* op = YB + ((size_t)(b * SEQ + tpos[ci])) * DM + head * 128 + fq * 4;
#pragma unroll
        for (int dt = 0; dt < 8; ++dt) { const f32x4 o = O[ci][dt] * sc; const u32x2 pv = *(const u32x2*)(op + dt * 16); u32x2 w; w.x = pk2(bflo(pv.x) + o[0], bfhi(pv.x) + o[1]); w.y = pk2(bflo(pv.y) + o[2], bfhi(pv.y) + o[3]); *(u32x2*)(op + dt * 16) = w; } }
}

__global__ void __launch_bounds__(512) fwd_kernel(Args a) {
    extern __shared__ __attribute__((aligned(16))) unsigned char lds_raw[];
    LAS unsigned char* lds = (LAS unsigned char*)lds_raw;
    const int G = gridDim.x, bx = blockIdx.x;
    const int NGW = G * 8, NGT = G * 512;
#define GW() (opq(bx) * 8 + __builtin_amdgcn_readfirstlane(opaque_tid() >> 6))
    unsigned char* ws = a.ws;
    int ph = 0;
    { volatile LAS unsigned* MISC = (volatile LAS unsigned*)(lds + pg8::STAGE_BYTES); if (threadIdx.x < 16) MISC[threadIdx.x] = 0u; }
    __syncthreads();
    (void)xcd_barrier_post((unsigned*)(ws + WS_BAR), (volatile LAS unsigned*)(lds + pg8::STAGE_BYTES));
#ifndef ONLY
#define ONLY -1
#endif
#define EN(id) (ONLY < 0 || ONLY == (id))
#define ON() (ph >= a.lo && ph < a.hi)
#define SEAM() do { ++ph; if (a.one) { if (ph == 1) cg::this_grid().sync(); else { XcdBarrier bar; bar.bar = (unsigned*)(opqp(ws) + WS_BAR); bar.x = xb_xcc_id(); bar.st = (volatile LAS unsigned*)(lds + pg8::STAGE_BYTES); xcd_barrier(bar); } } } while (0)

    bf16_t* XN = (bf16_t*)(ws + WS_XN); bf16_t* YB = (bf16_t*)(ws + WS_YB); unsigned char* Z = ws + WS_Z;
    float* posb = (float*)(ws + WS_POSB);

    if (EN(0) && ON())
#pragma unroll 1
    for (int rp0 = 0; rp0 < REP_P0; ++rp0) {
        const int tid = opaque_tid(), lane = tid & 63, wave = __builtin_amdgcn_readfirstlane(tid >> 6), gw = bx * 8 + wave, gt = bx * 512 + tid;
        LAS float* scr = (LAS float*)(lds + wave * 8448);
        int rot = 0;
        for (int i = 0; i < 4; ++i) {
            conv_mat(a.in[23] + (size_t)i * DM * DFF, DM, DFF, DFF, (bf16_t*)(ws + WS_WUP + i * SZ_UP), DM, scr, gw, NGW, lane, rot);
            conv_mat(a.in[24] + (size_t)i * DFF * DM, DFF, DM, DM, (bf16_t*)(ws + WS_WDN + i * SZ_UP), DFF, scr, gw, NGW, lane, rot);
            conv_mat(a.in[26] + (size_t)i * DM * DM, DM, DM, DM, (bf16_t*)(ws + WS_WG + i * SZ_SQ), DM, scr, gw, NGW, lane, rot);
            conv_mat(a.in[27] + (size_t)i * PLE * DM, PLE, DM, DM, (bf16_t*)(ws + WS_WP + i * SZ_WP), PLE, scr, gw, NGW, lane, rot);
        }
        for (int j = 0; j < 2; ++j) {
            conv_mat(a.in[3] + (size_t)j * DM * AB_IN, DM, 2048, AB_IN, (bf16_t*)(ws + WS_WIN + j * SZ_WIN), DM, scr, gw, NGW, lane, rot);
            conv_mat(a.in[13] + (size_t)j * DM * DM, DM, DM, DM, (bf16_t*)(ws + WS_WOUT + j * SZ_SQ), DM, scr, gw, NGW, lane, rot);
            conv_mat(a.in[14] + (size_t)j * DM * C_IN, DM, C_IN, C_IN, (bf16_t*)(ws + WS_CIN + j * SZ_CIN), DM, scr, gw, NGW, lane, rot);
            conv_mat(a.in[21] + (size_t)j * DM * DM, DM, DM, DM, (bf16_t*)(ws + WS_COUT + j * SZ_SQ), DM, scr, gw, NGW, lane, rot);
            conv_mat(a.in[16] + (size_t)j * 4096 * 512, 4096, 512, 512, (bf16_t*)(ws + WS_W1K + j * SZ_W1), 4096, scr, gw, NGW, lane, rot);
            conv_mat(a.in[19] + (size_t)j * 4096 * 512, 4096, 512, 512, (bf16_t*)(ws + WS_W1V + j * SZ_W1), 4096, scr, gw, NGW, lane, rot);
            conv_mat(a.in[17] + (size_t)j * 512 * 128, 512, 128, 128, (bf16_t*)(ws + WS_W2K + j * SZ_W2), 512, scr, gw, NGW, lane, rot);
            conv_mat(a.in[20] + (size_t)j * 512 * 128, 512, 128, 128, (bf16_t*)(ws + WS_W2V + j * SZ_W2), 512, scr, gw, NGW, lane, rot);
            for (int h = 0; h < 16; ++h) {
                conv_mat(a.in[6] + ((size_t)j * 16 + h) * 4096, 64, 64, 64, (bf16_t*)(ws + WS_WR + j * SZ_WRI) + h * 4096, 64, scr, gw, NGW, lane, rot);
                conv_mat(a.in[8] + ((size_t)j * 16 + h) * 4096, 64, 64, 64, (bf16_t*)(ws + WS_WI + j * SZ_WRI) + h * 4096, 64, scr, gw, NGW, lane, rot);
            }
            for (int gI = 0; gI < 4; ++gI)
                conv_mat(a.in[11] + ((size_t)j * 4 + gI) * 65536, 256, 256, 256, (bf16_t*)(ws + WS_POOLT + j * SZ_POOLT) + gI * 65536, 256, scr, gw, NGW, lane, rot);
            conv_plain(a.in[3] + (size_t)j * DM * AB_IN + 2048, DM, 1024, AB_IN, (bf16_t*)(ws + WS_WU + j * SZ_WU), 1024, gt, NGT);
            zero_fill16(ws + WS_CIN + j * SZ_CIN + (size_t)C_IN * DM * 2, (size_t)(C_INP - C_IN) * DM * 2, gt, NGT);
            zero_fill16(ws + WS_W2K + j * SZ_W2 + (size_t)128 * 512 * 2, (size_t)128 * 512 * 2, gt, NGT);
            zero_fill16(ws + WS_W2V + j * SZ_W2 + (size_t)128 * 512 * 2, (size_t)128 * 512 * 2, gt, NGT);
        }
        conv_plain(a.in[1], 4 * T_TOK, PLE, PLE, (bf16_t*)(ws + WS_PB), PLE, gt, NGT);
        __syncthreads();
        for (int it = gw; it < 4 * 8; it += NGW) { const int q = it >> 3, fc = it & 7, j = q >> 1;
            const float* pos = a.in[(q & 1) ? 18 : 15] + (size_t)j * 4096; const float* w1 = a.in[(q & 1) ? 19 : 16] + (size_t)j * 4096 * 512 + fc * 64 + lane;
            float acc0 = 0.f, acc1 = 0.f, acc2 = 0.f, acc3 = 0.f;
            for (int k = 0; k < 4096; k += 4) { acc0 += pos[k] * w1[(size_t)k * 512]; acc1 += pos[k + 1] * w1[(size_t)(k + 1) * 512]; acc2 += pos[k + 2] * w1[(size_t)(k + 2) * 512]; acc3 += pos[k + 3] * w1[(size_t)(k + 3) * 512]; }
            posb[q * 512 + fc * 64 + lane] = (acc0 + acc1) + (acc2 + acc3); }
    }
    SEAM();
    if (EN(1) && ON()) {
        if (bx < 64) { const int j = bx >> 5, gI = (bx >> 3) & 3, pn = bx & 7;
            pg8::Gemm gm{(const bf16_t*)(ws + WS_POOLT + j * SZ_POOLT) + gI * 65536, (const bf16_t*)(ws + WS_WU + j * SZ_WU) + gI * 256, 256, 2048, 256, 256, 1024};
            pg8::StaticOrder S; S.init(256, 2048, G, pn);
            EpiBf16<0> E{(bf16_t*)(ws + WS_WIN + j * SZ_WIN) + (size_t)(2048 + gI * 256) * DM, DM, nullptr};
            pg8::gemm_phase(lds, gm, S, E); }
    }
#pragma unroll 1
    for (int layer = 0; layer < 4; ++layer) {
        const int j = layer >> 1; const bool even = (layer & 1) == 0;
        unsigned char* wsl = opqp(ws); unsigned char* Zl = wsl + WS_Z; bf16_t* XNl = (bf16_t*)(wsl + WS_XN); bf16_t* YBl = (bf16_t*)(wsl + WS_YB); float* posbl = (float*)(wsl + WS_POSB);
        const float* hin = (layer == 0) ? a.in[0] : a.out;
        if (EN(2) && ON()) rmsnorm_rows<false>(hin, a.in[2] + layer * DM, XNl, nullptr, bx, NGW);
        SEAM();
        if (EN(3) && ON()) {
            if (even) { pg8::Gemm gm{XNl, (const bf16_t*)(wsl + WS_WIN + j * SZ_WIN), T_TOK, AB_IN, DM, DM, DM};
                pg8::StaticOrder S; S.init(T_TOK, AB_IN, opq(G), opq(bx)); EpiBf16<0> E{(bf16_t*)Zl, AB_IN, nullptr}; pg8::gemm_phase(lds, gm, S, E); }
            else { pg8::Gemm gm{XNl, (const bf16_t*)(wsl + WS_CIN + j * SZ_CIN), T_TOK, C_INP, DM, DM, DM};
                pg8::StaticOrder S; S.init(T_TOK, C_INP, opq(G), opq(bx));
                EpiNsa E{(bf16_t*)(Zl + Z_Q), (bf16_t*)(Zl + Z_KC), (bf16_t*)(Zl + Z_VC), (bf16_t*)(Zl + Z_KS), (bf16_t*)(Zl + Z_VST), (bf16_t*)(Zl + Z_KW), (bf16_t*)(Zl + Z_VWT), (float*)(Zl + Z_GL)};
                pg8::gemm_phase(lds, gm, S, E); }
        }
        SEAM();
        if (even) {
            if (EN(4) && ON()) {
#ifndef NO_LRU
#pragma unroll 1
                for (int rp = 0; rp < REP_LRU; ++rp)
                for (int it = opq(bx); it < 256; it += G)
                    lru_item(lds, it, (const bf16_t*)Zl, a.in[4] + (size_t)j * 4096, a.in[5] + j * 1024, (const bf16_t*)(wsl + WS_WR + j * SZ_WRI), (const bf16_t*)(wsl + WS_WI + j * SZ_WRI),
                             a.in[7] + j * 1024, a.in[9] + j * 1024, a.in[10] + j * 1024, YBl);
#endif
                for (int it = opq(bx); it < 256; it += G) pool_item(it, (const bf16_t*)Zl, a.in[12] + j * 1024, YBl);
            }
            SEAM();
        } else {
            if (EN(5) && ON()) {
                if (bx < 64) { const int kv = bx >> 5;
                    pg8::Gemm gm{(const bf16_t*)(Zl + (kv ? Z_VC : Z_KC)), (const bf16_t*)(wsl + (kv ? WS_W1V : WS_W1K) + j * SZ_W1), 4096, 512, 4096, 2048, 4096};
                    pg8::StaticOrder S; S.init(4096, 512, opq(G), opq(bx) & 31);
                    EpiBf16<2> E{(bf16_t*)(Zl + (kv ? Z_HIDV : Z_HIDK)), 512, posbl + (j * 2 + kv) * 512}; pg8::gemm_phase(lds, gm, S, E); }
            }
            SEAM();
            if (EN(6) && ON()) {
                if (bx < 16) { pg8::Gemm gm{(const bf16_t*)(Zl + Z_HIDK), (const bf16_t*)(wsl + WS_W2K + j * SZ_W2), 4096, 256, 512, 512, 512};
                    pg8::StaticOrder S; S.init(4096, 256, opq(G), opq(bx)); EpiCmp2<0> E{(bf16_t*)(Zl + Z_KCMP)}; pg8::gemm_phase(lds, gm, S, E); }
                else if (bx < 32) { pg8::Gemm gm{(const bf16_t*)(Zl + Z_HIDV), (const bf16_t*)(wsl + WS_W2V + j * SZ_W2), 4096, 256, 512, 512, 512};
                    pg8::StaticOrder S; S.init(4096, 256, opq(G), opq(bx) - 16); EpiCmp2<1> E{(bf16_t*)(Zl + Z_VCMPT)}; pg8::gemm_phase(lds, gm, S, E); }
            }
            SEAM();
            if (EN(7) && ON()) {
#pragma unroll 1
                for (int rp = 0; rp < REP_ATTN; ++rp)
                for (int it = opq(bx), r = 0; it < 1024; it += G, ++r) { const int c = it % 256, rr = it / 256; const int cp = (rr & 1) ? 255 - c : c;
                    const int tq = 63 - (rr * 16 + (cp >> 4)), bgi = cp & 15;
#ifndef NO_ATTN
                    nsa_item(lds, bgi >> 2, bgi & 3, tq, (const bf16_t*)(Zl + Z_Q), (const bf16_t*)(Zl + Z_KS), (const bf16_t*)(Zl + Z_VST), (const bf16_t*)(Zl + Z_KW), (const bf16_t*)(Zl + Z_VWT),
                             (const bf16_t*)(Zl + Z_KCMP), (const bf16_t*)(Zl + Z_VCMPT), (const float*)(Zl + Z_GL), YBl);
#endif
                }
                __syncthreads();
            }
            SEAM();
        }
        if (EN(8) && ON()) { pg8::Gemm gm{YBl, (const bf16_t*)(wsl + (even ? WS_WOUT : WS_COUT) + j * SZ_SQ), T_TOK, DM, DM, DM, DM};
            pg8::StaticOrder S; S.init(T_TOK, DM, opq(G), opq(bx)); EpiF32<0> E{hin, a.out, nullptr, DM}; pg8::gemm_phase(lds, gm, S, E); }
        SEAM();
        if (EN(9) && ON()) rmsnorm_rows<false>(a.out, a.in[22] + layer * DM, XNl, nullptr, bx, NGW);
        SEAM();
        if (EN(10) && ON())
#pragma unroll 1
        for (int rpu = 0; rpu < REP_UP; ++rpu) { pg8::Gemm gm{XNl, (const bf16_t*)(wsl + WS_WUP + layer * SZ_UP), T_TOK, DFF, DM, DM, DM};
            pg8::StaticOrder S; S.init(T_TOK, DFF, opq(G), opq(bx)); EpiBf16<1> E{(bf16_t*)Zl, DFF, nullptr}; pg8::gemm_phase(lds, gm, S, E); }
        SEAM();
        if (EN(11) && ON()) { pg8::Gemm gm{(const bf16_t*)Zl, (const bf16_t*)(wsl + WS_WDN + layer * SZ_UP), T_TOK, DM, DFF, DFF, DFF};
            pg8::StaticOrder S; S.init(T_TOK, DM, opq(G), opq(bx)); EpiF32<0> E{a.out, a.out, nullptr, DM}; pg8::gemm_phase(lds, gm, S, E); }
        SEAM();
        if (EN(12) && ON()) {
            { pg8::Gemm gm{(const bf16_t*)(wsl + WS_PB) + (size_t)layer * T_TOK * PLE, (const bf16_t*)(wsl + WS_WP + layer * SZ_WP), T_TOK, DM, PLE, PLE, PLE};
              pg8::StaticOrder S; S.init(T_TOK, DM, opq(G), opq(bx)); EpiF32<2> E{nullptr, (float*)Zl, nullptr, DM}; pg8::gemm_phase(lds, gm, S, E); }
            asm volatile("" ::: "memory");
            rmsnorm_rows<false>(a.out, a.in[25] + layer * DM, XNl, nullptr, bx, NGW);
        }
        SEAM();
        if (EN(13) && ON()) { pg8::Gemm gm{XNl, (const bf16_t*)(wsl + WS_WG + layer * SZ_SQ), T_TOK, DM, DM, DM, DM};
            pg8::StaticOrder S; S.init(T_TOK, DM, opq(G), opq(bx)); EpiF32<1> E{a.out, a.out, (const float*)Zl, DM}; pg8::gemm_phase(lds, gm, S, E); }
        SEAM();
    }
    if (EN(14) && ON()) rmsnorm_rows<true>(a.out, a.in[28], nullptr, a.out, bx, NGW);
#undef ON
#undef SEAM
}
constexpr int N_PHASES = 1 + 2 * 9 + 2 * 11 + 1;

extern "C" void kernel_launch(void* const* d_in, const int* in_sizes, int n_in, void* d_out, int out_size, void* d_ws, size_t ws_size, hipStream_t stream) {
    static int grid = 0;
    if (grid == 0) {
        if (n_in != 29 || ws_size < WS_END) { fprintf(stderr, "kernel_launch: unexpected n_in %d / ws %zu (need %zu)\n", n_in, ws_size, (size_t)WS_END); grid = -1; return; }
        int dev = 0, cus = 0, per_cu = 0;
        hipGetDevice(&dev); hipDeviceGetAttribute(&cus, hipDeviceAttributeMultiprocessorCount, dev);
        if (hipFuncSetAttribute((const void*)fwd_kernel, hipFuncAttributeMaxDynamicSharedMemorySize, LDS_BYTES) != hipSuccess) { fprintf(stderr, "hipFuncSetAttribute failed\n"); grid = -1; return; }
        if (hipOccupancyMaxActiveBlocksPerMultiprocessor(&per_cu, (const void*)fwd_kernel, 512, LDS_BYTES) != hipSuccess || per_cu < 1) { fprintf(stderr, "occupancy query: %d\n", per_cu); per_cu = 1; }
        (void)hipGetLastError();
        grid = cus;
    }
    if (grid < 0) return;
    Args a{};
    for (int i = 0; i < 29; ++i) a.in[i] = (const float*)d_in[i];
    a.out = (float*)d_out; a.ws = (unsigned char*)d_ws;
#if MK_ONE_LAUNCH
    (void)hipMemsetAsync((unsigned char*)d_ws + WS_BAR, 0, XCD_BAR_WORDS * 4, stream);
    a.lo = 0; a.hi = 1 << 30; a.one = 1; a.pad = 0;
    void* args[] = {&a};
    hipError_t e = hipLaunchCooperativeKernel((const void*)fwd_kernel, dim3(grid), dim3(512), args, LDS_BYTES, stream);
    if (e != hipSuccess) fprintf(stderr, "cooperative launch failed: %s (grid %d)\n", hipGetErrorString(e), grid);
#else
    for (int p = 0; p < N_PHASES; ++p) { a.lo = p; a.hi = p + 1; a.one = 0; a.pad = 0;
        hipLaunchKernelGGL(fwd_kernel, dim3(grid), dim3(512), LDS_BYTES, stream, a); }
#endif
}
```

```cpp
#include <hip/hip_runtime.h>
#include <hip/hip_cooperative_groups.h>
#include <cstdio>
namespace cg = cooperative_groups;

#ifndef REP_ATTN
#define REP_ATTN 1
#endif
#ifndef REP_LRU
#define REP_LRU 1
#endif
#ifndef REP_P0
#define REP_P0 1
#endif
#ifndef REP_UP
#define REP_UP 1
#endif
#ifndef MK_ONE_LAUNCH
#define MK_ONE_LAUNCH 1
#endif

#define LAS __attribute__((address_space(3)))
typedef unsigned short bf16_t;
typedef short bf16x8 __attribute__((ext_vector_type(8)));
typedef float f32x4 __attribute__((ext_vector_type(4)));
typedef float f32x2 __attribute__((ext_vector_type(2)));
typedef unsigned u32x4 __attribute__((ext_vector_type(4)));
typedef unsigned u32x2 __attribute__((ext_vector_type(2)));

constexpr int T_TOK = 16384, DM = 2048, SEQ = 4096, NB = 4, DFF = 8192, PLE = 256;
constexpr int AB_IN = 3072, C_IN = 5168, C_INP = 5376;
constexpr float EPSV = 1e-6f;
constexpr float LOG2E = 1.4426950408889634f;

__device__ __forceinline__ unsigned f2bf(float f) { unsigned u = __builtin_bit_cast(unsigned, f); return (u + 0x7fffu + ((u >> 16) & 1u)) >> 16; }
__device__ __forceinline__ unsigned pk2(float lo, float hi) { unsigned r; asm volatile("v_cvt_pk_bf16_f32 %0, %1, %2" : "=v"(r) : "v"(lo), "v"(hi)); return r; }
__device__ __forceinline__ float bf2f(unsigned short b) { return __builtin_bit_cast(float, ((unsigned)b) << 16); }
__device__ __forceinline__ float bflo(unsigned w) { return __builtin_bit_cast(float, w << 16); }
__device__ __forceinline__ float bfhi(unsigned w) { return __builtin_bit_cast(float, w & 0xffff0000u); }
__device__ __forceinline__ float shx(float v, int lane, int o) { return __builtin_bit_cast(float, __builtin_amdgcn_ds_bpermute((lane ^ o) << 2, __builtin_bit_cast(int, v))); }
__device__ __forceinline__ float wave_sum(float v, int lane) {
#pragma unroll
    for (int o = 1; o < 64; o <<= 1) v += shx(v, lane, o);
    return v;
}
__device__ __forceinline__ float sigmoidf_(float x) { return 1.0f / (1.0f + __expf(-x)); }
__device__ __forceinline__ float gelu_tanh(float x) {
    const float u = 0.7978845608028654f * (x + 0.044715f * x * x * x);
    const float e = __expf(2.0f * u);
    const float th = 1.0f - 2.0f / (e + 1.0f);
    return 0.5f * x * (1.0f + th);
}

__device__ __forceinline__ unsigned char* opqp(unsigned char* p) { size_t z = 0; asm volatile("" : "+s"(z)); return p + z; }
__device__ __forceinline__ int opq(int v) { asm volatile("" : "+s"(v)); return v; }
__device__ __forceinline__ int opaque_tid() { int t = threadIdx.x; asm volatile("" : "+v"(t)); return t; }
namespace pg8 {
constexpr int BM = 256, BK = 64, HALF = 128, HTB = HALF * BK * 2, STAGE_BYTES = 8 * HTB, NXCD = 8, WGM = 8;
__host__ __device__ __forceinline__ int lds_byte(int r, int c) { const int st = (r >> 4) * 2 + (c >> 5), rr = r & 15, cc = c & 31, ob = rr * 64 + cc * 2; return st * 1024 + (ob ^ (((ob >> 9) & 1) << 5)); }
__host__ __device__ __forceinline__ void stage_rc(int b, int& R, int& C) { const int st = b / 1024, sb = b % 1024, swz = sb ^ (((sb >> 9) & 1) << 5); R = (st >> 1) * 16 + swz / 64; C = (st & 1) * 32 + (swz % 64) / 2; }
__host__ __device__ __forceinline__ int perm32(int rho) { const int n = rho >> 4, i = rho & 15; return 8 * (i >> 2) + 4 * n + (i & 3); }

struct Unit { int pm, pn; };
struct Gemm { const bf16_t* A; const bf16_t* Bt; int M, N, K, lda, ldb; };

struct StaticOrder {
    int nM, nN, nwg, G, c;
    __device__ void init(int M, int N, int G_, int c_) { nM = M / BM; nN = N / BM; nwg = nM * nN; G = G_; c = c_; }
    __device__ bool next(int i, Unit& u) const {
        const long L = (long)i * G + c; if (L >= nwg || c < 0) return false;
        int wgid = (int)L; { const int q = nwg / NXCD, r = nwg % NXCD, xcd = wgid % NXCD, off = wgid / NXCD; wgid = (xcd < r ? xcd * (q + 1) : r * (q + 1) + (xcd - r) * q) + off; }
        const int nig = WGM * nN, gid = wgid / nig, fm = gid * WGM, gsz = (nM - fm) < WGM ? (nM - fm) : WGM;
        u.pm = fm + ((wgid % nig) % gsz); u.pn = (wgid % nig) / gsz; return true;
    }
};

template <class Epi, class Sched>
__device__ __forceinline__ void gemm_phase(LAS unsigned char* lds, const Gemm g, const Sched& S, const Epi& E) {
    const int tid = opaque_tid(), wid = __builtin_amdgcn_readfirstlane(tid >> 6), lane = tid & 63, wr = wid >> 2, wc = wid & 3, fr = lane & 15, fq = lane >> 4;
    const int K = g.K, nt = K / BK;
    unsigned voffA[2], voffB[2];
#pragma unroll
    for (int i = 0; i < 2; ++i) { int R, C; stage_rc(tid * 16 + i * 8192, R, C); const int Rb = Epi::PERM ? ((R & ~31) + perm32(R & 31)) : R;
        voffA[i] = (unsigned)(R * g.lda + C) * 2u; voffB[i] = (unsigned)(Rb * g.ldb + C) * 2u; }
    const size_t kstep = (size_t)(BK * 2);
    const size_t hstepA = (size_t)HALF * g.lda * 2, hstepB = (size_t)HALF * g.ldb * 2;
    const size_t tstepA = 2 * hstepA, tstepB = 2 * hstepB;
    const unsigned ldsw = (unsigned)wid * 1024u;
    const int aoff = lds_byte(wr * 64 + fr, fq * 8), boff = lds_byte(wc * 32 + fr, fq * 8);
#define PG8_SA(b, h) (((b) * 2 + (h)) * HTB)
#define PG8_SB(b, h) ((4 + (b) * 2 + (h)) * HTB)
#define PG8_STAGE(bufoff, gbase, voff) do { _Pragma("unroll") for (int _i = 0; _i < 2; ++_i) \
        __builtin_amdgcn_global_load_lds((const unsigned*)((const char*)(gbase) + (voff)[_i]), (LAS unsigned*)(lds + (bufoff) + ldsw + _i * 8192), 16, 0, 0); } while (0)
#define PG8_LDA(dst, b, h) do { _Pragma("unroll") for (int m = 0; m < 4; ++m) _Pragma("unroll") for (int k = 0; k < 2; ++k) dst[m][k] = *(const LAS bf16x8*)(lds + PG8_SA(b, h) + aoff + m * 2048 + k * 1024); } while (0)
#define PG8_LDB(dst, b, h) do { _Pragma("unroll") for (int n = 0; n < 2; ++n) _Pragma("unroll") for (int k = 0; k < 2; ++k) dst[n][k] = *(const LAS bf16x8*)(lds + PG8_SB(b, h) + boff + n * 2048 + k * 1024); } while (0)
#define PG8_MMA(ai, bj, At, Bt) do { __builtin_amdgcn_s_setprio(1); _Pragma("unroll") for (int m = 0; m < 4; ++m) _Pragma("unroll") for (int n = 0; n < 2; ++n) _Pragma("unroll") for (int k = 0; k < 2; ++k) \
        acc[ai][bj][m][n] = __builtin_amdgcn_mfma_f32_16x16x32_bf16(Bt[n][k], At[m][k], acc[ai][bj][m][n], 0, 0, 0); __builtin_amdgcn_s_setprio(0); } while (0)
#define PG8_WAIT_V(n) asm volatile("s_waitcnt vmcnt(" #n ")" ::: "memory")
#define PG8_WAIT_L(n) asm volatile("s_waitcnt lgkmcnt(" #n ")" ::: "memory")
#define PG8_BAR __builtin_amdgcn_s_barrier()
#define PG8_SCHED __builtin_amdgcn_sched_barrier(0)
    Unit cur, nxt; int ui = 0;
    if (!S.next(0, cur)) return;
    f32x4 acc[2][2][4][2];
#pragma unroll
    for (int a = 0; a < 2; ++a)
#pragma unroll
        for (int b = 0; b < 2; ++b)
#pragma unroll
            for (int m = 0; m < 4; ++m)
#pragma unroll
                for (int n = 0; n < 2; ++n) acc[a][b][m][n] = (f32x4){0.f, 0.f, 0.f, 0.f};
    bf16x8 At[4][2], B0[2][2], B1[2][2];
    const char* cA = (const char*)g.A + (size_t)cur.pm * tstepA; const char* cB = (const char*)g.Bt + (size_t)cur.pn * tstepB;
    PG8_STAGE(PG8_SB(0, 0), cB, voffB); PG8_STAGE(PG8_SB(0, 1), cB + hstepB, voffB); PG8_STAGE(PG8_SA(0, 0), cA, voffA); PG8_STAGE(PG8_SA(0, 1), cA + hstepA, voffA);
    if (wr == 1) PG8_BAR;
    PG8_WAIT_V(2); PG8_BAR;
    PG8_STAGE(PG8_SB(1, 0), cB + kstep, voffB); PG8_STAGE(PG8_SA(1, 0), cA + kstep, voffA); PG8_STAGE(PG8_SB(1, 1), cB + hstepB + kstep, voffB);
    PG8_WAIT_V(6); PG8_BAR;
    for (;;) {
        const bool has_next = S.next(ui + 1, nxt);
        const char* nA = has_next ? (const char*)g.A + (size_t)nxt.pm * tstepA : cA; const char* nB = has_next ? (const char*)g.Bt + (size_t)nxt.pn * tstepB : cB;
        for (int t = 0; t < nt; t += 2) {
            const bool last = (t == nt - 2);
            const char* a1 = cA + (size_t)(t + 1) * kstep;
            const char* a2 = last ? nA : cA + (size_t)(t + 2) * kstep; const char* b2 = last ? nB : cB + (size_t)(t + 2) * kstep;
            const char* a3 = a2 + kstep; const char* b3 = b2 + kstep;
            PG8_LDB(B0, 0, 0); PG8_LDB(B1, 0, 1); PG8_SCHED; PG8_LDA(At, 0, 0); PG8_STAGE(PG8_SA(1, 1), a1 + hstepA, voffA);
            PG8_WAIT_V(8); PG8_WAIT_L(0); PG8_BAR; PG8_MMA(0, 0, At, B0); PG8_MMA(0, 1, At, B1); PG8_BAR; PG8_SCHED;
            PG8_LDA(At, 0, 1); PG8_STAGE(PG8_SB(0, 0), b2, voffB); PG8_STAGE(PG8_SB(0, 1), b2 + hstepB, voffB); PG8_STAGE(PG8_SA(0, 0), a2, voffA);
            PG8_WAIT_V(8); PG8_WAIT_L(0); PG8_BAR; PG8_MMA(1, 0, At, B0); PG8_MMA(1, 1, At, B1); PG8_BAR; PG8_SCHED;
            PG8_LDB(B0, 1, 0); PG8_LDB(B1, 1, 1); PG8_SCHED; PG8_LDA(At, 1, 0); PG8_STAGE(PG8_SA(0, 1), a2 + hstepA, voffA);
            PG8_WAIT_V(8); PG8_WAIT_L(0); PG8_BAR; PG8_MMA(0, 0, At, B0); PG8_MMA(0, 1, At, B1); PG8_BAR; PG8_SCHED;
            PG8_LDA(At, 1, 1); PG8_STAGE(PG8_SB(1, 0), b3, voffB); PG8_STAGE(PG8_SB(1, 1), b3 + hstepB, voffB); PG8_STAGE(PG8_SA(1, 0), a3, voffA);
            PG8_WAIT_V(8); PG8_WAIT_L(0); PG8_BAR; PG8_MMA(1, 0, At, B0); PG8_MMA(1, 1, At, B1); PG8_BAR; PG8_SCHED;
        }
        if (wr == 0) PG8_BAR;
        { const int tl = opaque_tid() & 63; E(acc, cur, wr, wc, tl & 15, tl >> 4); }
        if (!has_next) break;
#pragma unroll
        for (int a = 0; a < 2; ++a)
#pragma unroll
            for (int b = 0; b < 2; ++b)
#pragma unroll
                for (int m = 0; m < 4; ++m)
#pragma unroll
                    for (int n = 0; n < 2; ++n) acc[a][b][m][n] = (f32x4){0.f, 0.f, 0.f, 0.f};
        cur = nxt; cA = nA; cB = nB; ++ui;
        if (wr == 1) PG8_BAR;
    }
    PG8_WAIT_V(0);
    PG8_BAR;
#undef PG8_SA
#undef PG8_SB
#undef PG8_STAGE
#undef PG8_LDA
#undef PG8_LDB
#undef PG8_MMA
#undef PG8_WAIT_V
#undef PG8_WAIT_L
#undef PG8_BAR
#undef PG8_SCHED
}
}
using pg8::Unit; using pg8::HALF; using pg8::BM;


#define XB_TMO      128
#define XB_XCNT(j)  (256  + 64 * (j))
#define XB_XSUB(j)  (1280 + 64 * (j))
#define XB_XGEN(j)  (2304 + 64 * (j))
#define XB_TOP      3328
#define XB_TOPGEN   3392
#define XCD_BAR_WORDS 3456
#define XB_SPIN_CAP (1u << 18)
__device__ __forceinline__ unsigned xb_ld(unsigned* p)              { return __hip_atomic_load(p, __ATOMIC_RELAXED, __HIP_MEMORY_SCOPE_AGENT); }
__device__ __forceinline__ unsigned xb_add(unsigned* p, unsigned v) { return __hip_atomic_fetch_add(p, v, __ATOMIC_RELAXED, __HIP_MEMORY_SCOPE_AGENT); }
__device__ __forceinline__ unsigned xb_xcc_id() { return (unsigned)__builtin_amdgcn_s_getreg((3 << 11) | 20) & 0xFu; }
#define XB_SPIN(cond, bar) do { unsigned _sp = 0; while (cond) { __builtin_amdgcn_s_sleep(1); \
    if ((++_sp & 255u) == 0u) { if (xb_ld(&(bar)[XB_TMO])) break; if (_sp > XB_SPIN_CAP) { atomicAdd(&(bar)[XB_TMO], 1u); break; } } } } while (0)
struct XcdBarrier { unsigned* bar; unsigned x; volatile LAS unsigned* st; };
__device__ __forceinline__ XcdBarrier xcd_barrier_post(unsigned* bar, volatile LAS unsigned* st) {
    XcdBarrier b; b.bar = bar; b.x = xb_xcc_id(); b.st = st;
    if (threadIdx.x == 0) (void)xb_add(&bar[XB_XCNT(b.x)], 1u);
    return b;
}
__device__ __forceinline__ void xcd_barrier_complete(unsigned* bar, unsigned x, unsigned& nloc, unsigned& nx) {
    const unsigned G = gridDim.x * gridDim.y * gridDim.z;
    unsigned sum, cnt, mine, sp = 0u;
    for (;;) {
        sum = 0u; cnt = 0u; mine = 0u;
#pragma unroll
        for (unsigned j = 0; j < 16; ++j) { const unsigned c = xb_ld(&bar[XB_XCNT(j)]); sum += c; cnt += (c > 0u) ? 1u : 0u; mine = (j == x) ? c : mine; }
        if (sum == G) break;
        __builtin_amdgcn_s_sleep(1);
        if ((++sp & 255u) == 0u) { if (xb_ld(&bar[XB_TMO])) break; if (sp > XB_SPIN_CAP) { atomicAdd(&bar[XB_TMO], 1u); break; } }
    }
    nloc = mine > 0u ? mine : 1u; nx = cnt > 0u ? cnt : 1u;
}
__device__ __forceinline__ void xcd_barrier(const XcdBarrier& b) {
    asm volatile("s_waitcnt vmcnt(0)" ::: "memory");
    __syncthreads();
    if (threadIdx.x == 0) {
        unsigned* bar = b.bar;
        __builtin_amdgcn_s_waitcnt(0);
        unsigned nloc = b.st[0], nx = b.st[1];
        if (nloc == 0u) { xcd_barrier_complete(bar, b.x, nloc, nx); b.st[0] = nloc; b.st[1] = nx; }
        const unsigned old = xb_add(&bar[XB_XSUB(b.x)], 1u);
        const unsigned gen = old / nloc;
        if (old + 1u == (gen + 1u) * nloc) {
            __builtin_amdgcn_fence(__ATOMIC_RELEASE, "agent");
            asm volatile("s_waitcnt vmcnt(0)" ::: "memory");
            const unsigned og = xb_add(&bar[XB_TOP], 1u);
            const unsigned tg = og / nx;
            if (og + 1u == (tg + 1u) * nx) xb_add(&bar[XB_TOPGEN], 1u);
            else XB_SPIN(xb_ld(&bar[XB_TOPGEN]) == tg, bar);
            __builtin_amdgcn_fence(__ATOMIC_ACQUIRE, "agent");
            xb_add(&bar[XB_XGEN(b.x)], 1u);
            asm volatile("s_waitcnt vmcnt(0)" ::: "memory");
        } else {
            XB_SPIN(xb_ld(&bar[XB_XGEN(b.x)]) == gen, bar);
            __builtin_amdgcn_fence(__ATOMIC_ACQUIRE, "agent");
            asm volatile("s_waitcnt vmcnt(0)" ::: "memory");
        }
    }
    __syncthreads();
}

__device__ __forceinline__ float row_rstd(const float* rp, int row, int fq, int lane) {
    const f32x4 a = *(const f32x4*)(rp + (size_t)row * 32 + fq * 8), b = *(const f32x4*)(rp + (size_t)row * 32 + fq * 8 + 4);
    float s = ((a[0] + a[1]) + (a[2] + a[3])) + ((b[0] + b[1]) + (b[2] + b[3]));
    s += shx(s, lane, 16); s += shx(s, lane, 32);
    return rsqrtf(s * (1.f / DM) + EPSV);
}
template <int ACT  > struct EpiBf16 {
    static constexpr bool PERM = true;
    bf16_t* O; int ldc; const float* bias; const float* rss;
    __device__ __forceinline__ void operator()(const f32x4 (&acc)[2][2][4][2], const Unit& u, int wr, int wc, int fr, int fq) const {
        const int row0 = u.pm * BM + wr * 64 + fr, col0 = u.pn * BM + wc * 32 + 8 * fq;
        f32x4 bv[2][2];
#pragma unroll
        for (int bj = 0; bj < 2; ++bj)
#pragma unroll
            for (int n = 0; n < 2; ++n) bv[bj][n] = (ACT == 2) ? *(const f32x4*)(bias + col0 + bj * HALF + 4 * n) : (f32x4){0.f, 0.f, 0.f, 0.f};
        float rsv[2][4];
#pragma unroll
        for (int ai = 0; ai < 2; ++ai)
#pragma unroll
            for (int m = 0; m < 4; ++m) rsv[ai][m] = rss ? row_rstd(rss, row0 + ai * HALF + m * 16, fq, fq * 16 + fr) : 1.f;
        asm volatile("" ::: "memory");
#pragma unroll
        for (int ai = 0; ai < 2; ++ai)
#pragma unroll
            for (int m = 0; m < 4; ++m) { bf16_t* rowp = O + (size_t)(row0 + ai * HALF + m * 16) * ldc + col0;
                const float rs = rsv[ai][m];
#pragma unroll
                for (int bj = 0; bj < 2; ++bj) { f32x4 v0 = acc[ai][bj][m][0] * rs + bv[bj][0], v1 = acc[ai][bj][m][1] * rs + bv[bj][1];
                    if (ACT == 1) {
#pragma unroll
                        for (int j = 0; j < 4; ++j) { const float a = fmaxf(v0[j], 0.f), b = fmaxf(v1[j], 0.f); v0[j] = a * a; v1[j] = b * b; } }
                    if (ACT == 2) {
#pragma unroll
                        for (int j = 0; j < 4; ++j) { v0[j] = gelu_tanh(v0[j]); v1[j] = gelu_tanh(v1[j]); } }
                    u32x4 w; w.x = pk2(v0[0], v0[1]); w.y = pk2(v0[2], v0[3]); w.z = pk2(v1[0], v1[1]); w.w = pk2(v1[2], v1[3]);
                    *(u32x4*)(rowp + bj * HALF) = w; } }
    }
};
template <int MODE> struct EpiF32 {
    static constexpr bool PERM = false;
    const float* base; float* out; const float* pp; int ldc; bf16_t* hb; float* rss_out; const float* rss_in;
    __device__ __forceinline__ void operator()(const f32x4 (&acc)[2][2][4][2], const Unit& u, int wr, int wc, int fr, int fq) const {
        const int row0 = u.pm * BM + wr * 64 + fr, col0 = u.pn * BM + wc * 32 + 4 * fq; const int lane = fq * 16 + fr;
        float rinv[8];
#pragma unroll
        for (int g = 0; g < 8; ++g) rinv[g] = (MODE == 1) ? row_rstd(rss_in, row0 + (g >> 2) * HALF + (g & 3) * 16, fq, lane) : 1.f;
        f32x4 bc[4], pc[4];
        if (MODE != 2) {
#pragma unroll
            for (int q = 0; q < 4; ++q) { const size_t o2 = (size_t)row0 * ldc + col0 + (q >> 1) * HALF + (q & 1) * 16; bc[q] = *(const f32x4*)(base + o2); if (MODE == 1) pc[q] = *(const f32x4*)(pp + o2); } }
#pragma unroll
        for (int g = 0; g < 8; ++g) { const int ai = g >> 2, m = g & 3; const int row = row0 + ai * HALF + m * 16; const size_t off = (size_t)row * ldc + col0;
            f32x4 av[4];
#pragma unroll
            for (int q = 0; q < 4; ++q) { f32x4 a = acc[ai][q >> 1][m][q & 1];
                if (MODE == 0) a = a + bc[q];
                if (MODE == 1) {
#pragma unroll
                    for (int j = 0; j < 4; ++j) a[j] = bc[q][j] + sigmoidf_(a[j] * rinv[g]) * pc[q][j]; }
                av[q] = a; }
            if (MODE != 2) { asm volatile("" : "+v"(av[0]), "+v"(av[1]), "+v"(av[2]), "+v"(av[3]));
                if (g < 7) { const int rown = row0 + ((g + 1) >> 2) * HALF + ((g + 1) & 3) * 16;
#pragma unroll
                    for (int q = 0; q < 4; ++q) { const size_t o2 = (size_t)rown * ldc + col0 + (q >> 1) * HALF + (q & 1) * 16; bc[q] = *(const f32x4*)(base + o2); if (MODE == 1) pc[q] = *(const f32x4*)(pp + o2); } }
                asm volatile("" ::: "memory"); }
            float ss = 0.f;
#pragma unroll
            for (int q = 0; q < 4; ++q) { const size_t o2 = off + (q >> 1) * HALF + (q & 1) * 16; const f32x4 a = av[q];
                *(f32x4*)(out + o2) = a;
                if (MODE != 2) { ss += (a[0] * a[0] + a[1] * a[1]) + (a[2] * a[2] + a[3] * a[3]); u32x2 w; w.x = pk2(a[0], a[1]); w.y = pk2(a[2], a[3]); *(u32x2*)(hb + o2) = w; } }
            if (MODE != 2) { ss += shx(ss, lane, 16); ss += shx(ss, lane, 32); if (fq == 0) rss_out[(size_t)row * 32 + u.pn * 4 + wc] = ss; }
        }
    }
};
struct EpiNsa {
    static constexpr bool PERM = true;
    bf16_t *Q, *KC, *VC, *KS, *VST, *KW, *VWT; float* GL; const float* rss;
    __device__ __forceinline__ void operator()(const f32x4 (&acc)[2][2][4][2], const Unit& u, int wr, int wc, int fr, int fq) const {
        const int row0 = u.pm * BM + wr * 64 + fr; const int pn = u.pn;
        float rsv[2][4];
#pragma unroll
        for (int ai = 0; ai < 2; ++ai)
#pragma unroll
            for (int m = 0; m < 4; ++m) rsv[ai][m] = row_rstd(rss, row0 + ai * HALF + m * 16, fq, fq * 16 + fr);
        asm volatile("" ::: "memory");
#pragma unroll
        for (int ai = 0; ai < 2; ++ai)
#pragma unroll
            for (int m = 0; m < 4; ++m) { const int row = row0 + ai * HALF + m * 16; const int b = row >> 12, s = row & 4095;
                const float rs = rsv[ai][m];
#pragma unroll
                for (int bj = 0; bj < 2; ++bj) { const f32x4 v0 = acc[ai][bj][m][0] * rs, v1 = acc[ai][bj][m][1] * rs;
                    const int cl = bj * HALF + wc * 32 + 8 * fq;
                    if (pn < 8) { u32x4 w; w.x = pk2(v0[0], v0[1]); w.y = pk2(v0[2], v0[3]); w.z = pk2(v1[0], v1[1]); w.w = pk2(v1[2], v1[3]);
                        *(u32x4*)(Q + (size_t)row * 2048 + pn * 256 + cl) = w; }
                    else if (pn < 20) { const int k = (pn - 8) >> 1; const int c = ((pn - 8) & 1) * 256 + cl; const int g = c >> 7, d = c & 127;
                        if (k == 3 || k == 5) { bf16_t* dst = (k == 3 ? VST : VWT) + ((size_t)((b * 4 + g) * 128 + d)) * 4096 + s;
#pragma unroll
                            for (int j = 0; j < 4; ++j) { dst[(size_t)j * 4096] = (bf16_t)f2bf(v0[j]); dst[(size_t)(4 + j) * 4096] = (bf16_t)f2bf(v1[j]); } }
                        else { bf16_t* dst = (k == 0 ? KC : k == 1 ? VC : k == 2 ? KS : KW) + ((size_t)((b * 4 + g) * 4096 + s)) * 128 + d;
                            u32x4 w; w.x = pk2(v0[0], v0[1]); w.y = pk2(v0[2], v0[3]); w.z = pk2(v1[0], v1[1]); w.w = pk2(v1[2], v1[3]);
                            *(u32x4*)dst = w; } }
                    else { if (cl < 48) { float* dst = GL + (size_t)row * 48 + cl;
                            f32x4 a, c2;
#pragma unroll
                            for (int j = 0; j < 4; ++j) { a[j] = sigmoidf_(v0[j]); c2[j] = sigmoidf_(v1[j]); }
                            *(f32x4*)dst = a; *(f32x4*)(dst + 4) = c2; } } } }
    }
};
template <int TR> struct EpiCmp2 {
    static constexpr bool PERM = true;
    bf16_t* O;
    __device__ __forceinline__ void operator()(const f32x4 (&acc)[2][2][4][2], const Unit& u, int wr, int wc, int fr, int fq) const {
        const int row0 = u.pm * BM + wr * 64 + fr; const int cl = wc * 32 + 8 * fq;
#pragma unroll
        for (int ai = 0; ai < 2; ++ai)
#pragma unroll
            for (int m = 0; m < 4; ++m) { const int row = row0 + ai * HALF + m * 16; const f32x4 v0 = acc[ai][0][m][0], v1 = acc[ai][0][m][1];
                if (TR == 0) { u32x4 w; w.x = pk2(v0[0], v0[1]); w.y = pk2(v0[2], v0[3]); w.z = pk2(v1[0], v1[1]); w.w = pk2(v1[2], v1[3]);
                    *(u32x4*)(O + (size_t)row * 128 + cl) = w; }
                else { bf16_t* dst = O + ((size_t)((row >> 8) * 128 + cl)) * 256 + (row & 255);
#pragma unroll
                    for (int j = 0; j < 4; ++j) { dst[(size_t)j * 256] = (bf16_t)f2bf(v0[j]); dst[(size_t)(4 + j) * 256] = (bf16_t)f2bf(v1[j]); } } }
    }
};

constexpr size_t al256(size_t x) { return (x + 255) & ~(size_t)255; }
constexpr size_t SZ_WIN = (size_t)AB_IN * DM * 2, SZ_SQ = (size_t)DM * DM * 2, SZ_CIN = (size_t)C_INP * DM * 2, SZ_W1 = (size_t)512 * 4096 * 2, SZ_W2 = (size_t)256 * 512 * 2;
constexpr size_t SZ_UP = (size_t)DFF * DM * 2, SZ_WP = (size_t)DM * PLE * 2, SZ_WRI = (size_t)16 * 64 * 64 * 2, SZ_POOLT = (size_t)4 * 256 * 256 * 2, SZ_WU = (size_t)DM * 1024 * 2;
constexpr size_t WS_WIN = 0;
constexpr size_t WS_WOUT = WS_WIN + 2 * SZ_WIN;
constexpr size_t WS_CIN = WS_WOUT + 2 * SZ_SQ;
constexpr size_t WS_COUT = WS_CIN + 2 * SZ_CIN;
constexpr size_t WS_W1K = WS_COUT + 2 * SZ_SQ;
constexpr size_t WS_W1V = WS_W1K + 2 * SZ_W1;
constexpr size_t WS_W2K = WS_W1V + 2 * SZ_W1;
constexpr size_t WS_W2V = WS_W2K + 2 * SZ_W2;
constexpr size_t WS_WUP = WS_W2V + 2 * SZ_W2;
constexpr size_t WS_WDN = WS_WUP + 4 * SZ_UP;
constexpr size_t WS_WG = WS_WDN + 4 * SZ_UP;
constexpr size_t WS_WP = WS_WG + 4 * SZ_SQ;
constexpr size_t WS_WR = WS_WP + 4 * SZ_WP;
constexpr size_t WS_WI = WS_WR + 2 * SZ_WRI;
constexpr size_t WS_POOLT = WS_WI + 2 * SZ_WRI;
constexpr size_t WS_WU = WS_POOLT + 2 * SZ_POOLT;
constexpr size_t WS_PB = WS_WU + 2 * SZ_WU;
constexpr size_t WS_POSB = WS_PB + (size_t)4 * T_TOK * PLE * 2;
constexpr size_t WS_XN = WS_POSB + 8192;
constexpr size_t WS_YB = WS_XN + (size_t)T_TOK * DM * 2;
constexpr size_t WS_Z = WS_YB + (size_t)T_TOK * DM * 2;
constexpr size_t SZ_KV = (size_t)16 * 4096 * 128 * 2;
constexpr size_t Z_Q = 0, Z_KC = (size_t)T_TOK * DM * 2, Z_VC = Z_KC + SZ_KV, Z_KS = Z_VC + SZ_KV, Z_VST = Z_KS + SZ_KV, Z_KW = Z_VST + SZ_KV, Z_VWT = Z_KW + SZ_KV;
constexpr size_t Z_GL = Z_VWT + SZ_KV, Z_HIDK = Z_GL + (size_t)T_TOK * 48 * 4, Z_HIDV = Z_HIDK + (size_t)4096 * 512 * 2, Z_KCMP = Z_HIDV + (size_t)4096 * 512 * 2, Z_VCMPT = Z_KCMP + (size_t)4096 * 128 * 2;
constexpr size_t WS_BAR = WS_Z + (size_t)T_TOK * DFF * 2;
constexpr size_t WS_ROWSS = WS_BAR + XCD_BAR_WORDS * 4 + 256;
constexpr size_t WS_PP = WS_ROWSS + (size_t)13 * T_TOK * 32 * 4;
constexpr size_t WS_END = WS_PP + (size_t)T_TOK * DM * 4;
static_assert(Z_VCMPT + 4096 * 128 * 2 <= (size_t)T_TOK * DFF * 2, "z region");
static_assert(WS_END <= (size_t)1 << 30, "workspace");
constexpr int LDS_BYTES = 147456;

struct Args { const float* in[29]; float* out; unsigned char* ws; int lo, hi, one, pad; };

__device__ __forceinline__ void titem_load(float (&v)[32], const float* W, int N, int ldw, int item, int lane) {
    const int nblk = (N + 31) / 32, kb = item / nblk, nb = item % nblk, k0 = 64 * kb, n0 = 32 * nb;
    const int nn = n0 + (lane & 31); const bool ok = nn < N;
    const float* p = W + (size_t)(k0 + (lane >> 5)) * ldw + nn;
#pragma unroll
    for (int i = 0; i < 32; ++i) v[i] = ok ? p[(size_t)(2 * i) * ldw] : 0.f;
}
__device__ __forceinline__ void titem_store(const float (&v)[32], int N, bf16_t* WT, int ldt, LAS float* scr, int item, int lane, const float* gk) {
    const int nblk = (N + 31) / 32, kb = item / nblk, nb = item % nblk, k0 = 64 * kb, n0 = 32 * nb;
#pragma unroll
    for (int i = 0; i < 32; ++i) scr[(2 * i + (lane >> 5)) * 33 + (lane & 31)] = v[i];
    asm volatile("s_waitcnt lgkmcnt(0)" ::: "memory");
    const int c = lane & 7;
    f32x4 g0 = (f32x4){1.f, 1.f, 1.f, 1.f}, g1 = g0; if (gk) { g0 = *(const f32x4*)(gk + k0 + 8 * c); g1 = *(const f32x4*)(gk + k0 + 8 * c + 4); }
#pragma unroll
    for (int j = 0; j < 4; ++j) { const int n = (lane >> 3) + 8 * j; const LAS float* s = scr + (8 * c) * 33 + n;
        u32x4 o; o.x = pk2(s[0 * 33] * g0[0], s[1 * 33] * g0[1]); o.y = pk2(s[2 * 33] * g0[2], s[3 * 33] * g0[3]); o.z = pk2(s[4 * 33] * g1[0], s[5 * 33] * g1[1]); o.w = pk2(s[6 * 33] * g1[2], s[7 * 33] * g1[3]);
        if (n0 + n < N) *(u32x4*)(WT + (size_t)(n0 + n) * ldt + k0 + 8 * c) = o; }
    asm volatile("s_waitcnt lgkmcnt(0)" ::: "memory");
}
__device__ __forceinline__ void conv_mat(const float* W, int K, int N, int ldw, bf16_t* WT, int ldt, LAS float* scr, int gw, int NGW, int lane, int& rot, const float* gk = nullptr) {
    const int nitems = (K / 64) * ((N + 31) / 32);
    int it = gw - rot; if (it < 0) it += NGW;
    rot = (rot + nitems) % NGW;
    if (it >= nitems) return;
    float va[32], vb[32];
    titem_load(va, W, N, ldw, it, lane);
    for (;;) {
        const int n1 = it + NGW; if (n1 < nitems) titem_load(vb, W, N, ldw, n1, lane);
        titem_store(va, N, WT, ldt, scr, it, lane, gk);
        if (n1 >= nitems) break;
        const int n2 = n1 + NGW; if (n2 < nitems) titem_load(va, W, N, ldw, n2, lane);
        titem_store(vb, N, WT, ldt, scr, n1, lane, gk);
        if (n2 >= nitems) break;
        it = n2;
    }
}
__device__ __forceinline__ void conv_plain(const float* src, int rows, int ncols, int lds_, bf16_t* dst, int ldd, int gt, int NGT, const float* gk = nullptr) {
    const int cpr = ncols / 8; const long total = (long)rows * cpr;
    for (long i = gt; i < total; i += NGT) { const int r = (int)(i / cpr), c = (int)(i % cpr) * 8;
        f32x4 a = *(const f32x4*)(src + (size_t)r * lds_ + c), b = *(const f32x4*)(src + (size_t)r * lds_ + c + 4);
        if (gk) { const float gg = gk[r]; a = a * gg; b = b * gg; }
        u32x4 o; o.x = f2bf(a[0]) | (f2bf(a[1]) << 16); o.y = f2bf(a[2]) | (f2bf(a[3]) << 16); o.z = f2bf(b[0]) | (f2bf(b[1]) << 16); o.w = f2bf(b[2]) | (f2bf(b[3]) << 16);
        *(u32x4*)(dst + (size_t)r * ldd + c) = o; }
}
__device__ __forceinline__ void zero_fill16(unsigned char* p, size_t bytes, int gt, int NGT) {
    const u32x4 z = (u32x4){0u, 0u, 0u, 0u};
    for (size_t i = (size_t)gt * 16; i < bytes; i += (size_t)NGT * 16) *(u32x4*)(p + i) = z;
}

template <bool F32OUT>
__device__ __forceinline__ void rmsnorm_rows(const float* X, const float* g, bf16_t* O, float* OF, int bx, int NGW) {
    asm volatile("" ::: "memory"); const int tid = opaque_tid(), lane = tid & 63; const int gw = opq(bx) * 8 + __builtin_amdgcn_readfirstlane(tid >> 6);
    f32x4 gv[8];
#pragma unroll
    for (int j = 0; j < 8; ++j) gv[j] = *(const f32x4*)(g + (lane + 64 * j) * 4);
    for (int r = gw; r < T_TOK; r += NGW) {
        const float* xr = X + (size_t)r * DM; f32x4 v[8]; float s = 0.f;
#pragma unroll
        for (int j = 0; j < 8; ++j) { v[j] = *(const f32x4*)(xr + (lane + 64 * j) * 4); s += (v[j][0] * v[j][0] + v[j][1] * v[j][1]) + (v[j][2] * v[j][2] + v[j][3] * v[j][3]); }
        const float rstd = rsqrtf(wave_sum(s, lane) * (1.f / DM) + EPSV);
#pragma unroll
        for (int j = 0; j < 8; ++j) { const f32x4 y = v[j] * rstd * gv[j];
            if (F32OUT) *(f32x4*)(OF + (size_t)r * DM + (lane + 64 * j) * 4) = y;
            else { u32x2 w; w.x = pk2(y[0], y[1]); w.y = pk2(y[2], y[3]); *(u32x2*)(O + (size_t)r * DM + (lane + 64 * j) * 4) = w; } }
    }
}

__device__ __forceinline__ void rows_to_bf16_ss(const float* X, bf16_t* O, float* rss, int bx, int NGW) {
    const int tid = opaque_tid(), lane = tid & 63; const int gw = opq(bx) * 8 + __builtin_amdgcn_readfirstlane(tid >> 6);
    for (int r = gw; r < T_TOK; r += NGW) {
        const float* xr = X + (size_t)r * DM; f32x4 v[8]; float s = 0.f;
#pragma unroll
        for (int j = 0; j < 8; ++j) { v[j] = *(const f32x4*)(xr + (lane + 64 * j) * 4); s += (v[j][0] * v[j][0] + v[j][1] * v[j][1]) + (v[j][2] * v[j][2] + v[j][3] * v[j][3]); }
        s = wave_sum(s, lane); if (lane < 32) rss[(size_t)r * 32 + lane] = (lane == 0) ? s : 0.f;
#pragma unroll
        for (int j = 0; j < 8; ++j) { u32x2 w; w.x = pk2(v[j][0], v[j][1]); w.y = pk2(v[j][2], v[j][3]); *(u32x2*)(O + (size_t)r * DM + (lane + 64 * j) * 4) = w; }
    }
}
__device__ __forceinline__ void lru_item(LAS unsigned char* lds, int item, const bf16_t* ZE, const float* conv_w, const float* conv_b,
                                         const bf16_t* WrT, const bf16_t* WiT, const float* b_r, const float* b_i, const float* lam, bf16_t* YB) {
    const int tid = opaque_tid(), w = __builtin_amdgcn_readfirstlane(tid >> 6), lane = tid & 63, fr = lane & 15, fq = lane >> 4;
    const int b = item >> 6, hh = (item >> 2) & 15, qq = item & 3;
    LAS unsigned char* XC = lds;
    LAS float* SEGA = (LAS float*)(lds + 36864);
    LAS float* SEGB = SEGA + 1024;
    LAS float* HIN = SEGB + 1024;
    const int co = tid & 7, tr = tid >> 3;
    float cw[4][8], cb[8];
#pragma unroll
    for (int k = 0; k < 4; ++k)
#pragma unroll
        for (int e = 0; e < 8; ++e) cw[k][e] = conv_w[k * 1024 + hh * 64 + co * 8 + e];
#pragma unroll
    for (int e = 0; e < 8; ++e) cb[e] = conv_b[hh * 64 + co * 8 + e];
    bf16x8 wrf[2], wif[2];
#pragma unroll
    for (int kk = 0; kk < 2; ++kk) { wrf[kk] = *(const bf16x8*)(WrT + ((size_t)hh * 64 + qq * 16 + fr) * 64 + kk * 32 + fq * 8); wif[kk] = *(const bf16x8*)(WiT + ((size_t)hh * 64 + qq * 16 + fr) * 64 + kk * 32 + fq * 8); }
    const int ch = hh * 64 + qq * 16 + fr;
    const float br = b_r[ch], bi = b_i[ch];
    const float lm = lam[ch]; float sp8; { const float e = __expf(-lm); const float ser = e * (1.f - e * (0.5f - e * (0.33333333f - e * 0.25f)));
        sp8 = 8.0f * ((-lm > 20.f) ? -lm : (e < 0.03f ? ser : __logf(1.0f + e))); }
    float carry = 0.f;
    const bf16_t* zb = ZE + (size_t)b * SEQ * AB_IN;
    for (int sc = 0; sc < 16; ++sc) {
        const int t0 = sc * 256;
        {
            float xin[7][8];
#pragma unroll
            for (int r = 0; r < 7; ++r) { const int t = t0 + tr * 4 - 3 + r;
                if (t >= 0) { const u32x4 v = *(const u32x4*)(zb + (size_t)t * AB_IN + hh * 64 + co * 8);
                    xin[r][0] = bflo(v.x); xin[r][1] = bfhi(v.x); xin[r][2] = bflo(v.y); xin[r][3] = bfhi(v.y); xin[r][4] = bflo(v.z); xin[r][5] = bfhi(v.z); xin[r][6] = bflo(v.w); xin[r][7] = bfhi(v.w); }
                else {
#pragma unroll
                    for (int e = 0; e < 8; ++e) xin[r][e] = 0.f; } }
#pragma unroll
            for (int q = 0; q < 4; ++q) { float o[8];
#pragma unroll
                for (int e = 0; e < 8; ++e) o[e] = cb[e] + cw[0][e] * xin[q][e] + cw[1][e] * xin[q + 1][e] + cw[2][e] * xin[q + 2][e] + cw[3][e] * xin[q + 3][e];
                u32x4 wv; wv.x = pk2(o[0], o[1]); wv.y = pk2(o[2], o[3]); wv.z = pk2(o[4], o[5]); wv.w = pk2(o[6], o[7]);
                *(LAS u32x4*)(XC + (tr * 4 + q) * 144 + co * 16) = wv; }
        }
        __syncthreads();
        float av[2][4], bv[2][4];
#pragma unroll
        for (int ml = 0; ml < 2; ++ml) { const int mt = w * 2 + ml;
            f32x4 ar = (f32x4){0.f, 0.f, 0.f, 0.f}, ai = ar;
#pragma unroll
            for (int kk = 0; kk < 2; ++kk) { const bf16x8 xa = *(const LAS bf16x8*)(XC + (mt * 16 + fr) * 144 + kk * 64 + fq * 16);
                ar = __builtin_amdgcn_mfma_f32_16x16x32_bf16(xa, wrf[kk], ar, 0, 0, 0); ai = __builtin_amdgcn_mfma_f32_16x16x32_bf16(xa, wif[kk], ai, 0, 0, 0); }
            float A = 1.f, Bc = 0.f;
#pragma unroll
            for (int r = 0; r < 4; ++r) { const int tok = mt * 16 + fq * 4 + r;
                const float xcv = bf2f(*(const LAS unsigned short*)(XC + tok * 144 + (qq * 16 + fr) * 2));
                const float rg = sigmoidf_(ar[r] + br), ig = sigmoidf_(ai[r] + bi);
                const float la = -rg * sp8; const float a = __expf(la); const float x2 = 2.f * la; const float em = (x2 > -0.3f) ? -x2 * (1.f + x2 * 0.5f * (1.f + x2 * 0.33333333f * (1.f + x2 * 0.25f * (1.f + x2 * 0.2f * (1.f + x2 * 0.16666667f))))) : 1.f - __expf(x2);
                const float mult = sqrtf(fmaxf(em, 0.f));
                av[ml][r] = a; bv[ml][r] = mult * ig * xcv;
                Bc = a * Bc + bv[ml][r]; A = A * a; }
            const int sg = mt * 4 + fq; SEGA[sg * 16 + fr] = A; SEGB[sg * 16 + fr] = Bc; }
        __syncthreads();
        if (w == 0 && lane < 16) { float h = carry;
#pragma unroll 8
            for (int sg = 0; sg < 64; ++sg) { HIN[sg * 16 + lane] = h; h = SEGA[sg * 16 + lane] * h + SEGB[sg * 16 + lane]; }
            carry = h; }
        __syncthreads();
#pragma unroll
        for (int ml = 0; ml < 2; ++ml) { const int mt = w * 2 + ml; float h = HIN[(mt * 4 + fq) * 16 + fr];
#pragma unroll
            for (int r = 0; r < 4; ++r) { const int t = t0 + mt * 16 + fq * 4 + r; h = av[ml][r] * h + bv[ml][r];
                const float gt = bf2f(zb[(size_t)t * AB_IN + 1024 + ch]);
                YB[((size_t)b * SEQ + t) * DM + ch] = (bf16_t)f2bf(h * gelu_tanh(gt)); } }
    }
    __syncthreads();
}
__device__ __forceinline__ void pool_item(int item, const bf16_t* ZE, const float* scale, bf16_t* YB) {
    const int tid = opaque_tid(), b = item >> 6, tch = item & 63, co = tid & 127, seg = tid >> 7;
    const int win = 2 << (co >> 5);
    float sc[8];
#pragma unroll
    for (int e = 0; e < 8; ++e) sc[e] = scale[co * 8 + e];
    const bf16_t* zb = ZE + (size_t)b * SEQ * AB_IN + 2048 + co * 8;
    const int ts = tch * 64 + seg * 16;
    float sum[8];
#pragma unroll
    for (int e = 0; e < 8; ++e) sum[e] = 0.f;
    for (int s = ts - win + 1; s < ts; ++s) if (s >= 0) { const u32x4 v = *(const u32x4*)(zb + (size_t)s * AB_IN);
        sum[0] += bflo(v.x); sum[1] += bfhi(v.x); sum[2] += bflo(v.y); sum[3] += bfhi(v.y); sum[4] += bflo(v.z); sum[5] += bfhi(v.z); sum[6] += bflo(v.w); sum[7] += bfhi(v.w); }
    for (int t = ts; t < ts + 16; ++t) {
        const u32x4 v = *(const u32x4*)(zb + (size_t)t * AB_IN);
        float x[8] = {bflo(v.x), bfhi(v.x), bflo(v.y), bfhi(v.y), bflo(v.z), bfhi(v.z), bflo(v.w), bfhi(v.w)};
        const float inv = 1.0f / (float)((t + 1) < win ? (t + 1) : win);
        float o[8];
#pragma unroll
        for (int e = 0; e < 8; ++e) { sum[e] += x[e]; o[e] = (sum[e] * inv - x[e]) * sc[e]; }
        u32x4 wv; wv.x = pk2(o[0], o[1]); wv.y = pk2(o[2], o[3]); wv.z = pk2(o[4], o[5]); wv.w = pk2(o[6], o[7]);
        *(u32x4*)(YB + ((size_t)b * SEQ + t) * DM + 1024 + co * 8) = wv;
        const int so = t - win + 1;
        if (so >= 0) { const u32x4 q = *(const u32x4*)(zb + (size_t)so * AB_IN);
            sum[0] -= bflo(q.x); sum[1] -= bfhi(q.x); sum[2] -= bflo(q.y); sum[3] -= bfhi(q.y); sum[4] -= bflo(q.z); sum[5] -= bfhi(q.z); sum[6] -= bflo(q.w); sum[7] -= bfhi(q.w); }
    }
}

constexpr int KT_PITCH = 272, VT_PITCH = 144;
constexpr int AL_KT = 0, AL_VT = 64 * KT_PITCH, AL_IMPA = 36864, AL_IMPB = AL_IMPA + 64 * 65 * 4, AL_SEL = AL_IMPB + 64 * 65 * 4, AL_UNI = AL_SEL + 512, AL_Q = 73728, Q_WAVE = 32 * KT_PITCH;
constexpr float QSCALE2 = 0.08838834764831845f * LOG2E;
constexpr float NEGB = -1e30f;

struct StageRegs { u32x4 k[2], v[2]; };
__device__ __forceinline__ void stage_load(StageRegs& R, const bf16_t* kbase, const bf16_t* vbase, int vpitch, int tid) {
    const int kr = tid >> 3, kc = tid & 7, vr = tid >> 2, vc = tid & 3;
    R.k[0] = *(const u32x4*)(kbase + kr * 128 + kc * 8); R.k[1] = *(const u32x4*)(kbase + kr * 128 + 64 + kc * 8);
    R.v[0] = *(const u32x4*)(vbase + (size_t)vr * vpitch + vc * 8); R.v[1] = *(const u32x4*)(vbase + (size_t)vr * vpitch + 32 + vc * 8);
}
__device__ __forceinline__ void stage_store(const StageRegs& R, LAS unsigned char* lds, int tid) {
    const int kr = tid >> 3, kc = tid & 7, vr = tid >> 2, vc = tid & 3;
    *(LAS u32x4*)(lds + AL_KT + kr * KT_PITCH + kc * 16) = R.k[0]; *(LAS u32x4*)(lds + AL_KT + kr * KT_PITCH + 128 + kc * 16) = R.k[1];
    *(LAS u32x4*)(lds + AL_VT + vr * VT_PITCH + vc * 16) = R.v[0]; *(LAS u32x4*)(lds + AL_VT + vr * VT_PITCH + 64 + vc * 16) = R.v[1];
}
template <int MODE>
__device__ __forceinline__ void attn_tile(bool MASK, LAS unsigned char* lds, f32x4 (&O)[2][8], float (&m)[2], float (&l)[2], const int (&tpos)[2], float slope2,
                                          int kp0, const bool (&selbit)[2], int fr, int fq, int wv, int tile64, int lane) {
    constexpr int KS = (MODE <= 1) ? 16 : 1;
    f32x4 s[2][4];
#pragma unroll
    for (int ci = 0; ci < 2; ++ci)
#pragma unroll
        for (int k4 = 0; k4 < 4; ++k4) s[ci][k4] = (f32x4){0.f, 0.f, 0.f, 0.f};
#pragma unroll
    for (int kk = 0; kk < 4; ++kk) {
        const bf16x8 q0 = *(const LAS bf16x8*)(lds + AL_Q + wv * Q_WAVE + fr * KT_PITCH + kk * 64 + fq * 16);
        const bf16x8 q1 = *(const LAS bf16x8*)(lds + AL_Q + wv * Q_WAVE + (16 + fr) * KT_PITCH + kk * 64 + fq * 16);
#pragma unroll
        for (int k4 = 0; k4 < 4; ++k4) { const bf16x8 kf = *(const LAS bf16x8*)(lds + AL_KT + (k4 * 16 + fr) * KT_PITCH + kk * 64 + fq * 16);
            s[0][k4] = __builtin_amdgcn_mfma_f32_16x16x32_bf16(kf, q0, s[0][k4], 0, 0, 0);
            s[1][k4] = __builtin_amdgcn_mfma_f32_16x16x32_bf16(kf, q1, s[1][k4], 0, 0, 0); } }
    const float sk = slope2 * (float)KS;
    float alpha[2] = {1.f, 1.f};
#pragma unroll
    for (int ci = 0; ci < 2; ++ci) {
        const int base = tpos[ci] - kp0 - KS * (fq * 4);
        const float bb = -slope2 * (float)base;
        float mx = NEGB;
#pragma unroll
        for (int k4 = 0; k4 < 4; ++k4)
#pragma unroll
            for (int j = 0; j < 4; ++j) {
                s[ci][k4][j] = __builtin_fmaf(s[ci][k4][j], QSCALE2, __builtin_fmaf(sk, (float)(k4 * 16 + j), bb)); }
        if (MASK) {
#pragma unroll
            for (int k4 = 0; k4 < 4; ++k4)
#pragma unroll
                for (int j = 0; j < 4; ++j) { const int c = KS * (k4 * 16 + j); bool ok = c <= base; if (MODE == 3) ok = ok && (base - c < 512); s[ci][k4][j] = ok ? s[ci][k4][j] : 2.0f * NEGB; } }
#pragma unroll
        for (int k4 = 0; k4 < 4; ++k4)
#pragma unroll
            for (int j = 0; j < 4; ++j) mx = fmaxf(mx, s[ci][k4][j]);
        if (MODE == 2) mx = selbit[ci] ? mx : NEGB;
        if (MODE != 1) {
            mx = fmaxf(mx, shx(mx, lane, 16)); mx = fmaxf(mx, shx(mx, lane, 32));
            const float mn = fmaxf(m[ci], mx); alpha[ci] = __builtin_amdgcn_exp2f(m[ci] - mn); m[ci] = mn;
            float ps = 0.f;
#pragma unroll
            for (int k4 = 0; k4 < 4; ++k4)
#pragma unroll
                for (int j = 0; j < 4; ++j) { const float p = __builtin_amdgcn_exp2f(s[ci][k4][j] - mn); s[ci][k4][j] = p; ps += p; }
            if (MODE == 2) ps = selbit[ci] ? ps : 0.f;
            l[ci] = l[ci] * alpha[ci] + ps;
        } else {
#pragma unroll
            for (int k4 = 0; k4 < 4; ++k4) {
#pragma unroll
                for (int j = 0; j < 4; ++j) s[ci][k4][j] = __builtin_amdgcn_exp2f(s[ci][k4][j] - m[ci]) * l[ci];
                float a = (s[ci][k4][0] + s[ci][k4][1]) + (s[ci][k4][2] + s[ci][k4][3]); float b3 = s[ci][k4][3];
                a += shx(a, lane, 1); a += shx(a, lane, 2); b3 += shx(b3, lane, 1); b3 += shx(b3, lane, 2);
                if ((fr & 3) == 0) { const int tl = wv * 8 + ci * 4 + (fr >> 2); const int ms = tile64 * 16 + k4 * 4 + fq;
                    ((LAS float*)(lds + AL_IMPA))[tl * 65 + ms] = a; ((LAS float*)(lds + AL_IMPB))[tl * 65 + ms + 1] = b3; } }
        }
    }
    if (MODE >= 2) {
        if (__builtin_amdgcn_ballot_w64(alpha[0] != 1.f || alpha[1] != 1.f) != 0ull) {
#pragma unroll
            for (int ci = 0; ci < 2; ++ci)
#pragma unroll
                for (int dt = 0; dt < 8; ++dt) O[ci][dt] = O[ci][dt] * alpha[ci]; }
    }
    if (MODE != 0) {
#pragma unroll
        for (int ks = 0; ks < 2; ++ks) {
            bf16x8 pf[2];
#pragma unroll
            for (int ci = 0; ci < 2; ++ci) { u32x4 w; w.x = pk2(s[ci][2 * ks][0], s[ci][2 * ks][1]); w.y = pk2(s[ci][2 * ks][2], s[ci][2 * ks][3]); w.z = pk2(s[ci][2 * ks + 1][0], s[ci][2 * ks + 1][1]); w.w = pk2(s[ci][2 * ks + 1][2], s[ci][2 * ks + 1][3]);
                if (MODE == 2) { w.x = selbit[ci] ? w.x : 0u; w.y = selbit[ci] ? w.y : 0u; w.z = selbit[ci] ? w.z : 0u; w.w = selbit[ci] ? w.w : 0u; }
                pf[ci] = __builtin_bit_cast(bf16x8, w); }
#pragma unroll
            for (int dt = 0; dt < 8; ++dt) { const LAS unsigned char* vp = lds + AL_VT + (dt * 16 + fr) * VT_PITCH + (ks * 32 + fq * 4) * 2;
                const u32x2 lo = *(const LAS u32x2*)vp, hi = *(const LAS u32x2*)(vp + 32);
                const bf16x8 vf = __builtin_bit_cast(bf16x8, (u32x4){lo.x, lo.y, hi.x, hi.y});
                O[0][dt] = __builtin_amdgcn_mfma_f32_16x16x32_bf16(vf, pf[0], O[0][dt], 0, 0, 0);
                O[1][dt] = __builtin_amdgcn_mfma_f32_16x16x32_bf16(vf, pf[1], O[1][dt], 0, 0, 0); }
        }
    }
}

__device__ __forceinline__ void nsa_item(LAS unsigned char* lds, int b, int g, int tq, const bf16_t* Q, const bf16_t* KS, const bf16_t* VST, const bf16_t* KW, const bf16_t* VWT,
                                         const bf16_t* KCMP, const bf16_t* VCMPT, const float* GL, bf16_t* YB) {
    const int tid = opaque_tid(), wv = __builtin_amdgcn_readfirstlane(tid >> 6), lane = tid & 63, fr = lane & 15, fq = lane >> 4;
    const int t0 = tq * 64, bg = b * 4 + g, head = g * 4 + (fr & 3);
    LAS float* IMPA = (LAS float*)(lds + AL_IMPA);
    LAS unsigned long long* SEL = (LAS unsigned long long*)(lds + AL_SEL);
    LAS unsigned long long* UNI = (LAS unsigned long long*)(lds + AL_UNI);
    __syncthreads();
    for (int i = tid; i < 2 * 64 * 65; i += 512) IMPA[i] = 0.f;
    int tpos[2];
#pragma unroll
    for (int ci = 0; ci < 2; ++ci) { tpos[ci] = t0 + wv * 8 + ci * 4 + (fr >> 2);
        const bf16_t* qp = Q + ((size_t)(b * SEQ + tpos[ci])) * DM + head * 128 + fq * 8;
#pragma unroll
        for (int kk = 0; kk < 4; ++kk) *(LAS bf16x8*)(lds + AL_Q + wv * Q_WAVE + (ci * 16 + fr) * KT_PITCH + kk * 64 + fq * 16) = *(const bf16x8*)(qp + kk * 32);
    }
    const float slope2 = exp2f(-0.5f * (float)(head + 1)) * LOG2E;
    f32x4 O[2][8]; float m[2], l[2]; bool selbit[2] = {true, true};
#pragma unroll
    for (int ci = 0; ci < 2; ++ci)
#pragma unroll
        for (int dt = 0; dt < 8; ++dt) { O[ci][dt] = (f32x4){0.f, 0.f, 0.f, 0.f}; }
    StageRegs R;
    const int ncmp = ((t0 + 32) >> 4) + 1, nct = (ncmp + 63) >> 6;
    const bf16_t* kcb = KCMP + (size_t)bg * 256 * 128; const bf16_t* vcb = VCMPT + (size_t)bg * 128 * 256;
    m[0] = m[1] = NEGB; l[0] = l[1] = 0.f;
    stage_load(R, kcb, vcb, 256, tid);
    for (int ct = 0; ct < nct; ++ct) {
        __syncthreads(); stage_store(R, lds, tid); __syncthreads();
        if (ct + 1 < nct) stage_load(R, kcb + (size_t)(ct + 1) * 64 * 128, vcb + (ct + 1) * 64, 256, tid);
        attn_tile<0>(1024 * ct + 1039 > t0, lds, O, m, l, tpos, slope2, 16 * (ct * 64) + 31, selbit, fr, fq, wv, ct, lane);
    }
#pragma unroll
    for (int ci = 0; ci < 2; ++ci) { float lt = l[ci]; lt += shx(lt, lane, 16); lt += shx(lt, lane, 32); l[ci] = lt > 0.f ? 1.0f / lt : 0.f; }
    stage_load(R, kcb, vcb, 256, tid);
    for (int ct = 0; ct < nct; ++ct) {
        __syncthreads(); stage_store(R, lds, tid); __syncthreads();
        if (ct + 1 < nct) stage_load(R, kcb + (size_t)(ct + 1) * 64 * 128, vcb + (ct + 1) * 64, 256, tid);
        attn_tile<1>(1024 * ct + 1039 > t0, lds, O, m, l, tpos, slope2, 16 * (ct * 64) + 31, selbit, fr, fq, wv, ct, lane);
    }
#pragma unroll
    for (int ci = 0; ci < 2; ++ci) { const float gc = GL[((size_t)(b * SEQ + tpos[ci])) * 48 + head];
        bf16_t* op = YB + ((size_t)(b * SEQ + tpos[ci])) * DM + head * 128 + fq * 4;
#pragma unroll
        for (int dt = 0; dt < 8; ++dt) { const f32x4 o = O[ci][dt] * gc; u32x2 w; w.x = pk2(o[0], o[1]); w.y = pk2(o[2], o[3]); *(u32x2*)(op + dt * 16) = w; O[ci][dt] = (f32x4){0.f, 0.f, 0.f, 0.f}; } }
    __syncthreads();
    {
        const int cur = tq; unsigned long long wun = 0ull;
#pragma unroll 1
        for (int tk = 0; tk < 8; ++tk) { const int tl = wv * 8 + tk;
            float v = IMPA[tl * 65 + lane] + IMPA[64 * 65 + tl * 65 + lane];
            if (lane == 0 || lane == cur || lane == cur - 1) v += 1e6f;
            if (lane > cur) v = NEGB;
            int rank = 0; const int vi = __builtin_bit_cast(int, v);
#pragma unroll
            for (int mm = 0; mm < 64; ++mm) { const float vm = __builtin_bit_cast(float, __builtin_amdgcn_readlane(vi, mm)); rank += ((vm > v) || (vm == v && mm < lane)) ? 1 : 0; }
            const unsigned long long mk = __ballot(rank < 16 && lane <= cur);
            wun |= mk;
            if (lane == 0) SEL[tl] = mk; }
        if (lane == 0) UNI[wv] = wun;
    }
    __syncthreads();
    unsigned long long selm[2], wun, bun = 0ull;
#pragma unroll
    for (int ci = 0; ci < 2; ++ci) selm[ci] = SEL[wv * 8 + ci * 4 + (fr >> 2)];
    wun = UNI[wv];
#pragma unroll
    for (int i = 0; i < 8; ++i) bun |= UNI[i];
    { const unsigned lo = __builtin_amdgcn_readfirstlane((unsigned)bun), hi = __builtin_amdgcn_readfirstlane((unsigned)(bun >> 32)); bun = ((unsigned long long)hi << 32) | lo;
      const unsigned lo2 = __builtin_amdgcn_readfirstlane((unsigned)wun), hi2 = __builtin_amdgcn_readfirstlane((unsigned)(wun >> 32)); wun = ((unsigned long long)hi2 << 32) | lo2; }
    const bf16_t* ksb = KS + (size_t)bg * SEQ * 128; const bf16_t* vsb = VST + (size_t)bg * 128 * SEQ;
    m[0] = m[1] = NEGB; l[0] = l[1] = 0.f;
    {
        unsigned long long rem = bun; int j = 63 - __builtin_clzll(rem); rem &= ~(1ull << j);
        stage_load(R, ksb + (size_t)j * 64 * 128, vsb + j * 64, SEQ, tid);
        for (;;) {
            __syncthreads(); stage_store(R, lds, tid); __syncthreads();
            const int jn = rem ? 63 - __builtin_clzll(rem) : -1; if (jn >= 0) { rem &= ~(1ull << jn); stage_load(R, ksb + (size_t)jn * 64 * 128, vsb + jn * 64, SEQ, tid); }
            if ((wun >> j) & 1ull) { selbit[0] = (selm[0] >> j) & 1ull; selbit[1] = (selm[1] >> j) & 1ull;
                attn_tile<2>(j == tq, lds, O, m, l, tpos, slope2, j * 64, selbit, fr, fq, wv, 0, lane); }
            if (jn < 0) break; j = jn;
        }
    }
#pragma unroll
    for (int ci = 0; ci < 2; ++ci) { float lt = l[ci]; lt += shx(lt, lane, 16); lt += shx(lt, lane, 32); const float gs = GL[((size_t)(b * SEQ + tpos[ci])) * 48 + 16 + head]; const float sc = lt > 0.f ? gs / lt : 0.f;
        bf16_t* op = YB + ((size_t)(b * SEQ + tpos[ci])) * DM + head * 128 + fq * 4;
#pragma unroll
        for (int dt = 0; dt < 8; ++dt) { const f32x4 o = O[ci][dt] * sc; const u32x2 pv = *(const u32x2*)(op + dt * 16); u32x2 w; w.x = pk2(bflo(pv.x) + o[0], bfhi(pv.x) + o[1]); w.y = pk2(bflo(pv.y) + o[2], bfhi(pv.y) + o[3]); *(u32x2*)(op + dt * 16) = w; O[ci][dt] = (f32x4){0.f, 0.f, 0.f, 0.f}; } }
    const bf16_t* kwb = KW + (size_t)bg * SEQ * 128; const bf16_t* vwb = VWT + (size_t)bg * 128 * SEQ;
    m[0] = m[1] = NEGB; l[0] = l[1] = 0.f; selbit[0] = selbit[1] = true;
    {
        const int j0 = tq >= 8 ? tq - 8 : 0;
        stage_load(R, kwb + (size_t)tq * 64 * 128, vwb + tq * 64, SEQ, tid);
        for (int j = tq; j >= j0; --j) {
            __syncthreads(); stage_store(R, lds, tid); __syncthreads();
            if (j > j0) stage_load(R, kwb + (size_t)(j - 1) * 64 * 128, vwb + (j - 1) * 64, SEQ, tid);
            attn_tile<3>(j == tq || j == tq - 8, lds, O, m, l, tpos, slope2, j * 64, selbit, fr, fq, wv, 0, lane);
        }
    }
#pragma unroll
    for (int ci = 0; ci < 2; ++ci) { float lt = l[ci]; lt += shx(lt, lane, 16); lt += shx(lt, lane, 32); const float gwv = GL[((size_t)(b * SEQ + tpos[ci])) * 48 + 32 + head]; const float sc = lt > 0.f ? gwv / lt : 0.f;
        bf16_t* op = YB + ((size_t)(b * SEQ + tpos[ci])) * DM + head * 128 + fq * 4;
#pragma unroll
        for (int dt = 0; dt < 8; ++dt) { const f32x4 o = O[ci][dt] * sc; const u32x2 pv = *(const u32x2*)(op + dt * 16); u32x2 w; w.x = pk2(bflo(pv.x) + o[0], bfhi(pv.x) + o[1]); w.y = pk2(bflo(pv.y) + o[2], bfhi(pv.y) + o[3]); *(u32x2*)(op + dt * 16) = w; } }
}

__global__ void __launch_bounds__(512) fwd_kernel(Args a) {
    extern __shared__ __attribute__((aligned(16))) unsigned char lds_raw[];
    LAS unsigned char* lds = (LAS unsigned char*)lds_raw;
    const int G = gridDim.x, bx = blockIdx.x;
    const int NGW = G * 8, NGT = G * 512;
#define GW() (opq(bx) * 8 + __builtin_amdgcn_readfirstlane(opaque_tid() >> 6))
    unsigned char* ws = a.ws;
    int ph = 0;
    { volatile LAS unsigned* MISC = (volatile LAS unsigned*)(lds + LDS_BYTES - 64); if (threadIdx.x < 16) MISC[threadIdx.x] = 0u; }
    __syncthreads();
    (void)xcd_barrier_post((unsigned*)(ws + WS_BAR), (volatile LAS unsigned*)(lds + LDS_BYTES - 64));
#ifndef ONLY
#define ONLY -1
#endif
#define EN(id) (ONLY < 0 || ONLY == (id))
#define ON() (ph >= a.lo && ph < a.hi)
#define SEAM() do { ++ph; if (a.one) { if (ph == 1) cg::this_grid().sync(); else { XcdBarrier bar; bar.bar = (unsigned*)(opqp(ws) + WS_BAR); bar.x = xb_xcc_id(); bar.st = (volatile LAS unsigned*)(lds + LDS_BYTES - 64); xcd_barrier(bar); } } } while (0)

    bf16_t* XN = (bf16_t*)(ws + WS_XN); bf16_t* YB = (bf16_t*)(ws + WS_YB); unsigned char* Z = ws + WS_Z;
    float* posb = (float*)(ws + WS_POSB);

    if (EN(0) && ON())
#pragma unroll 1
    for (int rp0 = 0; rp0 < REP_P0; ++rp0) {
        const int tid = opaque_tid(), lane = tid & 63, wave = __builtin_amdgcn_readfirstlane(tid >> 6), gw = bx * 8 + wave, gt = bx * 512 + tid;
        LAS float* scr = (LAS float*)(lds + wave * 8448);
        int rot = 0;
        for (int i = 0; i < 4; ++i) {
            conv_mat(a.in[23] + (size_t)i * DM * DFF, DM, DFF, DFF, (bf16_t*)(ws + WS_WUP + i * SZ_UP), DM, scr, gw, NGW, lane, rot, a.in[22] + i * DM);
            conv_mat(a.in[24] + (size_t)i * DFF * DM, DFF, DM, DM, (bf16_t*)(ws + WS_WDN + i * SZ_UP), DFF, scr, gw, NGW, lane, rot);
            conv_mat(a.in[26] + (size_t)i * DM * DM, DM, DM, DM, (bf16_t*)(ws + WS_WG + i * SZ_SQ), DM, scr, gw, NGW, lane, rot, a.in[25] + i * DM);
            conv_mat(a.in[27] + (size_t)i * PLE * DM, PLE, DM, DM, (bf16_t*)(ws + WS_WP + i * SZ_WP), PLE, scr, gw, NGW, lane, rot);
        }
        for (int j = 0; j < 2; ++j) {
            conv_mat(a.in[3] + (size_t)j * DM * AB_IN, DM, 2048, AB_IN, (bf16_t*)(ws + WS_WIN + j * SZ_WIN), DM, scr, gw, NGW, lane, rot, a.in[2] + (2 * j) * DM);
            conv_mat(a.in[13] + (size_t)j * DM * DM, DM, DM, DM, (bf16_t*)(ws + WS_WOUT + j * SZ_SQ), DM, scr, gw, NGW, lane, rot);
            conv_mat(a.in[14] + (size_t)j * DM * C_IN, DM, C_IN, C_IN, (bf16_t*)(ws + WS_CIN + j * SZ_CIN), DM, scr, gw, NGW, lane, rot, a.in[2] + (2 * j + 1) * DM);
            conv_mat(a.in[21] + (size_t)j * DM * DM, DM, DM, DM, (bf16_t*)(ws + WS_COUT + j * SZ_SQ), DM, scr, gw, NGW, lane, rot);
            conv_mat(a.in[16] + (size_t)j * 4096 * 512, 4096, 512, 512, (bf16_t*)(ws + WS_W1K + j * SZ_W1), 4096, scr, gw, NGW, lane, rot);
            conv_mat(a.in[19] + (size_t)j * 4096 * 512, 4096, 512, 512, (bf16_t*)(ws + WS_W1V + j * SZ_W1), 4096, scr, gw, NGW, lane, rot);
            conv_mat(a.in[17] + (size_t)j * 512 * 128, 512, 128, 128, (bf16_t*)(ws + WS_W2K + j * SZ_W2), 512, scr, gw, NGW, lane, rot);
            conv_mat(a.in[20] + (size_t)j * 512 * 128, 512, 128, 128, (bf16_t*)(ws + WS_W2V + j * SZ_W2), 512, scr, gw, NGW, lane, rot);
            for (int h = 0; h < 16; ++h) {
                conv_mat(a.in[6] + ((size_t)j * 16 + h) * 4096, 64, 64, 64, (bf16_t*)(ws + WS_WR + j * SZ_WRI) + h * 4096, 64, scr, gw, NGW, lane, rot);
                conv_mat(a.in[8] + ((size_t)j * 16 + h) * 4096, 64, 64, 64, (bf16_t*)(ws + WS_WI + j * SZ_WRI) + h * 4096, 64, scr, gw, NGW, lane, rot);
            }
            for (int gI = 0; gI < 4; ++gI)
                conv_mat(a.in[11] + ((size_t)j * 4 + gI) * 65536, 256, 256, 256, (bf16_t*)(ws + WS_POOLT + j * SZ_POOLT) + gI * 65536, 256, scr, gw, NGW, lane, rot);
            conv_plain(a.in[3] + (size_t)j * DM * AB_IN + 2048, DM, 1024, AB_IN, (bf16_t*)(ws + WS_WU + j * SZ_WU), 1024, gt, NGT, a.in[2] + (2 * j) * DM);
            zero_fill16(ws + WS_CIN + j * SZ_CIN + (size_t)C_IN * DM * 2, (size_t)(C_INP - C_IN) * DM * 2, gt, NGT);
            zero_fill16(ws + WS_W2K + j * SZ_W2 + (size_t)128 * 512 * 2, (size_t)128 * 512 * 2, gt, NGT);
            zero_fill16(ws + WS_W2V + j * SZ_W2 + (size_t)128 * 512 * 2, (size_t)128 * 512 * 2, gt, NGT);
        }
        conv_plain(a.in[1], 4 * T_TOK, PLE, PLE, (bf16_t*)(ws + WS_PB), PLE, gt, NGT);
        rows_to_bf16_ss(a.in[0], XN, (float*)(ws + WS_ROWSS), bx, NGW);
        __syncthreads();
        for (int it = gw; it < 4 * 8; it += NGW) { const int q = it >> 3, fc = it & 7, j = q >> 1;
            const float* pos = a.in[(q & 1) ? 18 : 15] + (size_t)j * 4096; const float* w1 = a.in[(q & 1) ? 19 : 16] + (size_t)j * 4096 * 512 + fc * 64 + lane;
            float acc0 = 0.f, acc1 = 0.f, acc2 = 0.f, acc3 = 0.f;
            for (int k = 0; k < 4096; k += 4) { acc0 += pos[k] * w1[(size_t)k * 512]; acc1 += pos[k + 1] * w1[(size_t)(k + 1) * 512]; acc2 += pos[k + 2] * w1[(size_t)(k + 2) * 512]; acc3 += pos[k + 3] * w1[(size_t)(k + 3) * 512]; }
            posb[q * 512 + fc * 64 + lane] = (acc0 + acc1) + (acc2 + acc3); }
    }
    SEAM();
    if (EN(1) && ON()) {
        if (bx < 64) { const int j = bx >> 5, gI = (bx >> 3) & 3, pn = bx & 7;
            pg8::Gemm gm{(const bf16_t*)(ws + WS_POOLT + j * SZ_POOLT) + gI * 65536, (const bf16_t*)(ws + WS_WU + j * SZ_WU) + gI * 256, 256, 2048, 256, 256, 1024};
            pg8::StaticOrder S; S.init(256, 2048, G, pn);
            EpiBf16<0> E{(bf16_t*)(ws + WS_WIN + j * SZ_WIN) + (size_t)(2048 + gI * 256) * DM, DM, nullptr, nullptr};
            pg8::gemm_phase(lds, gm, S, E); }
    }
    SEAM();
#pragma unroll 1
    for (int layer = 0; layer < 4; ++layer) {
        const int j = layer >> 1; const bool even = (layer & 1) == 0;
        unsigned char* wsl = opqp(ws); unsigned char* Zl = wsl + WS_Z; bf16_t* XNl = (bf16_t*)(wsl + WS_XN); bf16_t* YBl = (bf16_t*)(wsl + WS_YB); float* posbl = (float*)(wsl + WS_POSB);
        const float* hin = (layer == 0) ? a.in[0] : a.out;
        float* RSS = (float*)(wsl + WS_ROWSS); float* PPl = (float*)(wsl + WS_PP);
        const bf16_t* Ain = (layer == 0) ? XNl : YBl;
        if (EN(3) && ON()) {
            if (even) { pg8::Gemm gm{Ain, (const bf16_t*)(wsl + WS_WIN + j * SZ_WIN), T_TOK, AB_IN, DM, DM, DM};
                pg8::StaticOrder S; S.init(T_TOK, AB_IN, opq(G), opq(bx)); EpiBf16<0> E{(bf16_t*)Zl, AB_IN, nullptr, RSS + (size_t)(layer * 3) * T_TOK * 32}; pg8::gemm_phase(lds, gm, S, E); }
            else { pg8::Gemm gm{Ain, (const bf16_t*)(wsl + WS_CIN + j * SZ_CIN), T_TOK, C_INP, DM, DM, DM};
                pg8::StaticOrder S; S.init(T_TOK, C_INP, opq(G), opq(bx));
                EpiNsa E{(bf16_t*)(Zl + Z_Q), (bf16_t*)(Zl + Z_KC), (bf16_t*)(Zl + Z_VC), (bf16_t*)(Zl + Z_KS), (bf16_t*)(Zl + Z_VST), (bf16_t*)(Zl + Z_KW), (bf16_t*)(Zl + Z_VWT), (float*)(Zl + Z_GL), RSS + (size_t)(layer * 3) * T_TOK * 32};
                pg8::gemm_phase(lds, gm, S, E); }
        }
        SEAM();
        if (even) {
            if (EN(4) && ON()) {
#ifndef NO_LRU
#pragma unroll 1
                for (int rp = 0; rp < REP_LRU; ++rp)
                for (int it = opq(bx); it < 256; it += G)
                    lru_item(lds, it, (const bf16_t*)Zl, a.in[4] + (size_t)j * 4096, a.in[5] + j * 1024, (const bf16_t*)(wsl + WS_WR + j * SZ_WRI), (const bf16_t*)(wsl + WS_WI + j * SZ_WRI),
                             a.in[7] + j * 1024, a.in[9] + j * 1024, a.in[10] + j * 1024, YBl);
#endif
                for (int it = opq(bx); it < 256; it += G) pool_item(it, (const bf16_t*)Zl, a.in[12] + j * 1024, YBl);
            }
            SEAM();
        } else {
            if (EN(5) && ON()) {
                if (bx < 64) { const int kv = bx >> 5;
                    pg8::Gemm gm{(const bf16_t*)(Zl + (kv ? Z_VC : Z_KC)), (const bf16_t*)(wsl + (kv ? WS_W1V : WS_W1K) + j * SZ_W1), 4096, 512, 4096, 2048, 4096};
                    pg8::StaticOrder S; S.init(4096, 512, opq(G), opq(bx) & 31);
                    EpiBf16<2> E{(bf16_t*)(Zl + (kv ? Z_HIDV : Z_HIDK)), 512, posbl + (j * 2 + kv) * 512, nullptr}; pg8::gemm_phase(lds, gm, S, E); }
            }
            SEAM();
            if (EN(6) && ON()) {
                if (bx < 16) { pg8::Gemm gm{(const bf16_t*)(Zl + Z_HIDK), (const bf16_t*)(wsl + WS_W2K + j * SZ_W2), 4096, 256, 512, 512, 512};
                    pg8::StaticOrder S; S.init(4096, 256, opq(G), opq(bx)); EpiCmp2<0> E{(bf16_t*)(Zl + Z_KCMP)}; pg8::gemm_phase(lds, gm, S, E); }
                else if (bx < 32) { pg8::Gemm gm{(const bf16_t*)(Zl + Z_HIDV), (const bf16_t*)(wsl + WS_W2V + j * SZ_W2), 4096, 256, 512, 512, 512};
                    pg8::StaticOrder S; S.init(4096, 256, opq(G), opq(bx) - 16); EpiCmp2<1> E{(bf16_t*)(Zl + Z_VCMPT)}; pg8::gemm_phase(lds, gm, S, E); }
            }
            SEAM();
            if (EN(7) && ON()) {
#pragma unroll 1
                for (int rp = 0; rp < REP_ATTN; ++rp)
                for (int it = opq(bx), r = 0; it < 1024; it += G, ++r) { const int c = it % 256, rr = it / 256; const int cp = (rr & 1) ? 255 - c : c;
                    const int tq = 63 - (rr * 16 + (cp >> 4)), bgi = cp & 15;
#ifndef NO_ATTN
                    nsa_item(lds, bgi >> 2, bgi & 3, tq, (const bf16_t*)(Zl + Z_Q), (const bf16_t*)(Zl + Z_KS), (const bf16_t*)(Zl + Z_VST), (const bf16_t*)(Zl + Z_KW), (const bf16_t*)(Zl + Z_VWT),
                             (const bf16_t*)(Zl + Z_KCMP), (const bf16_t*)(Zl + Z_VCMPT), (const float*)(Zl + Z_GL), YBl);
#endif
                }
                __syncthreads();
            }
            SEAM();
        }
        if (EN(8) && ON()) { pg8::Gemm gm{YBl, (const bf16_t*)(wsl + (even ? WS_WOUT : WS_COUT) + j * SZ_SQ), T_TOK, DM, DM, DM, DM};
            pg8::StaticOrder S; S.init(T_TOK, DM, opq(G), opq(bx)); EpiF32<0> E{hin, a.out, nullptr, DM, XNl, RSS + (size_t)(layer * 3 + 1) * T_TOK * 32, nullptr}; pg8::gemm_phase(lds, gm, S, E);
            { pg8::Gemm gp{(const bf16_t*)(wsl + WS_PB) + (size_t)layer * T_TOK * PLE, (const bf16_t*)(wsl + WS_WP + layer * SZ_WP), T_TOK, DM, PLE, PLE, PLE};
              pg8::StaticOrder S2; S2.init(T_TOK, DM, opq(G), opq(bx)); EpiF32<2> E2{nullptr, PPl, nullptr, DM, nullptr, nullptr, nullptr}; pg8::gemm_phase(lds, gp, S2, E2); } }
        SEAM();
        if (EN(10) && ON())
#pragma unroll 1
        for (int rpu = 0; rpu < REP_UP; ++rpu) { pg8::Gemm gm{XNl, (const bf16_t*)(wsl + WS_WUP + layer * SZ_UP), T_TOK, DFF, DM, DM, DM};
            pg8::StaticOrder S; S.init(T_TOK, DFF, opq(G), opq(bx)); EpiBf16<1> E{(bf16_t*)Zl, DFF, nullptr, RSS + (size_t)(layer * 3 + 1) * T_TOK * 32}; pg8::gemm_phase(lds, gm, S, E); }
        SEAM();
        if (EN(11) && ON()) { pg8::Gemm gm{(const bf16_t*)Zl, (const bf16_t*)(wsl + WS_WDN + layer * SZ_UP), T_TOK, DM, DFF, DFF, DFF};
            pg8::StaticOrder S; S.init(T_TOK, DM, opq(G), opq(bx)); EpiF32<0> E{a.out, a.out, nullptr, DM, XNl, RSS + (size_t)(layer * 3 + 2) * T_TOK * 32, nullptr}; pg8::gemm_phase(lds, gm, S, E); }
        SEAM();
        if (EN(13) && ON()) { pg8::Gemm gm{XNl, (const bf16_t*)(wsl + WS_WG + layer * SZ_SQ), T_TOK, DM, DM, DM, DM};
            pg8::StaticOrder S; S.init(T_TOK, DM, opq(G), opq(bx)); EpiF32<1> E{a.out, a.out, PPl, DM, YBl, RSS + (size_t)(layer * 3 + 3) * T_TOK * 32, RSS + (size_t)(layer * 3 + 2) * T_TOK * 32}; pg8::gemm_phase(lds, gm, S, E); }
        SEAM();
    }
    if (EN(14) && ON()) rmsnorm_rows<true>(a.out, a.in[28], nullptr, a.out, bx, NGW);
#undef ON
#undef SEAM
}
constexpr int N_PHASES = 1 + 2 * 9 + 2 * 11 + 1;

extern "C" void kernel_launch(void* const* d_in, const int* in_sizes, int n_in, void* d_out, int out_size, void* d_ws, size_t ws_size, hipStream_t stream) {
    static int grid = 0;
    if (grid == 0) {
        if (n_in != 29 || ws_size < WS_END) { fprintf(stderr, "kernel_launch: unexpected n_in %d / ws %zu (need %zu)\n", n_in, ws_size, (size_t)WS_END); grid = -1; return; }
        int dev = 0, cus = 0, per_cu = 0;
        hipGetDevice(&dev); hipDeviceGetAttribute(&cus, hipDeviceAttributeMultiprocessorCount, dev);
        if (hipFuncSetAttribute((const void*)fwd_kernel, hipFuncAttributeMaxDynamicSharedMemorySize, LDS_BYTES) != hipSuccess) { fprintf(stderr, "hipFuncSetAttribute failed\n"); grid = -1; return; }
        if (hipOccupancyMaxActiveBlocksPerMultiprocessor(&per_cu, (const void*)fwd_kernel, 512, LDS_BYTES) != hipSuccess || per_cu < 1) { fprintf(stderr, "occupancy query: %d\n", per_cu); per_cu = 1; }
        (void)hipGetLastError();
        grid = cus;
    }
    if (grid < 0) return;
    Args a{};
    for (int i = 0; i < 29; ++i) a.in[i] = (const float*)d_in[i];
    a.out = (float*)d_out; a.ws = (unsigned char*)d_ws;
#if MK_ONE_LAUNCH
    (void)hipMemsetAsync((unsigned char*)d_ws + WS_BAR, 0, XCD_BAR_WORDS * 4, stream);
    a.lo = 0; a.hi = 1 << 30; a.one = 1; a.pad = 0;
    void* args[] = {&a};
    hipError_t e = hipLaunchCooperativeKernel((const void*)fwd_kernel, dim3(grid), dim3(512), args, LDS_BYTES, stream);
    if (e != hipSuccess) fprintf(stderr, "cooperative launch failed: %s (grid %d)\n", hipGetErrorString(e), grid);
#else
    for (int p = 0; p < N_PHASES; ++p) { a.lo = p; a.hi = p + 1; a.one = 0; a.pad = 0;
        hipLaunchKernelGGL(fwd_kernel, dim3(grid), dim3(512), LDS_BYTES, stream, a); }
#endif
}
```

```cpp
#include <hip/hip_runtime.h>
#include <hip/hip_cooperative_groups.h>
#include <cstdio>
namespace cg = cooperative_groups;

#ifndef REP_ATTN
#define REP_ATTN 1
#endif
#ifndef REP_LRU
#define REP_LRU 1
#endif
#ifndef REP_P0
#define REP_P0 1
#endif
#ifndef REP_UP
#define REP_UP 1
#endif
#ifndef MK_ONE_LAUNCH
#define MK_ONE_LAUNCH 1
#endif

#define LAS __attribute__((address_space(3)))
typedef unsigned short bf16_t;
typedef short bf16x8 __attribute__((ext_vector_type(8)));
typedef float f32x4 __attribute__((ext_vector_type(4)));
typedef float f32x2 __attribute__((ext_vector_type(2)));
typedef unsigned u32x4 __attribute__((ext_vector_type(4)));
typedef unsigned u32x2 __attribute__((ext_vector_type(2)));

constexpr int T_TOK = 16384, DM = 2048, SEQ = 4096, NB = 4, DFF = 8192, PLE = 256;
constexpr int AB_IN = 3072, C_IN = 5168, C_INP = 5120;
constexpr float EPSV = 1e-6f;
constexpr float LOG2E = 1.4426950408889634f;

__device__ __forceinline__ unsigned f2bf(float f) { unsigned u = __builtin_bit_cast(unsigned, f); return (u + 0x7fffu + ((u >> 16) & 1u)) >> 16; }
__device__ __forceinline__ unsigned pk2(float lo, float hi) { unsigned r; asm volatile("v_cvt_pk_bf16_f32 %0, %1, %2" : "=v"(r) : "v"(lo), "v"(hi)); return r; }
__device__ __forceinline__ float bf2f(unsigned short b) { return __builtin_bit_cast(float, ((unsigned)b) << 16); }
__device__ __forceinline__ float bflo(unsigned w) { return __builtin_bit_cast(float, w << 16); }
__device__ __forceinline__ float bfhi(unsigned w) { return __builtin_bit_cast(float, w & 0xffff0000u); }
__device__ __forceinline__ float shx(float v, int lane, int o) { return __builtin_bit_cast(float, __builtin_amdgcn_ds_bpermute((lane ^ o) << 2, __builtin_bit_cast(int, v))); }
__device__ __forceinline__ float wave_sum(float v, int lane) {
#pragma unroll
    for (int o = 1; o < 64; o <<= 1) v += shx(v, lane, o);
    return v;
}
__device__ __forceinline__ float sigmoidf_(float x) { return 1.0f / (1.0f + __expf(-x)); }
__device__ __forceinline__ float gelu_tanh(float x) {
    const float u = 0.7978845608028654f * (x + 0.044715f * x * x * x);
    const float e = __expf(2.0f * u);
    const float th = 1.0f - 2.0f / (e + 1.0f);
    return 0.5f * x * (1.0f + th);
}

__device__ __forceinline__ unsigned char* opqp(unsigned char* p) { size_t z = 0; asm volatile("" : "+s"(z)); return p + z; }
__device__ __forceinline__ int opq(int v) { asm volatile("" : "+s"(v)); return v; }
__device__ __forceinline__ int opaque_tid() { int t = threadIdx.x; asm volatile("" : "+v"(t)); return t; }
namespace pg8 {
constexpr int BM = 256, BK = 64, HALF = 128, HTB = HALF * BK * 2, STAGE_BYTES = 8 * HTB, NXCD = 8, WGM = 8;
__host__ __device__ __forceinline__ int lds_byte(int r, int c) { const int st = (r >> 4) * 2 + (c >> 5), rr = r & 15, cc = c & 31, ob = rr * 64 + cc * 2; return st * 1024 + (ob ^ (((ob >> 9) & 1) << 5)); }
__host__ __device__ __forceinline__ void stage_rc(int b, int& R, int& C) { const int st = b / 1024, sb = b % 1024, swz = sb ^ (((sb >> 9) & 1) << 5); R = (st >> 1) * 16 + swz / 64; C = (st & 1) * 32 + (swz % 64) / 2; }
__host__ __device__ __forceinline__ int perm32(int rho) { const int n = rho >> 4, i = rho & 15; return 8 * (i >> 2) + 4 * n + (i & 3); }

struct Unit { int pm, pn; };
struct Gemm { const bf16_t* A; const bf16_t* Bt; int M, N, K, lda, ldb; };

struct StaticOrder {
    int nM, nN, nwg, G, c;
    __device__ void init(int M, int N, int G_, int c_) { nM = M / BM; nN = N / BM; nwg = nM * nN; G = G_; c = c_; }
    __device__ bool next(int i, Unit& u) const {
        const long L = (long)i * G + c; if (L >= nwg || c < 0) return false;
        int wgid = (int)L; { const int q = nwg / NXCD, r = nwg % NXCD, xcd = wgid % NXCD, off = wgid / NXCD; wgid = (xcd < r ? xcd * (q + 1) : r * (q + 1) + (xcd - r) * q) + off; }
        const int nig = WGM * nN, gid = wgid / nig, fm = gid * WGM, gsz = (nM - fm) < WGM ? (nM - fm) : WGM;
        u.pm = fm + ((wgid % nig) % gsz); u.pn = (wgid % nig) / gsz; return true;
    }
};

template <class Epi, class Sched>
__device__ __forceinline__ void gemm_phase(LAS unsigned char* lds, const Gemm g, const Sched& S, const Epi& E) {
    const int tid = opaque_tid(), wid = __builtin_amdgcn_readfirstlane(tid >> 6), lane = tid & 63, wr = wid >> 2, wc = wid & 3, fr = lane & 15, fq = lane >> 4;
    const int K = g.K, nt = K / BK;
    unsigned voffA[2], voffB[2];
#pragma unroll
    for (int i = 0; i < 2; ++i) { int R, C; stage_rc(tid * 16 + i * 8192, R, C); const int Rb = Epi::PERM ? ((R & ~31) + perm32(R & 31)) : R;
        voffA[i] = (unsigned)(R * g.lda + C) * 2u; voffB[i] = (unsigned)(Rb * g.ldb + C) * 2u; }
    const size_t kstep = (size_t)(BK * 2);
    const size_t hstepA = (size_t)HALF * g.lda * 2, hstepB = (size_t)HALF * g.ldb * 2;
    const size_t tstepA = 2 * hstepA, tstepB = 2 * hstepB;
    const unsigned ldsw = (unsigned)wid * 1024u;
    const int aoff = lds_byte(wr * 64 + fr, fq * 8), boff = lds_byte(wc * 32 + fr, fq * 8);
#define PG8_SA(b, h) (((b) * 2 + (h)) * HTB)
#define PG8_SB(b, h) ((4 + (b) * 2 + (h)) * HTB)
#define PG8_STAGE(bufoff, gbase, voff) do { _Pragma("unroll") for (int _i = 0; _i < 2; ++_i) \
        __builtin_amdgcn_global_load_lds((const unsigned*)((const char*)(gbase) + (voff)[_i]), (LAS unsigned*)(lds + (bufoff) + ldsw + _i * 8192), 16, 0, 0); } while (0)
#define PG8_LDA(dst, b, h) do { _Pragma("unroll") for (int m = 0; m < 4; ++m) _Pragma("unroll") for (int k = 0; k < 2; ++k) dst[m][k] = *(const LAS bf16x8*)(lds + PG8_SA(b, h) + aoff + m * 2048 + k * 1024); } while (0)
#define PG8_LDB(dst, b, h) do { _Pragma("unroll") for (int n = 0; n < 2; ++n) _Pragma("unroll") for (int k = 0; k < 2; ++k) dst[n][k] = *(const LAS bf16x8*)(lds + PG8_SB(b, h) + boff + n * 2048 + k * 1024); } while (0)
#define PG8_MMA(ai, bj, At, Bt) do { __builtin_amdgcn_s_setprio(1); _Pragma("unroll") for (int m = 0; m < 4; ++m) _Pragma("unroll") for (int n = 0; n < 2; ++n) _Pragma("unroll") for (int k = 0; k < 2; ++k) \
        acc[ai][bj][m][n] = __builtin_amdgcn_mfma_f32_16x16x32_bf16(Bt[n][k], At[m][k], acc[ai][bj][m][n], 0, 0, 0); __builtin_amdgcn_s_setprio(0); } while (0)
#define PG8_WAIT_V(n) asm volatile("s_waitcnt vmcnt(" #n ")" ::: "memory")
#define PG8_WAIT_L(n) asm volatile("s_waitcnt lgkmcnt(" #n ")" ::: "memory")
#define PG8_BAR __builtin_amdgcn_s_barrier()
#define PG8_SCHED __builtin_amdgcn_sched_barrier(0)
    Unit cur, nxt; int ui = 0;
    if (!S.next(0, cur)) return;
    f32x4 acc[2][2][4][2];
#pragma unroll
    for (int a = 0; a < 2; ++a)
#pragma unroll
        for (int b = 0; b < 2; ++b)
#pragma unroll
            for (int m = 0; m < 4; ++m)
#pragma unroll
                for (int n = 0; n < 2; ++n) acc[a][b][m][n] = (f32x4){0.f, 0.f, 0.f, 0.f};
    bf16x8 At[4][2], B0[2][2], B1[2][2];
    const char* cA = (const char*)g.A + (size_t)cur.pm * tstepA; const char* cB = (const char*)g.Bt + (size_t)cur.pn * tstepB;
    PG8_STAGE(PG8_SB(0, 0), cB, voffB); PG8_STAGE(PG8_SB(0, 1), cB + hstepB, voffB); PG8_STAGE(PG8_SA(0, 0), cA, voffA); PG8_STAGE(PG8_SA(0, 1), cA + hstepA, voffA);
    if (wr == 1) PG8_BAR;
    PG8_WAIT_V(2); PG8_BAR;
    PG8_STAGE(PG8_SB(1, 0), cB + kstep, voffB); PG8_STAGE(PG8_SA(1, 0), cA + kstep, voffA); PG8_STAGE(PG8_SB(1, 1), cB + hstepB + kstep, voffB);
    PG8_WAIT_V(6); PG8_BAR;
    for (;;) {
        const bool has_next = S.next(ui + 1, nxt);
        const char* nA = has_next ? (const char*)g.A + (size_t)nxt.pm * tstepA : cA; const char* nB = has_next ? (const char*)g.Bt + (size_t)nxt.pn * tstepB : cB;
        for (int t = 0; t < nt; t += 2) {
            const bool last = (t == nt - 2);
            const char* a1 = cA + (size_t)(t + 1) * kstep;
            const char* a2 = last ? nA : cA + (size_t)(t + 2) * kstep; const char* b2 = last ? nB : cB + (size_t)(t + 2) * kstep;
            const char* a3 = a2 + kstep; const char* b3 = b2 + kstep;
            PG8_LDB(B0, 0, 0); PG8_LDB(B1, 0, 1); PG8_SCHED; PG8_LDA(At, 0, 0); PG8_STAGE(PG8_SA(1, 1), a1 + hstepA, voffA);
            PG8_WAIT_V(8); PG8_WAIT_L(0); PG8_BAR; PG8_MMA(0, 0, At, B0); PG8_MMA(0, 1, At, B1); PG8_BAR; PG8_SCHED;
            PG8_LDA(At, 0, 1); PG8_STAGE(PG8_SB(0, 0), b2, voffB); PG8_STAGE(PG8_SB(0, 1), b2 + hstepB, voffB); PG8_STAGE(PG8_SA(0, 0), a2, voffA);
            PG8_WAIT_V(8); PG8_WAIT_L(0); PG8_BAR; PG8_MMA(1, 0, At, B0); PG8_MMA(1, 1, At, B1); PG8_BAR; PG8_SCHED;
            PG8_LDB(B0, 1, 0); PG8_LDB(B1, 1, 1); PG8_SCHED; PG8_LDA(At, 1, 0); PG8_STAGE(PG8_SA(0, 1), a2 + hstepA, voffA);
            PG8_WAIT_V(8); PG8_WAIT_L(0); PG8_BAR; PG8_MMA(0, 0, At, B0); PG8_MMA(0, 1, At, B1); PG8_BAR; PG8_SCHED;
            PG8_LDA(At, 1, 1); PG8_STAGE(PG8_SB(1, 0), b3, voffB); PG8_STAGE(PG8_SB(1, 1), b3 + hstepB, voffB); PG8_STAGE(PG8_SA(1, 0), a3, voffA);
            PG8_WAIT_V(8); PG8_WAIT_L(0); PG8_BAR; PG8_MMA(1, 0, At, B0); PG8_MMA(1, 1, At, B1); PG8_BAR; PG8_SCHED;
        }
        if (wr == 0) PG8_BAR;
        { const int tl = opaque_tid() & 63; E(acc, cur, wr, wc, tl & 15, tl >> 4); }
        if (!has_next) break;
#pragma unroll
        for (int a = 0; a < 2; ++a)
#pragma unroll
            for (int b = 0; b < 2; ++b)
#pragma unroll
                for (int m = 0; m < 4; ++m)
#pragma unroll
                    for (int n = 0; n < 2; ++n) acc[a][b][m][n] = (f32x4){0.f, 0.f, 0.f, 0.f};
        cur = nxt; cA = nA; cB = nB; ++ui;
        if (wr == 1) PG8_BAR;
    }
    PG8_WAIT_V(0);
    PG8_BAR;
#undef PG8_SA
#undef PG8_SB
#undef PG8_STAGE
#undef PG8_LDA
#undef PG8_LDB
#undef PG8_MMA
#undef PG8_WAIT_V
#undef PG8_WAIT_L
#undef PG8_BAR
#undef PG8_SCHED
}
}
using pg8::Unit; using pg8::HALF; using pg8::BM;


#define XB_TMO      128
#define XB_XCNT(j)  (256  + 64 * (j))
#define XB_XSUB(j)  (1280 + 64 * (j))
#define XB_XGEN(j)  (2304 + 64 * (j))
#define XB_TOP      3328
#define XB_TOPGEN   3392
#define XCD_BAR_WORDS 3456
#define XB_SPIN_CAP (1u << 18)
__device__ __forceinline__ unsigned xb_ld(unsigned* p)              { return __hip_atomic_load(p, __ATOMIC_RELAXED, __HIP_MEMORY_SCOPE_AGENT); }
__device__ __forceinline__ unsigned xb_add(unsigned* p, unsigned v) { return __hip_atomic_fetch_add(p, v, __ATOMIC_RELAXED, __HIP_MEMORY_SCOPE_AGENT); }
__device__ __forceinline__ unsigned xb_xcc_id() { return (unsigned)__builtin_amdgcn_s_getreg((3 << 11) | 20) & 0xFu; }
#define XB_SPIN(cond, bar) do { unsigned _sp = 0; while (cond) { __builtin_amdgcn_s_sleep(1); \
    if ((++_sp & 255u) == 0u) { if (xb_ld(&(bar)[XB_TMO])) break; if (_sp > XB_SPIN_CAP) { atomicAdd(&(bar)[XB_TMO], 1u); break; } } } } while (0)
struct XcdBarrier { unsigned* bar; unsigned x; volatile LAS unsigned* st; };
__device__ __forceinline__ XcdBarrier xcd_barrier_post(unsigned* bar, volatile LAS unsigned* st) {
    XcdBarrier b; b.bar = bar; b.x = xb_xcc_id(); b.st = st;
    if (threadIdx.x == 0) (void)xb_add(&bar[XB_XCNT(b.x)], 1u);
    return b;
}
__device__ __forceinline__ void xcd_barrier_complete(unsigned* bar, unsigned x, unsigned& nloc, unsigned& nx) {
    const unsigned G = gridDim.x * gridDim.y * gridDim.z;
    unsigned sum, cnt, mine, sp = 0u;
    for (;;) {
        sum = 0u; cnt = 0u; mine = 0u;
#pragma unroll
        for (unsigned j = 0; j < 16; ++j) { const unsigned c = xb_ld(&bar[XB_XCNT(j)]); sum += c; cnt += (c > 0u) ? 1u : 0u; mine = (j == x) ? c : mine; }
        if (sum == G) break;
        __builtin_amdgcn_s_sleep(1);
        if ((++sp & 255u) == 0u) { if (xb_ld(&bar[XB_TMO])) break; if (sp > XB_SPIN_CAP) { atomicAdd(&bar[XB_TMO], 1u); break; } }
    }
    nloc = mine > 0u ? mine : 1u; nx = cnt > 0u ? cnt : 1u;
}
__device__ __forceinline__ void xcd_barrier(const XcdBarrier& b) {
    asm volatile("s_waitcnt vmcnt(0)" ::: "memory");
    __syncthreads();
    if (threadIdx.x == 0) {
        unsigned* bar = b.bar;
        __builtin_amdgcn_s_waitcnt(0);
        unsigned nloc = b.st[0], nx = b.st[1];
        if (nloc == 0u) { xcd_barrier_complete(bar, b.x, nloc, nx); b.st[0] = nloc; b.st[1] = nx; }
        const unsigned old = xb_add(&bar[XB_XSUB(b.x)], 1u);
        const unsigned gen = old / nloc;
        if (old + 1u == (gen + 1u) * nloc) {
            __builtin_amdgcn_fence(__ATOMIC_RELEASE, "agent");
            asm volatile("s_waitcnt vmcnt(0)" ::: "memory");
            const unsigned og = xb_add(&bar[XB_TOP], 1u);
            const unsigned tg = og / nx;
            if (og + 1u == (tg + 1u) * nx) xb_add(&bar[XB_TOPGEN], 1u);
            else XB_SPIN(xb_ld(&bar[XB_TOPGEN]) == tg, bar);
            __builtin_amdgcn_fence(__ATOMIC_ACQUIRE, "agent");
            xb_add(&bar[XB_XGEN(b.x)], 1u);
            asm volatile("s_waitcnt vmcnt(0)" ::: "memory");
        } else {
            XB_SPIN(xb_ld(&bar[XB_XGEN(b.x)]) == gen, bar);
            __builtin_amdgcn_fence(__ATOMIC_ACQUIRE, "agent");
            asm volatile("s_waitcnt vmcnt(0)" ::: "memory");
        }
    }
    __syncthreads();
}

__device__ __forceinline__ float row_rstd(const float* rp, int row, int fq, int lane) {
    const f32x4 a = *(const f32x4*)(rp + (size_t)row * 32 + fq * 8), b = *(const f32x4*)(rp + (size_t)row * 32 + fq * 8 + 4);
    float s = ((a[0] + a[1]) + (a[2] + a[3])) + ((b[0] + b[1]) + (b[2] + b[3]));
    s += shx(s, lane, 16); s += shx(s, lane, 32);
    return rsqrtf(s * (1.f / DM) + EPSV);
}
template <int ACT  > struct EpiBf16 {
    static constexpr bool PERM = true;
    bf16_t* O; int ldc; const float* bias; const float* rss;
    __device__ __forceinline__ void operator()(const f32x4 (&acc)[2][2][4][2], const Unit& u, int wr, int wc, int fr, int fq) const {
        const int row0 = u.pm * BM + wr * 64 + fr, col0 = u.pn * BM + wc * 32 + 8 * fq;
        f32x4 bv[2][2];
#pragma unroll
        for (int bj = 0; bj < 2; ++bj)
#pragma unroll
            for (int n = 0; n < 2; ++n) bv[bj][n] = (ACT == 2) ? *(const f32x4*)(bias + col0 + bj * HALF + 4 * n) : (f32x4){0.f, 0.f, 0.f, 0.f};
        float rsv[2][4];
#pragma unroll
        for (int ai = 0; ai < 2; ++ai)
#pragma unroll
            for (int m = 0; m < 4; ++m) rsv[ai][m] = rss ? row_rstd(rss, row0 + ai * HALF + m * 16, fq, fq * 16 + fr) : 1.f;
        asm volatile("" ::: "memory");
#pragma unroll
        for (int ai = 0; ai < 2; ++ai)
#pragma unroll
            for (int m = 0; m < 4; ++m) { bf16_t* rowp = O + (size_t)(row0 + ai * HALF + m * 16) * ldc + col0;
                const float rs = rsv[ai][m];
#pragma unroll
                for (int bj = 0; bj < 2; ++bj) { f32x4 v0 = acc[ai][bj][m][0] * rs + bv[bj][0], v1 = acc[ai][bj][m][1] * rs + bv[bj][1];
                    if (ACT == 1) {
#pragma unroll
                        for (int j = 0; j < 4; ++j) { const float a = fmaxf(v0[j], 0.f), b = fmaxf(v1[j], 0.f); v0[j] = a * a; v1[j] = b * b; } }
                    if (ACT == 2) {
#pragma unroll
                        for (int j = 0; j < 4; ++j) { v0[j] = gelu_tanh(v0[j]); v1[j] = gelu_tanh(v1[j]); } }
                    u32x4 w; w.x = pk2(v0[0], v0[1]); w.y = pk2(v0[2], v0[3]); w.z = pk2(v1[0], v1[1]); w.w = pk2(v1[2], v1[3]);
                    *(u32x4*)(rowp + bj * HALF) = w; } }
    }
};
template <int MODE> struct EpiF32 {
    static constexpr bool PERM = false;
    const float* base; float* out; const float* pp; int ldc; bf16_t* hb; float* rss_out; const float* rss_in;
    __device__ __forceinline__ void operator()(const f32x4 (&acc)[2][2][4][2], const Unit& u, int wr, int wc, int fr, int fq) const {
        const int row0 = u.pm * BM + wr * 64 + fr, col0 = u.pn * BM + wc * 32 + 4 * fq; const int lane = fq * 16 + fr;
        float rinv[8];
#pragma unroll
        for (int g = 0; g < 8; ++g) rinv[g] = (MODE == 1) ? row_rstd(rss_in, row0 + (g >> 2) * HALF + (g & 3) * 16, fq, lane) : 1.f;
        f32x4 bc[4], pc[4];
        if (MODE != 2) {
#pragma unroll
            for (int q = 0; q < 4; ++q) { const size_t o2 = (size_t)row0 * ldc + col0 + (q >> 1) * HALF + (q & 1) * 16; bc[q] = *(const f32x4*)(base + o2); if (MODE == 1) pc[q] = *(const f32x4*)(pp + o2); } }
#pragma unroll
        for (int g = 0; g < 8; ++g) { const int ai = g >> 2, m = g & 3; const int row = row0 + ai * HALF + m * 16; const size_t off = (size_t)row * ldc + col0;
            f32x4 av[4];
#pragma unroll
            for (int q = 0; q < 4; ++q) { f32x4 a = acc[ai][q >> 1][m][q & 1];
                if (MODE == 0) a = a + bc[q];
                if (MODE == 1) {
#pragma unroll
                    for (int j = 0; j < 4; ++j) a[j] = bc[q][j] + sigmoidf_(a[j] * rinv[g]) * pc[q][j]; }
                av[q] = a; }
            if (MODE != 2) { asm volatile("" : "+v"(av[0]), "+v"(av[1]), "+v"(av[2]), "+v"(av[3]));
                if (g < 7) { const int rown = row0 + ((g + 1) >> 2) * HALF + ((g + 1) & 3) * 16;
#pragma unroll
                    for (int q = 0; q < 4; ++q) { const size_t o2 = (size_t)rown * ldc + col0 + (q >> 1) * HALF + (q & 1) * 16; bc[q] = *(const f32x4*)(base + o2); if (MODE == 1) pc[q] = *(const f32x4*)(pp + o2); } }
                asm volatile("" ::: "memory"); }
            float ss = 0.f;
#pragma unroll
            for (int q = 0; q < 4; ++q) { const size_t o2 = off + (q >> 1) * HALF + (q & 1) * 16; const f32x4 a = av[q];
                *(f32x4*)(out + o2) = a;
                if (MODE != 2) { ss += (a[0] * a[0] + a[1] * a[1]) + (a[2] * a[2] + a[3] * a[3]); u32x2 w; w.x = pk2(a[0], a[1]); w.y = pk2(a[2], a[3]); *(u32x2*)(hb + o2) = w; } }
            if (MODE != 2) { ss += shx(ss, lane, 16); ss += shx(ss, lane, 32); if (fq == 0) rss_out[(size_t)row * 32 + u.pn * 4 + wc] = ss; }
        }
    }
};
struct EpiNsa {
    static constexpr bool PERM = true;
    bf16_t *Q, *KC, *VC, *KS, *VST, *KW, *VWT; float* GL; const float* rss;
    __device__ __forceinline__ void operator()(const f32x4 (&acc)[2][2][4][2], const Unit& u, int wr, int wc, int fr, int fq) const {
        const int row0 = u.pm * BM + wr * 64 + fr; const int pn = u.pn;
        float rsv[2][4];
#pragma unroll
        for (int ai = 0; ai < 2; ++ai)
#pragma unroll
            for (int m = 0; m < 4; ++m) rsv[ai][m] = row_rstd(rss, row0 + ai * HALF + m * 16, fq, fq * 16 + fr);
        asm volatile("" ::: "memory");
#pragma unroll
        for (int ai = 0; ai < 2; ++ai)
#pragma unroll
            for (int m = 0; m < 4; ++m) { const int row = row0 + ai * HALF + m * 16; const int b = row >> 12, s = row & 4095;
                const float rs = rsv[ai][m];
#pragma unroll
                for (int bj = 0; bj < 2; ++bj) { const f32x4 v0 = acc[ai][bj][m][0] * rs, v1 = acc[ai][bj][m][1] * rs;
                    const int cl = bj * HALF + wc * 32 + 8 * fq;
                    if (pn < 8) { u32x4 w; w.x = pk2(v0[0], v0[1]); w.y = pk2(v0[2], v0[3]); w.z = pk2(v1[0], v1[1]); w.w = pk2(v1[2], v1[3]);
                        *(u32x4*)(Q + (size_t)row * 2048 + pn * 256 + cl) = w; }
                    else { const int k = (pn - 8) >> 1; const int c = ((pn - 8) & 1) * 256 + cl; const int g = c >> 7, d = c & 127;
                        if (k == 3 || k == 5) { bf16_t* dst = (k == 3 ? VST : VWT) + ((size_t)((b * 4 + g) * 128 + d)) * 4096 + s;
#pragma unroll
                            for (int j = 0; j < 4; ++j) { dst[(size_t)j * 4096] = (bf16_t)f2bf(v0[j]); dst[(size_t)(4 + j) * 4096] = (bf16_t)f2bf(v1[j]); } }
                        else { bf16_t* dst = (k == 0 ? KC : k == 1 ? VC : k == 2 ? KS : KW) + ((size_t)((b * 4 + g) * 4096 + s)) * 128 + d;
                            u32x4 w; w.x = pk2(v0[0], v0[1]); w.y = pk2(v0[2], v0[3]); w.z = pk2(v1[0], v1[1]); w.w = pk2(v1[2], v1[3]);
                            *(u32x4*)dst = w; } }
 } }
    }
};
struct EpiGates {
    static constexpr bool PERM = true;
    float* GL; const float* rss;
    __device__ __forceinline__ void operator()(const f32x4 (&acc)[2][2][4][2], const Unit& u, int wr, int wc, int fr, int fq) const {
        const int row0 = u.pm * BM + wr * 64 + fr; const int cl = wc * 32 + 8 * fq;
        float rsv[2][4];
#pragma unroll
        for (int ai = 0; ai < 2; ++ai)
#pragma unroll
            for (int m = 0; m < 4; ++m) rsv[ai][m] = row_rstd(rss, row0 + ai * HALF + m * 16, fq, fq * 16 + fr);
        if (cl < 48) {
#pragma unroll
            for (int ai = 0; ai < 2; ++ai)
#pragma unroll
                for (int m = 0; m < 4; ++m) { const int row = row0 + ai * HALF + m * 16; const float rs = rsv[ai][m];
                    const f32x4 v0 = acc[ai][0][m][0] * rs, v1 = acc[ai][0][m][1] * rs; f32x4 a, c2;
#pragma unroll
                    for (int j = 0; j < 4; ++j) { a[j] = sigmoidf_(v0[j]); c2[j] = sigmoidf_(v1[j]); }
                    float* dst = GL + (size_t)row * 48 + cl; *(f32x4*)dst = a; *(f32x4*)(dst + 4) = c2; } }
    }
};
template <int TR> struct EpiCmp2 {
    static constexpr bool PERM = true;
    bf16_t* O;
    __device__ __forceinline__ void operator()(const f32x4 (&acc)[2][2][4][2], const Unit& u, int wr, int wc, int fr, int fq) const {
        const int row0 = u.pm * BM + wr * 64 + fr; const int cl = wc * 32 + 8 * fq;
#pragma unroll
        for (int ai = 0; ai < 2; ++ai)
#pragma unroll
            for (int m = 0; m < 4; ++m) { const int row = row0 + ai * HALF + m * 16; const f32x4 v0 = acc[ai][0][m][0], v1 = acc[ai][0][m][1];
                if (TR == 0) { u32x4 w; w.x = pk2(v0[0], v0[1]); w.y = pk2(v0[2], v0[3]); w.z = pk2(v1[0], v1[1]); w.w = pk2(v1[2], v1[3]);
                    *(u32x4*)(O + (size_t)row * 128 + cl) = w; }
                else { bf16_t* dst = O + ((size_t)((row >> 8) * 128 + cl)) * 256 + (row & 255);
#pragma unroll
                    for (int j = 0; j < 4; ++j) { dst[(size_t)j * 256] = (bf16_t)f2bf(v0[j]); dst[(size_t)(4 + j) * 256] = (bf16_t)f2bf(v1[j]); } } }
    }
};

constexpr size_t al256(size_t x) { return (x + 255) & ~(size_t)255; }
constexpr size_t SZ_WIN = (size_t)AB_IN * DM * 2, SZ_SQ = (size_t)DM * DM * 2, SZ_CIN = (size_t)C_INP * DM * 2, SZ_W1 = (size_t)512 * 4096 * 2, SZ_W2 = (size_t)256 * 512 * 2;
constexpr size_t SZ_UP = (size_t)DFF * DM * 2, SZ_WP = (size_t)DM * PLE * 2, SZ_WRI = (size_t)16 * 64 * 64 * 2, SZ_POOLT = (size_t)4 * 256 * 256 * 2, SZ_WU = (size_t)DM * 1024 * 2;
constexpr size_t WS_WIN = 0;
constexpr size_t WS_WOUT = WS_WIN + 2 * SZ_WIN;
constexpr size_t WS_CIN = WS_WOUT + 2 * SZ_SQ;
constexpr size_t WS_COUT = WS_CIN + 2 * SZ_CIN;
constexpr size_t WS_W1K = WS_COUT + 2 * SZ_SQ;
constexpr size_t WS_W1V = WS_W1K + 2 * SZ_W1;
constexpr size_t WS_W2K = WS_W1V + 2 * SZ_W1;
constexpr size_t WS_W2V = WS_W2K + 2 * SZ_W2;
constexpr size_t WS_WUP = WS_W2V + 2 * SZ_W2;
constexpr size_t WS_WDN = WS_WUP + 4 * SZ_UP;
constexpr size_t WS_WG = WS_WDN + 4 * SZ_UP;
constexpr size_t WS_WP = WS_WG + 4 * SZ_SQ;
constexpr size_t WS_WR = WS_WP + 4 * SZ_WP;
constexpr size_t WS_WI = WS_WR + 2 * SZ_WRI;
constexpr size_t WS_POOLT = WS_WI + 2 * SZ_WRI;
constexpr size_t WS_WU = WS_POOLT + 2 * SZ_POOLT;
constexpr size_t WS_PB = WS_WU + 2 * SZ_WU;
constexpr size_t WS_POSB = WS_PB + (size_t)4 * T_TOK * PLE * 2;
constexpr size_t WS_XN = WS_POSB + 8192;
constexpr size_t WS_YB = WS_XN + (size_t)T_TOK * DM * 2;
constexpr size_t WS_Z = WS_YB + (size_t)T_TOK * DM * 2;
constexpr size_t SZ_KV = (size_t)16 * 4096 * 128 * 2;
constexpr size_t Z_Q = 0, Z_KC = (size_t)T_TOK * DM * 2, Z_VC = Z_KC + SZ_KV, Z_KS = Z_VC + SZ_KV, Z_VST = Z_KS + SZ_KV, Z_KW = Z_VST + SZ_KV, Z_VWT = Z_KW + SZ_KV;
constexpr size_t Z_GL = Z_VWT + SZ_KV, Z_HIDK = Z_GL + (size_t)T_TOK * 48 * 4, Z_HIDV = Z_HIDK + (size_t)4096 * 512 * 2, Z_KCMP = Z_HIDV + (size_t)4096 * 512 * 2, Z_VCMPT = Z_KCMP + (size_t)4096 * 128 * 2;
constexpr size_t WS_BAR = WS_Z + (size_t)T_TOK * DFF * 2;
constexpr size_t WS_ROWSS = WS_BAR + XCD_BAR_WORDS * 4 + 256;
constexpr size_t WS_PP = WS_ROWSS + (size_t)13 * T_TOK * 32 * 4;
constexpr size_t WS_POSP = WS_PP + (size_t)T_TOK * DM * 4;
constexpr size_t WS_WGL = WS_POSP + (size_t)4 * 64 * 512 * 4;
constexpr size_t WS_END = WS_WGL + (size_t)2 * 256 * DM * 2;
static_assert(Z_VCMPT + 4096 * 128 * 2 <= (size_t)T_TOK * DFF * 2, "z region");
static_assert(WS_END <= (size_t)1 << 30, "workspace");
constexpr int LDS_BYTES = 147456;

struct Args { const float* in[29]; float* out; unsigned char* ws; int lo, hi, one, pad; };

__device__ __forceinline__ void titem_load(float (&v)[64], const float* W, int N, int ldw, int item, int lane) {
    const int nblk = (N + 63) / 64, kb = item / nblk, nb = item % nblk, k0 = 64 * kb, n0 = 64 * nb;
    const int nn = n0 + lane; const bool ok = nn < N;
    const float* p = W + (size_t)k0 * ldw + nn;
#pragma unroll
    for (int i = 0; i < 64; ++i) v[i] = ok ? p[(size_t)i * ldw] : 0.f;
}
__device__ __forceinline__ void titem_store(const float (&v)[64], int N, bf16_t* WT, int ldt, LAS float* scr, int item, int lane, const float* gk) {
    const int nblk = (N + 63) / 64, kb = item / nblk, nb = item % nblk, k0 = 64 * kb, n0 = 64 * nb;
#pragma unroll
    for (int i = 0; i < 64; ++i) scr[i * 65 + lane] = v[i];
    asm volatile("s_waitcnt lgkmcnt(0)" ::: "memory");
    const int c = lane & 7;
    f32x4 g0 = (f32x4){1.f, 1.f, 1.f, 1.f}, g1 = g0; if (gk) { g0 = *(const f32x4*)(gk + k0 + 8 * c); g1 = *(const f32x4*)(gk + k0 + 8 * c + 4); }
#pragma unroll
    for (int j = 0; j < 8; ++j) { const int n = (lane >> 3) + 8 * j; const LAS float* s = scr + (8 * c) * 65 + n;
        u32x4 o; o.x = pk2(s[0 * 65] * g0[0], s[1 * 65] * g0[1]); o.y = pk2(s[2 * 65] * g0[2], s[3 * 65] * g0[3]); o.z = pk2(s[4 * 65] * g1[0], s[5 * 65] * g1[1]); o.w = pk2(s[6 * 65] * g1[2], s[7 * 65] * g1[3]);
        if (n0 + n < N) *(u32x4*)(WT + (size_t)(n0 + n) * ldt + k0 + 8 * c) = o; }
    asm volatile("s_waitcnt lgkmcnt(0)" ::: "memory");
}
__device__ __forceinline__ void conv_mat(const float* W, int K, int N, int ldw, bf16_t* WT, int ldt, LAS float* scr, int gw, int NGW, int lane, int& rot, const float* gk = nullptr) {
    const int nitems = (K / 64) * ((N + 63) / 64);
    int it = gw - rot; if (it < 0) it += NGW;
    rot = (rot + nitems) % NGW;
    if (it >= nitems) return;
    float va[64], vb[64];
    titem_load(va, W, N, ldw, it, lane);
    for (;;) {
        const int n1 = it + NGW; if (n1 < nitems) titem_load(vb, W, N, ldw, n1, lane);
        titem_store(va, N, WT, ldt, scr, it, lane, gk);
        if (n1 >= nitems) break;
        const int n2 = n1 + NGW; if (n2 < nitems) titem_load(va, W, N, ldw, n2, lane);
        titem_store(vb, N, WT, ldt, scr, n1, lane, gk);
        if (n2 >= nitems) break;
        it = n2;
    }
}
__device__ __forceinline__ void conv_plain(const float* src, int rows, int ncols, int lds_, bf16_t* dst, int ldd, int gt, int NGT, const float* gk = nullptr) {
    const int cpr = ncols / 8; const long total = (long)rows * cpr;
    for (long i = gt; i < total; i += NGT) { const int r = (int)(i / cpr), c = (int)(i % cpr) * 8;
        f32x4 a = *(const f32x4*)(src + (size_t)r * lds_ + c), b = *(const f32x4*)(src + (size_t)r * lds_ + c + 4);
        if (gk) { const float gg = gk[r]; a = a * gg; b = b * gg; }
        u32x4 o; o.x = f2bf(a[0]) | (f2bf(a[1]) << 16); o.y = f2bf(a[2]) | (f2bf(a[3]) << 16); o.z = f2bf(b[0]) | (f2bf(b[1]) << 16); o.w = f2bf(b[2]) | (f2bf(b[3]) << 16);
        *(u32x4*)(dst + (size_t)r * ldd + c) = o; }
}
__device__ __forceinline__ void zero_fill16(unsigned char* p, size_t bytes, int gt, int NGT) {
    const u32x4 z = (u32x4){0u, 0u, 0u, 0u};
    for (size_t i = (size_t)gt * 16; i < bytes; i += (size_t)NGT * 16) *(u32x4*)(p + i) = z;
}

template <bool F32OUT>
__device__ __forceinline__ void rmsnorm_rows(const float* X, const float* g, bf16_t* O, float* OF, int bx, int NGW) {
    asm volatile("" ::: "memory"); const int tid = opaque_tid(), lane = tid & 63; const int gw = opq(bx) * 8 + __builtin_amdgcn_readfirstlane(tid >> 6);
    f32x4 gv[8];
#pragma unroll
    for (int j = 0; j < 8; ++j) gv[j] = *(const f32x4*)(g + (lane + 64 * j) * 4);
    for (int r = gw; r < T_TOK; r += NGW) {
        const float* xr = X + (size_t)r * DM; f32x4 v[8]; float s = 0.f;
#pragma unroll
        for (int j = 0; j < 8; ++j) { v[j] = *(const f32x4*)(xr + (lane + 64 * j) * 4); s += (v[j][0] * v[j][0] + v[j][1] * v[j][1]) + (v[j][2] * v[j][2] + v[j][3] * v[j][3]); }
        const float rstd = rsqrtf(wave_sum(s, lane) * (1.f / DM) + EPSV);
#pragma unroll
        for (int j = 0; j < 8; ++j) { const f32x4 y = v[j] * rstd * gv[j];
            if (F32OUT) *(f32x4*)(OF + (size_t)r * DM + (lane + 64 * j) * 4) = y;
            else { u32x2 w; w.x = pk2(y[0], y[1]); w.y = pk2(y[2], y[3]); *(u32x2*)(O + (size_t)r * DM + (lane + 64 * j) * 4) = w; } }
    }
}

__device__ __forceinline__ void rows_to_bf16_ss(const float* X, bf16_t* O, float* rss, int bx, int NGW) {
    const int tid = opaque_tid(), lane = tid & 63; const int gw = opq(bx) * 8 + __builtin_amdgcn_readfirstlane(tid >> 6);
    for (int r = gw; r < T_TOK; r += NGW) {
        const float* xr = X + (size_t)r * DM; f32x4 v[8]; float s = 0.f;
#pragma unroll
        for (int j = 0; j < 8; ++j) { v[j] = *(const f32x4*)(xr + (lane + 64 * j) * 4); s += (v[j][0] * v[j][0] + v[j][1] * v[j][1]) + (v[j][2] * v[j][2] + v[j][3] * v[j][3]); }
        s = wave_sum(s, lane); if (lane < 32) rss[(size_t)r * 32 + lane] = (lane == 0) ? s : 0.f;
#pragma unroll
        for (int j = 0; j < 8; ++j) { u32x2 w; w.x = pk2(v[j][0], v[j][1]); w.y = pk2(v[j][2], v[j][3]); *(u32x2*)(O + (size_t)r * DM + (lane + 64 * j) * 4) = w; }
    }
}
__device__ __forceinline__ void lru_item(LAS unsigned char* lds, int item, const bf16_t* ZE, const float* conv_w, const float* conv_b,
                                         const bf16_t* WrT, const bf16_t* WiT, const float* b_r, const float* b_i, const float* lam, bf16_t* YB) {
    const int tid = opaque_tid(), w = __builtin_amdgcn_readfirstlane(tid >> 6), lane = tid & 63, fr = lane & 15, fq = lane >> 4;
    const int b = item >> 6, hh = (item >> 2) & 15, qq = item & 3;
    LAS unsigned char* XC = lds;
    LAS float* SEGA = (LAS float*)(lds + 36864);
    LAS float* SEGB = SEGA + 1024;
    LAS float* HIN = SEGB + 1024;
    const int co = tid & 7, tr = tid >> 3;
    float cw[4][8], cb[8];
#pragma unroll
    for (int k = 0; k < 4; ++k)
#pragma unroll
        for (int e = 0; e < 8; ++e) cw[k][e] = conv_w[k * 1024 + hh * 64 + co * 8 + e];
#pragma unroll
    for (int e = 0; e < 8; ++e) cb[e] = conv_b[hh * 64 + co * 8 + e];
    bf16x8 wrf[2], wif[2];
#pragma unroll
    for (int kk = 0; kk < 2; ++kk) { wrf[kk] = *(const bf16x8*)(WrT + ((size_t)hh * 64 + qq * 16 + fr) * 64 + kk * 32 + fq * 8); wif[kk] = *(const bf16x8*)(WiT + ((size_t)hh * 64 + qq * 16 + fr) * 64 + kk * 32 + fq * 8); }
    const int ch = hh * 64 + qq * 16 + fr;
    const float br = b_r[ch], bi = b_i[ch];
    const float lm = lam[ch]; float sp8; { const float e = __expf(-lm); const float ser = e * (1.f - e * (0.5f - e * (0.33333333f - e * 0.25f)));
        sp8 = 8.0f * ((-lm > 20.f) ? -lm : (e < 0.03f ? ser : __logf(1.0f + e))); }
    float carry = 0.f;
    const bf16_t* zb = ZE + (size_t)b * SEQ * AB_IN;
    for (int sc = 0; sc < 16; ++sc) {
        const int t0 = sc * 256;
        {
            float xin[7][8];
#pragma unroll
            for (int r = 0; r < 7; ++r) { const int t = t0 + tr * 4 - 3 + r;
                if (t >= 0) { const u32x4 v = *(const u32x4*)(zb + (size_t)t * AB_IN + hh * 64 + co * 8);
                    xin[r][0] = bflo(v.x); xin[r][1] = bfhi(v.x); xin[r][2] = bflo(v.y); xin[r][3] = bfhi(v.y); xin[r][4] = bflo(v.z); xin[r][5] = bfhi(v.z); xin[r][6] = bflo(v.w); xin[r][7] = bfhi(v.w); }
                else {
#pragma unroll
                    for (int e = 0; e < 8; ++e) xin[r][e] = 0.f; } }
#pragma unroll
            for (int q = 0; q < 4; ++q) { float o[8];
#pragma unroll
                for (int e = 0; e < 8; ++e) o[e] = cb[e] + cw[0][e] * xin[q][e] + cw[1][e] * xin[q + 1][e] + cw[2][e] * xin[q + 2][e] + cw[3][e] * xin[q + 3][e];
                u32x4 wv; wv.x = pk2(o[0], o[1]); wv.y = pk2(o[2], o[3]); wv.z = pk2(o[4], o[5]); wv.w = pk2(o[6], o[7]);
                *(LAS u32x4*)(XC + (tr * 4 + q) * 144 + co * 16) = wv; }
        }
        __syncthreads();
        float av[2][4], bv[2][4];
#pragma unroll
        for (int ml = 0; ml < 2; ++ml) { const int mt = w * 2 + ml;
            f32x4 ar = (f32x4){0.f, 0.f, 0.f, 0.f}, ai = ar;
#pragma unroll
            for (int kk = 0; kk < 2; ++kk) { const bf16x8 xa = *(const LAS bf16x8*)(XC + (mt * 16 + fr) * 144 + kk * 64 + fq * 16);
                ar = __builtin_amdgcn_mfma_f32_16x16x32_bf16(xa, wrf[kk], ar, 0, 0, 0); ai = __builtin_amdgcn_mfma_f32_16x16x32_bf16(xa, wif[kk], ai, 0, 0, 0); }
            float A = 1.f, Bc = 0.f;
#pragma unroll
            for (int r = 0; r < 4; ++r) { const int tok = mt * 16 + fq * 4 + r;
                const float xcv = bf2f(*(const LAS unsigned short*)(XC + tok * 144 + (qq * 16 + fr) * 2));
                const float rg = sigmoidf_(ar[r] + br), ig = sigmoidf_(ai[r] + bi);
                const float la = -rg * sp8; const float a = __expf(la); const float x2 = 2.f * la; const float em = (x2 > -0.3f) ? -x2 * (1.f + x2 * 0.5f * (1.f + x2 * 0.33333333f * (1.f + x2 * 0.25f * (1.f + x2 * 0.2f * (1.f + x2 * 0.16666667f))))) : 1.f - __expf(x2);
                const float mult = sqrtf(fmaxf(em, 0.f));
                av[ml][r] = a; bv[ml][r] = mult * ig * xcv;
                Bc = a * Bc + bv[ml][r]; A = A * a; }
            const int sg = mt * 4 + fq; SEGA[sg * 16 + fr] = A; SEGB[sg * 16 + fr] = Bc; }
        __syncthreads();
        if (w == 0 && lane < 16) { float h = carry;
#pragma unroll 8
            for (int sg = 0; sg < 64; ++sg) { HIN[sg * 16 + lane] = h; h = SEGA[sg * 16 + lane] * h + SEGB[sg * 16 + lane]; }
            carry = h; }
        __syncthreads();
#pragma unroll
        for (int ml = 0; ml < 2; ++ml) { const int mt = w * 2 + ml; float h = HIN[(mt * 4 + fq) * 16 + fr];
#pragma unroll
            for (int r = 0; r < 4; ++r) { const int t = t0 + mt * 16 + fq * 4 + r; h = av[ml][r] * h + bv[ml][r];
                const float gt = bf2f(zb[(size_t)t * AB_IN + 1024 + ch]);
                YB[((size_t)b * SEQ + t) * DM + ch] = (bf16_t)f2bf(h * gelu_tanh(gt)); } }
    }
    __syncthreads();
}
__device__ __forceinline__ void pool_item(int item, const bf16_t* ZE, const float* scale, bf16_t* YB) {
    const int tid = opaque_tid(), b = item >> 6, tch = item & 63, co = tid & 127, seg = tid >> 7;
    const int win = 2 << (co >> 5);
    float sc[8];
#pragma unroll
    for (int e = 0; e < 8; ++e) sc[e] = scale[co * 8 + e];
    const bf16_t* zb = ZE + (size_t)b * SEQ * AB_IN + 2048 + co * 8;
    const int ts = tch * 64 + seg * 16;
    float sum[8];
#pragma unroll
    for (int e = 0; e < 8; ++e) sum[e] = 0.f;
    for (int s = ts - win + 1; s < ts; ++s) if (s >= 0) { const u32x4 v = *(const u32x4*)(zb + (size_t)s * AB_IN);
        sum[0] += bflo(v.x); sum[1] += bfhi(v.x); sum[2] += bflo(v.y); sum[3] += bfhi(v.y); sum[4] += bflo(v.z); sum[5] += bfhi(v.z); sum[6] += bflo(v.w); sum[7] += bfhi(v.w); }
    for (int t = ts; t < ts + 16; ++t) {
        const u32x4 v = *(const u32x4*)(zb + (size_t)t * AB_IN);
        float x[8] = {bflo(v.x), bfhi(v.x), bflo(v.y), bfhi(v.y), bflo(v.z), bfhi(v.z), bflo(v.w), bfhi(v.w)};
        const float inv = 1.0f / (float)((t + 1) < win ? (t + 1) : win);
        float o[8];
#pragma unroll
        for (int e = 0; e < 8; ++e) { sum[e] += x[e]; o[e] = (sum[e] * inv - x[e]) * sc[e]; }
        u32x4 wv; wv.x = pk2(o[0], o[1]); wv.y = pk2(o[2], o[3]); wv.z = pk2(o[4], o[5]); wv.w = pk2(o[6], o[7]);
        *(u32x4*)(YB + ((size_t)b * SEQ + t) * DM + 1024 + co * 8) = wv;
        const int so = t - win + 1;
        if (so >= 0) { const u32x4 q = *(const u32x4*)(zb + (size_t)so * AB_IN);
            sum[0] -= bflo(q.x); sum[1] -= bfhi(q.x); sum[2] -= bflo(q.y); sum[3] -= bfhi(q.y); sum[4] -= bflo(q.z); sum[5] -= bfhi(q.z); sum[6] -= bflo(q.w); sum[7] -= bfhi(q.w); }
    }
}

constexpr int KT_PITCH = 272, VT_PITCH = 144;
constexpr int AL_KT = 0, AL_VT = 64 * KT_PITCH, AL_IMPA = 36864, AL_IMPB = AL_IMPA + 64 * 65 * 4, AL_SEL = AL_IMPB + 64 * 65 * 4, AL_UNI = AL_SEL + 512, AL_Q = 73728, Q_WAVE = 32 * KT_PITCH;
constexpr float QSCALE2 = 0.08838834764831845f * LOG2E;
constexpr float NEGB = -1e30f;

struct StageRegs { u32x4 k[2], v[2]; };
__device__ __forceinline__ void stage_load(StageRegs& R, const bf16_t* kbase, const bf16_t* vbase, int vpitch, int tid) {
    const int kr = tid >> 3, kc = tid & 7, vr = tid >> 2, vc = tid & 3;
    R.k[0] = *(const u32x4*)(kbase + kr * 128 + kc * 8); R.k[1] = *(const u32x4*)(kbase + kr * 128 + 64 + kc * 8);
    R.v[0] = *(const u32x4*)(vbase + (size_t)vr * vpitch + vc * 8); R.v[1] = *(const u32x4*)(vbase + (size_t)vr * vpitch + 32 + vc * 8);
}
__device__ __forceinline__ void stage_store(const StageRegs& R, LAS unsigned char* lds, int tid) {
    const int kr = tid >> 3, kc = tid & 7, vr = tid >> 2, vc = tid & 3;
    *(LAS u32x4*)(lds + AL_KT + kr * KT_PITCH + kc * 16) = R.k[0]; *(LAS u32x4*)(lds + AL_KT + kr * KT_PITCH + 128 + kc * 16) = R.k[1];
    *(LAS u32x4*)(lds + AL_VT + vr * VT_PITCH + vc * 16) = R.v[0]; *(LAS u32x4*)(lds + AL_VT + vr * VT_PITCH + 64 + vc * 16) = R.v[1];
}
template <int MODE>
__device__ __forceinline__ void attn_tile(bool MASK, LAS unsigned char* lds, f32x4 (&O)[2][8], float (&m)[2], float (&l)[2], const int (&tpos)[2], float slope2,
                                          int kp0, const bool (&selbit)[2], int fr, int fq, int wv, int tile64, int lane) {
    constexpr int KS = (MODE <= 1) ? 16 : 1;
    f32x4 s[2][4];
#pragma unroll
    for (int ci = 0; ci < 2; ++ci)
#pragma unroll
        for (int k4 = 0; k4 < 4; ++k4) s[ci][k4] = (f32x4){0.f, 0.f, 0.f, 0.f};
#pragma unroll
    for (int kk = 0; kk < 4; ++kk) {
        const bf16x8 q0 = *(const LAS bf16x8*)(lds + AL_Q + wv * Q_WAVE + fr * KT_PITCH + kk * 64 + fq * 16);
        const bf16x8 q1 = *(const LAS bf16x8*)(lds + AL_Q + wv * Q_WAVE + (16 + fr) * KT_PITCH + kk * 64 + fq * 16);
#pragma unroll
        for (int k4 = 0; k4 < 4; ++k4) { const bf16x8 kf = *(const LAS bf16x8*)(lds + AL_KT + (k4 * 16 + fr) * KT_PITCH + kk * 64 + fq * 16);
            s[0][k4] = __builtin_amdgcn_mfma_f32_16x16x32_bf16(kf, q0, s[0][k4], 0, 0, 0);
            s[1][k4] = __builtin_amdgcn_mfma_f32_16x16x32_bf16(kf, q1, s[1][k4], 0, 0, 0); } }
    const float sk = slope2 * (float)KS;
    float alpha[2] = {1.f, 1.f};
#pragma unroll
    for (int ci = 0; ci < 2; ++ci) {
        const int base = tpos[ci] - kp0 - KS * (fq * 4);
        const float bb = -slope2 * (float)base;
        float mx = NEGB;
#pragma unroll
        for (int k4 = 0; k4 < 4; ++k4)
#pragma unroll
            for (int j = 0; j < 4; ++j) {
                s[ci][k4][j] = __builtin_fmaf(s[ci][k4][j], QSCALE2, __builtin_fmaf(sk, (float)(k4 * 16 + j), bb)); }
        if (MASK) {
#pragma unroll
            for (int k4 = 0; k4 < 4; ++k4)
#pragma unroll
                for (int j = 0; j < 4; ++j) { const int c = KS * (k4 * 16 + j); bool ok = c <= base; if (MODE == 3) ok = ok && (base - c < 512); s[ci][k4][j] = ok ? s[ci][k4][j] : 2.0f * NEGB; } }
#pragma unroll
        for (int k4 = 0; k4 < 4; ++k4)
#pragma unroll
            for (int j = 0; j < 4; ++j) mx = fmaxf(mx, s[ci][k4][j]);
        if (MODE == 2) mx = selbit[ci] ? mx : NEGB;
        if (MODE != 1) {
            mx = fmaxf(mx, shx(mx, lane, 16)); mx = fmaxf(mx, shx(mx, lane, 32));
            const float mn = fmaxf(m[ci], mx); alpha[ci] = __builtin_amdgcn_exp2f(m[ci] - mn); m[ci] = mn;
            float ps = 0.f;
#pragma unroll
            for (int k4 = 0; k4 < 4; ++k4)
#pragma unroll
                for (int j = 0; j < 4; ++j) { const float p = __builtin_amdgcn_exp2f(s[ci][k4][j] - mn); s[ci][k4][j] = p; ps += p; }
            if (MODE == 2) ps = selbit[ci] ? ps : 0.f;
            l[ci] = l[ci] * alpha[ci] + ps;
        } else {
#pragma unroll
            for (int k4 = 0; k4 < 4; ++k4) {
#pragma unroll
                for (int j = 0; j < 4; ++j) s[ci][k4][j] = __builtin_amdgcn_exp2f(s[ci][k4][j] - m[ci]) * l[ci];
                float a = (s[ci][k4][0] + s[ci][k4][1]) + (s[ci][k4][2] + s[ci][k4][3]); float b3 = s[ci][k4][3];
                a += shx(a, lane, 1); a += shx(a, lane, 2); b3 += shx(b3, lane, 1); b3 += shx(b3, lane, 2);
                if ((fr & 3) == 0) { const int tl = wv * 8 + ci * 4 + (fr >> 2); const int ms = tile64 * 16 + k4 * 4 + fq;
                    ((LAS float*)(lds + AL_IMPA))[tl * 65 + ms] = a; ((LAS float*)(lds + AL_IMPB))[tl * 65 + ms + 1] = b3; } }
        }
    }
    if (MODE >= 2) {
        if (__builtin_amdgcn_ballot_w64(alpha[0] != 1.f || alpha[1] != 1.f) != 0ull) {
#pragma unroll
            for (int ci = 0; ci < 2; ++ci)
#pragma unroll
                for (int dt = 0; dt < 8; ++dt) O[ci][dt] = O[ci][dt] * alpha[ci]; }
    }
    if (MODE != 0) {
#pragma unroll
        for (int ks = 0; ks < 2; ++ks) {
            bf16x8 pf[2];
#pragma unroll
            for (int ci = 0; ci < 2; ++ci) { u32x4 w; w.x = pk2(s[ci][2 * ks][0], s[ci][2 * ks][1]); w.y = pk2(s[ci][2 * ks][2], s[ci][2 * ks][3]); w.z = pk2(s[ci][2 * ks + 1][0], s[ci][2 * ks + 1][1]); w.w = pk2(s[ci][2 * ks + 1][2], s[ci][2 * ks + 1][3]);
                if (MODE == 2) { w.x = selbit[ci] ? w.x : 0u; w.y = selbit[ci] ? w.y : 0u; w.z = selbit[ci] ? w.z : 0u; w.w = selbit[ci] ? w.w : 0u; }
                pf[ci] = __builtin_bit_cast(bf16x8, w); }
#pragma unroll
            for (int dt = 0; dt < 8; ++dt) { const LAS unsigned char* vp = lds + AL_VT + (dt * 16 + fr) * VT_PITCH + (ks * 32 + fq * 4) * 2;
                const u32x2 lo = *(const LAS u32x2*)vp, hi = *(const LAS u32x2*)(vp + 32);
                const bf16x8 vf = __builtin_bit_cast(bf16x8, (u32x4){lo.x, lo.y, hi.x, hi.y});
                O[0][dt] = __builtin_amdgcn_mfma_f32_16x16x32_bf16(vf, pf[0], O[0][dt], 0, 0, 0);
                O[1][dt] = __builtin_amdgcn_mfma_f32_16x16x32_bf16(vf, pf[1], O[1][dt], 0, 0, 0); }
        }
    }
}

__device__ __forceinline__ void nsa_item(LAS unsigned char* lds, int b, int g, int tq, const bf16_t* Q, const bf16_t* KS, const bf16_t* VST, const bf16_t* KW, const bf16_t* VWT,
                                         const bf16_t* KCMP, const bf16_t* VCMPT, const float* GL, bf16_t* YB) {
    const int tid = opaque_tid(), wv = __builtin_amdgcn_readfirstlane(tid >> 6), lane = tid & 63, fr = lane & 15, fq = lane >> 4;
    const int t0 = tq * 64, bg = b * 4 + g, head = g * 4 + (fr & 3);
    LAS float* IMPA = (LAS float*)(lds + AL_IMPA);
    LAS unsigned long long* SEL = (LAS unsigned long long*)(lds + AL_SEL);
    LAS unsigned long long* UNI = (LAS unsigned long long*)(lds + AL_UNI);
    __syncthreads();
    for (int i = tid; i < 2 * 64 * 65; i += 512) IMPA[i] = 0.f;
    int tpos[2];
#pragma unroll
    for (int ci = 0; ci < 2; ++ci) { tpos[ci] = t0 + wv * 8 + ci * 4 + (fr >> 2);
        const bf16_t* qp = Q + ((size_t)(b * SEQ + tpos[ci])) * DM + head * 128 + fq * 8;
#pragma unroll
        for (int kk = 0; kk < 4; ++kk) *(LAS bf16x8*)(lds + AL_Q + wv * Q_WAVE + (ci * 16 + fr) * KT_PITCH + kk * 64 + fq * 16) = *(const bf16x8*)(qp + kk * 32);
    }
    const float slope2 = exp2f(-0.5f * (float)(head + 1)) * LOG2E;
    f32x4 O[2][8]; float m[2], l[2]; bool selbit[2] = {true, true};
#pragma unroll
    for (int ci = 0; ci < 2; ++ci)
#pragma unroll
        for (int dt = 0; dt < 8; ++dt) { O[ci][dt] = (f32x4){0.f, 0.f, 0.f, 0.f}; }
    StageRegs R;
    const int ncmp = ((t0 + 32) >> 4) + 1, nct = (ncmp + 63) >> 6;
    const bf16_t* kcb = KCMP + (size_t)bg * 256 * 128; const bf16_t* vcb = VCMPT + (size_t)bg * 128 * 256;
    m[0] = m[1] = NEGB; l[0] = l[1] = 0.f;
    stage_load(R, kcb, vcb, 256, tid);
    for (int ct = 0; ct < nct; ++ct) {
        __syncthreads(); stage_store(R, lds, tid); __syncthreads();
        if (ct + 1 < nct) stage_load(R, kcb + (size_t)(ct + 1) * 64 * 128, vcb + (ct + 1) * 64, 256, tid);
        attn_tile<0>(1024 * ct + 1039 > t0, lds, O, m, l, tpos, slope2, 16 * (ct * 64) + 31, selbit, fr, fq, wv, ct, lane);
    }
#pragma unroll
    for (int ci = 0; ci < 2; ++ci) { float lt = l[ci]; lt += shx(lt, lane, 16); lt += shx(lt, lane, 32); l[ci] = lt > 0.f ? 1.0f / lt : 0.f; }
    stage_load(R, kcb, vcb, 256, tid);
    for (int ct = 0; ct < nct; ++ct) {
        __syncthreads(); stage_store(R, lds, tid); __syncthreads();
        if (ct + 1 < nct) stage_load(R, kcb + (size_t)(ct + 1) * 64 * 128, vcb + (ct + 1) * 64, 256, tid);
        attn_tile<1>(1024 * ct + 1039 > t0, lds, O, m, l, tpos, slope2, 16 * (ct * 64) + 31, selbit, fr, fq, wv, ct, lane);
    }
#pragma unroll
    for (int ci = 0; ci < 2; ++ci) { const float gc = GL[((size_t)(b * SEQ + tpos[ci])) * 48 + head];
        bf16_t* op = YB + ((size_t)(b * SEQ + tpos[ci])) * DM + head * 128 + fq * 4;
#pragma unroll
        for (int dt = 0; dt < 8; ++dt) { const f32x4 o = O[ci][dt] * gc; u32x2 w; w.x = pk2(o[0], o[1]); w.y = pk2(o[2], o[3]); *(u32x2*)(op + dt * 16) = w; O[ci][dt] = (f32x4){0.f, 0.f, 0.f, 0.f}; } }
    __syncthreads();
    {
        const int cur = tq; unsigned long long wun = 0ull;
#pragma unroll 1
        for (int tk = 0; tk < 8; ++tk) { const int tl = wv * 8 + tk;
            float v = IMPA[tl * 65 + lane] + IMPA[64 * 65 + tl * 65 + lane];
            if (lane == 0 || lane == cur || lane == cur - 1) v += 1e6f;
            if (lane > cur) v = NEGB;
            int rank = 0; const int vi = __builtin_bit_cast(int, v);
#pragma unroll
            for (int mm = 0; mm < 64; ++mm) { const float vm = __builtin_bit_cast(float, __builtin_amdgcn_readlane(vi, mm)); rank += ((vm > v) || (vm == v && mm < lane)) ? 1 : 0; }
            const unsigned long long mk = __ballot(rank < 16 && lane <= cur);
            wun |= mk;
            if (lane == 0) SEL[tl] = mk; }
        if (lane == 0) UNI[wv] = wun;
    }
    __syncthreads();
    unsigned long long selm[2], wun, bun = 0ull;
#pragma unroll
    for (int ci = 0; ci < 2; ++ci) selm[ci] = SEL[wv * 8 + ci * 4 + (fr >> 2)];
    wun = UNI[wv];
#pragma unroll
    for (int i = 0; i < 8; ++i) bun |= UNI[i];
    { const unsigned lo = __builtin_amdgcn_readfirstlane((unsigned)bun), hi = __builtin_amdgcn_readfirstlane((unsigned)(bun >> 32)); bun = ((unsigned long long)hi << 32) | lo;
      const unsigned lo2 = __builtin_amdgcn_readfirstlane((unsigned)wun), hi2 = __builtin_amdgcn_readfirstlane((unsigned)(wun >> 32)); wun = ((unsigned long long)hi2 << 32) | lo2; }
    const bf16_t* ksb = KS + (size_t)bg * SEQ * 128; const bf16_t* vsb = VST + (size_t)bg * 128 * SEQ;
    m[0] = m[1] = NEGB; l[0] = l[1] = 0.f;
    {
        unsigned long long rem = bun; int j = 63 - __builtin_clzll(rem); rem &= ~(1ull << j);
        stage_load(R, ksb + (size_t)j * 64 * 128, vsb + j * 64, SEQ, tid);
        for (;;) {
            __syncthreads(); stage_store(R, lds, tid); __syncthreads();
            const int jn = rem ? 63 - __builtin_clzll(rem) : -1; if (jn >= 0) { rem &= ~(1ull << jn); stage_load(R, ksb + (size_t)jn * 64 * 128, vsb + jn * 64, SEQ, tid); }
            if ((wun >> j) & 1ull) { selbit[0] = (selm[0] >> j) & 1ull; selbit[1] = (selm[1] >> j) & 1ull;
                attn_tile<2>(j == tq, lds, O, m, l, tpos, slope2, j * 64, selbit, fr, fq, wv, 0, lane); }
            if (jn < 0) break; j = jn;
        }
    }
#pragma unroll
    for (int ci = 0; ci < 2; ++ci) { float lt = l[ci]; lt += shx(lt, lane, 16); lt += shx(lt, lane, 32); const float gs = GL[((size_t)(b * SEQ + tpos[ci])) * 48 + 16 + head]; const float sc = lt > 0.f ? gs / lt : 0.f;
        bf16_t* op = YB + ((size_t)(b * SEQ + tpos[ci])) * DM + head * 128 + fq * 4;
#pragma unroll
        for (int dt = 0; dt < 8; ++dt) { const f32x4 o = O[ci][dt] * sc; const u32x2 pv = *(const u32x2*)(op + dt * 16); u32x2 w; w.x = pk2(bflo(pv.x) + o[0], bfhi(pv.x) + o[1]); w.y = pk2(bflo(pv.y) + o[2], bfhi(pv.y) + o[3]); *(u32x2*)(op + dt * 16) = w; O[ci][dt] = (f32x4){0.f, 0.f, 0.f, 0.f}; } }
    const bf16_t* kwb = KW + (size_t)bg * SEQ * 128; const bf16_t* vwb = VWT + (size_t)bg * 128 * SEQ;
    m[0] = m[1] = NEGB; l[0] = l[1] = 0.f; selbit[0] = selbit[1] = true;
    {
        const int j0 = tq >= 8 ? tq - 8 : 0;
        stage_load(R, kwb + (size_t)tq * 64 * 128, vwb + tq * 64, SEQ, tid);
        for (int j = tq; j >= j0; --j) {
            __syncthreads(); stage_store(R, lds, tid); __syncthreads();
            if (j > j0) stage_load(R, kwb + (size_t)(j - 1) * 64 * 128, vwb + (j - 1) * 64, SEQ, tid);
            attn_tile<3>(j == tq || j == tq - 8, lds, O, m, l, tpos, slope2, j * 64, selbit, fr, fq, wv, 0, lane);
        }
    }
#pragma unroll
    for (int ci = 0; ci < 2; ++ci) { float lt = l[ci]; lt += shx(lt, lane, 16); lt += shx(lt, lane, 32); const float gwv = GL[((size_t)(b * SEQ + tpos[ci])) * 48 + 32 + head]; const float sc = lt > 0.f ? gwv / lt : 0.f;
        bf16_t* op = YB + ((size_t)(b * SEQ + tpos[ci])) * DM + head * 128 + fq * 4;
#pragma unroll
        for (int dt = 0; dt < 8; ++dt) { const f32x4 o = O[ci][dt] * sc; const u32x2 pv = *(const u32x2*)(op + dt * 16); u32x2 w; w.x = pk2(bflo(pv.x) + o[0], bfhi(pv.x) + o[1]); w.y = pk2(bflo(pv.y) + o[2], bfhi(pv.y) + o[3]); *(u32x2*)(op + dt * 16) = w; } }
}

__global__ void __launch_bounds__(512) fwd_kernel(Args a) {
    extern __shared__ __attribute__((aligned(16))) unsigned char lds_raw[];
    LAS unsigned char* lds = (LAS unsigned char*)lds_raw;
    const int G = gridDim.x, bx = blockIdx.x;
    const int NGW = G * 8, NGT = G * 512;
#define GW() (opq(bx) * 8 + __builtin_amdgcn_readfirstlane(opaque_tid() >> 6))
    unsigned char* ws = a.ws;
    int ph = 0;
    { volatile LAS unsigned* MISC = (volatile LAS unsigned*)(lds + LDS_BYTES - 64); if (threadIdx.x < 16) MISC[threadIdx.x] = 0u; }
    __syncthreads();
    (void)xcd_barrier_post((unsigned*)(ws + WS_BAR), (volatile LAS unsigned*)(lds + LDS_BYTES - 64));
#ifndef ONLY
#define ONLY -1
#endif
#define EN(id) (ONLY < 0 || ONLY == (id))
#define ON() (ph >= a.lo && ph < a.hi)
#define SEAM() do { ++ph; if (a.one) { if (ph == 1) cg::this_grid().sync(); else { XcdBarrier bar; bar.bar = (unsigned*)(opqp(ws) + WS_BAR); bar.x = xb_xcc_id(); bar.st = (volatile LAS unsigned*)(lds + LDS_BYTES - 64); xcd_barrier(bar); } } } while (0)

    bf16_t* XN = (bf16_t*)(ws + WS_XN); bf16_t* YB = (bf16_t*)(ws + WS_YB); unsigned char* Z = ws + WS_Z;
    float* posb = (float*)(ws + WS_POSB);

    if (EN(0) && ON())
#pragma unroll 1
    for (int rp0 = 0; rp0 < REP_P0; ++rp0) {
        const int tid = opaque_tid(), lane = tid & 63, wave = __builtin_amdgcn_readfirstlane(tid >> 6), gw = bx * 8 + wave, gt = bx * 512 + tid;
        LAS float* scr = (LAS float*)(lds + wave * 16640);
        int rot = 0;
        for (int i = 0; i < 4; ++i) {
            conv_mat(a.in[23] + (size_t)i * DM * DFF, DM, DFF, DFF, (bf16_t*)(ws + WS_WUP + i * SZ_UP), DM, scr, gw, NGW, lane, rot, a.in[22] + i * DM);
            conv_mat(a.in[24] + (size_t)i * DFF * DM, DFF, DM, DM, (bf16_t*)(ws + WS_WDN + i * SZ_UP), DFF, scr, gw, NGW, lane, rot);
            conv_mat(a.in[26] + (size_t)i * DM * DM, DM, DM, DM, (bf16_t*)(ws + WS_WG + i * SZ_SQ), DM, scr, gw, NGW, lane, rot, a.in[25] + i * DM);
            conv_mat(a.in[27] + (size_t)i * PLE * DM, PLE, DM, DM, (bf16_t*)(ws + WS_WP + i * SZ_WP), PLE, scr, gw, NGW, lane, rot);
        }
        for (int j = 0; j < 2; ++j) {
            conv_mat(a.in[3] + (size_t)j * DM * AB_IN, DM, 2048, AB_IN, (bf16_t*)(ws + WS_WIN + j * SZ_WIN), DM, scr, gw, NGW, lane, rot, a.in[2] + (2 * j) * DM);
            conv_mat(a.in[13] + (size_t)j * DM * DM, DM, DM, DM, (bf16_t*)(ws + WS_WOUT + j * SZ_SQ), DM, scr, gw, NGW, lane, rot);
            conv_mat(a.in[14] + (size_t)j * DM * C_IN, DM, C_INP, C_IN, (bf16_t*)(ws + WS_CIN + j * SZ_CIN), DM, scr, gw, NGW, lane, rot, a.in[2] + (2 * j + 1) * DM);
            conv_mat(a.in[14] + (size_t)j * DM * C_IN + C_INP, DM, 48, C_IN, (bf16_t*)(ws + WS_WGL + (size_t)j * 256 * DM * 2), DM, scr, gw, NGW, lane, rot, a.in[2] + (2 * j + 1) * DM);
            conv_mat(a.in[21] + (size_t)j * DM * DM, DM, DM, DM, (bf16_t*)(ws + WS_COUT + j * SZ_SQ), DM, scr, gw, NGW, lane, rot);
            conv_mat(a.in[16] + (size_t)j * 4096 * 512, 4096, 512, 512, (bf16_t*)(ws + WS_W1K + j * SZ_W1), 4096, scr, gw, NGW, lane, rot);
            conv_mat(a.in[19] + (size_t)j * 4096 * 512, 4096, 512, 512, (bf16_t*)(ws + WS_W1V + j * SZ_W1), 4096, scr, gw, NGW, lane, rot);
            conv_mat(a.in[17] + (size_t)j * 512 * 128, 512, 128, 128, (bf16_t*)(ws + WS_W2K + j * SZ_W2), 512, scr, gw, NGW, lane, rot);
            conv_mat(a.in[20] + (size_t)j * 512 * 128, 512, 128, 128, (bf16_t*)(ws + WS_W2V + j * SZ_W2), 512, scr, gw, NGW, lane, rot);
            for (int h = 0; h < 16; ++h) {
                conv_mat(a.in[6] + ((size_t)j * 16 + h) * 4096, 64, 64, 64, (bf16_t*)(ws + WS_WR + j * SZ_WRI) + h * 4096, 64, scr, gw, NGW, lane, rot);
                conv_mat(a.in[8] + ((size_t)j * 16 + h) * 4096, 64, 64, 64, (bf16_t*)(ws + WS_WI + j * SZ_WRI) + h * 4096, 64, scr, gw, NGW, lane, rot);
            }
            for (int gI = 0; gI < 4; ++gI)
                conv_mat(a.in[11] + ((size_t)j * 4 + gI) * 65536, 256, 256, 256, (bf16_t*)(ws + WS_POOLT + j * SZ_POOLT) + gI * 65536, 256, scr, gw, NGW, lane, rot);
            conv_plain(a.in[3] + (size_t)j * DM * AB_IN + 2048, DM, 1024, AB_IN, (bf16_t*)(ws + WS_WU + j * SZ_WU), 1024, gt, NGT, a.in[2] + (2 * j) * DM);
            zero_fill16(ws + WS_WGL + (size_t)j * 256 * DM * 2 + (size_t)48 * DM * 2, (size_t)208 * DM * 2, gt, NGT);
            zero_fill16(ws + WS_W2K + j * SZ_W2 + (size_t)128 * 512 * 2, (size_t)128 * 512 * 2, gt, NGT);
            zero_fill16(ws + WS_W2V + j * SZ_W2 + (size_t)128 * 512 * 2, (size_t)128 * 512 * 2, gt, NGT);
        }
        conv_plain(a.in[1], 4 * T_TOK, PLE, PLE, (bf16_t*)(ws + WS_PB), PLE, gt, NGT);
        rows_to_bf16_ss(a.in[0], XN, (float*)(ws + WS_ROWSS), bx, NGW);
        for (int it = gw; it < 4 * 8 * 64; it += NGW) { const int q = it >> 9, fc = (it >> 6) & 7, kc = it & 63, j = q >> 1;
            const float* pos = a.in[(q & 1) ? 18 : 15] + (size_t)j * 4096 + kc * 64; const float* w1 = a.in[(q & 1) ? 19 : 16] + (size_t)j * 4096 * 512 + (size_t)kc * 64 * 512 + fc * 64 + lane;
            float acc0 = 0.f, acc1 = 0.f, acc2 = 0.f, acc3 = 0.f;
#pragma unroll 4
            for (int k = 0; k < 64; k += 4) { acc0 += pos[k] * w1[(size_t)k * 512]; acc1 += pos[k + 1] * w1[(size_t)(k + 1) * 512]; acc2 += pos[k + 2] * w1[(size_t)(k + 2) * 512]; acc3 += pos[k + 3] * w1[(size_t)(k + 3) * 512]; }
            ((float*)(ws + WS_POSP))[((size_t)q * 64 + kc) * 512 + fc * 64 + lane] = (acc0 + acc1) + (acc2 + acc3); }
    }
    SEAM();
    if (EN(1) && ON()) {
        if (bx < 64) { const int j = bx >> 5, gI = (bx >> 3) & 3, pn = bx & 7;
            pg8::Gemm gm{(const bf16_t*)(ws + WS_POOLT + j * SZ_POOLT) + gI * 65536, (const bf16_t*)(ws + WS_WU + j * SZ_WU) + gI * 256, 256, 2048, 256, 256, 1024};
            pg8::StaticOrder S; S.init(256, 2048, G, pn);
            EpiBf16<0> E{(bf16_t*)(ws + WS_WIN + j * SZ_WIN) + (size_t)(2048 + gI * 256) * DM, DM, nullptr, nullptr};
            pg8::gemm_phase(lds, gm, S, E); }
        else { const int tid = opaque_tid(); const float* pp = (const float*)(ws + WS_POSP);
            for (int o = (bx - 64) * 512 + tid; o < 2048; o += (G - 64) * 512) { const int q = o >> 9, f = o & 511; float acc = 0.f;
                for (int kc = 0; kc < 64; ++kc) acc += pp[((size_t)q * 64 + kc) * 512 + f];
                posb[o] = acc; } }
    }
    SEAM();
#pragma unroll 1
    for (int layer = 0; layer < 4; ++layer) {
        const int j = layer >> 1; const bool even = (layer & 1) == 0;
        unsigned char* wsl = opqp(ws); unsigned char* Zl = wsl + WS_Z; bf16_t* XNl = (bf16_t*)(wsl + WS_XN); bf16_t* YBl = (bf16_t*)(wsl + WS_YB); float* posbl = (float*)(wsl + WS_POSB);
        const float* hin = (layer == 0) ? a.in[0] : a.out;
        float* RSS = (float*)(wsl + WS_ROWSS); float* PPl = (float*)(wsl + WS_PP);
        const bf16_t* Ain = (layer == 0) ? XNl : YBl;
        if (EN(3) && ON()) {
            if (even) { pg8::Gemm gm{Ain, (const bf16_t*)(wsl + WS_WIN + j * SZ_WIN), T_TOK, AB_IN, DM, DM, DM};
                pg8::StaticOrder S; S.init(T_TOK, AB_IN, opq(G), opq(bx)); EpiBf16<0> E{(bf16_t*)Zl, AB_IN, nullptr, RSS + (size_t)(layer * 3) * T_TOK * 32}; pg8::gemm_phase(lds, gm, S, E); }
            else { pg8::Gemm gm{Ain, (const bf16_t*)(wsl + WS_CIN + j * SZ_CIN), T_TOK, C_INP, DM, DM, DM};
                pg8::StaticOrder S; S.init(T_TOK, C_INP, opq(G), opq(bx));
                EpiNsa E{(bf16_t*)(Zl + Z_Q), (bf16_t*)(Zl + Z_KC), (bf16_t*)(Zl + Z_VC), (bf16_t*)(Zl + Z_KS), (bf16_t*)(Zl + Z_VST), (bf16_t*)(Zl + Z_KW), (bf16_t*)(Zl + Z_VWT), (float*)(Zl + Z_GL), RSS + (size_t)(layer * 3) * T_TOK * 32};
                pg8::gemm_phase(lds, gm, S, E); }
        }
        SEAM();
        if (even) {
            if (EN(4) && ON()) {
#ifndef NO_LRU
#pragma unroll 1
                for (int rp = 0; rp < REP_LRU; ++rp)
                for (int it = opq(bx); it < 256; it += G)
                    lru_item(lds, it, (const bf16_t*)Zl, a.in[4] + (size_t)j * 4096, a.in[5] + j * 1024, (const bf16_t*)(wsl + WS_WR + j * SZ_WRI), (const bf16_t*)(wsl + WS_WI + j * SZ_WRI),
                             a.in[7] + j * 1024, a.in[9] + j * 1024, a.in[10] + j * 1024, YBl);
#endif
                for (int it = opq(bx); it < 256; it += G) pool_item(it, (const bf16_t*)Zl, a.in[12] + j * 1024, YBl);
            }
            SEAM();
        } else {
            if (EN(5) && ON()) {
                if (bx < 64) { const int kv = bx >> 5;
                    pg8::Gemm gm{(const bf16_t*)(Zl + (kv ? Z_VC : Z_KC)), (const bf16_t*)(wsl + (kv ? WS_W1V : WS_W1K) + j * SZ_W1), 4096, 512, 4096, 2048, 4096};
                    pg8::StaticOrder S; S.init(4096, 512, opq(G), opq(bx) & 31);
                    EpiBf16<2> E{(bf16_t*)(Zl + (kv ? Z_HIDV : Z_HIDK)), 512, posbl + (j * 2 + kv) * 512, nullptr}; pg8::gemm_phase(lds, gm, S, E); }
                else if (bx < 128) { pg8::Gemm gm{Ain, (const bf16_t*)(wsl + WS_WGL + (size_t)j * 256 * DM * 2), T_TOK, 256, DM, DM, DM};
                    pg8::StaticOrder S; S.init(T_TOK, 256, opq(G), opq(bx) - 64); EpiGates E{(float*)(Zl + Z_GL), RSS + (size_t)(layer * 3) * T_TOK * 32}; pg8::gemm_phase(lds, gm, S, E); }
            }
            SEAM();
            if (EN(6) && ON()) {
                if (bx < 16) { pg8::Gemm gm{(const bf16_t*)(Zl + Z_HIDK), (const bf16_t*)(wsl + WS_W2K + j * SZ_W2), 4096, 256, 512, 512, 512};
                    pg8::StaticOrder S; S.init(4096, 256, opq(G), opq(bx)); EpiCmp2<0> E{(bf16_t*)(Zl + Z_KCMP)}; pg8::gemm_phase(lds, gm, S, E); }
                else if (bx < 32) { pg8::Gemm gm{(const bf16_t*)(Zl + Z_HIDV), (const bf16_t*)(wsl + WS_W2V + j * SZ_W2), 4096, 256, 512, 512, 512};
                    pg8::StaticOrder S; S.init(4096, 256, opq(G), opq(bx) - 16); EpiCmp2<1> E{(bf16_t*)(Zl + Z_VCMPT)}; pg8::gemm_phase(lds, gm, S, E); }
            }
            SEAM();
            if (EN(7) && ON()) {
#pragma unroll 1
                for (int rp = 0; rp < REP_ATTN; ++rp)
                for (int it = opq(bx), r = 0; it < 1024; it += G, ++r) { const int c = it % 256, rr = it / 256; const int cp = (rr & 1) ? 255 - c : c;
                    const int tq = 63 - (rr * 16 + (cp >> 4)), bgi = cp & 15;
#ifndef NO_ATTN
                    nsa_item(lds, bgi >> 2, bgi & 3, tq, (const bf16_t*)(Zl + Z_Q), (const bf16_t*)(Zl + Z_KS), (const bf16_t*)(Zl + Z_VST), (const bf16_t*)(Zl + Z_KW), (const bf16_t*)(Zl + Z_VWT),
                             (const bf16_t*)(Zl + Z_KCMP), (const bf16_t*)(Zl + Z_VCMPT), (const float*)(Zl + Z_GL), YBl);
#endif
                }
                __syncthreads();
            }
            SEAM();
        }
        if (EN(8) && ON()) { pg8::Gemm gm{YBl, (const bf16_t*)(wsl + (even ? WS_WOUT : WS_COUT) + j * SZ_SQ), T_TOK, DM, DM, DM, DM};
            pg8::StaticOrder S; S.init(T_TOK, DM, opq(G), opq(bx)); EpiF32<0> E{hin, a.out, nullptr, DM, XNl, RSS + (size_t)(layer * 3 + 1) * T_TOK * 32, nullptr}; pg8::gemm_phase(lds, gm, S, E);
            { pg8::Gemm gp{(const bf16_t*)(wsl + WS_PB) + (size_t)layer * T_TOK * PLE, (const bf16_t*)(wsl + WS_WP + layer * SZ_WP), T_TOK, DM, PLE, PLE, PLE};
              pg8::StaticOrder S2; S2.init(T_TOK, DM, opq(G), opq(bx)); EpiF32<2> E2{nullptr, PPl, nullptr, DM, nullptr, nullptr, nullptr}; pg8::gemm_phase(lds, gp, S2, E2); } }
        SEAM();
        if (EN(10) && ON())
#pragma unroll 1
        for (int rpu = 0; rpu < REP_UP; ++rpu) { pg8::Gemm gm{XNl, (const bf16_t*)(wsl + WS_WUP + layer * SZ_UP), T_TOK, DFF, DM, DM, DM};
            pg8::StaticOrder S; S.init(T_TOK, DFF, opq(G), opq(bx)); EpiBf16<1> E{(bf16_t*)Zl, DFF, nullptr, RSS + (size_t)(layer * 3 + 1) * T_TOK * 32}; pg8::gemm_phase(lds, gm, S, E); }
        SEAM();
        if (EN(11) && ON()) { pg8::Gemm gm{(const bf16_t*)Zl, (const bf16_t*)(wsl + WS_WDN + layer * SZ_UP), T_TOK, DM, DFF, DFF, DFF};
            pg8::StaticOrder S; S.init(T_TOK, DM, opq(G), opq(bx)); EpiF32<0> E{a.out, a.out, nullptr, DM, XNl, RSS + (size_t)(layer * 3 + 2) * T_TOK * 32, nullptr}; pg8::gemm_phase(lds, gm, S, E); }
        SEAM();
        if (EN(13) && ON()) { pg8::Gemm gm{XNl, (const bf16_t*)(wsl + WS_WG + layer * SZ_SQ), T_TOK, DM, DM, DM, DM};
            pg8::StaticOrder S; S.init(T_TOK, DM, opq(G), opq(bx)); EpiF32<1> E{a.out, a.out, PPl, DM, YBl, RSS + (size_t)(layer * 3 + 3) * T_TOK * 32, RSS + (size_t)(layer * 3 + 2) * T_TOK * 32}; pg8::gemm_phase(lds, gm, S, E); }
        SEAM();
    }
    if (EN(14) && ON()) rmsnorm_rows<true>(a.out, a.in[28], nullptr, a.out, bx, NGW);
#undef ON
#undef SEAM
}
constexpr int N_PHASES = 1 + 2 * 9 + 2 * 11 + 1;

extern "C" void kernel_launch(void* const* d_in, const int* in_sizes, int n_in, void* d_out, int out_size, void* d_ws, size_t ws_size, hipStream_t stream) {
    static int grid = 0;
    if (grid == 0) {
        if (n_in != 29 || ws_size < WS_END) { fprintf(stderr, "kernel_launch: unexpected n_in %d / ws %zu (need %zu)\n", n_in, ws_size, (size_t)WS_END); grid = -1; return; }
        int dev = 0, cus = 0, per_cu = 0;
        hipGetDevice(&dev); hipDeviceGetAttribute(&cus, hipDeviceAttributeMultiprocessorCount, dev);
        if (hipFuncSetAttribute((const void*)fwd_kernel, hipFuncAttributeMaxDynamicSharedMemorySize, LDS_BYTES) != hipSuccess) { fprintf(stderr, "hipFuncSetAttribute failed\n"); grid = -1; return; }
        if (hipOccupancyMaxActiveBlocksPerMultiprocessor(&per_cu, (const void*)fwd_kernel, 512, LDS_BYTES) != hipSuccess || per_cu < 1) { fprintf(stderr, "occupancy query: %d\n", per_cu); per_cu = 1; }
        (void)hipGetLastError();
        grid = cus;
    }
    if (grid < 0) return;
    Args a{};
    for (int i = 0; i < 29; ++i) a.in[i] = (const float*)d_in[i];
    a.out = (float*)d_out; a.ws = (unsigned char*)d_ws;
#if MK_ONE_LAUNCH
    (void)hipMemsetAsync((unsigned char*)d_ws + WS_BAR, 0, XCD_BAR_WORDS * 4, stream);
    a.lo = 0; a.hi = 1 << 30; a.one = 1; a.pad = 0;
    void* args[] = {&a};
    hipError_t e = hipLaunchCooperativeKernel((const void*)fwd_kernel, dim3(grid), dim3(512), args, LDS_BYTES, stream);
    if (e != hipSuccess) fprintf(stderr, "cooperative launch failed: %s (grid %d)\n", hipGetErrorString(e), grid);
#else
    for (int p = 0; p < N_PHASES; ++p) { a.lo = p; a.hi = p + 1; a.one = 0; a.pad = 0;
        hipLaunchKernelGGL(fwd_kernel, dim3(grid), dim3(512), LDS_BYTES, stream, a); }
#endif
}
```

```cpp
#include <hip/hip_runtime.h>
#include <hip/hip_cooperative_groups.h>
#include <cstdio>
namespace cg = cooperative_groups;

#ifndef REP_ATTN
#define REP_ATTN 1
#endif
#ifndef REP_LRU
#define REP_LRU 1
#endif
#ifndef REP_P0
#define REP_P0 1
#endif
#ifndef REP_UP
#define REP_UP 1
#endif
#ifndef MK_ONE_LAUNCH
#define MK_ONE_LAUNCH 1
#endif

#define LAS __attribute__((address_space(3)))
typedef unsigned short bf16_t;
typedef short bf16x8 __attribute__((ext_vector_type(8)));
typedef float f32x4 __attribute__((ext_vector_type(4)));
typedef float f32x2 __attribute__((ext_vector_type(2)));
typedef unsigned u32x4 __attribute__((ext_vector_type(4)));
typedef unsigned u32x2 __attribute__((ext_vector_type(2)));

constexpr int T_TOK = 16384, DM = 2048, SEQ = 4096, NB = 4, DFF = 8192, PLE = 256;
constexpr int AB_IN = 3072, C_IN = 5168, C_INP = 5120;
constexpr float EPSV = 1e-6f;
constexpr float LOG2E = 1.4426950408889634f;

__device__ __forceinline__ unsigned f2bf(float f) { unsigned u = __builtin_bit_cast(unsigned, f); return (u + 0x7fffu + ((u >> 16) & 1u)) >> 16; }
__device__ __forceinline__ unsigned pk2(float lo, float hi) { unsigned r; asm volatile("v_cvt_pk_bf16_f32 %0, %1, %2" : "=v"(r) : "v"(lo), "v"(hi)); return r; }
__device__ __forceinline__ float bf2f(unsigned short b) { return __builtin_bit_cast(float, ((unsigned)b) << 16); }
__device__ __forceinline__ float bflo(unsigned w) { return __builtin_bit_cast(float, w << 16); }
__device__ __forceinline__ float bfhi(unsigned w) { return __builtin_bit_cast(float, w & 0xffff0000u); }
__device__ __forceinline__ float shx(float v, int lane, int o) { return __builtin_bit_cast(float, __builtin_amdgcn_ds_bpermute((lane ^ o) << 2, __builtin_bit_cast(int, v))); }
__device__ __forceinline__ float wave_sum(float v, int lane) {
#pragma unroll
    for (int o = 1; o < 64; o <<= 1) v += shx(v, lane, o);
    return v;
}
__device__ __forceinline__ float sigmoidf_(float x) { return 1.0f / (1.0f + __expf(-x)); }
__device__ __forceinline__ float gelu_tanh(float x) {
    const float u = 0.7978845608028654f * (x + 0.044715f * x * x * x);
    const float e = __expf(2.0f * u);
    const float th = 1.0f - 2.0f / (e + 1.0f);
    return 0.5f * x * (1.0f + th);
}

__device__ __forceinline__ unsigned char* opqp(unsigned char* p) { size_t z = 0; asm volatile("" : "+s"(z)); return p + z; }
__device__ __forceinline__ int opq(int v) { asm volatile("" : "+s"(v)); return v; }
__device__ __forceinline__ int opaque_tid() { int t = threadIdx.x; asm volatile("" : "+v"(t)); return t; }
namespace pg8 {
constexpr int BM = 256, BK = 64, HALF = 128, HTB = HALF * BK * 2, STAGE_BYTES = 8 * HTB, NXCD = 8, WGM = 8;
__host__ __device__ __forceinline__ int lds_byte(int r, int c) { const int st = (r >> 4) * 2 + (c >> 5), rr = r & 15, cc = c & 31, ob = rr * 64 + cc * 2; return st * 1024 + (ob ^ (((ob >> 9) & 1) << 5)); }
__host__ __device__ __forceinline__ void stage_rc(int b, int& R, int& C) { const int st = b / 1024, sb = b % 1024, swz = sb ^ (((sb >> 9) & 1) << 5); R = (st >> 1) * 16 + swz / 64; C = (st & 1) * 32 + (swz % 64) / 2; }
__host__ __device__ __forceinline__ int perm32(int rho) { const int n = rho >> 4, i = rho & 15; return 8 * (i >> 2) + 4 * n + (i & 3); }

struct Unit { int pm, pn; };
struct Gemm { const bf16_t* A; const bf16_t* Bt; int M, N, K, lda, ldb; };

struct StaticOrder {
    int nM, nN, nwg, G, c;
    __device__ void init(int M, int N, int G_, int c_) { nM = M / BM; nN = N / BM; nwg = nM * nN; G = G_; c = c_; }
    __device__ bool next(int i, Unit& u) const {
        const long L = (long)i * G + c; if (L >= nwg || c < 0) return false;
        int wgid = (int)L; { const int q = nwg / NXCD, r = nwg % NXCD, xcd = wgid % NXCD, off = wgid / NXCD; wgid = (xcd < r ? xcd * (q + 1) : r * (q + 1) + (xcd - r) * q) + off; }
        const int nig = WGM * nN, gid = wgid / nig, fm = gid * WGM, gsz = (nM - fm) < WGM ? (nM - fm) : WGM;
        u.pm = fm + ((wgid % nig) % gsz); u.pn = (wgid % nig) / gsz; return true;
    }
};

template <class Epi, class Sched>
__device__ __forceinline__ void gemm_phase(LAS unsigned char* lds, const Gemm g, const Sched& S, const Epi& E) {
    const int tid = opaque_tid(), wid = __builtin_amdgcn_readfirstlane(tid >> 6), lane = tid & 63, wr = wid >> 2, wc = wid & 3, fr = lane & 15, fq = lane >> 4;
    const int K = g.K, nt = K / BK;
    unsigned voffA[2], voffB[2];
#pragma unroll
    for (int i = 0; i < 2; ++i) { int R, C; stage_rc(tid * 16 + i * 8192, R, C); const int Rb = Epi::PERM ? ((R & ~31) + perm32(R & 31)) : R;
        voffA[i] = (unsigned)(R * g.lda + C) * 2u; voffB[i] = (unsigned)(Rb * g.ldb + C) * 2u; }
    const size_t kstep = (size_t)(BK * 2);
    const size_t hstepA = (size_t)HALF * g.lda * 2, hstepB = (size_t)HALF * g.ldb * 2;
    const size_t tstepA = 2 * hstepA, tstepB = 2 * hstepB;
    const unsigned ldsw = (unsigned)wid * 1024u;
    const int aoff = lds_byte(wr * 64 + fr, fq * 8), boff = lds_byte(wc * 32 + fr, fq * 8);
#define PG8_SA(b, h) (((b) * 2 + (h)) * HTB)
#define PG8_SB(b, h) ((4 + (b) * 2 + (h)) * HTB)
#define PG8_STAGE(bufoff, gbase, voff) do { _Pragma("unroll") for (int _i = 0; _i < 2; ++_i) \
        __builtin_amdgcn_global_load_lds((const unsigned*)((const char*)(gbase) + (voff)[_i]), (LAS unsigned*)(lds + (bufoff) + ldsw + _i * 8192), 16, 0, 0); } while (0)
#define PG8_LDA(dst, b, h) do { _Pragma("unroll") for (int m = 0; m < 4; ++m) _Pragma("unroll") for (int k = 0; k < 2; ++k) dst[m][k] = *(const LAS bf16x8*)(lds + PG8_SA(b, h) + aoff + m * 2048 + k * 1024); } while (0)
#define PG8_LDB(dst, b, h) do { _Pragma("unroll") for (int n = 0; n < 2; ++n) _Pragma("unroll") for (int k = 0; k < 2; ++k) dst[n][k] = *(const LAS bf16x8*)(lds + PG8_SB(b, h) + boff + n * 2048 + k * 1024); } while (0)
#define PG8_MMA(ai, bj, At, Bt) do { __builtin_amdgcn_s_setprio(1); _Pragma("unroll") for (int m = 0; m < 4; ++m) _Pragma("unroll") for (int n = 0; n < 2; ++n) _Pragma("unroll") for (int k = 0; k < 2; ++k) \
        acc[ai][bj][m][n] = __builtin_amdgcn_mfma_f32_16x16x32_bf16(Bt[n][k], At[m][k], acc[ai][bj][m][n], 0, 0, 0); __builtin_amdgcn_s_setprio(0); } while (0)
#define PG8_WAIT_V(n) asm volatile("s_waitcnt vmcnt(" #n ")" ::: "memory")
#define PG8_WAIT_L(n) asm volatile("s_waitcnt lgkmcnt(" #n ")" ::: "memory")
#define PG8_BAR __builtin_amdgcn_s_barrier()
#define PG8_SCHED __builtin_amdgcn_sched_barrier(0)
    Unit cur, nxt; int ui = 0;
    if (!S.next(0, cur)) return;
    f32x4 acc[2][2][4][2];
#pragma unroll
    for (int a = 0; a < 2; ++a)
#pragma unroll
        for (int b = 0; b < 2; ++b)
#pragma unroll
            for (int m = 0; m < 4; ++m)
#pragma unroll
                for (int n = 0; n < 2; ++n) acc[a][b][m][n] = (f32x4){0.f, 0.f, 0.f, 0.f};
    bf16x8 At[4][2], B0[2][2], B1[2][2];
    const char* cA = (const char*)g.A + (size_t)cur.pm * tstepA; const char* cB = (const char*)g.Bt + (size_t)cur.pn * tstepB;
    PG8_STAGE(PG8_SB(0, 0), cB, voffB); PG8_STAGE(PG8_SB(0, 1), cB + hstepB, voffB); PG8_STAGE(PG8_SA(0, 0), cA, voffA); PG8_STAGE(PG8_SA(0, 1), cA + hstepA, voffA);
    if (wr == 1) PG8_BAR;
    PG8_WAIT_V(2); PG8_BAR;
    PG8_STAGE(PG8_SB(1, 0), cB + kstep, voffB); PG8_STAGE(PG8_SA(1, 0), cA + kstep, voffA); PG8_STAGE(PG8_SB(1, 1), cB + hstepB + kstep, voffB);
    PG8_WAIT_V(6); PG8_BAR;
    for (;;) {
        const bool has_next = S.next(ui + 1, nxt);
        const char* nA = has_next ? (const char*)g.A + (size_t)nxt.pm * tstepA : cA; const char* nB = has_next ? (const char*)g.Bt + (size_t)nxt.pn * tstepB : cB;
        for (int t = 0; t < nt; t += 2) {
            const bool last = (t == nt - 2);
            const char* a1 = cA + (size_t)(t + 1) * kstep;
            const char* a2 = last ? nA : cA + (size_t)(t + 2) * kstep; const char* b2 = last ? nB : cB + (size_t)(t + 2) * kstep;
            const char* a3 = a2 + kstep; const char* b3 = b2 + kstep;
            PG8_LDB(B0, 0, 0); PG8_LDB(B1, 0, 1); PG8_SCHED; PG8_LDA(At, 0, 0); PG8_STAGE(PG8_SA(1, 1), a1 + hstepA, voffA);
            PG8_WAIT_V(8); PG8_WAIT_L(0); PG8_BAR; PG8_MMA(0, 0, At, B0); PG8_MMA(0, 1, At, B1); PG8_BAR; PG8_SCHED;
            PG8_LDA(At, 0, 1); PG8_STAGE(PG8_SB(0, 0), b2, voffB); PG8_STAGE(PG8_SB(0, 1), b2 + hstepB, voffB); PG8_STAGE(PG8_SA(0, 0), a2, voffA);
            PG8_WAIT_V(8); PG8_WAIT_L(0); PG8_BAR; PG8_MMA(1, 0, At, B0); PG8_MMA(1, 1, At, B1); PG8_BAR; PG8_SCHED;
            PG8_LDB(B0, 1, 0); PG8_LDB(B1, 1, 1); PG8_SCHED; PG8_LDA(At, 1, 0); PG8_STAGE(PG8_SA(0, 1), a2 + hstepA, voffA);
            PG8_WAIT_V(8); PG8_WAIT_L(0); PG8_BAR; PG8_MMA(0, 0, At, B0); PG8_MMA(0, 1, At, B1); PG8_BAR; PG8_SCHED;
            PG8_LDA(At, 1, 1); PG8_STAGE(PG8_SB(1, 0), b3, voffB); PG8_STAGE(PG8_SB(1, 1), b3 + hstepB, voffB); PG8_STAGE(PG8_SA(1, 0), a3, voffA);
            PG8_WAIT_V(8); PG8_WAIT_L(0); PG8_BAR; PG8_MMA(1, 0, At, B0); PG8_MMA(1, 1, At, B1); PG8_BAR; PG8_SCHED;
        }
        if (wr == 0) PG8_BAR;
        { const int tl = opaque_tid() & 63; E(acc, cur, wr, wc, tl & 15, tl >> 4); }
        if (!has_next) break;
#pragma unroll
        for (int a = 0; a < 2; ++a)
#pragma unroll
            for (int b = 0; b < 2; ++b)
#pragma unroll
                for (int m = 0; m < 4; ++m)
#pragma unroll
                    for (int n = 0; n < 2; ++n) acc[a][b][m][n] = (f32x4){0.f, 0.f, 0.f, 0.f};
        cur = nxt; cA = nA; cB = nB; ++ui;
        if (wr == 1) PG8_BAR;
    }
    PG8_WAIT_V(0);
    PG8_BAR;
#undef PG8_SA
#undef PG8_SB
#undef PG8_STAGE
#undef PG8_LDA
#undef PG8_LDB
#undef PG8_MMA
#undef PG8_WAIT_V
#undef PG8_WAIT_L
#undef PG8_BAR
#undef PG8_SCHED
}
}
using pg8::Unit; using pg8::HALF; using pg8::BM;


#define XB_TMO      128
#define XB_XCNT(j)  (256  + 64 * (j))
#define XB_XSUB(j)  (1280 + 64 * (j))
#define XB_XGEN(j)  (2304 + 64 * (j))
#define XB_TOP      3328
#define XB_TOPGEN   3392
#define XCD_BAR_WORDS 3456
#define XB_SPIN_CAP (1u << 18)
__device__ __forceinline__ unsigned xb_ld(unsigned* p)              { return __hip_atomic_load(p, __ATOMIC_RELAXED, __HIP_MEMORY_SCOPE_AGENT); }
__device__ __forceinline__ unsigned xb_add(unsigned* p, unsigned v) { return __hip_atomic_fetch_add(p, v, __ATOMIC_RELAXED, __HIP_MEMORY_SCOPE_AGENT); }
__device__ __forceinline__ unsigned xb_xcc_id() { return (unsigned)__builtin_amdgcn_s_getreg((3 << 11) | 20) & 0xFu; }
#define XB_SPIN(cond, bar) do { unsigned _sp = 0; while (cond) { __builtin_amdgcn_s_sleep(1); \
    if ((++_sp & 255u) == 0u) { if (xb_ld(&(bar)[XB_TMO])) break; if (_sp > XB_SPIN_CAP) { atomicAdd(&(bar)[XB_TMO], 1u); break; } } } } while (0)
struct XcdBarrier { unsigned* bar; unsigned x; volatile LAS unsigned* st; };
__device__ __forceinline__ XcdBarrier xcd_barrier_post(unsigned* bar, volatile LAS unsigned* st) {
    XcdBarrier b; b.bar = bar; b.x = xb_xcc_id(); b.st = st;
    if (threadIdx.x == 0) (void)xb_add(&bar[XB_XCNT(b.x)], 1u);
    return b;
}
__device__ __forceinline__ void xcd_barrier_complete(unsigned* bar, unsigned x, unsigned& nloc, unsigned& nx) {
    const unsigned G = gridDim.x * gridDim.y * gridDim.z;
    unsigned sum, cnt, mine, sp = 0u;
    for (;;) {
        sum = 0u; cnt = 0u; mine = 0u;
#pragma unroll
        for (unsigned j = 0; j < 16; ++j) { const unsigned c = xb_ld(&bar[XB_XCNT(j)]); sum += c; cnt += (c > 0u) ? 1u : 0u; mine = (j == x) ? c : mine; }
        if (sum == G) break;
        __builtin_amdgcn_s_sleep(1);
        if ((++sp & 255u) == 0u) { if (xb_ld(&bar[XB_TMO])) break; if (sp > XB_SPIN_CAP) { atomicAdd(&bar[XB_TMO], 1u); break; } }
    }
    nloc = mine > 0u ? mine : 1u; nx = cnt > 0u ? cnt : 1u;
}
__device__ __forceinline__ void xcd_barrier(const XcdBarrier& b) {
    asm volatile("s_waitcnt vmcnt(0)" ::: "memory");
    __syncthreads();
    if (threadIdx.x == 0) {
        unsigned* bar = b.bar;
        __builtin_amdgcn_s_waitcnt(0);
        unsigned nloc = b.st[0], nx = b.st[1];
        if (nloc == 0u) { xcd_barrier_complete(bar, b.x, nloc, nx); b.st[0] = nloc; b.st[1] = nx; }
        const unsigned old = xb_add(&bar[XB_XSUB(b.x)], 1u);
        const unsigned gen = old / nloc;
        if (old + 1u == (gen + 1u) * nloc) {
            __builtin_amdgcn_fence(__ATOMIC_RELEASE, "agent");
            asm volatile("s_waitcnt vmcnt(0)" ::: "memory");
            const unsigned og = xb_add(&bar[XB_TOP], 1u);
            const unsigned tg = og / nx;
            if (og + 1u == (tg + 1u) * nx) xb_add(&bar[XB_TOPGEN], 1u);
            else XB_SPIN(xb_ld(&bar[XB_TOPGEN]) == tg, bar);
            __builtin_amdgcn_fence(__ATOMIC_ACQUIRE, "agent");
            xb_add(&bar[XB_XGEN(b.x)], 1u);
            asm volatile("s_waitcnt vmcnt(0)" ::: "memory");
        } else {
            XB_SPIN(xb_ld(&bar[XB_XGEN(b.x)]) == gen, bar);
            __builtin_amdgcn_fence(__ATOMIC_ACQUIRE, "agent");
            asm volatile("s_waitcnt vmcnt(0)" ::: "memory");
        }
    }
    __syncthreads();
}

__device__ __forceinline__ float row_rstd(const float* rp, int row, int fq, int lane) {
    const f32x4 a = *(const f32x4*)(rp + (size_t)row * 32 + fq * 8), b = *(const f32x4*)(rp + (size_t)row * 32 + fq * 8 + 4);
    float s = ((a[0] + a[1]) + (a[2] + a[3])) + ((b[0] + b[1]) + (b[2] + b[3]));
    s += shx(s, lane, 16); s += shx(s, lane, 32);
    return rsqrtf(s * (1.f / DM) + EPSV);
}
template <int ACT  > struct EpiBf16 {
    static constexpr bool PERM = true;
    bf16_t* O; int ldc; const float* bias; const float* rss;
    __device__ __forceinline__ void operator()(const f32x4 (&acc)[2][2][4][2], const Unit& u, int wr, int wc, int fr, int fq) const {
        const int row0 = u.pm * BM + wr * 64 + fr, col0 = u.pn * BM + wc * 32 + 8 * fq;
        f32x4 bv[2][2];
#pragma unroll
        for (int bj = 0; bj < 2; ++bj)
#pragma unroll
            for (int n = 0; n < 2; ++n) bv[bj][n] = (ACT == 2) ? *(const f32x4*)(bias + col0 + bj * HALF + 4 * n) : (f32x4){0.f, 0.f, 0.f, 0.f};
        float rsv[2][4];
#pragma unroll
        for (int ai = 0; ai < 2; ++ai)
#pragma unroll
            for (int m = 0; m < 4; ++m) rsv[ai][m] = rss ? row_rstd(rss, row0 + ai * HALF + m * 16, fq, fq * 16 + fr) : 1.f;
        asm volatile("" ::: "memory");
#pragma unroll
        for (int ai = 0; ai < 2; ++ai)
#pragma unroll
            for (int m = 0; m < 4; ++m) { bf16_t* rowp = O + (size_t)(row0 + ai * HALF + m * 16) * ldc + col0;
                const float rs = rsv[ai][m];
#pragma unroll
                for (int bj = 0; bj < 2; ++bj) { f32x4 v0 = acc[ai][bj][m][0] * rs + bv[bj][0], v1 = acc[ai][bj][m][1] * rs + bv[bj][1];
                    if (ACT == 1) {
#pragma unroll
                        for (int j = 0; j < 4; ++j) { const float a = fmaxf(v0[j], 0.f), b = fmaxf(v1[j], 0.f); v0[j] = a * a; v1[j] = b * b; } }
                    if (ACT == 2) {
#pragma unroll
                        for (int j = 0; j < 4; ++j) { v0[j] = gelu_tanh(v0[j]); v1[j] = gelu_tanh(v1[j]); } }
                    u32x4 w; w.x = pk2(v0[0], v0[1]); w.y = pk2(v0[2], v0[3]); w.z = pk2(v1[0], v1[1]); w.w = pk2(v1[2], v1[3]);
                    *(u32x4*)(rowp + bj * HALF) = w; } }
    }
};
template <int MODE> struct EpiF32 {
    static constexpr bool PERM = false;
    const float* base; float* out; const float* pp; int ldc; bf16_t* hb; float* rss_out; const float* rss_in;
    __device__ __forceinline__ void operator()(const f32x4 (&acc)[2][2][4][2], const Unit& u, int wr, int wc, int fr, int fq) const {
        const int row0 = u.pm * BM + wr * 64 + fr, col0 = u.pn * BM + wc * 32 + 4 * fq; const int lane = fq * 16 + fr;
        float rinv[8];
#pragma unroll
        for (int g = 0; g < 8; ++g) rinv[g] = (MODE == 1) ? row_rstd(rss_in, row0 + (g >> 2) * HALF + (g & 3) * 16, fq, lane) : 1.f;
        f32x4 bc[4], pc[4];
        if (MODE != 2) {
#pragma unroll
            for (int q = 0; q < 4; ++q) { const size_t o2 = (size_t)row0 * ldc + col0 + (q >> 1) * HALF + (q & 1) * 16; bc[q] = *(const f32x4*)(base + o2); if (MODE == 1) pc[q] = *(const f32x4*)(pp + o2); } }
#pragma unroll
        for (int g = 0; g < 8; ++g) { const int ai = g >> 2, m = g & 3; const int row = row0 + ai * HALF + m * 16; const size_t off = (size_t)row * ldc + col0;
            f32x4 av[4];
#pragma unroll
            for (int q = 0; q < 4; ++q) { f32x4 a = acc[ai][q >> 1][m][q & 1];
                if (MODE == 0) a = a + bc[q];
                if (MODE == 1) {
#pragma unroll
                    for (int j = 0; j < 4; ++j) a[j] = bc[q][j] + sigmoidf_(a[j] * rinv[g]) * pc[q][j]; }
                av[q] = a; }
            if (MODE != 2) { asm volatile("" : "+v"(av[0]), "+v"(av[1]), "+v"(av[2]), "+v"(av[3]));
                if (g < 7) { const int rown = row0 + ((g + 1) >> 2) * HALF + ((g + 1) & 3) * 16;
#pragma unroll
                    for (int q = 0; q < 4; ++q) { const size_t o2 = (size_t)rown * ldc + col0 + (q >> 1) * HALF + (q & 1) * 16; bc[q] = *(const f32x4*)(base + o2); if (MODE == 1) pc[q] = *(const f32x4*)(pp + o2); } }
                asm volatile("" ::: "memory"); }
            float ss = 0.f;
#pragma unroll
            for (int q = 0; q < 4; ++q) { const size_t o2 = off + (q >> 1) * HALF + (q & 1) * 16; const f32x4 a = av[q];
                *(f32x4*)(out + o2) = a;
                if (MODE != 2) { ss += (a[0] * a[0] + a[1] * a[1]) + (a[2] * a[2] + a[3] * a[3]); u32x2 w; w.x = pk2(a[0], a[1]); w.y = pk2(a[2], a[3]); *(u32x2*)(hb + o2) = w; } }
            if (MODE != 2) { ss += shx(ss, lane, 16); ss += shx(ss, lane, 32); if (fq == 0) rss_out[(size_t)row * 32 + u.pn * 4 + wc] = ss; }
        }
    }
};
struct EpiNsa {
    static constexpr bool PERM = true;
    bf16_t *Q, *KC, *VC, *KS, *VST, *KW, *VWT; float* GL; const float* rss;
    __device__ __forceinline__ void operator()(const f32x4 (&acc)[2][2][4][2], const Unit& u, int wr, int wc, int fr, int fq) const {
        const int row0 = u.pm * BM + wr * 64 + fr; const int pn = u.pn;
        float rsv[2][4];
#pragma unroll
        for (int ai = 0; ai < 2; ++ai)
#pragma unroll
            for (int m = 0; m < 4; ++m) rsv[ai][m] = row_rstd(rss, row0 + ai * HALF + m * 16, fq, fq * 16 + fr);
        asm volatile("" ::: "memory");
#pragma unroll
        for (int ai = 0; ai < 2; ++ai)
#pragma unroll
            for (int m = 0; m < 4; ++m) { const int row = row0 + ai * HALF + m * 16; const int b = row >> 12, s = row & 4095;
                const float rs = rsv[ai][m];
#pragma unroll
                for (int bj = 0; bj < 2; ++bj) { const f32x4 v0 = acc[ai][bj][m][0] * rs, v1 = acc[ai][bj][m][1] * rs;
                    const int cl = bj * HALF + wc * 32 + 8 * fq;
                    if (pn < 8) { u32x4 w; w.x = pk2(v0[0], v0[1]); w.y = pk2(v0[2], v0[3]); w.z = pk2(v1[0], v1[1]); w.w = pk2(v1[2], v1[3]);
                        *(u32x4*)(Q + (size_t)row * 2048 + pn * 256 + cl) = w; }
                    else { const int k = (pn - 8) >> 1; const int c = ((pn - 8) & 1) * 256 + cl; const int g = c >> 7, d = c & 127;
                        if (k == 3 || k == 5) { bf16_t* dst = (k == 3 ? VST : VWT) + ((size_t)((b * 4 + g) * 128 + d)) * 4096 + s;
#pragma unroll
                            for (int j = 0; j < 4; ++j) { dst[(size_t)j * 4096] = (bf16_t)f2bf(v0[j]); dst[(size_t)(4 + j) * 4096] = (bf16_t)f2bf(v1[j]); } }
                        else { bf16_t* dst = (k == 0 ? KC : k == 1 ? VC : k == 2 ? KS : KW) + ((size_t)((b * 4 + g) * 4096 + s)) * 128 + d;
                            u32x4 w; w.x = pk2(v0[0], v0[1]); w.y = pk2(v0[2], v0[3]); w.z = pk2(v1[0], v1[1]); w.w = pk2(v1[2], v1[3]);
                            *(u32x4*)dst = w; } }
 } }
    }
};
struct EpiGates {
    static constexpr bool PERM = true;
    float* GL; const float* rss;
    __device__ __forceinline__ void operator()(const f32x4 (&acc)[2][2][4][2], const Unit& u, int wr, int wc, int fr, int fq) const {
        const int row0 = u.pm * BM + wr * 64 + fr; const int cl = wc * 32 + 8 * fq;
        float rsv[2][4];
#pragma unroll
        for (int ai = 0; ai < 2; ++ai)
#pragma unroll
            for (int m = 0; m < 4; ++m) rsv[ai][m] = row_rstd(rss, row0 + ai * HALF + m * 16, fq, fq * 16 + fr);
        if (cl < 48) {
#pragma unroll
            for (int ai = 0; ai < 2; ++ai)
#pragma unroll
                for (int m = 0; m < 4; ++m) { const int row = row0 + ai * HALF + m * 16; const float rs = rsv[ai][m];
                    const f32x4 v0 = acc[ai][0][m][0] * rs, v1 = acc[ai][0][m][1] * rs; f32x4 a, c2;
#pragma unroll
                    for (int j = 0; j < 4; ++j) { a[j] = sigmoidf_(v0[j]); c2[j] = sigmoidf_(v1[j]); }
                    float* dst = GL + (size_t)row * 48 + cl; *(f32x4*)dst = a; *(f32x4*)(dst + 4) = c2; } }
    }
};
template <int TR> struct EpiCmp2 {
    static constexpr bool PERM = true;
    bf16_t* O;
    __device__ __forceinline__ void operator()(const f32x4 (&acc)[2][2][4][2], const Unit& u, int wr, int wc, int fr, int fq) const {
        const int row0 = u.pm * BM + wr * 64 + fr; const int cl = wc * 32 + 8 * fq;
#pragma unroll
        for (int ai = 0; ai < 2; ++ai)
#pragma unroll
            for (int m = 0; m < 4; ++m) { const int row = row0 + ai * HALF + m * 16; const f32x4 v0 = acc[ai][0][m][0], v1 = acc[ai][0][m][1];
                if (TR == 0) { u32x4 w; w.x = pk2(v0[0], v0[1]); w.y = pk2(v0[2], v0[3]); w.z = pk2(v1[0], v1[1]); w.w = pk2(v1[2], v1[3]);
                    *(u32x4*)(O + (size_t)row * 128 + cl) = w; }
                else { bf16_t* dst = O + ((size_t)((row >> 8) * 128 + cl)) * 256 + (row & 255);
#pragma unroll
                    for (int j = 0; j < 4; ++j) { dst[(size_t)j * 256] = (bf16_t)f2bf(v0[j]); dst[(size_t)(4 + j) * 256] = (bf16_t)f2bf(v1[j]); } } }
    }
};

constexpr size_t al256(size_t x) { return (x + 255) & ~(size_t)255; }
constexpr size_t SZ_WIN = (size_t)AB_IN * DM * 2, SZ_SQ = (size_t)DM * DM * 2, SZ_CIN = (size_t)C_INP * DM * 2, SZ_W1 = (size_t)512 * 4096 * 2, SZ_W2 = (size_t)256 * 512 * 2;
constexpr size_t SZ_UP = (size_t)DFF * DM * 2, SZ_WP = (size_t)DM * PLE * 2, SZ_WRI = (size_t)16 * 64 * 64 * 2, SZ_POOLT = (size_t)4 * 256 * 256 * 2, SZ_WU = (size_t)DM * 1024 * 2;
constexpr size_t WS_WIN = 0;
constexpr size_t WS_WOUT = WS_WIN + 2 * SZ_WIN;
constexpr size_t WS_CIN = WS_WOUT + 2 * SZ_SQ;
constexpr size_t WS_COUT = WS_CIN + 2 * SZ_CIN;
constexpr size_t WS_W1K = WS_COUT + 2 * SZ_SQ;
constexpr size_t WS_W1V = WS_W1K + 2 * SZ_W1;
constexpr size_t WS_W2K = WS_W1V + 2 * SZ_W1;
constexpr size_t WS_W2V = WS_W2K + 2 * SZ_W2;
constexpr size_t WS_WUP = WS_W2V + 2 * SZ_W2;
constexpr size_t WS_WDN = WS_WUP + 4 * SZ_UP;
constexpr size_t WS_WG = WS_WDN + 4 * SZ_UP;
constexpr size_t WS_WP = WS_WG + 4 * SZ_SQ;
constexpr size_t WS_WR = WS_WP + 4 * SZ_WP;
constexpr size_t WS_WI = WS_WR + 2 * SZ_WRI;
constexpr size_t WS_POOLT = WS_WI + 2 * SZ_WRI;
constexpr size_t WS_WU = WS_POOLT + 2 * SZ_POOLT;
constexpr size_t WS_PB = WS_WU + 2 * SZ_WU;
constexpr size_t WS_POSB = WS_PB + (size_t)4 * T_TOK * PLE * 2;
constexpr size_t WS_XN = WS_POSB + 8192;
constexpr size_t WS_YB = WS_XN + (size_t)T_TOK * DM * 2;
constexpr size_t WS_Z = WS_YB + (size_t)T_TOK * DM * 2;
constexpr size_t SZ_KV = (size_t)16 * 4096 * 128 * 2;
constexpr size_t Z_Q = 0, Z_KC = (size_t)T_TOK * DM * 2, Z_VC = Z_KC + SZ_KV, Z_KS = Z_VC + SZ_KV, Z_VST = Z_KS + SZ_KV, Z_KW = Z_VST + SZ_KV, Z_VWT = Z_KW + SZ_KV;
constexpr size_t Z_GL = Z_VWT + SZ_KV, Z_HIDK = Z_GL + (size_t)T_TOK * 48 * 4, Z_HIDV = Z_HIDK + (size_t)4096 * 512 * 2, Z_KCMP = Z_HIDV + (size_t)4096 * 512 * 2, Z_VCMPT = Z_KCMP + (size_t)4096 * 128 * 2;
constexpr size_t WS_BAR = WS_Z + (size_t)T_TOK * DFF * 2;
constexpr size_t WS_ROWSS = WS_BAR + XCD_BAR_WORDS * 4 + 256;
constexpr size_t WS_PP = WS_ROWSS + (size_t)13 * T_TOK * 32 * 4;
constexpr size_t WS_POSP = WS_PP + (size_t)T_TOK * DM * 4;
constexpr size_t WS_WGL = WS_POSP + (size_t)4 * 64 * 512 * 4;
constexpr size_t WS_END = WS_WGL + (size_t)2 * 256 * DM * 2;
static_assert(Z_VCMPT + 4096 * 128 * 2 <= (size_t)T_TOK * DFF * 2, "z region");
static_assert(WS_END <= (size_t)1 << 30, "workspace");
constexpr int LDS_BYTES = 147456;

struct Args { const float* in[29]; float* out; unsigned char* ws; int lo, hi, one, pad; };

__device__ __forceinline__ void titem_load(float (&v)[64], const float* W, int N, int ldw, int item, int lane) {
    const int nblk = (N + 63) / 64, kb = item / nblk, nb = item % nblk, k0 = 64 * kb, n0 = 64 * nb;
    const int nn = n0 + lane; const bool ok = nn < N;
    const float* p = W + (size_t)k0 * ldw + nn;
#pragma unroll
    for (int i = 0; i < 64; ++i) v[i] = ok ? p[(size_t)i * ldw] : 0.f;
}
__device__ __forceinline__ void titem_store(const float (&v)[64], int N, bf16_t* WT, int ldt, LAS float* scr, int item, int lane, const float* gk) {
    const int nblk = (N + 63) / 64, kb = item / nblk, nb = item % nblk, k0 = 64 * kb, n0 = 64 * nb;
#pragma unroll
    for (int i = 0; i < 64; ++i) scr[i * 65 + lane] = v[i];
    asm volatile("s_waitcnt lgkmcnt(0)" ::: "memory");
    const int c = lane & 7;
    f32x4 g0 = (f32x4){1.f, 1.f, 1.f, 1.f}, g1 = g0; if (gk) { g0 = *(const f32x4*)(gk + k0 + 8 * c); g1 = *(const f32x4*)(gk + k0 + 8 * c + 4); }
#pragma unroll
    for (int j = 0; j < 8; ++j) { const int n = (lane >> 3) + 8 * j; const LAS float* s = scr + (8 * c) * 65 + n;
        u32x4 o; o.x = pk2(s[0 * 65] * g0[0], s[1 * 65] * g0[1]); o.y = pk2(s[2 * 65] * g0[2], s[3 * 65] * g0[3]); o.z = pk2(s[4 * 65] * g1[0], s[5 * 65] * g1[1]); o.w = pk2(s[6 * 65] * g1[2], s[7 * 65] * g1[3]);
        if (n0 + n < N) *(u32x4*)(WT + (size_t)(n0 + n) * ldt + k0 + 8 * c) = o; }
    asm volatile("s_waitcnt lgkmcnt(0)" ::: "memory");
}
__device__ __forceinline__ void conv_mat(const float* W, int K, int N, int ldw, bf16_t* WT, int ldt, LAS float* scr, int gw, int NGW, int lane, int& rot, const float* gk = nullptr) {
    const int nitems = (K / 64) * ((N + 63) / 64);
    int it = gw - rot; if (it < 0) it += NGW;
    rot = (rot + nitems) % NGW;
    if (it >= nitems) return;
    float va[64], vb[64];
    titem_load(va, W, N, ldw, it, lane);
    for (;;) {
        const int n1 = it + NGW; if (n1 < nitems) titem_load(vb, W, N, ldw, n1, lane);
        titem_store(va, N, WT, ldt, scr, it, lane, gk);
        if (n1 >= nitems) break;
        const int n2 = n1 + NGW; if (n2 < nitems) titem_load(va, W, N, ldw, n2, lane);
        titem_store(vb, N, WT, ldt, scr, n1, lane, gk);
        if (n2 >= nitems) break;
        it = n2;
    }
}
__device__ __forceinline__ void conv_plain(const float* src, int rows, int ncols, int lds_, bf16_t* dst, int ldd, int gt, int NGT, const float* gk = nullptr) {
    const int cpr = ncols / 8; const long total = (long)rows * cpr;
    for (long i = gt; i < total; i += NGT) { const int r = (int)(i / cpr), c = (int)(i % cpr) * 8;
        f32x4 a = *(const f32x4*)(src + (size_t)r * lds_ + c), b = *(const f32x4*)(src + (size_t)r * lds_ + c + 4);
        if (gk) { const float gg = gk[r]; a = a * gg; b = b * gg; }
        u32x4 o; o.x = f2bf(a[0]) | (f2bf(a[1]) << 16); o.y = f2bf(a[2]) | (f2bf(a[3]) << 16); o.z = f2bf(b[0]) | (f2bf(b[1]) << 16); o.w = f2bf(b[2]) | (f2bf(b[3]) << 16);
        *(u32x4*)(dst + (size_t)r * ldd + c) = o; }
}
__device__ __forceinline__ void zero_fill16(unsigned char* p, size_t bytes, int gt, int NGT) {
    const u32x4 z = (u32x4){0u, 0u, 0u, 0u};
    for (size_t i = (size_t)gt * 16; i < bytes; i += (size_t)NGT * 16) *(u32x4*)(p + i) = z;
}

template <bool F32OUT>
__device__ __forceinline__ void rmsnorm_rows(const float* X, const float* g, bf16_t* O, float* OF, int bx, int NGW) {
    asm volatile("" ::: "memory"); const int tid = opaque_tid(), lane = tid & 63; const int gw = opq(bx) * 8 + __builtin_amdgcn_readfirstlane(tid >> 6);
    f32x4 gv[8];
#pragma unroll
    for (int j = 0; j < 8; ++j) gv[j] = *(const f32x4*)(g + (lane + 64 * j) * 4);
    for (int r = gw; r < T_TOK; r += NGW) {
        const float* xr = X + (size_t)r * DM; f32x4 v[8]; float s = 0.f;
#pragma unroll
        for (int j = 0; j < 8; ++j) { v[j] = *(const f32x4*)(xr + (lane + 64 * j) * 4); s += (v[j][0] * v[j][0] + v[j][1] * v[j][1]) + (v[j][2] * v[j][2] + v[j][3] * v[j][3]); }
        const float rstd = rsqrtf(wave_sum(s, lane) * (1.f / DM) + EPSV);
#pragma unroll
        for (int j = 0; j < 8; ++j) { const f32x4 y = v[j] * rstd * gv[j];
            if (F32OUT) *(f32x4*)(OF + (size_t)r * DM + (lane + 64 * j) * 4) = y;
            else { u32x2 w; w.x = pk2(y[0], y[1]); w.y = pk2(y[2], y[3]); *(u32x2*)(O + (size_t)r * DM + (lane + 64 * j) * 4) = w; } }
    }
}

__device__ __forceinline__ void rows_to_bf16_ss(const float* X, bf16_t* O, float* rss, int bx, int NGW) {
    const int tid = opaque_tid(), lane = tid & 63; const int gw = opq(bx) * 8 + __builtin_amdgcn_readfirstlane(tid >> 6);
    for (int r = gw; r < T_TOK; r += NGW) {
        const float* xr = X + (size_t)r * DM; f32x4 v[8]; float s = 0.f;
#pragma unroll
        for (int j = 0; j < 8; ++j) { v[j] = *(const f32x4*)(xr + (lane + 64 * j) * 4); s += (v[j][0] * v[j][0] + v[j][1] * v[j][1]) + (v[j][2] * v[j][2] + v[j][3] * v[j][3]); }
        s = wave_sum(s, lane); if (lane < 32) rss[(size_t)r * 32 + lane] = (lane == 0) ? s : 0.f;
#pragma unroll
        for (int j = 0; j < 8; ++j) { u32x2 w; w.x = pk2(v[j][0], v[j][1]); w.y = pk2(v[j][2], v[j][3]); *(u32x2*)(O + (size_t)r * DM + (lane + 64 * j) * 4) = w; }
    }
}
__device__ __forceinline__ void lru_item(LAS unsigned char* lds, int item, const bf16_t* ZE, const float* conv_w, const float* conv_b,
                                         const bf16_t* WrT, const bf16_t* WiT, const float* b_r, const float* b_i, const float* lam, bf16_t* YB) {
    const int tid = opaque_tid(), w = __builtin_amdgcn_readfirstlane(tid >> 6), lane = tid & 63, fr = lane & 15, fq = lane >> 4;
    const int b = item >> 6, hh = (item >> 2) & 15, qq = item & 3;
    LAS unsigned char* XC = lds;
    LAS float* SEGA = (LAS float*)(lds + 36864);
    LAS float* SEGB = SEGA + 1024;
    LAS float* HIN = SEGB + 1024;
    const int co = tid & 7, tr = tid >> 3;
    float cw[4][8], cb[8];
#pragma unroll
    for (int k = 0; k < 4; ++k)
#pragma unroll
        for (int e = 0; e < 8; ++e) cw[k][e] = conv_w[k * 1024 + hh * 64 + co * 8 + e];
#pragma unroll
    for (int e = 0; e < 8; ++e) cb[e] = conv_b[hh * 64 + co * 8 + e];
    bf16x8 wrf[2], wif[2];
#pragma unroll
    for (int kk = 0; kk < 2; ++kk) { wrf[kk] = *(const bf16x8*)(WrT + ((size_t)hh * 64 + qq * 16 + fr) * 64 + kk * 32 + fq * 8); wif[kk] = *(const bf16x8*)(WiT + ((size_t)hh * 64 + qq * 16 + fr) * 64 + kk * 32 + fq * 8); }
    const int ch = hh * 64 + qq * 16 + fr;
    const float br = b_r[ch], bi = b_i[ch];
    const float lm = lam[ch]; float sp8; { const float e = __expf(-lm); const float ser = e * (1.f - e * (0.5f - e * (0.33333333f - e * 0.25f)));
        sp8 = 8.0f * ((-lm > 20.f) ? -lm : (e < 0.03f ? ser : __logf(1.0f + e))); }
    float carry = 0.f;
    const bf16_t* zb = ZE + (size_t)b * SEQ * AB_IN;
    u32x4 xr[7];
#pragma unroll
    for (int r = 0; r < 7; ++r) { const int t = tr * 4 - 3 + r; xr[r] = (t >= 0) ? *(const u32x4*)(zb + (size_t)t * AB_IN + hh * 64 + co * 8) : (u32x4){0u, 0u, 0u, 0u}; }
    for (int sc = 0; sc < 16; ++sc) {
        const int t0 = sc * 256;
        unsigned short gr[2][4];
#pragma unroll
        for (int ml = 0; ml < 2; ++ml)
#pragma unroll
            for (int r = 0; r < 4; ++r) gr[ml][r] = zb[(size_t)(t0 + (w * 2 + ml) * 16 + fq * 4 + r) * AB_IN + 1024 + ch];
        {
            float xin[7][8];
#pragma unroll
            for (int r = 0; r < 7; ++r) { const u32x4 v = xr[r];
                xin[r][0] = bflo(v.x); xin[r][1] = bfhi(v.x); xin[r][2] = bflo(v.y); xin[r][3] = bfhi(v.y); xin[r][4] = bflo(v.z); xin[r][5] = bfhi(v.z); xin[r][6] = bflo(v.w); xin[r][7] = bfhi(v.w); }
#pragma unroll
            for (int q = 0; q < 4; ++q) { float o[8];
#pragma unroll
                for (int e = 0; e < 8; ++e) o[e] = cb[e] + cw[0][e] * xin[q][e] + cw[1][e] * xin[q + 1][e] + cw[2][e] * xin[q + 2][e] + cw[3][e] * xin[q + 3][e];
                u32x4 wv; wv.x = pk2(o[0], o[1]); wv.y = pk2(o[2], o[3]); wv.z = pk2(o[4], o[5]); wv.w = pk2(o[6], o[7]);
                *(LAS u32x4*)(XC + (tr * 4 + q) * 144 + co * 16) = wv; }
            if (sc < 15) {
#pragma unroll
                for (int r = 0; r < 7; ++r) xr[r] = *(const u32x4*)(zb + (size_t)(t0 + 256 + tr * 4 - 3 + r) * AB_IN + hh * 64 + co * 8); }
        }
        __syncthreads();
        float av[2][4], bv[2][4];
#pragma unroll
        for (int ml = 0; ml < 2; ++ml) { const int mt = w * 2 + ml;
            f32x4 ar = (f32x4){0.f, 0.f, 0.f, 0.f}, ai = ar;
#pragma unroll
            for (int kk = 0; kk < 2; ++kk) { const bf16x8 xa = *(const LAS bf16x8*)(XC + (mt * 16 + fr) * 144 + kk * 64 + fq * 16);
                ar = __builtin_amdgcn_mfma_f32_16x16x32_bf16(xa, wrf[kk], ar, 0, 0, 0); ai = __builtin_amdgcn_mfma_f32_16x16x32_bf16(xa, wif[kk], ai, 0, 0, 0); }
            float A = 1.f, Bc = 0.f;
#pragma unroll
            for (int r = 0; r < 4; ++r) { const int tok = mt * 16 + fq * 4 + r;
                const float xcv = bf2f(*(const LAS unsigned short*)(XC + tok * 144 + (qq * 16 + fr) * 2));
                const float rg = sigmoidf_(ar[r] + br), ig = sigmoidf_(ai[r] + bi);
                const float la = -rg * sp8; const float a = __expf(la); const float x2 = 2.f * la; const float em = (x2 > -0.3f) ? -x2 * (1.f + x2 * 0.5f * (1.f + x2 * 0.33333333f * (1.f + x2 * 0.25f * (1.f + x2 * 0.2f * (1.f + x2 * 0.16666667f))))) : 1.f - __expf(x2);
                const float mult = sqrtf(fmaxf(em, 0.f));
                av[ml][r] = a; bv[ml][r] = mult * ig * xcv;
                Bc = a * Bc + bv[ml][r]; A = A * a; }
            const int sg = mt * 4 + fq; SEGA[sg * 16 + fr] = A; SEGB[sg * 16 + fr] = Bc; }
        __syncthreads();
        if (w == 0 && lane < 16) { float h = carry;
#pragma unroll 8
            for (int sg = 0; sg < 64; ++sg) { HIN[sg * 16 + lane] = h; h = SEGA[sg * 16 + lane] * h + SEGB[sg * 16 + lane]; }
            carry = h; }
        __syncthreads();
#pragma unroll
        for (int ml = 0; ml < 2; ++ml) { const int mt = w * 2 + ml; float h = HIN[(mt * 4 + fq) * 16 + fr];
#pragma unroll
            for (int r = 0; r < 4; ++r) { const int t = t0 + mt * 16 + fq * 4 + r; h = av[ml][r] * h + bv[ml][r];
                const float gt = bf2f(gr[ml][r]);
                YB[((size_t)b * SEQ + t) * DM + ch] = (bf16_t)f2bf(h * gelu_tanh(gt)); } }
    }
    __syncthreads();
}
__device__ __forceinline__ void pool_item(int item, const bf16_t* ZE, const float* scale, bf16_t* YB) {
    const int tid = opaque_tid(), b = item >> 6, tch = item & 63, co = tid & 127, seg = tid >> 7;
    const int win = 2 << (co >> 5);
    float sc[8];
#pragma unroll
    for (int e = 0; e < 8; ++e) sc[e] = scale[co * 8 + e];
    const bf16_t* zb = ZE + (size_t)b * SEQ * AB_IN + 2048 + co * 8;
    const int ts = tch * 64 + seg * 16;
    float sum[8];
#pragma unroll
    for (int e = 0; e < 8; ++e) sum[e] = 0.f;
    for (int s = ts - win + 1; s < ts; ++s) if (s >= 0) { const u32x4 v = *(const u32x4*)(zb + (size_t)s * AB_IN);
        sum[0] += bflo(v.x); sum[1] += bfhi(v.x); sum[2] += bflo(v.y); sum[3] += bfhi(v.y); sum[4] += bflo(v.z); sum[5] += bfhi(v.z); sum[6] += bflo(v.w); sum[7] += bfhi(v.w); }
    for (int t = ts; t < ts + 16; ++t) {
        const u32x4 v = *(const u32x4*)(zb + (size_t)t * AB_IN);
        float x[8] = {bflo(v.x), bfhi(v.x), bflo(v.y), bfhi(v.y), bflo(v.z), bfhi(v.z), bflo(v.w), bfhi(v.w)};
        const float inv = 1.0f / (float)((t + 1) < win ? (t + 1) : win);
        float o[8];
#pragma unroll
        for (int e = 0; e < 8; ++e) { sum[e] += x[e]; o[e] = (sum[e] * inv - x[e]) * sc[e]; }
        u32x4 wv; wv.x = pk2(o[0], o[1]); wv.y = pk2(o[2], o[3]); wv.z = pk2(o[4], o[5]); wv.w = pk2(o[6], o[7]);
        *(u32x4*)(YB + ((size_t)b * SEQ + t) * DM + 1024 + co * 8) = wv;
        const int so = t - win + 1;
        if (so >= 0) { const u32x4 q = *(const u32x4*)(zb + (size_t)so * AB_IN);
            sum[0] -= bflo(q.x); sum[1] -= bfhi(q.x); sum[2] -= bflo(q.y); sum[3] -= bfhi(q.y); sum[4] -= bflo(q.z); sum[5] -= bfhi(q.z); sum[6] -= bflo(q.w); sum[7] -= bfhi(q.w); }
    }
}

constexpr int KT_PITCH = 272, VT_PITCH = 144;
constexpr int AL_KT = 0, AL_VT = 64 * KT_PITCH, AL_BUF = 36864  , AL_IMPA = 2 * 36864, AL_IMPB = AL_IMPA + 64 * 65 * 4, AL_SEL = AL_IMPB + 64 * 65 * 4, AL_UNI = AL_SEL + 512, AL_Q = 73728, Q_WAVE = 32 * KT_PITCH;
constexpr float QSCALE2 = 0.08838834764831845f * LOG2E;
constexpr float NEGB = -1e30f;

struct StageRegs { u32x4 k[2], v[2]; };
__device__ __forceinline__ void stage_load(StageRegs& R, const bf16_t* kbase, const bf16_t* vbase, int vpitch, int tid) {
    const int kr = tid >> 3, kc = tid & 7, vr = tid >> 2, vc = tid & 3;
    R.k[0] = *(const u32x4*)(kbase + kr * 128 + kc * 8); R.k[1] = *(const u32x4*)(kbase + kr * 128 + 64 + kc * 8);
    R.v[0] = *(const u32x4*)(vbase + (size_t)vr * vpitch + vc * 8); R.v[1] = *(const u32x4*)(vbase + (size_t)vr * vpitch + 32 + vc * 8);
}
__device__ __forceinline__ void stage_store(const StageRegs& R, LAS unsigned char* lds, int tid) {
    const int kr = tid >> 3, kc = tid & 7, vr = tid >> 2, vc = tid & 3;
    *(LAS u32x4*)(lds + AL_KT + kr * KT_PITCH + kc * 16) = R.k[0]; *(LAS u32x4*)(lds + AL_KT + kr * KT_PITCH + 128 + kc * 16) = R.k[1];
    *(LAS u32x4*)(lds + AL_VT + vr * VT_PITCH + vc * 16) = R.v[0]; *(LAS u32x4*)(lds + AL_VT + vr * VT_PITCH + 64 + vc * 16) = R.v[1];
}
template <int MODE>
__device__ __forceinline__ void attn_tile(bool MASK, LAS unsigned char* lds, LAS unsigned char* ldsi, const bf16x8 (&qf)[2][4], f32x4 (&O)[2][8], float (&m)[2], float (&l)[2], const int (&tpos)[2], float slope2,
                                          int kp0, const bool (&selbit)[2], int fr, int fq, int wv, int tile64, int lane) {
    constexpr int KS = (MODE <= 1) ? 16 : 1;
    f32x4 s[2][4];
#pragma unroll
    for (int ci = 0; ci < 2; ++ci)
#pragma unroll
        for (int k4 = 0; k4 < 4; ++k4) s[ci][k4] = (f32x4){0.f, 0.f, 0.f, 0.f};
#pragma unroll
    for (int kk = 0; kk < 4; ++kk) {
        const bf16x8 q0 = qf[0][kk], q1 = qf[1][kk];
#pragma unroll
        for (int k4 = 0; k4 < 4; ++k4) { const bf16x8 kf = *(const LAS bf16x8*)(lds + AL_KT + (k4 * 16 + fr) * KT_PITCH + kk * 64 + fq * 16);
            s[0][k4] = __builtin_amdgcn_mfma_f32_16x16x32_bf16(kf, q0, s[0][k4], 0, 0, 0);
            s[1][k4] = __builtin_amdgcn_mfma_f32_16x16x32_bf16(kf, q1, s[1][k4], 0, 0, 0); } }
    const float sk = slope2 * (float)KS;
    float alpha[2] = {1.f, 1.f};
#pragma unroll
    for (int ci = 0; ci < 2; ++ci) {
        const int base = tpos[ci] - kp0 - KS * (fq * 4);
        const float bb = -slope2 * (float)base;
        float mx = NEGB;
#pragma unroll
        for (int k4 = 0; k4 < 4; ++k4)
#pragma unroll
            for (int j = 0; j < 4; ++j) {
                s[ci][k4][j] = __builtin_fmaf(s[ci][k4][j], QSCALE2, __builtin_fmaf(sk, (float)(k4 * 16 + j), bb)); }
        if (MASK) {
#pragma unroll
            for (int k4 = 0; k4 < 4; ++k4)
#pragma unroll
                for (int j = 0; j < 4; ++j) { const int c = KS * (k4 * 16 + j); bool ok = c <= base; if (MODE == 3) ok = ok && (base - c < 512); s[ci][k4][j] = ok ? s[ci][k4][j] : 2.0f * NEGB; } }
#pragma unroll
        for (int k4 = 0; k4 < 4; ++k4)
#pragma unroll
            for (int j = 0; j < 4; ++j) mx = fmaxf(mx, s[ci][k4][j]);
        if (MODE == 2) mx = selbit[ci] ? mx : NEGB;
        if (MODE != 1) {
            mx = fmaxf(mx, shx(mx, lane, 16)); mx = fmaxf(mx, shx(mx, lane, 32));
            const float mn = fmaxf(m[ci], mx); alpha[ci] = __builtin_amdgcn_exp2f(m[ci] - mn); m[ci] = mn;
            float ps = 0.f;
#pragma unroll
            for (int k4 = 0; k4 < 4; ++k4)
#pragma unroll
                for (int j = 0; j < 4; ++j) { const float p = __builtin_amdgcn_exp2f(s[ci][k4][j] - mn); s[ci][k4][j] = p; ps += p; }
            if (MODE == 2) ps = selbit[ci] ? ps : 0.f;
            l[ci] = l[ci] * alpha[ci] + ps;
        } else {
#pragma unroll
            for (int k4 = 0; k4 < 4; ++k4) {
#pragma unroll
                for (int j = 0; j < 4; ++j) s[ci][k4][j] = __builtin_amdgcn_exp2f(s[ci][k4][j] - m[ci]) * l[ci];
                float a = (s[ci][k4][0] + s[ci][k4][1]) + (s[ci][k4][2] + s[ci][k4][3]); float b3 = s[ci][k4][3];
                a += shx(a, lane, 1); a += shx(a, lane, 2); b3 += shx(b3, lane, 1); b3 += shx(b3, lane, 2);
                if ((fr & 3) == 0) { const int tl = wv * 8 + ci * 4 + (fr >> 2); const int ms = tile64 * 16 + k4 * 4 + fq;
                    ((LAS float*)(ldsi + AL_IMPA))[tl * 65 + ms] = a; ((LAS float*)(ldsi + AL_IMPB))[tl * 65 + ms + 1] = b3; } }
        }
    }
    if (MODE >= 2) {
        if (__builtin_amdgcn_ballot_w64(alpha[0] != 1.f || alpha[1] != 1.f) != 0ull) {
#pragma unroll
            for (int ci = 0; ci < 2; ++ci)
#pragma unroll
                for (int dt = 0; dt < 8; ++dt) O[ci][dt] = O[ci][dt] * alpha[ci]; }
    }
    if (MODE != 0) {
#pragma unroll
        for (int ks = 0; ks < 2; ++ks) {
            bf16x8 pf[2];
#pragma unroll
            for (int ci = 0; ci < 2; ++ci) { u32x4 w; w.x = pk2(s[ci][2 * ks][0], s[ci][2 * ks][1]); w.y = pk2(s[ci][2 * ks][2], s[ci][2 * ks][3]); w.z = pk2(s[ci][2 * ks + 1][0], s[ci][2 * ks + 1][1]); w.w = pk2(s[ci][2 * ks + 1][2], s[ci][2 * ks + 1][3]);
                if (MODE == 2) { w.x = selbit[ci] ? w.x : 0u; w.y = selbit[ci] ? w.y : 0u; w.z = selbit[ci] ? w.z : 0u; w.w = selbit[ci] ? w.w : 0u; }
                pf[ci] = __builtin_bit_cast(bf16x8, w); }
#pragma unroll
            for (int dt = 0; dt < 8; ++dt) { const LAS unsigned char* vp = lds + AL_VT + (dt * 16 + fr) * VT_PITCH + (ks * 32 + fq * 4) * 2;
                const u32x2 lo = *(const LAS u32x2*)vp, hi = *(const LAS u32x2*)(vp + 32);
                const bf16x8 vf = __builtin_bit_cast(bf16x8, (u32x4){lo.x, lo.y, hi.x, hi.y});
                O[0][dt] = __builtin_amdgcn_mfma_f32_16x16x32_bf16(vf, pf[0], O[0][dt], 0, 0, 0);
                O[1][dt] = __builtin_amdgcn_mfma_f32_16x16x32_bf16(vf, pf[1], O[1][dt], 0, 0, 0); }
        }
    }
}

__device__ __forceinline__ void nsa_item(LAS unsigned char* lds, int b, int g, int tq, const bf16_t* Q, const bf16_t* KS, const bf16_t* VST, const bf16_t* KW, const bf16_t* VWT,
                                         const bf16_t* KCMP, const bf16_t* VCMPT, const float* GL, bf16_t* YB) {
    const int tid = opaque_tid(), wv = __builtin_amdgcn_readfirstlane(tid >> 6), lane = tid & 63, fr = lane & 15, fq = lane >> 4;
    const int t0 = tq * 64, bg = b * 4 + g, head = g * 4 + (fr & 3);
    LAS float* IMPA = (LAS float*)(lds + AL_IMPA);
    LAS unsigned long long* SEL = (LAS unsigned long long*)(lds + AL_SEL);
    LAS unsigned long long* UNI = (LAS unsigned long long*)(lds + AL_UNI);
    __syncthreads();
    for (int i = tid; i < 2 * 64 * 65; i += 512) IMPA[i] = 0.f;
    int tpos[2]; bf16x8 qf[2][4]; int tc = 0;
#pragma unroll
    for (int ci = 0; ci < 2; ++ci) { tpos[ci] = t0 + wv * 8 + ci * 4 + (fr >> 2);
        const bf16_t* qp = Q + ((size_t)(b * SEQ + tpos[ci])) * DM + head * 128 + fq * 8;
#pragma unroll
        for (int kk = 0; kk < 4; ++kk) qf[ci][kk] = *(const bf16x8*)(qp + kk * 32);
    }
    const float slope2 = exp2f(-0.5f * (float)(head + 1)) * LOG2E;
    f32x4 O[2][8]; float m[2], l[2]; bool selbit[2] = {true, true};
#pragma unroll
    for (int ci = 0; ci < 2; ++ci)
#pragma unroll
        for (int dt = 0; dt < 8; ++dt) { O[ci][dt] = (f32x4){0.f, 0.f, 0.f, 0.f}; }
    StageRegs R;
    const int ncmp = ((t0 + 32) >> 4) + 1, nct = (ncmp + 63) >> 6;
    const bf16_t* kcb = KCMP + (size_t)bg * 256 * 128; const bf16_t* vcb = VCMPT + (size_t)bg * 128 * 256;
    m[0] = m[1] = NEGB; l[0] = l[1] = 0.f;
    stage_load(R, kcb, vcb, 256, tid);
    for (int ct = 0; ct < nct; ++ct) {
        LAS unsigned char* kvb = lds + (tc & 1) * AL_BUF; ++tc; stage_store(R, kvb, tid); __syncthreads();
        if (ct + 1 < nct) stage_load(R, kcb + (size_t)(ct + 1) * 64 * 128, vcb + (ct + 1) * 64, 256, tid);
        attn_tile<0>(1024 * ct + 1039 > t0, kvb, lds, qf, O, m, l, tpos, slope2, 16 * (ct * 64) + 31, selbit, fr, fq, wv, ct, lane);
    }
#pragma unroll
    for (int ci = 0; ci < 2; ++ci) { float lt = l[ci]; lt += shx(lt, lane, 16); lt += shx(lt, lane, 32); l[ci] = lt > 0.f ? 1.0f / lt : 0.f; }
    stage_load(R, kcb, vcb, 256, tid);
    for (int ct = 0; ct < nct; ++ct) {
        LAS unsigned char* kvb = lds + (tc & 1) * AL_BUF; ++tc; stage_store(R, kvb, tid); __syncthreads();
        if (ct + 1 < nct) stage_load(R, kcb + (size_t)(ct + 1) * 64 * 128, vcb + (ct + 1) * 64, 256, tid);
        attn_tile<1>(1024 * ct + 1039 > t0, kvb, lds, qf, O, m, l, tpos, slope2, 16 * (ct * 64) + 31, selbit, fr, fq, wv, ct, lane);
    }
#pragma unroll
    for (int ci = 0; ci < 2; ++ci) { const float gc = GL[((size_t)(b * SEQ + tpos[ci])) * 48 + head];
        bf16_t* op = YB + ((size_t)(b * SEQ + tpos[ci])) * DM + head * 128 + fq * 4;
#pragma unroll
        for (int dt = 0; dt < 8; ++dt) { const f32x4 o = O[ci][dt] * gc; u32x2 w; w.x = pk2(o[0], o[1]); w.y = pk2(o[2], o[3]); *(u32x2*)(op + dt * 16) = w; O[ci][dt] = (f32x4){0.f, 0.f, 0.f, 0.f}; } }
    __syncthreads();
    {
        const int cur = tq; unsigned long long wun = 0ull;
#pragma unroll 1
        for (int tk = 0; tk < 8; ++tk) { const int tl = wv * 8 + tk;
            float v = IMPA[tl * 65 + lane] + IMPA[64 * 65 + tl * 65 + lane];
            if (lane == 0 || lane == cur || lane == cur - 1) v += 1e6f;
            if (lane > cur) v = NEGB;
            int rank = 0; const int vi = __builtin_bit_cast(int, v);
#pragma unroll
            for (int mm = 0; mm < 64; ++mm) { const float vm = __builtin_bit_cast(float, __builtin_amdgcn_readlane(vi, mm)); rank += ((vm > v) || (vm == v && mm < lane)) ? 1 : 0; }
            const unsigned long long mk = __ballot(rank < 16 && lane <= cur);
            wun |= mk;
            if (lane == 0) SEL[tl] = mk; }
        if (lane == 0) UNI[wv] = wun;
    }
    __syncthreads();
    unsigned long long selm[2], wun, bun = 0ull;
#pragma unroll
    for (int ci = 0; ci < 2; ++ci) selm[ci] = SEL[wv * 8 + ci * 4 + (fr >> 2)];
    wun = UNI[wv];
#pragma unroll
    for (int i = 0; i < 8; ++i) bun |= UNI[i];
    { const unsigned lo = __builtin_amdgcn_readfirstlane((unsigned)bun), hi = __builtin_amdgcn_readfirstlane((unsigned)(bun >> 32)); bun = ((unsigned long long)hi << 32) | lo;
      const unsigned lo2 = __builtin_amdgcn_readfirstlane((unsigned)wun), hi2 = __builtin_amdgcn_readfirstlane((unsigned)(wun >> 32)); wun = ((unsigned long long)hi2 << 32) | lo2; }
    const bf16_t* ksb = KS + (size_t)bg * SEQ * 128; const bf16_t* vsb = VST + (size_t)bg * 128 * SEQ;
    m[0] = m[1] = NEGB; l[0] = l[1] = 0.f;
    {
        unsigned long long rem = bun; int j = 63 - __builtin_clzll(rem); rem &= ~(1ull << j);
        stage_load(R, ksb + (size_t)j * 64 * 128, vsb + j * 64, SEQ, tid);
        for (;;) {
            LAS unsigned char* kvb = lds + (tc & 1) * AL_BUF; ++tc; stage_store(R, kvb, tid); __syncthreads();
            const int jn = rem ? 63 - __builtin_clzll(rem) : -1; if (jn >= 0) { rem &= ~(1ull << jn); stage_load(R, ksb + (size_t)jn * 64 * 128, vsb + jn * 64, SEQ, tid); }
            if ((wun >> j) & 1ull) { selbit[0] = (selm[0] >> j) & 1ull; selbit[1] = (selm[1] >> j) & 1ull;
                attn_tile<2>(j == tq, kvb, lds, qf, O, m, l, tpos, slope2, j * 64, selbit, fr, fq, wv, 0, lane); }
            if (jn < 0) break; j = jn;
        }
    }
#pragma unroll
    for (int ci = 0; ci < 2; ++ci) { float lt = l[ci]; lt += shx(lt, lane, 16); lt += shx(lt, lane, 32); const float gs = GL[((size_t)(b * SEQ + tpos[ci])) * 48 + 16 + head]; const float sc = lt > 0.f ? gs / lt : 0.f;
        bf16_t* op = YB + ((size_t)(b * SEQ + tpos[ci])) * DM + head * 128 + fq * 4;
#pragma unroll
        for (int dt = 0; dt < 8; ++dt) { const f32x4 o = O[ci][dt] * sc; const u32x2 pv = *(const u32x2*)(op + dt * 16); u32x2 w; w.x = pk2(bflo(pv.x) + o[0], bfhi(pv.x) + o[1]); w.y = pk2(bflo(pv.y) + o[2], bfhi(pv.y) + o[3]); *(u32x2*)(op + dt * 16) = w; O[ci][dt] = (f32x4){0.f, 0.f, 0.f, 0.f}; } }
    const bf16_t* kwb = KW + (size_t)bg * SEQ * 128; const bf16_t* vwb = VWT + (size_t)bg * 128 * SEQ;
    m[0] = m[1] = NEGB; l[0] = l[1] = 0.f; selbit[0] = selbit[1] = true;
    {
        const int j0 = tq >= 8 ? tq - 8 : 0;
        stage_load(R, kwb + (size_t)tq * 64 * 128, vwb + tq * 64, SEQ, tid);
        for (int j = tq; j >= j0; --j) {
            LAS unsigned char* kvb = lds + (tc & 1) * AL_BUF; ++tc; stage_store(R, kvb, tid); __syncthreads();
            if (j > j0) stage_load(R, kwb + (size_t)(j - 1) * 64 * 128, vwb + (j - 1) * 64, SEQ, tid);
            attn_tile<3>(j == tq || j == tq - 8, kvb, lds, qf, O, m, l, tpos, slope2, j * 64, selbit, fr, fq, wv, 0, lane);
        }
    }
#pragma unroll
    for (int ci = 0; ci < 2; ++ci) { float lt = l[ci]; lt += shx(lt, lane, 16); lt += shx(lt, lane, 32); const float gwv = GL[((size_t)(b * SEQ + tpos[ci])) * 48 + 32 + head]; const float sc = lt > 0.f ? gwv / lt : 0.f;
        bf16_t* op = YB + ((size_t)(b * SEQ + tpos[ci])) * DM + head * 128 + fq * 4;
#pragma unroll
        for (int dt = 0; dt < 8; ++dt) { const f32x4 o = O[ci][dt] * sc; const u32x2 pv = *(const u32x2*)(op + dt * 16); u32x2 w; w.x = pk2(bflo(pv.x) + o[0], bfhi(pv.x) + o[1]); w.y = pk2(bflo(pv.y) + o[2], bfhi(pv.y) + o[3]); *(u32x2*)(op + dt * 16) = w; } }
}

__global__ void __launch_bounds__(512) fwd_kernel(Args a) {
    extern __shared__ __attribute__((aligned(16))) unsigned char lds_raw[];
    LAS unsigned char* lds = (LAS unsigned char*)lds_raw;
    const int G = gridDim.x, bx = blockIdx.x;
    const int NGW = G * 8, NGT = G * 512;
#define GW() (opq(bx) * 8 + __builtin_amdgcn_readfirstlane(opaque_tid() >> 6))
    unsigned char* ws = a.ws;
    int ph = 0;
    { volatile LAS unsigned* MISC = (volatile LAS unsigned*)(lds + LDS_BYTES - 64); if (threadIdx.x < 16) MISC[threadIdx.x] = 0u; }
    __syncthreads();
    (void)xcd_barrier_post((unsigned*)(ws + WS_BAR), (volatile LAS unsigned*)(lds + LDS_BYTES - 64));
#ifndef ONLY
#define ONLY -1
#endif
#define EN(id) (ONLY < 0 || ONLY == (id))
#define ON() (ph >= a.lo && ph < a.hi)
#define SEAM() do { ++ph; if (a.one) { if (ph == 1) cg::this_grid().sync(); else { XcdBarrier bar; bar.bar = (unsigned*)(opqp(ws) + WS_BAR); bar.x = xb_xcc_id(); bar.st = (volatile LAS unsigned*)(lds + LDS_BYTES - 64); xcd_barrier(bar); } } } while (0)

    bf16_t* XN = (bf16_t*)(ws + WS_XN); bf16_t* YB = (bf16_t*)(ws + WS_YB); unsigned char* Z = ws + WS_Z;
    float* posb = (float*)(ws + WS_POSB);

    if (EN(0) && ON())
#pragma unroll 1
    for (int rp0 = 0; rp0 < REP_P0; ++rp0) {
        const int tid = opaque_tid(), lane = tid & 63, wave = __builtin_amdgcn_readfirstlane(tid >> 6), gw = bx * 8 + wave, gt = bx * 512 + tid;
        LAS float* scr = (LAS float*)(lds + wave * 16640);
        int rot = 0;
        for (int i = 0; i < 4; ++i) {
            conv_mat(a.in[23] + (size_t)i * DM * DFF, DM, DFF, DFF, (bf16_t*)(ws + WS_WUP + i * SZ_UP), DM, scr, gw, NGW, lane, rot, a.in[22] + i * DM);
            conv_mat(a.in[24] + (size_t)i * DFF * DM, DFF, DM, DM, (bf16_t*)(ws + WS_WDN + i * SZ_UP), DFF, scr, gw, NGW, lane, rot);
            conv_mat(a.in[26] + (size_t)i * DM * DM, DM, DM, DM, (bf16_t*)(ws + WS_WG + i * SZ_SQ), DM, scr, gw, NGW, lane, rot, a.in[25] + i * DM);
            conv_mat(a.in[27] + (size_t)i * PLE * DM, PLE, DM, DM, (bf16_t*)(ws + WS_WP + i * SZ_WP), PLE, scr, gw, NGW, lane, rot);
        }
        for (int j = 0; j < 2; ++j) {
            conv_mat(a.in[3] + (size_t)j * DM * AB_IN, DM, 2048, AB_IN, (bf16_t*)(ws + WS_WIN + j * SZ_WIN), DM, scr, gw, NGW, lane, rot, a.in[2] + (2 * j) * DM);
            conv_mat(a.in[13] + (size_t)j * DM * DM, DM, DM, DM, (bf16_t*)(ws + WS_WOUT + j * SZ_SQ), DM, scr, gw, NGW, lane, rot);
            conv_mat(a.in[14] + (size_t)j * DM * C_IN, DM, C_INP, C_IN, (bf16_t*)(ws + WS_CIN + j * SZ_CIN), DM, scr, gw, NGW, lane, rot, a.in[2] + (2 * j + 1) * DM);
            conv_mat(a.in[14] + (size_t)j * DM * C_IN + C_INP, DM, 48, C_IN, (bf16_t*)(ws + WS_WGL + (size_t)j * 256 * DM * 2), DM, scr, gw, NGW, lane, rot, a.in[2] + (2 * j + 1) * DM);
            conv_mat(a.in[21] + (size_t)j * DM * DM, DM, DM, DM, (bf16_t*)(ws + WS_COUT + j * SZ_SQ), DM, scr, gw, NGW, lane, rot);
            conv_mat(a.in[16] + (size_t)j * 4096 * 512, 4096, 512, 512, (bf16_t*)(ws + WS_W1K + j * SZ_W1), 4096, scr, gw, NGW, lane, rot);
            conv_mat(a.in[19] + (size_t)j * 4096 * 512, 4096, 512, 512, (bf16_t*)(ws + WS_W1V + j * SZ_W1), 4096, scr, gw, NGW, lane, rot);
            conv_mat(a.in[17] + (size_t)j * 512 * 128, 512, 128, 128, (bf16_t*)(ws + WS_W2K + j * SZ_W2), 512, scr, gw, NGW, lane, rot);
            conv_mat(a.in[20] + (size_t)j * 512 * 128, 512, 128, 128, (bf16_t*)(ws + WS_W2V + j * SZ_W2), 512, scr, gw, NGW, lane, rot);
            for (int h = 0; h < 16; ++h) {
                conv_mat(a.in[6] + ((size_t)j * 16 + h) * 4096, 64, 64, 64, (bf16_t*)(ws + WS_WR + j * SZ_WRI) + h * 4096, 64, scr, gw, NGW, lane, rot);
                conv_mat(a.in[8] + ((size_t)j * 16 + h) * 4096, 64, 64, 64, (bf16_t*)(ws + WS_WI + j * SZ_WRI) + h * 4096, 64, scr, gw, NGW, lane, rot);
            }
            for (int gI = 0; gI < 4; ++gI)
                conv_mat(a.in[11] + ((size_t)j * 4 + gI) * 65536, 256, 256, 256, (bf16_t*)(ws + WS_POOLT + j * SZ_POOLT) + gI * 65536, 256, scr, gw, NGW, lane, rot);
            conv_plain(a.in[3] + (size_t)j * DM * AB_IN + 2048, DM, 1024, AB_IN, (bf16_t*)(ws + WS_WU + j * SZ_WU), 1024, gt, NGT, a.in[2] + (2 * j) * DM);
            zero_fill16(ws + WS_WGL + (size_t)j * 256 * DM * 2 + (size_t)48 * DM * 2, (size_t)208 * DM * 2, gt, NGT);
            zero_fill16(ws + WS_W2K + j * SZ_W2 + (size_t)128 * 512 * 2, (size_t)128 * 512 * 2, gt, NGT);
            zero_fill16(ws + WS_W2V + j * SZ_W2 + (size_t)128 * 512 * 2, (size_t)128 * 512 * 2, gt, NGT);
        }
        conv_plain(a.in[1], 4 * T_TOK, PLE, PLE, (bf16_t*)(ws + WS_PB), PLE, gt, NGT);
        rows_to_bf16_ss(a.in[0], XN, (float*)(ws + WS_ROWSS), bx, NGW);
        for (int it = gw; it < 4 * 8 * 64; it += NGW) { const int q = it >> 9, fc = (it >> 6) & 7, kc = it & 63, j = q >> 1;
            const float* pos = a.in[(q & 1) ? 18 : 15] + (size_t)j * 4096 + kc * 64; const float* w1 = a.in[(q & 1) ? 19 : 16] + (size_t)j * 4096 * 512 + (size_t)kc * 64 * 512 + fc * 64 + lane;
            float acc0 = 0.f, acc1 = 0.f, acc2 = 0.f, acc3 = 0.f;
#pragma unroll 4
            for (int k = 0; k < 64; k += 4) { acc0 += pos[k] * w1[(size_t)k * 512]; acc1 += pos[k + 1] * w1[(size_t)(k + 1) * 512]; acc2 += pos[k + 2] * w1[(size_t)(k + 2) * 512]; acc3 += pos[k + 3] * w1[(size_t)(k + 3) * 512]; }
            ((float*)(ws + WS_POSP))[((size_t)q * 64 + kc) * 512 + fc * 64 + lane] = (acc0 + acc1) + (acc2 + acc3); }
    }
    SEAM();
    if (EN(1) && ON()) {
        if (bx < 64) { const int j = bx >> 5, gI = (bx >> 3) & 3, pn = bx & 7;
            pg8::Gemm gm{(const bf16_t*)(ws + WS_POOLT + j * SZ_POOLT) + gI * 65536, (const bf16_t*)(ws + WS_WU + j * SZ_WU) + gI * 256, 256, 2048, 256, 256, 1024};
            pg8::StaticOrder S; S.init(256, 2048, G, pn);
            EpiBf16<0> E{(bf16_t*)(ws + WS_WIN + j * SZ_WIN) + (size_t)(2048 + gI * 256) * DM, DM, nullptr, nullptr};
            pg8::gemm_phase(lds, gm, S, E); }
        else { const int tid = opaque_tid(); const float* pp = (const float*)(ws + WS_POSP);
            for (int o = (bx - 64) * 512 + tid; o < 2048; o += (G - 64) * 512) { const int q = o >> 9, f = o & 511; float acc = 0.f;
                for (int kc = 0; kc < 64; ++kc) acc += pp[((size_t)q * 64 + kc) * 512 + f];
                posb[o] = acc; } }
    }
    SEAM();
#pragma unroll 1
    for (int layer = 0; layer < 4; ++layer) {
        const int j = layer >> 1; const bool even = (layer & 1) == 0;
        unsigned char* wsl = opqp(ws); unsigned char* Zl = wsl + WS_Z; bf16_t* XNl = (bf16_t*)(wsl + WS_XN); bf16_t* YBl = (bf16_t*)(wsl + WS_YB); float* posbl = (float*)(wsl + WS_POSB);
        const float* hin = (layer == 0) ? a.in[0] : a.out;
        float* RSS = (float*)(wsl + WS_ROWSS); float* PPl = (float*)(wsl + WS_PP);
        const bf16_t* Ain = (layer == 0) ? XNl : YBl;
        if (EN(3) && ON()) {
            if (even) { pg8::Gemm gm{Ain, (const bf16_t*)(wsl + WS_WIN + j * SZ_WIN), T_TOK, AB_IN, DM, DM, DM};
                pg8::StaticOrder S; S.init(T_TOK, AB_IN, opq(G), opq(bx)); EpiBf16<0> E{(bf16_t*)Zl, AB_IN, nullptr, RSS + (size_t)(layer * 3) * T_TOK * 32}; pg8::gemm_phase(lds, gm, S, E); }
            else { pg8::Gemm gm{Ain, (const bf16_t*)(wsl + WS_CIN + j * SZ_CIN), T_TOK, C_INP, DM, DM, DM};
                pg8::StaticOrder S; S.init(T_TOK, C_INP, opq(G), opq(bx));
                EpiNsa E{(bf16_t*)(Zl + Z_Q), (bf16_t*)(Zl + Z_KC), (bf16_t*)(Zl + Z_VC), (bf16_t*)(Zl + Z_KS), (bf16_t*)(Zl + Z_VST), (bf16_t*)(Zl + Z_KW), (bf16_t*)(Zl + Z_VWT), (float*)(Zl + Z_GL), RSS + (size_t)(layer * 3) * T_TOK * 32};
                pg8::gemm_phase(lds, gm, S, E); }
        }
        SEAM();
        if (even) {
            if (EN(4) && ON()) {
#ifndef NO_LRU
#pragma unroll 1
                for (int rp = 0; rp < REP_LRU; ++rp)
                for (int it = opq(bx); it < 256; it += G)
                    lru_item(lds, it, (const bf16_t*)Zl, a.in[4] + (size_t)j * 4096, a.in[5] + j * 1024, (const bf16_t*)(wsl + WS_WR + j * SZ_WRI), (const bf16_t*)(wsl + WS_WI + j * SZ_WRI),
                             a.in[7] + j * 1024, a.in[9] + j * 1024, a.in[10] + j * 1024, YBl);
#endif
                for (int it = opq(bx); it < 256; it += G) pool_item(it, (const bf16_t*)Zl, a.in[12] + j * 1024, YBl);
            }
            SEAM();
        } else {
            if (EN(5) && ON()) {
                if (bx < 64) { const int kv = bx >> 5;
                    pg8::Gemm gm{(const bf16_t*)(Zl + (kv ? Z_VC : Z_KC)), (const bf16_t*)(wsl + (kv ? WS_W1V : WS_W1K) + j * SZ_W1), 4096, 512, 4096, 2048, 4096};
                    pg8::StaticOrder S; S.init(4096, 512, opq(G), opq(bx) & 31);
                    EpiBf16<2> E{(bf16_t*)(Zl + (kv ? Z_HIDV : Z_HIDK)), 512, posbl + (j * 2 + kv) * 512, nullptr}; pg8::gemm_phase(lds, gm, S, E); }
                else if (bx < 128) { pg8::Gemm gm{Ain, (const bf16_t*)(wsl + WS_WGL + (size_t)j * 256 * DM * 2), T_TOK, 256, DM, DM, DM};
                    pg8::StaticOrder S; S.init(T_TOK, 256, opq(G), opq(bx) - 64); EpiGates E{(float*)(Zl + Z_GL), RSS + (size_t)(layer * 3) * T_TOK * 32}; pg8::gemm_phase(lds, gm, S, E); }
                else { pg8::Gemm gp{(const bf16_t*)(wsl + WS_PB) + (size_t)layer * T_TOK * PLE, (const bf16_t*)(wsl + WS_WP + layer * SZ_WP), T_TOK, DM, PLE, PLE, PLE};
                    pg8::StaticOrder S2; S2.init(T_TOK, DM, 128, opq(bx) - 128); EpiF32<2> E2{nullptr, PPl, nullptr, DM, nullptr, nullptr, nullptr}; pg8::gemm_phase(lds, gp, S2, E2); }
            }
            SEAM();
            if (EN(6) && ON()) {
                if (bx < 16) { pg8::Gemm gm{(const bf16_t*)(Zl + Z_HIDK), (const bf16_t*)(wsl + WS_W2K + j * SZ_W2), 4096, 256, 512, 512, 512};
                    pg8::StaticOrder S; S.init(4096, 256, opq(G), opq(bx)); EpiCmp2<0> E{(bf16_t*)(Zl + Z_KCMP)}; pg8::gemm_phase(lds, gm, S, E); }
                else if (bx < 32) { pg8::Gemm gm{(const bf16_t*)(Zl + Z_HIDV), (const bf16_t*)(wsl + WS_W2V + j * SZ_W2), 4096, 256, 512, 512, 512};
                    pg8::StaticOrder S; S.init(4096, 256, opq(G), opq(bx) - 16); EpiCmp2<1> E{(bf16_t*)(Zl + Z_VCMPT)}; pg8::gemm_phase(lds, gm, S, E); }
            }
            SEAM();
            if (EN(7) && ON()) {
#pragma unroll 1
                for (int rp = 0; rp < REP_ATTN; ++rp)
                for (int it = opq(bx), r = 0; it < 1024; it += G, ++r) { const int c = it % 256, rr = it / 256; const int cp = (rr & 1) ? 255 - c : c;
                    const int tq = 63 - (rr * 16 + (cp >> 4)), bgi = cp & 15;
#ifndef NO_ATTN
                    nsa_item(lds, bgi >> 2, bgi & 3, tq, (const bf16_t*)(Zl + Z_Q), (const bf16_t*)(Zl + Z_KS), (const bf16_t*)(Zl + Z_VST), (const bf16_t*)(Zl + Z_KW), (const bf16_t*)(Zl + Z_VWT),
                             (const bf16_t*)(Zl + Z_KCMP), (const bf16_t*)(Zl + Z_VCMPT), (const float*)(Zl + Z_GL), YBl);
#endif
                }
                __syncthreads();
            }
            SEAM();
        }
        if (EN(8) && ON()) { pg8::Gemm gm{YBl, (const bf16_t*)(wsl + (even ? WS_WOUT : WS_COUT) + j * SZ_SQ), T_TOK, DM, DM, DM, DM};
            pg8::StaticOrder S; S.init(T_TOK, DM, opq(G), opq(bx)); EpiF32<0> E{hin, a.out, nullptr, DM, XNl, RSS + (size_t)(layer * 3 + 1) * T_TOK * 32, nullptr}; pg8::gemm_phase(lds, gm, S, E);
            if (even) { pg8::Gemm gp{(const bf16_t*)(wsl + WS_PB) + (size_t)layer * T_TOK * PLE, (const bf16_t*)(wsl + WS_WP + layer * SZ_WP), T_TOK, DM, PLE, PLE, PLE};
              pg8::StaticOrder S2; S2.init(T_TOK, DM, opq(G), opq(bx)); EpiF32<2> E2{nullptr, PPl, nullptr, DM, nullptr, nullptr, nullptr}; pg8::gemm_phase(lds, gp, S2, E2); } }
        SEAM();
        if (EN(10) && ON())
#pragma unroll 1
        for (int rpu = 0; rpu < REP_UP; ++rpu) { pg8::Gemm gm{XNl, (const bf16_t*)(wsl + WS_WUP + layer * SZ_UP), T_TOK, DFF, DM, DM, DM};
            pg8::StaticOrder S; S.init(T_TOK, DFF, opq(G), opq(bx)); EpiBf16<1> E{(bf16_t*)Zl, DFF, nullptr, RSS + (size_t)(layer * 3 + 1) * T_TOK * 32}; pg8::gemm_phase(lds, gm, S, E); }
        SEAM();
        if (EN(11) && ON()) { pg8::Gemm gm{(const bf16_t*)Zl, (const bf16_t*)(wsl + WS_WDN + layer * SZ_UP), T_TOK, DM, DFF, DFF, DFF};
            pg8::StaticOrder S; S.init(T_TOK, DM, opq(G), opq(bx)); EpiF32<0> E{a.out, a.out, nullptr, DM, XNl, RSS + (size_t)(layer * 3 + 2) * T_TOK * 32, nullptr}; pg8::gemm_phase(lds, gm, S, E); }
        SEAM();
        if (EN(13) && ON()) { pg8::Gemm gm{XNl, (const bf16_t*)(wsl + WS_WG + layer * SZ_SQ), T_TOK, DM, DM, DM, DM};
            pg8::StaticOrder S; S.init(T_TOK, DM, opq(G), opq(bx)); EpiF32<1> E{a.out, a.out, PPl, DM, YBl, RSS + (size_t)(layer * 3 + 3) * T_TOK * 32, RSS + (size_t)(layer * 3 + 2) * T_TOK * 32}; pg8::gemm_phase(lds, gm, S, E); }
        SEAM();
    }
    if (EN(14) && ON()) rmsnorm_rows<true>(a.out, a.in[28], nullptr, a.out, bx, NGW);
#undef ON
#undef SEAM
}
constexpr int N_PHASES = 1 + 2 * 9 + 2 * 11 + 1;

extern "C" void kernel_launch(void* const* d_in, const int* in_sizes, int n_in, void* d_out, int out_size, void* d_ws, size_t ws_size, hipStream_t stream) {
    static int grid = 0;
    if (grid == 0) {
        if (n_in != 29 || ws_size < WS_END) { fprintf(stderr, "kernel_launch: unexpected n_in %d / ws %zu (need %zu)\n", n_in, ws_size, (size_t)WS_END); grid = -1; return; }
        int dev = 0, cus = 0, per_cu = 0;
        hipGetDevice(&dev); hipDeviceGetAttribute(&cus, hipDeviceAttributeMultiprocessorCount, dev);
        if (hipFuncSetAttribute((const void*)fwd_kernel, hipFuncAttributeMaxDynamicSharedMemorySize, LDS_BYTES) != hipSuccess) { fprintf(stderr, "hipFuncSetAttribute failed\n"); grid = -1; return; }
        if (hipOccupancyMaxActiveBlocksPerMultiprocessor(&per_cu, (const void*)fwd_kernel, 512, LDS_BYTES) != hipSuccess || per_cu < 1) { fprintf(stderr, "occupancy query: %d\n", per_cu); per_cu = 1; }
        (void)hipGetLastError();
        grid = cus;
    }
    if (grid < 0) return;
    Args a{};
    for (int i = 0; i < 29; ++i) a.in[i] = (const float*)d_in[i];
    a.out = (float*)d_out; a.ws = (unsigned char*)d_ws;
#if MK_ONE_LAUNCH
    (void)hipMemsetAsync((unsigned char*)d_ws + WS_BAR, 0, XCD_BAR_WORDS * 4, stream);
    a.lo = 0; a.hi = 1 << 30; a.one = 1; a.pad = 0;
    void* args[] = {&a};
    hipError_t e = hipLaunchCooperativeKernel((const void*)fwd_kernel, dim3(grid), dim3(512), args, LDS_BYTES, stream);
    if (e != hipSuccess) fprintf(stderr, "cooperative launch failed: %s (grid %d)\n", hipGetErrorString(e), grid);
#else
    for (int p = 0; p < N_PHASES; ++p) { a.lo = p; a.hi = p + 1; a.one = 0; a.pad = 0;
        hipLaunchKernelGGL(fwd_kernel, dim3(grid), dim3(512), LDS_BYTES, stream, a); }
#endif
}
```

```cpp
#include <hip/hip_runtime.h>
#include <hip/hip_cooperative_groups.h>
#include <cstdio>
namespace cg = cooperative_groups;

#ifndef REP_ATTN
#define REP_ATTN 1
#endif
#ifndef REP_LRU
#define REP_LRU 1
#endif
#ifndef REP_P0
#define REP_P0 1
#endif
#ifndef REP_UP
#define REP_UP 1
#endif
#ifndef MK_ONE_LAUNCH
#define MK_ONE_LAUNCH 1
#endif

#define LAS __attribute__((address_space(3)))
typedef unsigned short bf16_t;
typedef short bf16x8 __attribute__((ext_vector_type(8)));
typedef float f32x4 __attribute__((ext_vector_type(4)));
typedef float f32x2 __attribute__((ext_vector_type(2)));
typedef unsigned u32x4 __attribute__((ext_vector_type(4)));
typedef unsigned u32x2 __attribute__((ext_vector_type(2)));

constexpr int T_TOK = 16384, DM = 2048, SEQ = 4096, NB = 4, DFF = 8192, PLE = 256;
constexpr int AB_IN = 3072, C_IN = 5168, C_INP = 5120;
constexpr float EPSV = 1e-6f;
constexpr float LOG2E = 1.4426950408889634f;

__device__ __forceinline__ unsigned f2bf(float f) { unsigned u = __builtin_bit_cast(unsigned, f); return (u + 0x7fffu + ((u >> 16) & 1u)) >> 16; }
__device__ __forceinline__ unsigned pk2(float lo, float hi) { unsigned r; asm volatile("v_cvt_pk_bf16_f32 %0, %1, %2" : "=v"(r) : "v"(lo), "v"(hi)); return r; }
__device__ __forceinline__ float bf2f(unsigned short b) { return __builtin_bit_cast(float, ((unsigned)b) << 16); }
__device__ __forceinline__ float bflo(unsigned w) { return __builtin_bit_cast(float, w << 16); }
__device__ __forceinline__ float bfhi(unsigned w) { return __builtin_bit_cast(float, w & 0xffff0000u); }
__device__ __forceinline__ float shx(float v, int lane, int o) { return __builtin_bit_cast(float, __builtin_amdgcn_ds_bpermute((lane ^ o) << 2, __builtin_bit_cast(int, v))); }
__device__ __forceinline__ float wave_sum(float v, int lane) {
#pragma unroll
    for (int o = 1; o < 64; o <<= 1) v += shx(v, lane, o);
    return v;
}
__device__ __forceinline__ float sigmoidf_(float x) { return 1.0f / (1.0f + __expf(-x)); }
__device__ __forceinline__ float gelu_tanh(float x) {
    const float u = 0.7978845608028654f * (x + 0.044715f * x * x * x);
    const float e = __expf(2.0f * u);
    const float th = 1.0f - 2.0f / (e + 1.0f);
    return 0.5f * x * (1.0f + th);
}

__device__ __forceinline__ unsigned char* opqp(unsigned char* p) { size_t z = 0; asm volatile("" : "+s"(z)); return p + z; }
__device__ __forceinline__ int opq(int v) { asm volatile("" : "+s"(v)); return v; }
__device__ __forceinline__ int opaque_tid() { int t = threadIdx.x; asm volatile("" : "+v"(t)); return t; }
namespace pg8 {
constexpr int BM = 256, BK = 64, HALF = 128, HTB = HALF * BK * 2, STAGE_BYTES = 8 * HTB, NXCD = 8, WGM = 8;
__host__ __device__ __forceinline__ int lds_byte(int r, int c) { const int st = (r >> 4) * 2 + (c >> 5), rr = r & 15, cc = c & 31, ob = rr * 64 + cc * 2; return st * 1024 + (ob ^ (((ob >> 9) & 1) << 5)); }
__host__ __device__ __forceinline__ void stage_rc(int b, int& R, int& C) { const int st = b / 1024, sb = b % 1024, swz = sb ^ (((sb >> 9) & 1) << 5); R = (st >> 1) * 16 + swz / 64; C = (st & 1) * 32 + (swz % 64) / 2; }
__host__ __device__ __forceinline__ int perm32(int rho) { const int n = rho >> 4, i = rho & 15; return 8 * (i >> 2) + 4 * n + (i & 3); }

struct Unit { int pm, pn; };
struct Gemm { const bf16_t* A; const bf16_t* Bt; int M, N, K, lda, ldb; };

struct StaticOrder {
    int nM, nN, nwg, G, c;
    __device__ void init(int M, int N, int G_, int c_) { nM = M / BM; nN = N / BM; nwg = nM * nN; G = G_; c = c_; }
    __device__ bool next(int i, Unit& u) const {
        const long L = (long)i * G + c; if (L >= nwg || c < 0) return false;
        int wgid = (int)L; { const int q = nwg / NXCD, r = nwg % NXCD, xcd = wgid % NXCD, off = wgid / NXCD; wgid = (xcd < r ? xcd * (q + 1) : r * (q + 1) + (xcd - r) * q) + off; }
        const int nig = WGM * nN, gid = wgid / nig, fm = gid * WGM, gsz = (nM - fm) < WGM ? (nM - fm) : WGM;
        u.pm = fm + ((wgid % nig) % gsz); u.pn = (wgid % nig) / gsz; return true;
    }
};

template <class Epi, class Sched>
__device__ __forceinline__ void gemm_phase(LAS unsigned char* lds, const Gemm g, const Sched& S, const Epi& E) {
    const int tid = opaque_tid(), wid = __builtin_amdgcn_readfirstlane(tid >> 6), lane = tid & 63, wr = wid >> 2, wc = wid & 3, fr = lane & 15, fq = lane >> 4;
    const int K = g.K, nt = K / BK;
    unsigned voffA[2], voffB[2];
#pragma unroll
    for (int i = 0; i < 2; ++i) { int R, C; stage_rc(tid * 16 + i * 8192, R, C); const int Rb = Epi::PERM ? ((R & ~31) + perm32(R & 31)) : R;
        voffA[i] = (unsigned)(R * g.lda + C) * 2u; voffB[i] = (unsigned)(Rb * g.ldb + C) * 2u; }
    const size_t kstep = (size_t)(BK * 2);
    const size_t hstepA = (size_t)HALF * g.lda * 2, hstepB = (size_t)HALF * g.ldb * 2;
    const size_t tstepA = 2 * hstepA, tstepB = 2 * hstepB;
    const unsigned ldsw = (unsigned)wid * 1024u;
    const int aoff = lds_byte(wr * 64 + fr, fq * 8), boff = lds_byte(wc * 32 + fr, fq * 8);
#define PG8_SA(b, h) (((b) * 2 + (h)) * HTB)
#define PG8_SB(b, h) ((4 + (b) * 2 + (h)) * HTB)
#define PG8_STAGE(bufoff, gbase, voff) do { _Pragma("unroll") for (int _i = 0; _i < 2; ++_i) \
        __builtin_amdgcn_global_load_lds((const unsigned*)((const char*)(gbase) + (voff)[_i]), (LAS unsigned*)(lds + (bufoff) + ldsw + _i * 8192), 16, 0, 0); } while (0)
#define PG8_LDA(dst, b, h) do { _Pragma("unroll") for (int m = 0; m < 4; ++m) _Pragma("unroll") for (int k = 0; k < 2; ++k) dst[m][k] = *(const LAS bf16x8*)(lds + PG8_SA(b, h) + aoff + m * 2048 + k * 1024); } while (0)
#define PG8_LDB(dst, b, h) do { _Pragma("unroll") for (int n = 0; n < 2; ++n) _Pragma("unroll") for (int k = 0; k < 2; ++k) dst[n][k] = *(const LAS bf16x8*)(lds + PG8_SB(b, h) + boff + n * 2048 + k * 1024); } while (0)
#define PG8_MMA(ai, bj, At, Bt) do { __builtin_amdgcn_s_setprio(1); _Pragma("unroll") for (int m = 0; m < 4; ++m) _Pragma("unroll") for (int n = 0; n < 2; ++n) _Pragma("unroll") for (int k = 0; k < 2; ++k) \
        acc[ai][bj][m][n] = __builtin_amdgcn_mfma_f32_16x16x32_bf16(Bt[n][k], At[m][k], acc[ai][bj][m][n], 0, 0, 0); __builtin_amdgcn_s_setprio(0); } while (0)
#define PG8_WAIT_V(n) asm volatile("s_waitcnt vmcnt(" #n ")" ::: "memory")
#define PG8_WAIT_L(n) asm volatile("s_waitcnt lgkmcnt(" #n ")" ::: "memory")
#define PG8_BAR __builtin_amdgcn_s_barrier()
#define PG8_SCHED __builtin_amdgcn_sched_barrier(0)
    Unit cur, nxt; int ui = 0;
    if (!S.next(0, cur)) return;
    f32x4 acc[2][2][4][2];
#pragma unroll
    for (int a = 0; a < 2; ++a)
#pragma unroll
        for (int b = 0; b < 2; ++b)
#pragma unroll
            for (int m = 0; m < 4; ++m)
#pragma unroll
                for (int n = 0; n < 2; ++n) acc[a][b][m][n] = (f32x4){0.f, 0.f, 0.f, 0.f};
    bf16x8 At[4][2], B0[2][2], B1[2][2];
    const char* cA = (const char*)g.A + (size_t)cur.pm * tstepA; const char* cB = (const char*)g.Bt + (size_t)cur.pn * tstepB;
    PG8_STAGE(PG8_SB(0, 0), cB, voffB); PG8_STAGE(PG8_SB(0, 1), cB + hstepB, voffB); PG8_STAGE(PG8_SA(0, 0), cA, voffA); PG8_STAGE(PG8_SA(0, 1), cA + hstepA, voffA);
    if (wr == 1) PG8_BAR;
    PG8_WAIT_V(2); PG8_BAR;
    PG8_STAGE(PG8_SB(1, 0), cB + kstep, voffB); PG8_STAGE(PG8_SA(1, 0), cA + kstep, voffA); PG8_STAGE(PG8_SB(1, 1), cB + hstepB + kstep, voffB);
    PG8_WAIT_V(6); PG8_BAR;
    for (;;) {
        const bool has_next = S.next(ui + 1, nxt);
        const char* nA = has_next ? (const char*)g.A + (size_t)nxt.pm * tstepA : cA; const char* nB = has_next ? (const char*)g.Bt + (size_t)nxt.pn * tstepB : cB;
        for (int t = 0; t < nt; t += 2) {
            const bool last = (t == nt - 2);
            const char* a1 = cA + (size_t)(t + 1) * kstep;
            const char* a2 = last ? nA : cA + (size_t)(t + 2) * kstep; const char* b2 = last ? nB : cB + (size_t)(t + 2) * kstep;
            const char* a3 = a2 + kstep; const char* b3 = b2 + kstep;
            PG8_LDB(B0, 0, 0); PG8_LDB(B1, 0, 1); PG8_SCHED; PG8_LDA(At, 0, 0); PG8_STAGE(PG8_SA(1, 1), a1 + hstepA, voffA);
            PG8_WAIT_V(8); PG8_WAIT_L(0); PG8_BAR; PG8_MMA(0, 0, At, B0); PG8_MMA(0, 1, At, B1); PG8_BAR; PG8_SCHED;
            PG8_LDA(At, 0, 1); PG8_STAGE(PG8_SB(0, 0), b2, voffB); PG8_STAGE(PG8_SB(0, 1), b2 + hstepB, voffB); PG8_STAGE(PG8_SA(0, 0), a2, voffA);
            PG8_WAIT_V(8); PG8_WAIT_L(0); PG8_BAR; PG8_MMA(1, 0, At, B0); PG8_MMA(1, 1, At, B1); PG8_BAR; PG8_SCHED;
            PG8_LDB(B0, 1, 0); PG8_LDB(B1, 1, 1); PG8_SCHED; PG8_LDA(At, 1, 0); PG8_STAGE(PG8_SA(0, 1), a2 + hstepA, voffA);
            PG8_WAIT_V(8); PG8_WAIT_L(0); PG8_BAR; PG8_MMA(0, 0, At, B0); PG8_MMA(0, 1, At, B1); PG8_BAR; PG8_SCHED;
            PG8_LDA(At, 1, 1); PG8_STAGE(PG8_SB(1, 0), b3, voffB); PG8_STAGE(PG8_SB(1, 1), b3 + hstepB, voffB); PG8_STAGE(PG8_SA(1, 0), a3, voffA);
            PG8_WAIT_V(8); PG8_WAIT_L(0); PG8_BAR; PG8_MMA(1, 0, At, B0); PG8_MMA(1, 1, At, B1); PG8_BAR; PG8_SCHED;
        }
        if (wr == 0) PG8_BAR;
        { const int tl = opaque_tid() & 63; E(acc, cur, wr, wc, tl & 15, tl >> 4); }
        if (!has_next) break;
#pragma unroll
        for (int a = 0; a < 2; ++a)
#pragma unroll
            for (int b = 0; b < 2; ++b)
#pragma unroll
                for (int m = 0; m < 4; ++m)
#pragma unroll
                    for (int n = 0; n < 2; ++n) acc[a][b][m][n] = (f32x4){0.f, 0.f, 0.f, 0.f};
        cur = nxt; cA = nA; cB = nB; ++ui;
        if (wr == 1) PG8_BAR;
    }
    PG8_WAIT_V(0);
    PG8_BAR;
#undef PG8_SA
#undef PG8_SB
#undef PG8_STAGE
#undef PG8_LDA
#undef PG8_LDB
#undef PG8_MMA
#undef PG8_WAIT_V
#undef PG8_WAIT_L
#undef PG8_BAR
#undef PG8_SCHED
}
}
using pg8::Unit; using pg8::HALF; using pg8::BM;


#define XB_TMO      128
#define XB_XCNT(j)  (256  + 64 * (j))
#define XB_XSUB(j)  (1280 + 64 * (j))
#define XB_XGEN(j)  (2304 + 64 * (j))
#define XB_TOP      3328
#define XB_TOPGEN   3392
#define XCD_BAR_WORDS 3456
#define XB_SPIN_CAP (1u << 18)
__device__ __forceinline__ unsigned xb_ld(unsigned* p)              { return __hip_atomic_load(p, __ATOMIC_RELAXED, __HIP_MEMORY_SCOPE_AGENT); }
__device__ __forceinline__ unsigned xb_add(unsigned* p, unsigned v) { return __hip_atomic_fetch_add(p, v, __ATOMIC_RELAXED, __HIP_MEMORY_SCOPE_AGENT); }
__device__ __forceinline__ unsigned xb_xcc_id() { return (unsigned)__builtin_amdgcn_s_getreg((3 << 11) | 20) & 0xFu; }
#define XB_SPIN(cond, bar) do { unsigned _sp = 0; while (cond) { __builtin_amdgcn_s_sleep(1); \
    if ((++_sp & 255u) == 0u) { if (xb_ld(&(bar)[XB_TMO])) break; if (_sp > XB_SPIN_CAP) { atomicAdd(&(bar)[XB_TMO], 1u); break; } } } } while (0)
struct XcdBarrier { unsigned* bar; unsigned x; volatile LAS unsigned* st; };
__device__ __forceinline__ XcdBarrier xcd_barrier_post(unsigned* bar, volatile LAS unsigned* st) {
    XcdBarrier b; b.bar = bar; b.x = xb_xcc_id(); b.st = st;
    if (threadIdx.x == 0) (void)xb_add(&bar[XB_XCNT(b.x)], 1u);
    return b;
}
__device__ __forceinline__ void xcd_barrier_complete(unsigned* bar, unsigned x, unsigned& nloc, unsigned& nx) {
    const unsigned G = gridDim.x * gridDim.y * gridDim.z;
    unsigned sum, cnt, mine, sp = 0u;
    for (;;) {
        sum = 0u; cnt = 0u; mine = 0u;
#pragma unroll
        for (unsigned j = 0; j < 16; ++j) { const unsigned c = xb_ld(&bar[XB_XCNT(j)]); sum += c; cnt += (c > 0u) ? 1u : 0u; mine = (j == x) ? c : mine; }
        if (sum == G) break;
        __builtin_amdgcn_s_sleep(1);
        if ((++sp & 255u) == 0u) { if (xb_ld(&bar[XB_TMO])) break; if (sp > XB_SPIN_CAP) { atomicAdd(&bar[XB_TMO], 1u); break; } }
    }
    nloc = mine > 0u ? mine : 1u; nx = cnt > 0u ? cnt : 1u;
}
__device__ __forceinline__ void xcd_barrier(const XcdBarrier& b) {
    asm volatile("s_waitcnt vmcnt(0)" ::: "memory");
    __syncthreads();
    if (threadIdx.x == 0) {
        unsigned* bar = b.bar;
        __builtin_amdgcn_s_waitcnt(0);
        unsigned nloc = b.st[0], nx = b.st[1];
        if (nloc == 0u) { xcd_barrier_complete(bar, b.x, nloc, nx); b.st[0] = nloc; b.st[1] = nx; }
        const unsigned old = xb_add(&bar[XB_XSUB(b.x)], 1u);
        const unsigned gen = old / nloc;
        if (old + 1u == (gen + 1u) * nloc) {
            __builtin_amdgcn_fence(__ATOMIC_RELEASE, "agent");
            asm volatile("s_waitcnt vmcnt(0)" ::: "memory");
            const unsigned og = xb_add(&bar[XB_TOP], 1u);
            const unsigned tg = og / nx;
            if (og + 1u == (tg + 1u) * nx) xb_add(&bar[XB_TOPGEN], 1u);
            else XB_SPIN(xb_ld(&bar[XB_TOPGEN]) == tg, bar);
            __builtin_amdgcn_fence(__ATOMIC_ACQUIRE, "agent");
            xb_add(&bar[XB_XGEN(b.x)], 1u);
            asm volatile("s_waitcnt vmcnt(0)" ::: "memory");
        } else {
            XB_SPIN(xb_ld(&bar[XB_XGEN(b.x)]) == gen, bar);
            __builtin_amdgcn_fence(__ATOMIC_ACQUIRE, "agent");
            asm volatile("s_waitcnt vmcnt(0)" ::: "memory");
        }
    }
    __syncthreads();
}

__device__ __forceinline__ float row_rstd(const float* rp, int row, int fq, int lane) {
    const f32x4 a = *(const f32x4*)(rp + (size_t)row * 32 + fq * 8), b = *(const f32x4*)(rp + (size_t)row * 32 + fq * 8 + 4);
    float s = ((a[0] + a[1]) + (a[2] + a[3])) + ((b[0] + b[1]) + (b[2] + b[3]));
    s += shx(s, lane, 16); s += shx(s, lane, 32);
    return rsqrtf(s * (1.f / DM) + EPSV);
}
template <int ACT  > struct EpiBf16 {
    static constexpr bool PERM = true;
    bf16_t* O; int ldc; const float* bias; const float* rss;
    __device__ __forceinline__ void operator()(const f32x4 (&acc)[2][2][4][2], const Unit& u, int wr, int wc, int fr, int fq) const {
        const int row0 = u.pm * BM + wr * 64 + fr, col0 = u.pn * BM + wc * 32 + 8 * fq;
        f32x4 bv[2][2];
#pragma unroll
        for (int bj = 0; bj < 2; ++bj)
#pragma unroll
            for (int n = 0; n < 2; ++n) bv[bj][n] = (ACT == 2) ? *(const f32x4*)(bias + col0 + bj * HALF + 4 * n) : (f32x4){0.f, 0.f, 0.f, 0.f};
        float rsv[2][4];
#pragma unroll
        for (int ai = 0; ai < 2; ++ai)
#pragma unroll
            for (int m = 0; m < 4; ++m) rsv[ai][m] = rss ? row_rstd(rss, row0 + ai * HALF + m * 16, fq, fq * 16 + fr) : 1.f;
        asm volatile("" ::: "memory");
#pragma unroll
        for (int ai = 0; ai < 2; ++ai)
#pragma unroll
            for (int m = 0; m < 4; ++m) { bf16_t* rowp = O + (size_t)(row0 + ai * HALF + m * 16) * ldc + col0;
                const float rs = rsv[ai][m];
#pragma unroll
                for (int bj = 0; bj < 2; ++bj) { f32x4 v0 = acc[ai][bj][m][0] * rs + bv[bj][0], v1 = acc[ai][bj][m][1] * rs + bv[bj][1];
                    if (ACT == 1) {
#pragma unroll
                        for (int j = 0; j < 4; ++j) { const float a = fmaxf(v0[j], 0.f), b = fmaxf(v1[j], 0.f); v0[j] = a * a; v1[j] = b * b; } }
                    if (ACT == 2) {
#pragma unroll
                        for (int j = 0; j < 4; ++j) { v0[j] = gelu_tanh(v0[j]); v1[j] = gelu_tanh(v1[j]); } }
                    u32x4 w; w.x = pk2(v0[0], v0[1]); w.y = pk2(v0[2], v0[3]); w.z = pk2(v1[0], v1[1]); w.w = pk2(v1[2], v1[3]);
                    *(u32x4*)(rowp + bj * HALF) = w; } }
    }
};
template <int MODE> struct EpiRes {
    static constexpr bool PERM = true;
    const bf16_t* base; bf16_t* out; const bf16_t* pp; int ldc; float* rss_out; const float* rss_in;
    __device__ __forceinline__ void operator()(const f32x4 (&acc)[2][2][4][2], const Unit& u, int wr, int wc, int fr, int fq) const {
        const int row0 = u.pm * BM + wr * 64 + fr, col0 = u.pn * BM + wc * 32 + 8 * fq; const int lane = fq * 16 + fr;
        float rinv[8];
#pragma unroll
        for (int g = 0; g < 8; ++g) rinv[g] = (MODE == 1) ? row_rstd(rss_in, row0 + (g >> 2) * HALF + (g & 3) * 16, fq, lane) : 1.f;
        u32x4 bc[2], pc[2];
#pragma unroll
        for (int bj = 0; bj < 2; ++bj) { const size_t o2 = (size_t)row0 * ldc + col0 + bj * HALF; bc[bj] = *(const u32x4*)(base + o2); if (MODE == 1) pc[bj] = *(const u32x4*)(pp + o2); }
#pragma unroll
        for (int g = 0; g < 8; ++g) { const int ai = g >> 2, m = g & 3; const int row = row0 + ai * HALF + m * 16; const size_t off = (size_t)row * ldc + col0;
            f32x4 av[2][2];
#pragma unroll
            for (int bj = 0; bj < 2; ++bj) { f32x4 a0 = acc[ai][bj][m][0], a1 = acc[ai][bj][m][1];
                const f32x4 b0 = (f32x4){bflo(bc[bj].x), bfhi(bc[bj].x), bflo(bc[bj].y), bfhi(bc[bj].y)}, b1 = (f32x4){bflo(bc[bj].z), bfhi(bc[bj].z), bflo(bc[bj].w), bfhi(bc[bj].w)};
                if (MODE == 0) { a0 = a0 + b0; a1 = a1 + b1; }
                if (MODE == 1) { const f32x4 p0 = (f32x4){bflo(pc[bj].x), bfhi(pc[bj].x), bflo(pc[bj].y), bfhi(pc[bj].y)}, p1 = (f32x4){bflo(pc[bj].z), bfhi(pc[bj].z), bflo(pc[bj].w), bfhi(pc[bj].w)};
#pragma unroll
                    for (int j = 0; j < 4; ++j) { a0[j] = b0[j] + sigmoidf_(a0[j] * rinv[g]) * p0[j]; a1[j] = b1[j] + sigmoidf_(a1[j] * rinv[g]) * p1[j]; } }
                av[bj][0] = a0; av[bj][1] = a1; }
            asm volatile("" : "+v"(av[0][0]), "+v"(av[0][1]), "+v"(av[1][0]), "+v"(av[1][1]));
            if (g < 7) { const int rown = row0 + ((g + 1) >> 2) * HALF + ((g + 1) & 3) * 16;
#pragma unroll
                for (int bj = 0; bj < 2; ++bj) { const size_t o2 = (size_t)rown * ldc + col0 + bj * HALF; bc[bj] = *(const u32x4*)(base + o2); if (MODE == 1) pc[bj] = *(const u32x4*)(pp + o2); } }
            asm volatile("" ::: "memory");
            float ss = 0.f;
#pragma unroll
            for (int bj = 0; bj < 2; ++bj) { const f32x4 a0 = av[bj][0], a1 = av[bj][1];
                ss += ((a0[0] * a0[0] + a0[1] * a0[1]) + (a0[2] * a0[2] + a0[3] * a0[3])) + ((a1[0] * a1[0] + a1[1] * a1[1]) + (a1[2] * a1[2] + a1[3] * a1[3]));
                u32x4 w; w.x = pk2(a0[0], a0[1]); w.y = pk2(a0[2], a0[3]); w.z = pk2(a1[0], a1[1]); w.w = pk2(a1[2], a1[3]); *(u32x4*)(out + off + bj * HALF) = w; }
            ss += shx(ss, lane, 16); ss += shx(ss, lane, 32); if (fq == 0) rss_out[(size_t)row * 32 + u.pn * 4 + wc] = ss;
        }
    }
};
struct EpiNsa {
    static constexpr bool PERM = true;
    bf16_t *Q, *KC, *VC, *KS, *VST, *KW, *VWT; float* GL; const float* rss;
    __device__ __forceinline__ void operator()(const f32x4 (&acc)[2][2][4][2], const Unit& u, int wr, int wc, int fr, int fq) const {
        const int row0 = u.pm * BM + wr * 64 + fr; const int pn = u.pn;
        float rsv[2][4];
#pragma unroll
        for (int ai = 0; ai < 2; ++ai)
#pragma unroll
            for (int m = 0; m < 4; ++m) rsv[ai][m] = row_rstd(rss, row0 + ai * HALF + m * 16, fq, fq * 16 + fr);
        asm volatile("" ::: "memory");
#pragma unroll
        for (int ai = 0; ai < 2; ++ai)
#pragma unroll
            for (int m = 0; m < 4; ++m) { const int row = row0 + ai * HALF + m * 16; const int b = row >> 12, s = row & 4095;
                const float rs = rsv[ai][m];
#pragma unroll
                for (int bj = 0; bj < 2; ++bj) { const f32x4 v0 = acc[ai][bj][m][0] * rs, v1 = acc[ai][bj][m][1] * rs;
                    const int cl = bj * HALF + wc * 32 + 8 * fq;
                    if (pn < 8) { u32x4 w; w.x = pk2(v0[0], v0[1]); w.y = pk2(v0[2], v0[3]); w.z = pk2(v1[0], v1[1]); w.w = pk2(v1[2], v1[3]);
                        *(u32x4*)(Q + (size_t)row * 2048 + pn * 256 + cl) = w; }
                    else { const int k = (pn - 8) >> 1; const int c = ((pn - 8) & 1) * 256 + cl; const int g = c >> 7, d = c & 127;
                        if (k == 3 || k == 5) { bf16_t* dst = (k == 3 ? VST : VWT) + ((size_t)((b * 4 + g) * 128 + d)) * 4096 + s;
#pragma unroll
                            for (int j = 0; j < 4; ++j) { dst[(size_t)j * 4096] = (bf16_t)f2bf(v0[j]); dst[(size_t)(4 + j) * 4096] = (bf16_t)f2bf(v1[j]); } }
                        else { bf16_t* dst = (k == 0 ? KC : k == 1 ? VC : k == 2 ? KS : KW) + ((size_t)((b * 4 + g) * 4096 + s)) * 128 + d;
                            u32x4 w; w.x = pk2(v0[0], v0[1]); w.y = pk2(v0[2], v0[3]); w.z = pk2(v1[0], v1[1]); w.w = pk2(v1[2], v1[3]);
                            *(u32x4*)dst = w; } }
 } }
    }
};
struct EpiGates {
    static constexpr bool PERM = true;
    float* GL; const float* rss;
    __device__ __forceinline__ void operator()(const f32x4 (&acc)[2][2][4][2], const Unit& u, int wr, int wc, int fr, int fq) const {
        const int row0 = u.pm * BM + wr * 64 + fr; const int cl = wc * 32 + 8 * fq;
        float rsv[2][4];
#pragma unroll
        for (int ai = 0; ai < 2; ++ai)
#pragma unroll
            for (int m = 0; m < 4; ++m) rsv[ai][m] = row_rstd(rss, row0 + ai * HALF + m * 16, fq, fq * 16 + fr);
        if (cl < 48) {
#pragma unroll
            for (int ai = 0; ai < 2; ++ai)
#pragma unroll
                for (int m = 0; m < 4; ++m) { const int row = row0 + ai * HALF + m * 16; const float rs = rsv[ai][m];
                    const f32x4 v0 = acc[ai][0][m][0] * rs, v1 = acc[ai][0][m][1] * rs; f32x4 a, c2;
#pragma unroll
                    for (int j = 0; j < 4; ++j) { a[j] = sigmoidf_(v0[j]); c2[j] = sigmoidf_(v1[j]); }
                    float* dst = GL + (size_t)row * 48 + cl; *(f32x4*)dst = a; *(f32x4*)(dst + 4) = c2; } }
    }
};
template <int TR> struct EpiCmp2 {
    static constexpr bool PERM = true;
    bf16_t* O;
    __device__ __forceinline__ void operator()(const f32x4 (&acc)[2][2][4][2], const Unit& u, int wr, int wc, int fr, int fq) const {
        const int row0 = u.pm * BM + wr * 64 + fr; const int cl = wc * 32 + 8 * fq;
#pragma unroll
        for (int ai = 0; ai < 2; ++ai)
#pragma unroll
            for (int m = 0; m < 4; ++m) { const int row = row0 + ai * HALF + m * 16; const f32x4 v0 = acc[ai][0][m][0], v1 = acc[ai][0][m][1];
                if (TR == 0) { u32x4 w; w.x = pk2(v0[0], v0[1]); w.y = pk2(v0[2], v0[3]); w.z = pk2(v1[0], v1[1]); w.w = pk2(v1[2], v1[3]);
                    *(u32x4*)(O + (size_t)row * 128 + cl) = w; }
                else { bf16_t* dst = O + ((size_t)((row >> 8) * 128 + cl)) * 256 + (row & 255);
#pragma unroll
                    for (int j = 0; j < 4; ++j) { dst[(size_t)j * 256] = (bf16_t)f2bf(v0[j]); dst[(size_t)(4 + j) * 256] = (bf16_t)f2bf(v1[j]); } } }
    }
};

constexpr size_t al256(size_t x) { return (x + 255) & ~(size_t)255; }
constexpr size_t SZ_WIN = (size_t)AB_IN * DM * 2, SZ_SQ = (size_t)DM * DM * 2, SZ_CIN = (size_t)C_INP * DM * 2, SZ_W1 = (size_t)512 * 4096 * 2, SZ_W2 = (size_t)256 * 512 * 2;
constexpr size_t SZ_UP = (size_t)DFF * DM * 2, SZ_WP = (size_t)DM * PLE * 2, SZ_WRI = (size_t)16 * 64 * 64 * 2, SZ_POOLT = (size_t)4 * 256 * 256 * 2, SZ_WU = (size_t)DM * 1024 * 2;
constexpr size_t WS_WIN = 0;
constexpr size_t WS_WOUT = WS_WIN + 2 * SZ_WIN;
constexpr size_t WS_CIN = WS_WOUT + 2 * SZ_SQ;
constexpr size_t WS_COUT = WS_CIN + 2 * SZ_CIN;
constexpr size_t WS_W1K = WS_COUT + 2 * SZ_SQ;
constexpr size_t WS_W1V = WS_W1K + 2 * SZ_W1;
constexpr size_t WS_W2K = WS_W1V + 2 * SZ_W1;
constexpr size_t WS_W2V = WS_W2K + 2 * SZ_W2;
constexpr size_t WS_WUP = WS_W2V + 2 * SZ_W2;
constexpr size_t WS_WDN = WS_WUP + 4 * SZ_UP;
constexpr size_t WS_WG = WS_WDN + 4 * SZ_UP;
constexpr size_t WS_WP = WS_WG + 4 * SZ_SQ;
constexpr size_t WS_WR = WS_WP + 4 * SZ_WP;
constexpr size_t WS_WI = WS_WR + 2 * SZ_WRI;
constexpr size_t WS_POOLT = WS_WI + 2 * SZ_WRI;
constexpr size_t WS_WU = WS_POOLT + 2 * SZ_POOLT;
constexpr size_t WS_PB = WS_WU + 2 * SZ_WU;
constexpr size_t WS_POSB = WS_PB + (size_t)4 * T_TOK * PLE * 2;
constexpr size_t WS_XN = WS_POSB + 8192;
constexpr size_t WS_YB = WS_XN + (size_t)T_TOK * DM * 2;
constexpr size_t WS_Z = WS_YB + (size_t)T_TOK * DM * 2;
constexpr size_t SZ_KV = (size_t)16 * 4096 * 128 * 2;
constexpr size_t Z_Q = 0, Z_KC = (size_t)T_TOK * DM * 2, Z_VC = Z_KC + SZ_KV, Z_KS = Z_VC + SZ_KV, Z_VST = Z_KS + SZ_KV, Z_KW = Z_VST + SZ_KV, Z_VWT = Z_KW + SZ_KV;
constexpr size_t Z_GL = Z_VWT + SZ_KV, Z_HIDK = Z_GL + (size_t)T_TOK * 48 * 4, Z_HIDV = Z_HIDK + (size_t)4096 * 512 * 2, Z_KCMP = Z_HIDV + (size_t)4096 * 512 * 2, Z_VCMPT = Z_KCMP + (size_t)4096 * 128 * 2;
constexpr size_t WS_BAR = WS_Z + (size_t)T_TOK * DFF * 2;
constexpr size_t WS_ROWSS = WS_BAR + XCD_BAR_WORDS * 4 + 256;
constexpr size_t WS_PP = WS_ROWSS + (size_t)13 * T_TOK * 32 * 4;
constexpr size_t WS_POSP = WS_PP + (size_t)T_TOK * DM * 2;
constexpr size_t WS_WGL = WS_POSP + (size_t)4 * 64 * 512 * 4;
constexpr size_t WS_H2 = WS_WGL + (size_t)2 * 256 * DM * 2;
constexpr size_t WS_END = WS_H2 + (size_t)T_TOK * DM * 2;
static_assert(Z_VCMPT + 4096 * 128 * 2 <= (size_t)T_TOK * DFF * 2, "z region");
static_assert(WS_END <= (size_t)1 << 30, "workspace");
constexpr int LDS_BYTES = 147456;

struct Args { const float* in[29]; float* out; unsigned char* ws; int lo, hi, one, pad; };

__device__ __forceinline__ void titem_load(float (&v)[64], const float* W, int N, int ldw, int item, int lane) {
    const int nblk = (N + 63) / 64, kb = item / nblk, nb = item % nblk, k0 = 64 * kb, n0 = 64 * nb;
    const int nn = n0 + lane; const bool ok = nn < N;
    const float* p = W + (size_t)k0 * ldw + nn;
#pragma unroll
    for (int i = 0; i < 64; ++i) v[i] = ok ? p[(size_t)i * ldw] : 0.f;
}
__device__ __forceinline__ void titem_store(const float (&v)[64], int N, bf16_t* WT, int ldt, LAS float* scr, int item, int lane, const float* gk) {
    const int nblk = (N + 63) / 64, kb = item / nblk, nb = item % nblk, k0 = 64 * kb, n0 = 64 * nb;
#pragma unroll
    for (int i = 0; i < 64; ++i) scr[i * 65 + lane] = v[i];
    asm volatile("s_waitcnt lgkmcnt(0)" ::: "memory");
    const int c = lane & 7;
    f32x4 g0 = (f32x4){1.f, 1.f, 1.f, 1.f}, g1 = g0; if (gk) { g0 = *(const f32x4*)(gk + k0 + 8 * c); g1 = *(const f32x4*)(gk + k0 + 8 * c + 4); }
#pragma unroll
    for (int j = 0; j < 8; ++j) { const int n = (lane >> 3) + 8 * j; const LAS float* s = scr + (8 * c) * 65 + n;
        u32x4 o; o.x = pk2(s[0 * 65] * g0[0], s[1 * 65] * g0[1]); o.y = pk2(s[2 * 65] * g0[2], s[3 * 65] * g0[3]); o.z = pk2(s[4 * 65] * g1[0], s[5 * 65] * g1[1]); o.w = pk2(s[6 * 65] * g1[2], s[7 * 65] * g1[3]);
        if (n0 + n < N) *(u32x4*)(WT + (size_t)(n0 + n) * ldt + k0 + 8 * c) = o; }
    asm volatile("s_waitcnt lgkmcnt(0)" ::: "memory");
}
__device__ __forceinline__ void conv_mat(const float* W, int K, int N, int ldw, bf16_t* WT, int ldt, LAS float* scr, int gw, int NGW, int lane, int& rot, const float* gk = nullptr) {
    const int nitems = (K / 64) * ((N + 63) / 64);
    int it = gw - rot; if (it < 0) it += NGW;
    rot = (rot + nitems) % NGW;
    if (it >= nitems) return;
    float va[64], vb[64];
    titem_load(va, W, N, ldw, it, lane);
    for (;;) {
        const int n1 = it + NGW; if (n1 < nitems) titem_load(vb, W, N, ldw, n1, lane);
        titem_store(va, N, WT, ldt, scr, it, lane, gk);
        if (n1 >= nitems) break;
        const int n2 = n1 + NGW; if (n2 < nitems) titem_load(va, W, N, ldw, n2, lane);
        titem_store(vb, N, WT, ldt, scr, n1, lane, gk);
        if (n2 >= nitems) break;
        it = n2;
    }
}
__device__ __forceinline__ void conv_plain(const float* src, int rows, int ncols, int lds_, bf16_t* dst, int ldd, int gt, int NGT, const float* gk = nullptr) {
    const int cpr = ncols / 8; const long total = (long)rows * cpr;
    for (long i = gt; i < total; i += NGT) { const int r = (int)(i / cpr), c = (int)(i % cpr) * 8;
        f32x4 a = *(const f32x4*)(src + (size_t)r * lds_ + c), b = *(const f32x4*)(src + (size_t)r * lds_ + c + 4);
        if (gk) { const float gg = gk[r]; a = a * gg; b = b * gg; }
        u32x4 o; o.x = f2bf(a[0]) | (f2bf(a[1]) << 16); o.y = f2bf(a[2]) | (f2bf(a[3]) << 16); o.z = f2bf(b[0]) | (f2bf(b[1]) << 16); o.w = f2bf(b[2]) | (f2bf(b[3]) << 16);
        *(u32x4*)(dst + (size_t)r * ldd + c) = o; }
}
__device__ __forceinline__ void zero_fill16(unsigned char* p, size_t bytes, int gt, int NGT) {
    const u32x4 z = (u32x4){0u, 0u, 0u, 0u};
    for (size_t i = (size_t)gt * 16; i < bytes; i += (size_t)NGT * 16) *(u32x4*)(p + i) = z;
}

template <bool F32OUT>
__device__ __forceinline__ void rmsnorm_rows(const float* X, const float* g, bf16_t* O, float* OF, int bx, int NGW) {
    asm volatile("" ::: "memory"); const int tid = opaque_tid(), lane = tid & 63; const int gw = opq(bx) * 8 + __builtin_amdgcn_readfirstlane(tid >> 6);
    f32x4 gv[8];
#pragma unroll
    for (int j = 0; j < 8; ++j) gv[j] = *(const f32x4*)(g + (lane + 64 * j) * 4);
    for (int r = gw; r < T_TOK; r += NGW) {
        const bf16_t* xr = (const bf16_t*)X + (size_t)r * DM; f32x4 v[8]; float s = 0.f;
#pragma unroll
        for (int j = 0; j < 8; ++j) { const u32x2 w = *(const u32x2*)(xr + (lane + 64 * j) * 4); v[j] = (f32x4){bflo(w.x), bfhi(w.x), bflo(w.y), bfhi(w.y)}; s += (v[j][0] * v[j][0] + v[j][1] * v[j][1]) + (v[j][2] * v[j][2] + v[j][3] * v[j][3]); }
        const float rstd = rsqrtf(wave_sum(s, lane) * (1.f / DM) + EPSV);
#pragma unroll
        for (int j = 0; j < 8; ++j) { const f32x4 y = v[j] * rstd * gv[j];
            if (F32OUT) *(f32x4*)(OF + (size_t)r * DM + (lane + 64 * j) * 4) = y;
            else { u32x2 w; w.x = pk2(y[0], y[1]); w.y = pk2(y[2], y[3]); *(u32x2*)(O + (size_t)r * DM + (lane + 64 * j) * 4) = w; } }
    }
}

__device__ __forceinline__ void rows_to_bf16_ss(const float* X, bf16_t* O, float* rss, int bx, int NGW) {
    const int tid = opaque_tid(), lane = tid & 63; const int gw = opq(bx) * 8 + __builtin_amdgcn_readfirstlane(tid >> 6);
    for (int r = gw; r < T_TOK; r += NGW) {
        const float* xr = X + (size_t)r * DM; f32x4 v[8]; float s = 0.f;
#pragma unroll
        for (int j = 0; j < 8; ++j) { v[j] = *(const f32x4*)(xr + (lane + 64 * j) * 4); s += (v[j][0] * v[j][0] + v[j][1] * v[j][1]) + (v[j][2] * v[j][2] + v[j][3] * v[j][3]); }
        s = wave_sum(s, lane); if (lane < 32) rss[(size_t)r * 32 + lane] = (lane == 0) ? s : 0.f;
#pragma unroll
        for (int j = 0; j < 8; ++j) { u32x2 w; w.x = pk2(v[j][0], v[j][1]); w.y = pk2(v[j][2], v[j][3]); *(u32x2*)(O + (size_t)r * DM + (lane + 64 * j) * 4) = w; }
    }
}
__device__ __forceinline__ void lru_item(LAS unsigned char* lds, int item, const bf16_t* ZE, const float* conv_w, const float* conv_b,
                                         const bf16_t* WrT, const bf16_t* WiT, const float* b_r, const float* b_i, const float* lam, bf16_t* YB) {
    const int tid = opaque_tid(), w = __builtin_amdgcn_readfirstlane(tid >> 6), lane = tid & 63, fr = lane & 15, fq = lane >> 4;
    const int b = item >> 6, hh = (item >> 2) & 15, qq = item & 3;
    LAS unsigned char* XC = lds;
    LAS float* SEGA = (LAS float*)(lds + 36864);
    LAS float* SEGB = SEGA + 1024;
    LAS float* HIN = SEGB + 1024;
    const int co = tid & 7, tr = tid >> 3;
    float cw[4][8], cb[8];
#pragma unroll
    for (int k = 0; k < 4; ++k)
#pragma unroll
        for (int e = 0; e < 8; ++e) cw[k][e] = conv_w[k * 1024 + hh * 64 + co * 8 + e];
#pragma unroll
    for (int e = 0; e < 8; ++e) cb[e] = conv_b[hh * 64 + co * 8 + e];
    bf16x8 wrf[2], wif[2];
#pragma unroll
    for (int kk = 0; kk < 2; ++kk) { wrf[kk] = *(const bf16x8*)(WrT + ((size_t)hh * 64 + qq * 16 + fr) * 64 + kk * 32 + fq * 8); wif[kk] = *(const bf16x8*)(WiT + ((size_t)hh * 64 + qq * 16 + fr) * 64 + kk * 32 + fq * 8); }
    const int ch = hh * 64 + qq * 16 + fr;
    const float br = b_r[ch], bi = b_i[ch];
    const float lm = lam[ch]; float sp8; { const float e = __expf(-lm); const float ser = e * (1.f - e * (0.5f - e * (0.33333333f - e * 0.25f)));
        sp8 = 8.0f * ((-lm > 20.f) ? -lm : (e < 0.03f ? ser : __logf(1.0f + e))); }
    float carry = 0.f;
    const bf16_t* zb = ZE + (size_t)b * SEQ * AB_IN;
    u32x4 xr[7];
#pragma unroll
    for (int r = 0; r < 7; ++r) { const int t = tr * 4 - 3 + r; xr[r] = (t >= 0) ? *(const u32x4*)(zb + (size_t)t * AB_IN + hh * 64 + co * 8) : (u32x4){0u, 0u, 0u, 0u}; }
    for (int sc = 0; sc < 16; ++sc) {
        const int t0 = sc * 256;
        unsigned short gr[2][4];
#pragma unroll
        for (int ml = 0; ml < 2; ++ml)
#pragma unroll
            for (int r = 0; r < 4; ++r) gr[ml][r] = zb[(size_t)(t0 + (w * 2 + ml) * 16 + fq * 4 + r) * AB_IN + 1024 + ch];
        {
            float xin[7][8];
#pragma unroll
            for (int r = 0; r < 7; ++r) { const u32x4 v = xr[r];
                xin[r][0] = bflo(v.x); xin[r][1] = bfhi(v.x); xin[r][2] = bflo(v.y); xin[r][3] = bfhi(v.y); xin[r][4] = bflo(v.z); xin[r][5] = bfhi(v.z); xin[r][6] = bflo(v.w); xin[r][7] = bfhi(v.w); }
#pragma unroll
            for (int q = 0; q < 4; ++q) { float o[8];
#pragma unroll
                for (int e = 0; e < 8; ++e) o[e] = cb[e] + cw[0][e] * xin[q][e] + cw[1][e] * xin[q + 1][e] + cw[2][e] * xin[q + 2][e] + cw[3][e] * xin[q + 3][e];
                u32x4 wv; wv.x = pk2(o[0], o[1]); wv.y = pk2(o[2], o[3]); wv.z = pk2(o[4], o[5]); wv.w = pk2(o[6], o[7]);
                *(LAS u32x4*)(XC + (tr * 4 + q) * 144 + co * 16) = wv; }
            if (sc < 15) {
#pragma unroll
                for (int r = 0; r < 7; ++r) xr[r] = *(const u32x4*)(zb + (size_t)(t0 + 256 + tr * 4 - 3 + r) * AB_IN + hh * 64 + co * 8); }
        }
        __syncthreads();
        float av[2][4], bv[2][4];
#pragma unroll
        for (int ml = 0; ml < 2; ++ml) { const int mt = w * 2 + ml;
            f32x4 ar = (f32x4){0.f, 0.f, 0.f, 0.f}, ai = ar;
#pragma unroll
            for (int kk = 0; kk < 2; ++kk) { const bf16x8 xa = *(const LAS bf16x8*)(XC + (mt * 16 + fr) * 144 + kk * 64 + fq * 16);
                ar = __builtin_amdgcn_mfma_f32_16x16x32_bf16(xa, wrf[kk], ar, 0, 0, 0); ai = __builtin_amdgcn_mfma_f32_16x16x32_bf16(xa, wif[kk], ai, 0, 0, 0); }
            float A = 1.f, Bc = 0.f;
#pragma unroll
            for (int r = 0; r < 4; ++r) { const int tok = mt * 16 + fq * 4 + r;
                const float xcv = bf2f(*(const LAS unsigned short*)(XC + tok * 144 + (qq * 16 + fr) * 2));
                const float rg = sigmoidf_(ar[r] + br), ig = sigmoidf_(ai[r] + bi);
                const float la = -rg * sp8; const float a = __expf(la); const float x2 = 2.f * la; const float em = (x2 > -0.3f) ? -x2 * (1.f + x2 * 0.5f * (1.f + x2 * 0.33333333f * (1.f + x2 * 0.25f * (1.f + x2 * 0.2f * (1.f + x2 * 0.16666667f))))) : 1.f - __expf(x2);
                const float mult = sqrtf(fmaxf(em, 0.f));
                av[ml][r] = a; bv[ml][r] = mult * ig * xcv;
                Bc = a * Bc + bv[ml][r]; A = A * a; }
            const int sg = mt * 4 + fq; SEGA[sg * 16 + fr] = A; SEGB[sg * 16 + fr] = Bc; }
        __syncthreads();
        if (w == 0 && lane < 16) { float h = carry;
#pragma unroll 8
            for (int sg = 0; sg < 64; ++sg) { HIN[sg * 16 + lane] = h; h = SEGA[sg * 16 + lane] * h + SEGB[sg * 16 + lane]; }
            carry = h; }
        __syncthreads();
#pragma unroll
        for (int ml = 0; ml < 2; ++ml) { const int mt = w * 2 + ml; float h = HIN[(mt * 4 + fq) * 16 + fr];
#pragma unroll
            for (int r = 0; r < 4; ++r) { const int t = t0 + mt * 16 + fq * 4 + r; h = av[ml][r] * h + bv[ml][r];
                const float gt = bf2f(gr[ml][r]);
                YB[((size_t)b * SEQ + t) * DM + ch] = (bf16_t)f2bf(h * gelu_tanh(gt)); } }
    }
    __syncthreads();
}
__device__ __forceinline__ void pool_item(int item, const bf16_t* ZE, const float* scale, bf16_t* YB) {
    const int tid = opaque_tid(), b = item >> 6, tch = item & 63, co = tid & 127, seg = tid >> 7;
    const int win = 2 << (co >> 5);
    float sc[8];
#pragma unroll
    for (int e = 0; e < 8; ++e) sc[e] = scale[co * 8 + e];
    const bf16_t* zb = ZE + (size_t)b * SEQ * AB_IN + 2048 + co * 8;
    const int ts = tch * 64 + seg * 16;
    float sum[8];
#pragma unroll
    for (int e = 0; e < 8; ++e) sum[e] = 0.f;
    for (int s = ts - win + 1; s < ts; ++s) if (s >= 0) { const u32x4 v = *(const u32x4*)(zb + (size_t)s * AB_IN);
        sum[0] += bflo(v.x); sum[1] += bfhi(v.x); sum[2] += bflo(v.y); sum[3] += bfhi(v.y); sum[4] += bflo(v.z); sum[5] += bfhi(v.z); sum[6] += bflo(v.w); sum[7] += bfhi(v.w); }
    for (int t = ts; t < ts + 16; ++t) {
        const u32x4 v = *(const u32x4*)(zb + (size_t)t * AB_IN);
        float x[8] = {bflo(v.x), bfhi(v.x), bflo(v.y), bfhi(v.y), bflo(v.z), bfhi(v.z), bflo(v.w), bfhi(v.w)};
        const float inv = 1.0f / (float)((t + 1) < win ? (t + 1) : win);
        float o[8];
#pragma unroll
        for (int e = 0; e < 8; ++e) { sum[e] += x[e]; o[e] = (sum[e] * inv - x[e]) * sc[e]; }
        u32x4 wv; wv.x = pk2(o[0], o[1]); wv.y = pk2(o[2], o[3]); wv.z = pk2(o[4], o[5]); wv.w = pk2(o[6], o[7]);
        *(u32x4*)(YB + ((size_t)b * SEQ + t) * DM + 1024 + co * 8) = wv;
        const int so = t - win + 1;
        if (so >= 0) { const u32x4 q = *(const u32x4*)(zb + (size_t)so * AB_IN);
            sum[0] -= bflo(q.x); sum[1] -= bfhi(q.x); sum[2] -= bflo(q.y); sum[3] -= bfhi(q.y); sum[4] -= bflo(q.z); sum[5] -= bfhi(q.z); sum[6] -= bflo(q.w); sum[7] -= bfhi(q.w); }
    }
}

constexpr int KT_PITCH = 272, VT_PITCH = 144;
constexpr int AL_KT = 0, AL_VT = 64 * KT_PITCH, AL_BUF = 36864  , AL_IMPA = 2 * 36864, AL_IMPB = AL_IMPA + 64 * 65 * 4, AL_SEL = AL_IMPB + 64 * 65 * 4, AL_UNI = AL_SEL + 512, AL_Q = 73728, Q_WAVE = 32 * KT_PITCH;
constexpr float QSCALE2 = 0.08838834764831845f * LOG2E;
constexpr float NEGB = -1e30f;

struct StageRegs { u32x4 k[2], v[2]; };
__device__ __forceinline__ void stage_load(StageRegs& R, const bf16_t* kbase, const bf16_t* vbase, int vpitch, int tid) {
    const int kr = tid >> 3, kc = tid & 7, vr = tid >> 2, vc = tid & 3;
    R.k[0] = *(const u32x4*)(kbase + kr * 128 + kc * 8); R.k[1] = *(const u32x4*)(kbase + kr * 128 + 64 + kc * 8);
    R.v[0] = *(const u32x4*)(vbase + (size_t)vr * vpitch + vc * 8); R.v[1] = *(const u32x4*)(vbase + (size_t)vr * vpitch + 32 + vc * 8);
}
__device__ __forceinline__ void stage_store(const StageRegs& R, LAS unsigned char* lds, int tid) {
    const int kr = tid >> 3, kc = tid & 7, vr = tid >> 2, vc = tid & 3;
    *(LAS u32x4*)(lds + AL_KT + kr * KT_PITCH + kc * 16) = R.k[0]; *(LAS u32x4*)(lds + AL_KT + kr * KT_PITCH + 128 + kc * 16) = R.k[1];
    *(LAS u32x4*)(lds + AL_VT + vr * VT_PITCH + vc * 16) = R.v[0]; *(LAS u32x4*)(lds + AL_VT + vr * VT_PITCH + 64 + vc * 16) = R.v[1];
}
template <int MODE>
__device__ __forceinline__ void attn_tile(bool MASK, LAS unsigned char* lds, LAS unsigned char* ldsi, const bf16x8 (&qf)[2][4], f32x4 (&O)[2][8], float (&m)[2], float (&l)[2], const int (&tpos)[2], float slope2,
                                          int kp0, const bool (&selbit)[2], int fr, int fq, int wv, int tile64, int lane) {
    constexpr int KS = (MODE <= 1) ? 16 : 1;
    f32x4 s[2][4];
#pragma unroll
    for (int ci = 0; ci < 2; ++ci)
#pragma unroll
        for (int k4 = 0; k4 < 4; ++k4) s[ci][k4] = (f32x4){0.f, 0.f, 0.f, 0.f};
#pragma unroll
    for (int kk = 0; kk < 4; ++kk) {
        const bf16x8 q0 = qf[0][kk], q1 = qf[1][kk];
#pragma unroll
        for (int k4 = 0; k4 < 4; ++k4) { const bf16x8 kf = *(const LAS bf16x8*)(lds + AL_KT + (k4 * 16 + fr) * KT_PITCH + kk * 64 + fq * 16);
            s[0][k4] = __builtin_amdgcn_mfma_f32_16x16x32_bf16(kf, q0, s[0][k4], 0, 0, 0);
            s[1][k4] = __builtin_amdgcn_mfma_f32_16x16x32_bf16(kf, q1, s[1][k4], 0, 0, 0); } }
    const float sk = slope2 * (float)KS;
    float alpha[2] = {1.f, 1.f};
#pragma unroll
    for (int ci = 0; ci < 2; ++ci) {
        const int base = tpos[ci] - kp0 - KS * (fq * 4);
        const float bb = -slope2 * (float)base;
        float mx = NEGB;
#pragma unroll
        for (int k4 = 0; k4 < 4; ++k4)
#pragma unroll
            for (int j = 0; j < 4; ++j) {
                s[ci][k4][j] = __builtin_fmaf(s[ci][k4][j], QSCALE2, __builtin_fmaf(sk, (float)(k4 * 16 + j), bb)); }
        if (MASK) {
#pragma unroll
            for (int k4 = 0; k4 < 4; ++k4)
#pragma unroll
                for (int j = 0; j < 4; ++j) { const int c = KS * (k4 * 16 + j); bool ok = c <= base; if (MODE == 3) ok = ok && (base - c < 512); s[ci][k4][j] = ok ? s[ci][k4][j] : 2.0f * NEGB; } }
#pragma unroll
        for (int k4 = 0; k4 < 4; ++k4)
#pragma unroll
            for (int j = 0; j < 4; ++j) mx = fmaxf(mx, s[ci][k4][j]);
        if (MODE == 2) mx = selbit[ci] ? mx : NEGB;
        if (MODE != 1) {
            mx = fmaxf(mx, shx(mx, lane, 16)); mx = fmaxf(mx, shx(mx, lane, 32));
            const float mn = fmaxf(m[ci], mx); alpha[ci] = __builtin_amdgcn_exp2f(m[ci] - mn); m[ci] = mn;
            float ps = 0.f;
#pragma unroll
            for (int k4 = 0; k4 < 4; ++k4)
#pragma unroll
                for (int j = 0; j < 4; ++j) { const float p = __builtin_amdgcn_exp2f(s[ci][k4][j] - mn); s[ci][k4][j] = p; ps += p; }
            if (MODE == 2) ps = selbit[ci] ? ps : 0.f;
            l[ci] = l[ci] * alpha[ci] + ps;
        } else {
#pragma unroll
            for (int k4 = 0; k4 < 4; ++k4) {
#pragma unroll
                for (int j = 0; j < 4; ++j) s[ci][k4][j] = __builtin_amdgcn_exp2f(s[ci][k4][j] - m[ci]) * l[ci];
                float a = (s[ci][k4][0] + s[ci][k4][1]) + (s[ci][k4][2] + s[ci][k4][3]); float b3 = s[ci][k4][3];
                a += shx(a, lane, 1); a += shx(a, lane, 2); b3 += shx(b3, lane, 1); b3 += shx(b3, lane, 2);
                if ((fr & 3) == 0) { const int tl = wv * 8 + ci * 4 + (fr >> 2); const int ms = tile64 * 16 + k4 * 4 + fq;
                    ((LAS float*)(ldsi + AL_IMPA))[tl * 65 + ms] = a; ((LAS float*)(ldsi + AL_IMPB))[tl * 65 + ms + 1] = b3; } }
        }
    }
    if (MODE >= 2) {
        if (__builtin_amdgcn_ballot_w64(alpha[0] != 1.f || alpha[1] != 1.f) != 0ull) {
#pragma unroll
            for (int ci = 0; ci < 2; ++ci)
#pragma unroll
                for (int dt = 0; dt < 8; ++dt) O[ci][dt] = O[ci][dt] * alpha[ci]; }
    }
    if (MODE != 0) {
#pragma unroll
        for (int ks = 0; ks < 2; ++ks) {
            bf16x8 pf[2];
#pragma unroll
            for (int ci = 0; ci < 2; ++ci) { u32x4 w; w.x = pk2(s[ci][2 * ks][0], s[ci][2 * ks][1]); w.y = pk2(s[ci][2 * ks][2], s[ci][2 * ks][3]); w.z = pk2(s[ci][2 * ks + 1][0], s[ci][2 * ks + 1][1]); w.w = pk2(s[ci][2 * ks + 1][2], s[ci][2 * ks + 1][3]);
                if (MODE == 2) { w.x = selbit[ci] ? w.x : 0u; w.y = selbit[ci] ? w.y : 0u; w.z = selbit[ci] ? w.z : 0u; w.w = selbit[ci] ? w.w : 0u; }
                pf[ci] = __builtin_bit_cast(bf16x8, w); }
#pragma unroll
            for (int dt = 0; dt < 8; ++dt) { const LAS unsigned char* vp = lds + AL_VT + (dt * 16 + fr) * VT_PITCH + (ks * 32 + fq * 4) * 2;
                const u32x2 lo = *(const LAS u32x2*)vp, hi = *(const LAS u32x2*)(vp + 32);
                const bf16x8 vf = __builtin_bit_cast(bf16x8, (u32x4){lo.x, lo.y, hi.x, hi.y});
                O[0][dt] = __builtin_amdgcn_mfma_f32_16x16x32_bf16(vf, pf[0], O[0][dt], 0, 0, 0);
                O[1][dt] = __builtin_amdgcn_mfma_f32_16x16x32_bf16(vf, pf[1], O[1][dt], 0, 0, 0); }
        }
    }
}

__device__ __forceinline__ void nsa_item(LAS unsigned char* lds, int b, int g, int tq, const bf16_t* Q, const bf16_t* KS, const bf16_t* VST, const bf16_t* KW, const bf16_t* VWT,
                                         const bf16_t* KCMP, const bf16_t* VCMPT, const float* GL, bf16_t* YB) {
    const int tid = opaque_tid(), wv = __builtin_amdgcn_readfirstlane(tid >> 6), lane = tid & 63, fr = lane & 15, fq = lane >> 4;
    const int t0 = tq * 64, bg = b * 4 + g, head = g * 4 + (fr & 3);
    LAS float* IMPA = (LAS float*)(lds + AL_IMPA);
    LAS unsigned long long* SEL = (LAS unsigned long long*)(lds + AL_SEL);
    LAS unsigned long long* UNI = (LAS unsigned long long*)(lds + AL_UNI);
    __syncthreads();
    for (int i = tid; i < 2 * 64 * 65; i += 512) IMPA[i] = 0.f;
    int tpos[2]; bf16x8 qf[2][4]; int tc = 0;
#pragma unroll
    for (int ci = 0; ci < 2; ++ci) { tpos[ci] = t0 + wv * 8 + ci * 4 + (fr >> 2);
        const bf16_t* qp = Q + ((size_t)(b * SEQ + tpos[ci])) * DM + head * 128 + fq * 8;
#pragma unroll
        for (int kk = 0; kk < 4; ++kk) qf[ci][kk] = *(const bf16x8*)(qp + kk * 32);
    }
    const float slope2 = exp2f(-0.5f * (float)(head + 1)) * LOG2E;
    f32x4 O[2][8]; float m[2], l[2]; bool selbit[2] = {true, true};
#pragma unroll
    for (int ci = 0; ci < 2; ++ci)
#pragma unroll
        for (int dt = 0; dt < 8; ++dt) { O[ci][dt] = (f32x4){0.f, 0.f, 0.f, 0.f}; }
    StageRegs R;
    const int ncmp = ((t0 + 32) >> 4) + 1, nct = (ncmp + 63) >> 6;
    const bf16_t* kcb = KCMP + (size_t)bg * 256 * 128; const bf16_t* vcb = VCMPT + (size_t)bg * 128 * 256;
    m[0] = m[1] = NEGB; l[0] = l[1] = 0.f;
    stage_load(R, kcb, vcb, 256, tid);
    for (int ct = 0; ct < nct; ++ct) {
        LAS unsigned char* kvb = lds + (tc & 1) * AL_BUF; ++tc; stage_store(R, kvb, tid); __syncthreads();
        if (ct + 1 < nct) stage_load(R, kcb + (size_t)(ct + 1) * 64 * 128, vcb + (ct + 1) * 64, 256, tid);
        attn_tile<0>(1024 * ct + 1039 > t0, kvb, lds, qf, O, m, l, tpos, slope2, 16 * (ct * 64) + 31, selbit, fr, fq, wv, ct, lane);
    }
#pragma unroll
    for (int ci = 0; ci < 2; ++ci) { float lt = l[ci]; lt += shx(lt, lane, 16); lt += shx(lt, lane, 32); l[ci] = lt > 0.f ? 1.0f / lt : 0.f; }
    stage_load(R, kcb, vcb, 256, tid);
    for (int ct = 0; ct < nct; ++ct) {
        LAS unsigned char* kvb = lds + (tc & 1) * AL_BUF; ++tc; stage_store(R, kvb, tid); __syncthreads();
        if (ct + 1 < nct) stage_load(R, kcb + (size_t)(ct + 1) * 64 * 128, vcb + (ct + 1) * 64, 256, tid);
        attn_tile<1>(1024 * ct + 1039 > t0, kvb, lds, qf, O, m, l, tpos, slope2, 16 * (ct * 64) + 31, selbit, fr, fq, wv, ct, lane);
    }
#pragma unroll
    for (int ci = 0; ci < 2; ++ci) { const float gc = GL[((size_t)(b * SEQ + tpos[ci])) * 48 + head];
        bf16_t* op = YB + ((size_t)(b * SEQ + tpos[ci])) * DM + head * 128 + fq * 4;
#pragma unroll
        for (int dt = 0; dt < 8; ++dt) { const f32x4 o = O[ci][dt] * gc; u32x2 w; w.x = pk2(o[0], o[1]); w.y = pk2(o[2], o[3]); *(u32x2*)(op + dt * 16) = w; O[ci][dt] = (f32x4){0.f, 0.f, 0.f, 0.f}; } }
    __syncthreads();
    {
        const int cur = tq; unsigned long long wun = 0ull;
#pragma unroll 1
        for (int tk = 0; tk < 8; ++tk) { const int tl = wv * 8 + tk;
            float v = IMPA[tl * 65 + lane] + IMPA[64 * 65 + tl * 65 + lane];
            if (lane == 0 || lane == cur || lane == cur - 1) v += 1e6f;
            if (lane > cur) v = NEGB;
            int rank = 0; const int vi = __builtin_bit_cast(int, v);
#pragma unroll
            for (int mm = 0; mm < 64; ++mm) { const float vm = __builtin_bit_cast(float, __builtin_amdgcn_readlane(vi, mm)); rank += ((vm > v) || (vm == v && mm < lane)) ? 1 : 0; }
            const unsigned long long mk = __ballot(rank < 16 && lane <= cur);
            wun |= mk;
            if (lane == 0) SEL[tl] = mk; }
        if (lane == 0) UNI[wv] = wun;
    }
    __syncthreads();
    unsigned long long selm[2], wun, bun = 0ull;
#pragma unroll
    for (int ci = 0; ci < 2; ++ci) selm[ci] = SEL[wv * 8 + ci * 4 + (fr >> 2)];
    wun = UNI[wv];
#pragma unroll
    for (int i = 0; i < 8; ++i) bun |= UNI[i];
    { const unsigned lo = __builtin_amdgcn_readfirstlane((unsigned)bun), hi = __builtin_amdgcn_readfirstlane((unsigned)(bun >> 32)); bun = ((unsigned long long)hi << 32) | lo;
      const unsigned lo2 = __builtin_amdgcn_readfirstlane((unsigned)wun), hi2 = __builtin_amdgcn_readfirstlane((unsigned)(wun >> 32)); wun = ((unsigned long long)hi2 << 32) | lo2; }
    const bf16_t* ksb = KS + (size_t)bg * SEQ * 128; const bf16_t* vsb = VST + (size_t)bg * 128 * SEQ;
    m[0] = m[1] = NEGB; l[0] = l[1] = 0.f;
    {
        unsigned long long rem = bun; int j = 63 - __builtin_clzll(rem); rem &= ~(1ull << j);
        stage_load(R, ksb + (size_t)j * 64 * 128, vsb + j * 64, SEQ, tid);
        for (;;) {
            LAS unsigned char* kvb = lds + (tc & 1) * AL_BUF; ++tc; stage_store(R, kvb, tid); __syncthreads();
            const int jn = rem ? 63 - __builtin_clzll(rem) : -1; if (jn >= 0) { rem &= ~(1ull << jn); stage_load(R, ksb + (size_t)jn * 64 * 128, vsb + jn * 64, SEQ, tid); }
            if ((wun >> j) & 1ull) { selbit[0] = (selm[0] >> j) & 1ull; selbit[1] = (selm[1] >> j) & 1ull;
                attn_tile<2>(j == tq, kvb, lds, qf, O, m, l, tpos, slope2, j * 64, selbit, fr, fq, wv, 0, lane); }
            if (jn < 0) break; j = jn;
        }
    }
#pragma unroll
    for (int ci = 0; ci < 2; ++ci) { float lt = l[ci]; lt += shx(lt, lane, 16); lt += shx(lt, lane, 32); const float gs = GL[((size_t)(b * SEQ + tpos[ci])) * 48 + 16 + head]; const float sc = lt > 0.f ? gs / lt : 0.f;
        bf16_t* op = YB + ((size_t)(b * SEQ + tpos[ci])) * DM + head * 128 + fq * 4;
#pragma unroll
        for (int dt = 0; dt < 8; ++dt) { const f32x4 o = O[ci][dt] * sc; const u32x2 pv = *(const u32x2*)(op + dt * 16); u32x2 w; w.x = pk2(bflo(pv.x) + o[0], bfhi(pv.x) + o[1]); w.y = pk2(bflo(pv.y) + o[2], bfhi(pv.y) + o[3]); *(u32x2*)(op + dt * 16) = w; O[ci][dt] = (f32x4){0.f, 0.f, 0.f, 0.f}; } }
    const bf16_t* kwb = KW + (size_t)bg * SEQ * 128; const bf16_t* vwb = VWT + (size_t)bg * 128 * SEQ;
    m[0] = m[1] = NEGB; l[0] = l[1] = 0.f; selbit[0] = selbit[1] = true;
    {
        const int j0 = tq >= 8 ? tq - 8 : 0;
        stage_load(R, kwb + (size_t)tq * 64 * 128, vwb + tq * 64, SEQ, tid);
        for (int j = tq; j >= j0; --j) {
            LAS unsigned char* kvb = lds + (tc & 1) * AL_BUF; ++tc; stage_store(R, kvb, tid); __syncthreads();
            if (j > j0) stage_load(R, kwb + (size_t)(j - 1) * 64 * 128, vwb + (j - 1) * 64, SEQ, tid);
            attn_tile<3>(j == tq || j == tq - 8, kvb, lds, qf, O, m, l, tpos, slope2, j * 64, selbit, fr, fq, wv, 0, lane);
        }
    }
#pragma unroll
    for (int ci = 0; ci < 2; ++ci) { float lt = l[ci]; lt += shx(lt, lane, 16); lt += shx(lt, lane, 32); const float gwv = GL[((size_t)(b * SEQ + tpos[ci])) * 48 + 32 + head]; const float sc = lt > 0.f ? gwv / lt : 0.f;
        bf16_t* op = YB + ((size_t)(b * SEQ + tpos[ci])) * DM + head * 128 + fq * 4;
#pragma unroll
        for (int dt = 0; dt < 8; ++dt) { const f32x4 o = O[ci][dt] * sc; const u32x2 pv = *(const u32x2*)(op + dt * 16); u32x2 w; w.x = pk2(bflo(pv.x) + o[0], bfhi(pv.x) + o[1]); w.y = pk2(bflo(pv.y) + o[2], bfhi(pv.y) + o[3]); *(u32x2*)(op + dt * 16) = w; } }
}

__global__ void __launch_bounds__(512) fwd_kernel(Args a) {
    extern __shared__ __attribute__((aligned(16))) unsigned char lds_raw[];
    LAS unsigned char* lds = (LAS unsigned char*)lds_raw;
    const int G = gridDim.x, bx = blockIdx.x;
    const int NGW = G * 8, NGT = G * 512;
#define GW() (opq(bx) * 8 + __builtin_amdgcn_readfirstlane(opaque_tid() >> 6))
    unsigned char* ws = a.ws;
    int ph = 0;
    { volatile LAS unsigned* MISC = (volatile LAS unsigned*)(lds + LDS_BYTES - 64); if (threadIdx.x < 16) MISC[threadIdx.x] = 0u; }
    __syncthreads();
    (void)xcd_barrier_post((unsigned*)(ws + WS_BAR), (volatile LAS unsigned*)(lds + LDS_BYTES - 64));
#ifndef ONLY
#define ONLY -1
#endif
#define EN(id) (ONLY < 0 || ONLY == (id))
#define ON() (ph >= a.lo && ph < a.hi)
#define SEAM() do { ++ph; if (a.one) { if (ph == 1) cg::this_grid().sync(); else { XcdBarrier bar; bar.bar = (unsigned*)(opqp(ws) + WS_BAR); bar.x = xb_xcc_id(); bar.st = (volatile LAS unsigned*)(lds + LDS_BYTES - 64); xcd_barrier(bar); } } } while (0)

    bf16_t* XN = (bf16_t*)(ws + WS_XN); bf16_t* YB = (bf16_t*)(ws + WS_YB); unsigned char* Z = ws + WS_Z;
    float* posb = (float*)(ws + WS_POSB);

    if (EN(0) && ON())
#pragma unroll 1
    for (int rp0 = 0; rp0 < REP_P0; ++rp0) {
        const int tid = opaque_tid(), lane = tid & 63, wave = __builtin_amdgcn_readfirstlane(tid >> 6), gw = bx * 8 + wave, gt = bx * 512 + tid;
        LAS float* scr = (LAS float*)(lds + wave * 16640);
        int rot = 0;
        for (int i = 0; i < 4; ++i) {
            conv_mat(a.in[23] + (size_t)i * DM * DFF, DM, DFF, DFF, (bf16_t*)(ws + WS_WUP + i * SZ_UP), DM, scr, gw, NGW, lane, rot, a.in[22] + i * DM);
            conv_mat(a.in[24] + (size_t)i * DFF * DM, DFF, DM, DM, (bf16_t*)(ws + WS_WDN + i * SZ_UP), DFF, scr, gw, NGW, lane, rot);
            conv_mat(a.in[26] + (size_t)i * DM * DM, DM, DM, DM, (bf16_t*)(ws + WS_WG + i * SZ_SQ), DM, scr, gw, NGW, lane, rot, a.in[25] + i * DM);
            conv_mat(a.in[27] + (size_t)i * PLE * DM, PLE, DM, DM, (bf16_t*)(ws + WS_WP + i * SZ_WP), PLE, scr, gw, NGW, lane, rot);
        }
        for (int j = 0; j < 2; ++j) {
            conv_mat(a.in[3] + (size_t)j * DM * AB_IN, DM, 2048, AB_IN, (bf16_t*)(ws + WS_WIN + j * SZ_WIN), DM, scr, gw, NGW, lane, rot, a.in[2] + (2 * j) * DM);
            conv_mat(a.in[13] + (size_t)j * DM * DM, DM, DM, DM, (bf16_t*)(ws + WS_WOUT + j * SZ_SQ), DM, scr, gw, NGW, lane, rot);
            conv_mat(a.in[14] + (size_t)j * DM * C_IN, DM, C_INP, C_IN, (bf16_t*)(ws + WS_CIN + j * SZ_CIN), DM, scr, gw, NGW, lane, rot, a.in[2] + (2 * j + 1) * DM);
            conv_mat(a.in[14] + (size_t)j * DM * C_IN + C_INP, DM, 48, C_IN, (bf16_t*)(ws + WS_WGL + (size_t)j * 256 * DM * 2), DM, scr, gw, NGW, lane, rot, a.in[2] + (2 * j + 1) * DM);
            conv_mat(a.in[21] + (size_t)j * DM * DM, DM, DM, DM, (bf16_t*)(ws + WS_COUT + j * SZ_SQ), DM, scr, gw, NGW, lane, rot);
            conv_mat(a.in[16] + (size_t)j * 4096 * 512, 4096, 512, 512, (bf16_t*)(ws + WS_W1K + j * SZ_W1), 4096, scr, gw, NGW, lane, rot);
            conv_mat(a.in[19] + (size_t)j * 4096 * 512, 4096, 512, 512, (bf16_t*)(ws + WS_W1V + j * SZ_W1), 4096, scr, gw, NGW, lane, rot);
            conv_mat(a.in[17] + (size_t)j * 512 * 128, 512, 128, 128, (bf16_t*)(ws + WS_W2K + j * SZ_W2), 512, scr, gw, NGW, lane, rot);
            conv_mat(a.in[20] + (size_t)j * 512 * 128, 512, 128, 128, (bf16_t*)(ws + WS_W2V + j * SZ_W2), 512, scr, gw, NGW, lane, rot);
            for (int h = 0; h < 16; ++h) {
                conv_mat(a.in[6] + ((size_t)j * 16 + h) * 4096, 64, 64, 64, (bf16_t*)(ws + WS_WR + j * SZ_WRI) + h * 4096, 64, scr, gw, NGW, lane, rot);
                conv_mat(a.in[8] + ((size_t)j * 16 + h) * 4096, 64, 64, 64, (bf16_t*)(ws + WS_WI + j * SZ_WRI) + h * 4096, 64, scr, gw, NGW, lane, rot);
            }
            for (int gI = 0; gI < 4; ++gI)
                conv_mat(a.in[11] + ((size_t)j * 4 + gI) * 65536, 256, 256, 256, (bf16_t*)(ws + WS_POOLT + j * SZ_POOLT) + gI * 65536, 256, scr, gw, NGW, lane, rot);
            conv_plain(a.in[3] + (size_t)j * DM * AB_IN + 2048, DM, 1024, AB_IN, (bf16_t*)(ws + WS_WU + j * SZ_WU), 1024, gt, NGT, a.in[2] + (2 * j) * DM);
            zero_fill16(ws + WS_WGL + (size_t)j * 256 * DM * 2 + (size_t)48 * DM * 2, (size_t)208 * DM * 2, gt, NGT);
            zero_fill16(ws + WS_W2K + j * SZ_W2 + (size_t)128 * 512 * 2, (size_t)128 * 512 * 2, gt, NGT);
            zero_fill16(ws + WS_W2V + j * SZ_W2 + (size_t)128 * 512 * 2, (size_t)128 * 512 * 2, gt, NGT);
        }
        conv_plain(a.in[1], 4 * T_TOK, PLE, PLE, (bf16_t*)(ws + WS_PB), PLE, gt, NGT);
        rows_to_bf16_ss(a.in[0], XN, (float*)(ws + WS_ROWSS), bx, NGW);
        for (int it = gw; it < 4 * 8 * 64; it += NGW) { const int q = it >> 9, fc = (it >> 6) & 7, kc = it & 63, j = q >> 1;
            const float* pos = a.in[(q & 1) ? 18 : 15] + (size_t)j * 4096 + kc * 64; const float* w1 = a.in[(q & 1) ? 19 : 16] + (size_t)j * 4096 * 512 + (size_t)kc * 64 * 512 + fc * 64 + lane;
            float acc0 = 0.f, acc1 = 0.f, acc2 = 0.f, acc3 = 0.f;
#pragma unroll 4
            for (int k = 0; k < 64; k += 4) { acc0 += pos[k] * w1[(size_t)k * 512]; acc1 += pos[k + 1] * w1[(size_t)(k + 1) * 512]; acc2 += pos[k + 2] * w1[(size_t)(k + 2) * 512]; acc3 += pos[k + 3] * w1[(size_t)(k + 3) * 512]; }
            ((float*)(ws + WS_POSP))[((size_t)q * 64 + kc) * 512 + fc * 64 + lane] = (acc0 + acc1) + (acc2 + acc3); }
    }
    SEAM();
    if (EN(1) && ON()) {
        if (bx < 64) { const int j = bx >> 5, gI = (bx >> 3) & 3, pn = bx & 7;
            pg8::Gemm gm{(const bf16_t*)(ws + WS_POOLT + j * SZ_POOLT) + gI * 65536, (const bf16_t*)(ws + WS_WU + j * SZ_WU) + gI * 256, 256, 2048, 256, 256, 1024};
            pg8::StaticOrder S; S.init(256, 2048, G, pn);
            EpiBf16<0> E{(bf16_t*)(ws + WS_WIN + j * SZ_WIN) + (size_t)(2048 + gI * 256) * DM, DM, nullptr, nullptr};
            pg8::gemm_phase(lds, gm, S, E); }
        else { const int tid = opaque_tid(); const float* pp = (const float*)(ws + WS_POSP);
            for (int o = (bx - 64) * 512 + tid; o < 2048; o += (G - 64) * 512) { const int q = o >> 9, f = o & 511; float acc = 0.f;
                for (int kc = 0; kc < 64; ++kc) acc += pp[((size_t)q * 64 + kc) * 512 + f];
                posb[o] = acc; } }
    }
    SEAM();
#pragma unroll 1
    for (int layer = 0; layer < 4; ++layer) {
        const int j = layer >> 1; const bool even = (layer & 1) == 0;
        unsigned char* wsl = opqp(ws); unsigned char* Zl = wsl + WS_Z; bf16_t* XNl = (bf16_t*)(wsl + WS_XN); bf16_t* YBl = (bf16_t*)(wsl + WS_YB); float* posbl = (float*)(wsl + WS_POSB);
        const float* hin = (layer == 0) ? a.in[0] : a.out;
        float* RSS = (float*)(wsl + WS_ROWSS); bf16_t* PPl = (bf16_t*)(wsl + WS_PP);
        bf16_t* hc = (layer & 1) ? (bf16_t*)(wsl + WS_H2) : XNl;
        bf16_t* hn = (layer & 1) ? XNl : (bf16_t*)(wsl + WS_H2);
        const bf16_t* Ain = hc;
        if (EN(3) && ON()) {
            if (even) { pg8::Gemm gm{Ain, (const bf16_t*)(wsl + WS_WIN + j * SZ_WIN), T_TOK, AB_IN, DM, DM, DM};
                pg8::StaticOrder S; S.init(T_TOK, AB_IN, opq(G), opq(bx)); EpiBf16<0> E{(bf16_t*)Zl, AB_IN, nullptr, RSS + (size_t)(layer * 3) * T_TOK * 32}; pg8::gemm_phase(lds, gm, S, E); }
            else { pg8::Gemm gm{Ain, (const bf16_t*)(wsl + WS_CIN + j * SZ_CIN), T_TOK, C_INP, DM, DM, DM};
                pg8::StaticOrder S; S.init(T_TOK, C_INP, opq(G), opq(bx));
                EpiNsa E{(bf16_t*)(Zl + Z_Q), (bf16_t*)(Zl + Z_KC), (bf16_t*)(Zl + Z_VC), (bf16_t*)(Zl + Z_KS), (bf16_t*)(Zl + Z_VST), (bf16_t*)(Zl + Z_KW), (bf16_t*)(Zl + Z_VWT), (float*)(Zl + Z_GL), RSS + (size_t)(layer * 3) * T_TOK * 32};
                pg8::gemm_phase(lds, gm, S, E); }
        }
        SEAM();
        if (even) {
            if (EN(4) && ON()) {
#ifndef NO_LRU
#pragma unroll 1
                for (int rp = 0; rp < REP_LRU; ++rp)
                for (int it = opq(bx); it < 256; it += G)
                    lru_item(lds, it, (const bf16_t*)Zl, a.in[4] + (size_t)j * 4096, a.in[5] + j * 1024, (const bf16_t*)(wsl + WS_WR + j * SZ_WRI), (const bf16_t*)(wsl + WS_WI + j * SZ_WRI),
                             a.in[7] + j * 1024, a.in[9] + j * 1024, a.in[10] + j * 1024, YBl);
#endif
                for (int it = opq(bx); it < 256; it += G) pool_item(it, (const bf16_t*)Zl, a.in[12] + j * 1024, YBl);
            }
            SEAM();
        } else {
            if (EN(5) && ON()) {
                if (bx < 64) { const int kv = bx >> 5;
                    pg8::Gemm gm{(const bf16_t*)(Zl + (kv ? Z_VC : Z_KC)), (const bf16_t*)(wsl + (kv ? WS_W1V : WS_W1K) + j * SZ_W1), 4096, 512, 4096, 2048, 4096};
                    pg8::StaticOrder S; S.init(4096, 512, opq(G), opq(bx) & 31);
                    EpiBf16<2> E{(bf16_t*)(Zl + (kv ? Z_HIDV : Z_HIDK)), 512, posbl + (j * 2 + kv) * 512, nullptr}; pg8::gemm_phase(lds, gm, S, E); }
                else if (bx < 128) { pg8::Gemm gm{Ain, (const bf16_t*)(wsl + WS_WGL + (size_t)j * 256 * DM * 2), T_TOK, 256, DM, DM, DM};
                    pg8::StaticOrder S; S.init(T_TOK, 256, opq(G), opq(bx) - 64); EpiGates E{(float*)(Zl + Z_GL), RSS + (size_t)(layer * 3) * T_TOK * 32}; pg8::gemm_phase(lds, gm, S, E); }
                else { pg8::Gemm gp{(const bf16_t*)(wsl + WS_PB) + (size_t)layer * T_TOK * PLE, (const bf16_t*)(wsl + WS_WP + layer * SZ_WP), T_TOK, DM, PLE, PLE, PLE};
                    pg8::StaticOrder S2; S2.init(T_TOK, DM, 128, opq(bx) - 128); EpiBf16<0> E2{PPl, DM, nullptr, nullptr}; pg8::gemm_phase(lds, gp, S2, E2); }
            }
            SEAM();
            if (EN(6) && ON()) {
                if (bx < 16) { pg8::Gemm gm{(const bf16_t*)(Zl + Z_HIDK), (const bf16_t*)(wsl + WS_W2K + j * SZ_W2), 4096, 256, 512, 512, 512};
                    pg8::StaticOrder S; S.init(4096, 256, opq(G), opq(bx)); EpiCmp2<0> E{(bf16_t*)(Zl + Z_KCMP)}; pg8::gemm_phase(lds, gm, S, E); }
                else if (bx < 32) { pg8::Gemm gm{(const bf16_t*)(Zl + Z_HIDV), (const bf16_t*)(wsl + WS_W2V + j * SZ_W2), 4096, 256, 512, 512, 512};
                    pg8::StaticOrder S; S.init(4096, 256, opq(G), opq(bx) - 16); EpiCmp2<1> E{(bf16_t*)(Zl + Z_VCMPT)}; pg8::gemm_phase(lds, gm, S, E); }
            }
            SEAM();
            if (EN(7) && ON()) {
#pragma unroll 1
                for (int rp = 0; rp < REP_ATTN; ++rp)
                for (int it = opq(bx), r = 0; it < 1024; it += G, ++r) { const int c = it % 256, rr = it / 256; const int cp = (rr & 1) ? 255 - c : c;
                    const int tq = 63 - (rr * 16 + (cp >> 4)), bgi = cp & 15;
#ifndef NO_ATTN
                    nsa_item(lds, bgi >> 2, bgi & 3, tq, (const bf16_t*)(Zl + Z_Q), (const bf16_t*)(Zl + Z_KS), (const bf16_t*)(Zl + Z_VST), (const bf16_t*)(Zl + Z_KW), (const bf16_t*)(Zl + Z_VWT),
                             (const bf16_t*)(Zl + Z_KCMP), (const bf16_t*)(Zl + Z_VCMPT), (const float*)(Zl + Z_GL), YBl);
#endif
                }
                __syncthreads();
            }
            SEAM();
        }
        if (EN(8) && ON()) { pg8::Gemm gm{YBl, (const bf16_t*)(wsl + (even ? WS_WOUT : WS_COUT) + j * SZ_SQ), T_TOK, DM, DM, DM, DM};
            pg8::StaticOrder S; S.init(T_TOK, DM, opq(G), opq(bx)); EpiRes<0> E{hc, hc, nullptr, DM, RSS + (size_t)(layer * 3 + 1) * T_TOK * 32, nullptr}; pg8::gemm_phase(lds, gm, S, E);
            if (even) { pg8::Gemm gp{(const bf16_t*)(wsl + WS_PB) + (size_t)layer * T_TOK * PLE, (const bf16_t*)(wsl + WS_WP + layer * SZ_WP), T_TOK, DM, PLE, PLE, PLE};
              pg8::StaticOrder S2; S2.init(T_TOK, DM, opq(G), opq(bx)); EpiBf16<0> E2{PPl, DM, nullptr, nullptr}; pg8::gemm_phase(lds, gp, S2, E2); } }
        SEAM();
        if (EN(10) && ON())
#pragma unroll 1
        for (int rpu = 0; rpu < REP_UP; ++rpu) { pg8::Gemm gm{hc, (const bf16_t*)(wsl + WS_WUP + layer * SZ_UP), T_TOK, DFF, DM, DM, DM};
            pg8::StaticOrder S; S.init(T_TOK, DFF, opq(G), opq(bx)); EpiBf16<1> E{(bf16_t*)Zl, DFF, nullptr, RSS + (size_t)(layer * 3 + 1) * T_TOK * 32}; pg8::gemm_phase(lds, gm, S, E); }
        SEAM();
        if (EN(11) && ON()) { pg8::Gemm gm{(const bf16_t*)Zl, (const bf16_t*)(wsl + WS_WDN + layer * SZ_UP), T_TOK, DM, DFF, DFF, DFF};
            pg8::StaticOrder S; S.init(T_TOK, DM, opq(G), opq(bx)); EpiRes<0> E{hc, hc, nullptr, DM, RSS + (size_t)(layer * 3 + 2) * T_TOK * 32, nullptr}; pg8::gemm_phase(lds, gm, S, E); }
        SEAM();
        if (EN(13) && ON()) { pg8::Gemm gm{hc, (const bf16_t*)(wsl + WS_WG + layer * SZ_SQ), T_TOK, DM, DM, DM, DM};
            pg8::StaticOrder S; S.init(T_TOK, DM, opq(G), opq(bx)); EpiRes<1> E{hc, hn, PPl, DM, RSS + (size_t)(layer * 3 + 3) * T_TOK * 32, RSS + (size_t)(layer * 3 + 2) * T_TOK * 32}; pg8::gemm_phase(lds, gm, S, E); }
        SEAM();
    }
    if (EN(14) && ON()) rmsnorm_rows<true>((const float*)XN, a.in[28], nullptr, a.out, bx, NGW);
#undef ON
#undef SEAM
}
constexpr int N_PHASES = 1 + 2 * 9 + 2 * 11 + 1;

extern "C" void kernel_launch(void* const* d_in, const int* in_sizes, int n_in, void* d_out, int out_size, void* d_ws, size_t ws_size, hipStream_t stream) {
    static int grid = 0;
    if (grid == 0) {
        if (n_in != 29 || ws_size < WS_END) { fprintf(stderr, "kernel_launch: unexpected n_in %d / ws %zu (need %zu)\n", n_in, ws_size, (size_t)WS_END); grid = -1; return; }
        int dev = 0, cus = 0, per_cu = 0;
        hipGetDevice(&dev); hipDeviceGetAttribute(&cus, hipDeviceAttributeMultiprocessorCount, dev);
        if (hipFuncSetAttribute((const void*)fwd_kernel, hipFuncAttributeMaxDynamicSharedMemorySize, LDS_BYTES) != hipSuccess) { fprintf(stderr, "hipFuncSetAttribute failed\n"); grid = -1; return; }
        if (hipOccupancyMaxActiveBlocksPerMultiprocessor(&per_cu, (const void*)fwd_kernel, 512, LDS_BYTES) != hipSuccess || per_cu < 1) { fprintf(stderr, "occupancy query: %d\n", per_cu); per_cu = 1; }
        (void)hipGetLastError();
        grid = cus;
    }
    if (grid < 0) return;
    Args a{};
    for (int i = 0; i < 29; ++i) a.in[i] = (const float*)d_in[i];
    a.out = (float*)d_out; a.ws = (unsigned char*)d_ws;
#if MK_ONE_LAUNCH
    (void)hipMemsetAsync((unsigned char*)d_ws + WS_BAR, 0, XCD_BAR_WORDS * 4, stream);
    a.lo = 0; a.hi = 1 << 30; a.one = 1; a.pad = 0;
    void* args[] = {&a};
    hipError_t e = hipLaunchCooperativeKernel((const void*)fwd_kernel, dim3(grid), dim3(512), args, LDS_BYTES, stream);
    if (e != hipSuccess) fprintf(stderr, "cooperative launch failed: %s (grid %d)\n", hipGetErrorString(e), grid);
#else
    for (int p = 0; p < N_PHASES; ++p) { a.lo = p; a.hi = p + 1; a.one = 0; a.pad = 0;
        hipLaunchKernelGGL(fwd_kernel, dim3(grid), dim3(512), LDS_BYTES, stream, a); }
#endif
}
```

```cpp
#include <hip/hip_runtime.h>
#include <hip/hip_cooperative_groups.h>
#include <cstdio>
namespace cg = cooperative_groups;

#ifndef REP_ATTN
#define REP_ATTN 1
#endif
#ifndef REP_LRU
#define REP_LRU 1
#endif
#ifndef REP_P0
#define REP_P0 1
#endif
#ifndef REP_UP
#define REP_UP 1
#endif
#ifndef MK_ONE_LAUNCH
#define MK_ONE_LAUNCH 1
#endif

#define LAS __attribute__((address_space(3)))
typedef unsigned short bf16_t;
typedef short bf16x8 __attribute__((ext_vector_type(8)));
typedef float f32x4 __attribute__((ext_vector_type(4)));
typedef float f32x2 __attribute__((ext_vector_type(2)));
typedef unsigned u32x4 __attribute__((ext_vector_type(4)));
typedef unsigned u32x2 __attribute__((ext_vector_type(2)));

constexpr int T_TOK = 16384, DM = 2048, SEQ = 4096, NB = 4, DFF = 8192, PLE = 256;
constexpr int AB_IN = 3072, C_IN = 5168, C_INP = 5120;
constexpr float EPSV = 1e-6f;
constexpr float LOG2E = 1.4426950408889634f;

__device__ __forceinline__ unsigned f2bf(float f) { unsigned u = __builtin_bit_cast(unsigned, f); return (u + 0x7fffu + ((u >> 16) & 1u)) >> 16; }
__device__ __forceinline__ unsigned pk2(float lo, float hi) { unsigned r; asm volatile("v_cvt_pk_bf16_f32 %0, %1, %2" : "=v"(r) : "v"(lo), "v"(hi)); return r; }
__device__ __forceinline__ float bf2f(unsigned short b) { return __builtin_bit_cast(float, ((unsigned)b) << 16); }
__device__ __forceinline__ float bflo(unsigned w) { return __builtin_bit_cast(float, w << 16); }
__device__ __forceinline__ float bfhi(unsigned w) { return __builtin_bit_cast(float, w & 0xffff0000u); }
__device__ __forceinline__ float shx(float v, int lane, int o) { return __builtin_bit_cast(float, __builtin_amdgcn_ds_bpermute((lane ^ o) << 2, __builtin_bit_cast(int, v))); }
__device__ __forceinline__ float wave_sum(float v, int lane) {
#pragma unroll
    for (int o = 1; o < 64; o <<= 1) v += shx(v, lane, o);
    return v;
}
__device__ __forceinline__ float sigmoidf_(float x) { return __builtin_amdgcn_rcpf(1.0f + __expf(-x)); }
__device__ __forceinline__ float gelu_tanh(float x) {
    const float u = 0.7978845608028654f * (x + 0.044715f * x * x * x);
    const float e = __expf(2.0f * u);
    const float th = 1.0f - 2.0f * __builtin_amdgcn_rcpf(e + 1.0f);
    return 0.5f * x * (1.0f + th);
}

__device__ __forceinline__ unsigned char* opqp(unsigned char* p) { size_t z = 0; asm volatile("" : "+s"(z)); return p + z; }
__device__ __forceinline__ int opq(int v) { asm volatile("" : "+s"(v)); return v; }
__device__ __forceinline__ int opaque_tid() { int t = threadIdx.x; asm volatile("" : "+v"(t)); return t; }
namespace pg8 {
constexpr int BM = 256, BK = 64, HALF = 128, HTB = HALF * BK * 2, STAGE_BYTES = 8 * HTB, NXCD = 8, WGM = 8;
__host__ __device__ __forceinline__ int lds_byte(int r, int c) { const int st = (r >> 4) * 2 + (c >> 5), rr = r & 15, cc = c & 31, ob = rr * 64 + cc * 2; return st * 1024 + (ob ^ (((ob >> 9) & 1) << 5)); }
__host__ __device__ __forceinline__ void stage_rc(int b, int& R, int& C) { const int st = b / 1024, sb = b % 1024, swz = sb ^ (((sb >> 9) & 1) << 5); R = (st >> 1) * 16 + swz / 64; C = (st & 1) * 32 + (swz % 64) / 2; }
__host__ __device__ __forceinline__ int perm32(int rho) { const int n = rho >> 4, i = rho & 15; return 8 * (i >> 2) + 4 * n + (i & 3); }

struct Unit { int pm, pn; };
struct Gemm { const bf16_t* A; const bf16_t* Bt; int M, N, K, lda, ldb; };

struct StaticOrder {
    int nM, nN, nwg, G, c;
    __device__ void init(int M, int N, int G_, int c_) { nM = M / BM; nN = N / BM; nwg = nM * nN; G = G_; c = c_; }
    __device__ bool next(int i, Unit& u) const {
        const long L = (long)i * G + c; if (L >= nwg || c < 0) return false;
        int wgid = (int)L; { const int q = nwg / NXCD, r = nwg % NXCD, xcd = wgid % NXCD, off = wgid / NXCD; wgid = (xcd < r ? xcd * (q + 1) : r * (q + 1) + (xcd - r) * q) + off; }
        const int nig = WGM * nN, gid = wgid / nig, fm = gid * WGM, gsz = (nM - fm) < WGM ? (nM - fm) : WGM;
        u.pm = fm + ((wgid % nig) % gsz); u.pn = (wgid % nig) / gsz; return true;
    }
};

template <class Epi, class Sched>
__device__ __forceinline__ void gemm_phase(LAS unsigned char* lds, const Gemm g, const Sched& S, const Epi& E) {
    const int tid = opaque_tid(), wid = __builtin_amdgcn_readfirstlane(tid >> 6), lane = tid & 63, wr = wid >> 2, wc = wid & 3, fr = lane & 15, fq = lane >> 4;
    const int K = g.K, nt = K / BK;
    unsigned voffA[2], voffB[2];
#pragma unroll
    for (int i = 0; i < 2; ++i) { int R, C; stage_rc(tid * 16 + i * 8192, R, C); const int Rb = Epi::PERM ? ((R & ~31) + perm32(R & 31)) : R;
        voffA[i] = (unsigned)(R * g.lda + C) * 2u; voffB[i] = (unsigned)(Rb * g.ldb + C) * 2u; }
    const size_t kstep = (size_t)(BK * 2);
    const size_t hstepA = (size_t)HALF * g.lda * 2, hstepB = (size_t)HALF * g.ldb * 2;
    const size_t tstepA = 2 * hstepA, tstepB = 2 * hstepB;
    const unsigned ldsw = (unsigned)wid * 1024u;
    const int aoff = lds_byte(wr * 64 + fr, fq * 8), boff = lds_byte(wc * 32 + fr, fq * 8);
#define PG8_SA(b, h) (((b) * 2 + (h)) * HTB)
#define PG8_SB(b, h) ((4 + (b) * 2 + (h)) * HTB)
#define PG8_STAGE(bufoff, gbase, voff) do { _Pragma("unroll") for (int _i = 0; _i < 2; ++_i) \
        __builtin_amdgcn_global_load_lds((const unsigned*)((const char*)(gbase) + (voff)[_i]), (LAS unsigned*)(lds + (bufoff) + ldsw + _i * 8192), 16, 0, 0); } while (0)
#define PG8_LDA(dst, b, h) do { _Pragma("unroll") for (int m = 0; m < 4; ++m) _Pragma("unroll") for (int k = 0; k < 2; ++k) dst[m][k] = *(const LAS bf16x8*)(lds + PG8_SA(b, h) + aoff + m * 2048 + k * 1024); } while (0)
#define PG8_LDB(dst, b, h) do { _Pragma("unroll") for (int n = 0; n < 2; ++n) _Pragma("unroll") for (int k = 0; k < 2; ++k) dst[n][k] = *(const LAS bf16x8*)(lds + PG8_SB(b, h) + boff + n * 2048 + k * 1024); } while (0)
#define PG8_MMA(ai, bj, At, Bt) do { __builtin_amdgcn_s_setprio(1); _Pragma("unroll") for (int m = 0; m < 4; ++m) _Pragma("unroll") for (int n = 0; n < 2; ++n) _Pragma("unroll") for (int k = 0; k < 2; ++k) \
        acc[ai][bj][m][n] = __builtin_amdgcn_mfma_f32_16x16x32_bf16(Bt[n][k], At[m][k], acc[ai][bj][m][n], 0, 0, 0); __builtin_amdgcn_s_setprio(0); } while (0)
#define PG8_WAIT_V(n) asm volatile("s_waitcnt vmcnt(" #n ")" ::: "memory")
#define PG8_WAIT_L(n) asm volatile("s_waitcnt lgkmcnt(" #n ")" ::: "memory")
#define PG8_BAR __builtin_amdgcn_s_barrier()
#define PG8_SCHED __builtin_amdgcn_sched_barrier(0)
    Unit cur, nxt; int ui = 0;
    if (!S.next(0, cur)) return;
    f32x4 acc[2][2][4][2];
#pragma unroll
    for (int a = 0; a < 2; ++a)
#pragma unroll
        for (int b = 0; b < 2; ++b)
#pragma unroll
            for (int m = 0; m < 4; ++m)
#pragma unroll
                for (int n = 0; n < 2; ++n) acc[a][b][m][n] = (f32x4){0.f, 0.f, 0.f, 0.f};
    bf16x8 At[4][2], B0[2][2], B1[2][2];
    const char* cA = (const char*)g.A + (size_t)cur.pm * tstepA; const char* cB = (const char*)g.Bt + (size_t)cur.pn * tstepB;
    PG8_STAGE(PG8_SB(0, 0), cB, voffB); PG8_STAGE(PG8_SB(0, 1), cB + hstepB, voffB); PG8_STAGE(PG8_SA(0, 0), cA, voffA); PG8_STAGE(PG8_SA(0, 1), cA + hstepA, voffA);
    if (wr == 1) PG8_BAR;
    PG8_WAIT_V(2); PG8_BAR;
    PG8_STAGE(PG8_SB(1, 0), cB + kstep, voffB); PG8_STAGE(PG8_SA(1, 0), cA + kstep, voffA); PG8_STAGE(PG8_SB(1, 1), cB + hstepB + kstep, voffB);
    PG8_WAIT_V(6); PG8_BAR;
    for (;;) {
        const bool has_next = S.next(ui + 1, nxt);
        const char* nA = has_next ? (const char*)g.A + (size_t)nxt.pm * tstepA : cA; const char* nB = has_next ? (const char*)g.Bt + (size_t)nxt.pn * tstepB : cB;
        for (int t = 0; t < nt; t += 2) {
            const bool last = (t == nt - 2);
            const char* a1 = cA + (size_t)(t + 1) * kstep;
            const char* a2 = last ? nA : cA + (size_t)(t + 2) * kstep; const char* b2 = last ? nB : cB + (size_t)(t + 2) * kstep;
            const char* a3 = a2 + kstep; const char* b3 = b2 + kstep;
            PG8_LDB(B0, 0, 0); PG8_LDB(B1, 0, 1); PG8_SCHED; PG8_LDA(At, 0, 0); PG8_STAGE(PG8_SA(1, 1), a1 + hstepA, voffA);
            PG8_WAIT_V(8); PG8_WAIT_L(0); PG8_BAR; PG8_MMA(0, 0, At, B0); PG8_MMA(0, 1, At, B1); PG8_BAR; PG8_SCHED;
            PG8_LDA(At, 0, 1); PG8_STAGE(PG8_SB(0, 0), b2, voffB); PG8_STAGE(PG8_SB(0, 1), b2 + hstepB, voffB); PG8_STAGE(PG8_SA(0, 0), a2, voffA);
            PG8_WAIT_V(8); PG8_WAIT_L(0); PG8_BAR; PG8_MMA(1, 0, At, B0); PG8_MMA(1, 1, At, B1); PG8_BAR; PG8_SCHED;
            PG8_LDB(B0, 1, 0); PG8_LDB(B1, 1, 1); PG8_SCHED; PG8_LDA(At, 1, 0); PG8_STAGE(PG8_SA(0, 1), a2 + hstepA, voffA);
            PG8_WAIT_V(8); PG8_WAIT_L(0); PG8_BAR; PG8_MMA(0, 0, At, B0); PG8_MMA(0, 1, At, B1); PG8_BAR; PG8_SCHED;
            PG8_LDA(At, 1, 1); PG8_STAGE(PG8_SB(1, 0), b3, voffB); PG8_STAGE(PG8_SB(1, 1), b3 + hstepB, voffB); PG8_STAGE(PG8_SA(1, 0), a3, voffA);
            PG8_WAIT_V(8); PG8_WAIT_L(0); PG8_BAR; PG8_MMA(1, 0, At, B0); PG8_MMA(1, 1, At, B1); PG8_BAR; PG8_SCHED;
        }
        if (wr == 0) PG8_BAR;
        { const int tl = opaque_tid() & 63; E(acc, cur, wr, wc, tl & 15, tl >> 4); }
        if (!has_next) break;
#pragma unroll
        for (int a = 0; a < 2; ++a)
#pragma unroll
            for (int b = 0; b < 2; ++b)
#pragma unroll
                for (int m = 0; m < 4; ++m)
#pragma unroll
                    for (int n = 0; n < 2; ++n) acc[a][b][m][n] = (f32x4){0.f, 0.f, 0.f, 0.f};
        cur = nxt; cA = nA; cB = nB; ++ui;
        if (wr == 1) PG8_BAR;
    }
    PG8_WAIT_V(0);
    PG8_BAR;
#undef PG8_SA
#undef PG8_SB
#undef PG8_STAGE
#undef PG8_LDA
#undef PG8_LDB
#undef PG8_MMA
#undef PG8_WAIT_V
#undef PG8_WAIT_L
#undef PG8_BAR
#undef PG8_SCHED
}
}
using pg8::Unit; using pg8::HALF; using pg8::BM;


#define XB_TMO      128
#define XB_XCNT(j)  (256  + 64 * (j))
#define XB_XSUB(j)  (1280 + 64 * (j))
#define XB_XGEN(j)  (2304 + 64 * (j))
#define XB_TOP      3328
#define XB_TOPGEN   3392
#define XCD_BAR_WORDS 3456
#define XB_SPIN_CAP (1u << 18)
__device__ __forceinline__ unsigned xb_ld(unsigned* p)              { return __hip_atomic_load(p, __ATOMIC_RELAXED, __HIP_MEMORY_SCOPE_AGENT); }
__device__ __forceinline__ unsigned xb_add(unsigned* p, unsigned v) { return __hip_atomic_fetch_add(p, v, __ATOMIC_RELAXED, __HIP_MEMORY_SCOPE_AGENT); }
__device__ __forceinline__ unsigned xb_xcc_id() { return (unsigned)__builtin_amdgcn_s_getreg((3 << 11) | 20) & 0xFu; }
#define XB_SPIN(cond, bar) do { unsigned _sp = 0; while (cond) { __builtin_amdgcn_s_sleep(1); \
    if ((++_sp & 255u) == 0u) { if (xb_ld(&(bar)[XB_TMO])) break; if (_sp > XB_SPIN_CAP) { atomicAdd(&(bar)[XB_TMO], 1u); break; } } } } while (0)
struct XcdBarrier { unsigned* bar; unsigned x; volatile LAS unsigned* st; };
__device__ __forceinline__ XcdBarrier xcd_barrier_post(unsigned* bar, volatile LAS unsigned* st) {
    XcdBarrier b; b.bar = bar; b.x = xb_xcc_id(); b.st = st;
    if (threadIdx.x == 0) (void)xb_add(&bar[XB_XCNT(b.x)], 1u);
    return b;
}
__device__ __forceinline__ void xcd_barrier_complete(unsigned* bar, unsigned x, unsigned& nloc, unsigned& nx) {
    const unsigned G = gridDim.x * gridDim.y * gridDim.z;
    unsigned sum, cnt, mine, sp = 0u;
    for (;;) {
        sum = 0u; cnt = 0u; mine = 0u;
#pragma unroll
        for (unsigned j = 0; j < 16; ++j) { const unsigned c = xb_ld(&bar[XB_XCNT(j)]); sum += c; cnt += (c > 0u) ? 1u : 0u; mine = (j == x) ? c : mine; }
        if (sum == G) break;
        __builtin_amdgcn_s_sleep(1);
        if ((++sp & 255u) == 0u) { if (xb_ld(&bar[XB_TMO])) break; if (sp > XB_SPIN_CAP) { atomicAdd(&bar[XB_TMO], 1u); break; } }
    }
    nloc = mine > 0u ? mine : 1u; nx = cnt > 0u ? cnt : 1u;
}
__device__ __forceinline__ void xcd_barrier(const XcdBarrier& b) {
    asm volatile("s_waitcnt vmcnt(0)" ::: "memory");
    __syncthreads();
    if (threadIdx.x == 0) {
        unsigned* bar = b.bar;
        __builtin_amdgcn_s_waitcnt(0);
        unsigned nloc = b.st[0], nx = b.st[1];
        if (nloc == 0u) { xcd_barrier_complete(bar, b.x, nloc, nx); b.st[0] = nloc; b.st[1] = nx; }
        const unsigned old = xb_add(&bar[XB_XSUB(b.x)], 1u);
        const unsigned gen = old / nloc;
        if (old + 1u == (gen + 1u) * nloc) {
            __builtin_amdgcn_fence(__ATOMIC_RELEASE, "agent");
            asm volatile("s_waitcnt vmcnt(0)" ::: "memory");
            const unsigned og = xb_add(&bar[XB_TOP], 1u);
            const unsigned tg = og / nx;
            if (og + 1u == (tg + 1u) * nx) xb_add(&bar[XB_TOPGEN], 1u);
            else XB_SPIN(xb_ld(&bar[XB_TOPGEN]) == tg, bar);
            __builtin_amdgcn_fence(__ATOMIC_ACQUIRE, "agent");
            xb_add(&bar[XB_XGEN(b.x)], 1u);
            asm volatile("s_waitcnt vmcnt(0)" ::: "memory");
        } else {
            XB_SPIN(xb_ld(&bar[XB_XGEN(b.x)]) == gen, bar);
            __builtin_amdgcn_fence(__ATOMIC_ACQUIRE, "agent");
            asm volatile("s_waitcnt vmcnt(0)" ::: "memory");
        }
    }
    __syncthreads();
}

__device__ __forceinline__ float row_rstd(const float* rp, int row, int fq, int lane) {
    const f32x4 a = *(const f32x4*)(rp + (size_t)row * 32 + fq * 8), b = *(const f32x4*)(rp + (size_t)row * 32 + fq * 8 + 4);
    float s = ((a[0] + a[1]) + (a[2] + a[3])) + ((b[0] + b[1]) + (b[2] + b[3]));
    s += shx(s, lane, 16); s += shx(s, lane, 32);
    return rsqrtf(s * (1.f / DM) + EPSV);
}
template <int ACT  > struct EpiBf16 {
    static constexpr bool PERM = true;
    bf16_t* O; int ldc; const float* bias; const float* rss;
    __device__ __forceinline__ void operator()(const f32x4 (&acc)[2][2][4][2], const Unit& u, int wr, int wc, int fr, int fq) const {
        const int row0 = u.pm * BM + wr * 64 + fr, col0 = u.pn * BM + wc * 32 + 8 * fq;
        f32x4 bv[2][2];
#pragma unroll
        for (int bj = 0; bj < 2; ++bj)
#pragma unroll
            for (int n = 0; n < 2; ++n) bv[bj][n] = (ACT == 2) ? *(const f32x4*)(bias + col0 + bj * HALF + 4 * n) : (f32x4){0.f, 0.f, 0.f, 0.f};
        float rsv[2][4];
#pragma unroll
        for (int ai = 0; ai < 2; ++ai)
#pragma unroll
            for (int m = 0; m < 4; ++m) rsv[ai][m] = rss ? row_rstd(rss, row0 + ai * HALF + m * 16, fq, fq * 16 + fr) : 1.f;
        asm volatile("" ::: "memory");
#pragma unroll
        for (int ai = 0; ai < 2; ++ai)
#pragma unroll
            for (int m = 0; m < 4; ++m) { bf16_t* rowp = O + (size_t)(row0 + ai * HALF + m * 16) * ldc + col0;
                const float rs = rsv[ai][m];
#pragma unroll
                for (int bj = 0; bj < 2; ++bj) { f32x4 v0 = acc[ai][bj][m][0] * rs + bv[bj][0], v1 = acc[ai][bj][m][1] * rs + bv[bj][1];
                    if (ACT == 1) {
#pragma unroll
                        for (int j = 0; j < 4; ++j) { const float a = fmaxf(v0[j], 0.f), b = fmaxf(v1[j], 0.f); v0[j] = a * a; v1[j] = b * b; } }
                    if (ACT == 2) {
#pragma unroll
                        for (int j = 0; j < 4; ++j) { v0[j] = gelu_tanh(v0[j]); v1[j] = gelu_tanh(v1[j]); } }
                    u32x4 w; w.x = pk2(v0[0], v0[1]); w.y = pk2(v0[2], v0[3]); w.z = pk2(v1[0], v1[1]); w.w = pk2(v1[2], v1[3]);
                    *(u32x4*)(rowp + bj * HALF) = w; } }
    }
};
template <int MODE> struct EpiRes {
    static constexpr bool PERM = true;
    const bf16_t* base; bf16_t* out; const bf16_t* pp; int ldc; float* rss_out; const float* rss_in;
    __device__ __forceinline__ void operator()(const f32x4 (&acc)[2][2][4][2], const Unit& u, int wr, int wc, int fr, int fq) const {
        const int row0 = u.pm * BM + wr * 64 + fr, col0 = u.pn * BM + wc * 32 + 8 * fq; const int lane = fq * 16 + fr;
        float rinv[8];
#pragma unroll
        for (int g = 0; g < 8; ++g) rinv[g] = (MODE == 1) ? row_rstd(rss_in, row0 + (g >> 2) * HALF + (g & 3) * 16, fq, lane) : 1.f;
        u32x4 bc[2], pc[2];
#pragma unroll
        for (int bj = 0; bj < 2; ++bj) { const size_t o2 = (size_t)row0 * ldc + col0 + bj * HALF; bc[bj] = *(const u32x4*)(base + o2); if (MODE == 1) pc[bj] = *(const u32x4*)(pp + o2); }
#pragma unroll
        for (int g = 0; g < 8; ++g) { const int ai = g >> 2, m = g & 3; const int row = row0 + ai * HALF + m * 16; const size_t off = (size_t)row * ldc + col0;
            f32x4 av[2][2];
#pragma unroll
            for (int bj = 0; bj < 2; ++bj) { f32x4 a0 = acc[ai][bj][m][0], a1 = acc[ai][bj][m][1];
                const f32x4 b0 = (f32x4){bflo(bc[bj].x), bfhi(bc[bj].x), bflo(bc[bj].y), bfhi(bc[bj].y)}, b1 = (f32x4){bflo(bc[bj].z), bfhi(bc[bj].z), bflo(bc[bj].w), bfhi(bc[bj].w)};
                if (MODE == 0) { a0 = a0 + b0; a1 = a1 + b1; }
                if (MODE == 1) { const f32x4 p0 = (f32x4){bflo(pc[bj].x), bfhi(pc[bj].x), bflo(pc[bj].y), bfhi(pc[bj].y)}, p1 = (f32x4){bflo(pc[bj].z), bfhi(pc[bj].z), bflo(pc[bj].w), bfhi(pc[bj].w)};
#pragma unroll
                    for (int j = 0; j < 4; ++j) { a0[j] = b0[j] + sigmoidf_(a0[j] * rinv[g]) * p0[j]; a1[j] = b1[j] + sigmoidf_(a1[j] * rinv[g]) * p1[j]; } }
                av[bj][0] = a0; av[bj][1] = a1; }
            asm volatile("" : "+v"(av[0][0]), "+v"(av[0][1]), "+v"(av[1][0]), "+v"(av[1][1]));
            if (g < 7) { const int rown = row0 + ((g + 1) >> 2) * HALF + ((g + 1) & 3) * 16;
#pragma unroll
                for (int bj = 0; bj < 2; ++bj) { const size_t o2 = (size_t)rown * ldc + col0 + bj * HALF; bc[bj] = *(const u32x4*)(base + o2); if (MODE == 1) pc[bj] = *(const u32x4*)(pp + o2); } }
            asm volatile("" ::: "memory");
            float ss = 0.f;
#pragma unroll
            for (int bj = 0; bj < 2; ++bj) { const f32x4 a0 = av[bj][0], a1 = av[bj][1];
                ss += ((a0[0] * a0[0] + a0[1] * a0[1]) + (a0[2] * a0[2] + a0[3] * a0[3])) + ((a1[0] * a1[0] + a1[1] * a1[1]) + (a1[2] * a1[2] + a1[3] * a1[3]));
                u32x4 w; w.x = pk2(a0[0], a0[1]); w.y = pk2(a0[2], a0[3]); w.z = pk2(a1[0], a1[1]); w.w = pk2(a1[2], a1[3]); *(u32x4*)(out + off + bj * HALF) = w; }
            ss += shx(ss, lane, 16); ss += shx(ss, lane, 32); if (fq == 0) rss_out[(size_t)row * 32 + u.pn * 4 + wc] = ss;
        }
    }
};
struct EpiNsa {
    static constexpr bool PERM = true;
    bf16_t *Q, *KC, *VC, *KS, *VST, *KW, *VWT; float* GL; const float* rss;
    __device__ __forceinline__ void operator()(const f32x4 (&acc)[2][2][4][2], const Unit& u, int wr, int wc, int fr, int fq) const {
        const int row0 = u.pm * BM + wr * 64 + fr; const int pn = u.pn;
        float rsv[2][4];
#pragma unroll
        for (int ai = 0; ai < 2; ++ai)
#pragma unroll
            for (int m = 0; m < 4; ++m) rsv[ai][m] = row_rstd(rss, row0 + ai * HALF + m * 16, fq, fq * 16 + fr);
        asm volatile("" ::: "memory");
#pragma unroll
        for (int ai = 0; ai < 2; ++ai)
#pragma unroll
            for (int m = 0; m < 4; ++m) { const int row = row0 + ai * HALF + m * 16; const int b = row >> 12, s = row & 4095;
                const float rs = rsv[ai][m];
#pragma unroll
                for (int bj = 0; bj < 2; ++bj) { const f32x4 v0 = acc[ai][bj][m][0] * rs, v1 = acc[ai][bj][m][1] * rs;
                    const int cl = bj * HALF + wc * 32 + 8 * fq;
                    if (pn < 8) { u32x4 w; w.x = pk2(v0[0], v0[1]); w.y = pk2(v0[2], v0[3]); w.z = pk2(v1[0], v1[1]); w.w = pk2(v1[2], v1[3]);
                        *(u32x4*)(Q + (size_t)row * 2048 + pn * 256 + cl) = w; }
                    else { const int k = (pn - 8) >> 1; const int c = ((pn - 8) & 1) * 256 + cl; const int g = c >> 7, d = c & 127;
                        if (k == 3 || k == 5) { bf16_t* dst = (k == 3 ? VST : VWT) + ((size_t)((b * 4 + g) * 128 + d)) * 4096 + s;
#pragma unroll
                            for (int j = 0; j < 4; ++j) { dst[(size_t)j * 4096] = (bf16_t)f2bf(v0[j]); dst[(size_t)(4 + j) * 4096] = (bf16_t)f2bf(v1[j]); } }
                        else { bf16_t* dst = (k == 0 ? KC : k == 1 ? VC : k == 2 ? KS : KW) + ((size_t)((b * 4 + g) * 4096 + s)) * 128 + d;
                            u32x4 w; w.x = pk2(v0[0], v0[1]); w.y = pk2(v0[2], v0[3]); w.z = pk2(v1[0], v1[1]); w.w = pk2(v1[2], v1[3]);
                            *(u32x4*)dst = w; } }
 } }
    }
};
struct EpiGates {
    static constexpr bool PERM = true;
    float* GL; const float* rss;
    __device__ __forceinline__ void operator()(const f32x4 (&acc)[2][2][4][2], const Unit& u, int wr, int wc, int fr, int fq) const {
        const int row0 = u.pm * BM + wr * 64 + fr; const int cl = wc * 32 + 8 * fq;
        float rsv[2][4];
#pragma unroll
        for (int ai = 0; ai < 2; ++ai)
#pragma unroll
            for (int m = 0; m < 4; ++m) rsv[ai][m] = row_rstd(rss, row0 + ai * HALF + m * 16, fq, fq * 16 + fr);
        if (cl < 48) {
#pragma unroll
            for (int ai = 0; ai < 2; ++ai)
#pragma unroll
                for (int m = 0; m < 4; ++m) { const int row = row0 + ai * HALF + m * 16; const float rs = rsv[ai][m];
                    const f32x4 v0 = acc[ai][0][m][0] * rs, v1 = acc[ai][0][m][1] * rs; f32x4 a, c2;
#pragma unroll
                    for (int j = 0; j < 4; ++j) { a[j] = sigmoidf_(v0[j]); c2[j] = sigmoidf_(v1[j]); }
                    float* dst = GL + (size_t)row * 48 + cl; *(f32x4*)dst = a; *(f32x4*)(dst + 4) = c2; } }
    }
};
template <int TR> struct EpiCmp2 {
    static constexpr bool PERM = true;
    bf16_t* O;
    __device__ __forceinline__ void operator()(const f32x4 (&acc)[2][2][4][2], const Unit& u, int wr, int wc, int fr, int fq) const {
        const int row0 = u.pm * BM + wr * 64 + fr; const int cl = wc * 32 + 8 * fq;
#pragma unroll
        for (int ai = 0; ai < 2; ++ai)
#pragma unroll
            for (int m = 0; m < 4; ++m) { const int row = row0 + ai * HALF + m * 16; const f32x4 v0 = acc[ai][0][m][0], v1 = acc[ai][0][m][1];
                if (TR == 0) { u32x4 w; w.x = pk2(v0[0], v0[1]); w.y = pk2(v0[2], v0[3]); w.z = pk2(v1[0], v1[1]); w.w = pk2(v1[2], v1[3]);
                    *(u32x4*)(O + (size_t)row * 128 + cl) = w; }
                else { bf16_t* dst = O + ((size_t)((row >> 8) * 128 + cl)) * 256 + (row & 255);
#pragma unroll
                    for (int j = 0; j < 4; ++j) { dst[(size_t)j * 256] = (bf16_t)f2bf(v0[j]); dst[(size_t)(4 + j) * 256] = (bf16_t)f2bf(v1[j]); } } }
    }
};

constexpr size_t al256(size_t x) { return (x + 255) & ~(size_t)255; }
constexpr size_t SZ_WIN = (size_t)AB_IN * DM * 2, SZ_SQ = (size_t)DM * DM * 2, SZ_CIN = (size_t)C_INP * DM * 2, SZ_W1 = (size_t)512 * 4096 * 2, SZ_W2 = (size_t)256 * 512 * 2;
constexpr size_t SZ_UP = (size_t)DFF * DM * 2, SZ_WP = (size_t)DM * PLE * 2, SZ_WRI = (size_t)16 * 64 * 64 * 2, SZ_POOLT = (size_t)4 * 256 * 256 * 2, SZ_WU = (size_t)DM * 1024 * 2;
constexpr size_t WS_WIN = 0;
constexpr size_t WS_WOUT = WS_WIN + 2 * SZ_WIN;
constexpr size_t WS_CIN = WS_WOUT + 2 * SZ_SQ;
constexpr size_t WS_COUT = WS_CIN + 2 * SZ_CIN;
constexpr size_t WS_W1K = WS_COUT + 2 * SZ_SQ;
constexpr size_t WS_W1V = WS_W1K + 2 * SZ_W1;
constexpr size_t WS_W2K = WS_W1V + 2 * SZ_W1;
constexpr size_t WS_W2V = WS_W2K + 2 * SZ_W2;
constexpr size_t WS_WUP = WS_W2V + 2 * SZ_W2;
constexpr size_t WS_WDN = WS_WUP + 4 * SZ_UP;
constexpr size_t WS_WG = WS_WDN + 4 * SZ_UP;
constexpr size_t WS_WP = WS_WG + 4 * SZ_SQ;
constexpr size_t WS_WR = WS_WP + 4 * SZ_WP;
constexpr size_t WS_WI = WS_WR + 2 * SZ_WRI;
constexpr size_t WS_POOLT = WS_WI + 2 * SZ_WRI;
constexpr size_t WS_WU = WS_POOLT + 2 * SZ_POOLT;
constexpr size_t WS_PB = WS_WU + 2 * SZ_WU;
constexpr size_t WS_POSB = WS_PB + (size_t)4 * T_TOK * PLE * 2;
constexpr size_t WS_XN = WS_POSB + 8192;
constexpr size_t WS_YB = WS_XN + (size_t)T_TOK * DM * 2;
constexpr size_t WS_Z = WS_YB + (size_t)T_TOK * DM * 2;
constexpr size_t SZ_KV = (size_t)16 * 4096 * 128 * 2;
constexpr size_t Z_Q = 0, Z_KC = (size_t)T_TOK * DM * 2, Z_VC = Z_KC + SZ_KV, Z_KS = Z_VC + SZ_KV, Z_VST = Z_KS + SZ_KV, Z_KW = Z_VST + SZ_KV, Z_VWT = Z_KW + SZ_KV;
constexpr size_t Z_GL = Z_VWT + SZ_KV, Z_HIDK = Z_GL + (size_t)T_TOK * 48 * 4, Z_HIDV = Z_HIDK + (size_t)4096 * 512 * 2, Z_KCMP = Z_HIDV + (size_t)4096 * 512 * 2, Z_VCMPT = Z_KCMP + (size_t)4096 * 128 * 2;
constexpr size_t WS_BAR = WS_Z + (size_t)T_TOK * DFF * 2;
constexpr size_t WS_ROWSS = WS_BAR + XCD_BAR_WORDS * 4 + 256;
constexpr size_t WS_PP = WS_ROWSS + (size_t)13 * T_TOK * 32 * 4;
constexpr size_t WS_POSP = WS_PP + (size_t)T_TOK * DM * 2;
constexpr size_t WS_WGL = WS_POSP + (size_t)4 * 64 * 512 * 4;
constexpr size_t WS_H2 = WS_WGL + (size_t)2 * 256 * DM * 2;
constexpr size_t WS_END = WS_H2 + (size_t)T_TOK * DM * 2;
static_assert(Z_VCMPT + 4096 * 128 * 2 <= (size_t)T_TOK * DFF * 2, "z region");
static_assert(WS_END <= (size_t)1 << 30, "workspace");
constexpr int LDS_BYTES = 147456;

struct Args { const float* in[29]; float* out; unsigned char* ws; int lo, hi, one, pad; };

__device__ __forceinline__ void titem_load(float (&v)[64], const float* W, int N, int ldw, int item, int lane) {
    const int nblk = (N + 63) / 64, kb = item / nblk, nb = item % nblk, k0 = 64 * kb, n0 = 64 * nb;
    const int nn = n0 + lane; const bool ok = nn < N;
    const float* p = W + (size_t)k0 * ldw + nn;
#pragma unroll
    for (int i = 0; i < 64; ++i) v[i] = ok ? p[(size_t)i * ldw] : 0.f;
}
__device__ __forceinline__ void titem_store(const float (&v)[64], int N, bf16_t* WT, int ldt, LAS float* scr, int item, int lane, const float* gk) {
    const int nblk = (N + 63) / 64, kb = item / nblk, nb = item % nblk, k0 = 64 * kb, n0 = 64 * nb;
#pragma unroll
    for (int i = 0; i < 64; ++i) scr[i * 65 + lane] = v[i];
    asm volatile("s_waitcnt lgkmcnt(0)" ::: "memory");
    const int c = lane & 7;
    f32x4 g0 = (f32x4){1.f, 1.f, 1.f, 1.f}, g1 = g0; if (gk) { g0 = *(const f32x4*)(gk + k0 + 8 * c); g1 = *(const f32x4*)(gk + k0 + 8 * c + 4); }
#pragma unroll
    for (int j = 0; j < 8; ++j) { const int n = (lane >> 3) + 8 * j; const LAS float* s = scr + (8 * c) * 65 + n;
        u32x4 o; o.x = pk2(s[0 * 65] * g0[0], s[1 * 65] * g0[1]); o.y = pk2(s[2 * 65] * g0[2], s[3 * 65] * g0[3]); o.z = pk2(s[4 * 65] * g1[0], s[5 * 65] * g1[1]); o.w = pk2(s[6 * 65] * g1[2], s[7 * 65] * g1[3]);
        if (n0 + n < N) *(u32x4*)(WT + (size_t)(n0 + n) * ldt + k0 + 8 * c) = o; }
    asm volatile("s_waitcnt lgkmcnt(0)" ::: "memory");
}
__device__ __forceinline__ void conv_mat(const float* W, int K, int N, int ldw, bf16_t* WT, int ldt, LAS float* scr, int gw, int NGW, int lane, int& rot, const float* gk = nullptr) {
    const int nitems = (K / 64) * ((N + 63) / 64);
    int it = gw - rot; if (it < 0) it += NGW;
    rot = (rot + nitems) % NGW;
    if (it >= nitems) return;
    float va[64], vb[64];
    titem_load(va, W, N, ldw, it, lane);
    for (;;) {
        const int n1 = it + NGW; if (n1 < nitems) titem_load(vb, W, N, ldw, n1, lane);
        titem_store(va, N, WT, ldt, scr, it, lane, gk);
        if (n1 >= nitems) break;
        const int n2 = n1 + NGW; if (n2 < nitems) titem_load(va, W, N, ldw, n2, lane);
        titem_store(vb, N, WT, ldt, scr, n1, lane, gk);
        if (n2 >= nitems) break;
        it = n2;
    }
}
__device__ __forceinline__ void conv_plain(const float* src, int rows, int ncols, int lds_, bf16_t* dst, int ldd, int gt, int NGT, const float* gk = nullptr) {
    const unsigned cpr = (unsigned)ncols / 8u; const unsigned total = (unsigned)rows * cpr;
    for (unsigned i = (unsigned)gt; i < total; i += (unsigned)NGT) { const int r = (int)(i / cpr), c = (int)(i % cpr) * 8;
        f32x4 a = *(const f32x4*)(src + (size_t)r * lds_ + c), b = *(const f32x4*)(src + (size_t)r * lds_ + c + 4);
        if (gk) { const float gg = gk[r]; a = a * gg; b = b * gg; }
        u32x4 o; o.x = f2bf(a[0]) | (f2bf(a[1]) << 16); o.y = f2bf(a[2]) | (f2bf(a[3]) << 16); o.z = f2bf(b[0]) | (f2bf(b[1]) << 16); o.w = f2bf(b[2]) | (f2bf(b[3]) << 16);
        *(u32x4*)(dst + (size_t)r * ldd + c) = o; }
}
__device__ __forceinline__ void zero_fill16(unsigned char* p, size_t bytes, int gt, int NGT) {
    const u32x4 z = (u32x4){0u, 0u, 0u, 0u};
    for (size_t i = (size_t)gt * 16; i < bytes; i += (size_t)NGT * 16) *(u32x4*)(p + i) = z;
}

template <bool F32OUT>
__device__ __forceinline__ void rmsnorm_rows(const float* X, const float* g, bf16_t* O, float* OF, int bx, int NGW) {
    asm volatile("" ::: "memory"); const int tid = opaque_tid(), lane = tid & 63; const int gw = opq(bx) * 8 + __builtin_amdgcn_readfirstlane(tid >> 6);
    f32x4 gv[8];
#pragma unroll
    for (int j = 0; j < 8; ++j) gv[j] = *(const f32x4*)(g + (lane + 64 * j) * 4);
    for (int r = gw; r < T_TOK; r += NGW) {
        const bf16_t* xr = (const bf16_t*)X + (size_t)r * DM; f32x4 v[8]; float s = 0.f;
#pragma unroll
        for (int j = 0; j < 8; ++j) { const u32x2 w = *(const u32x2*)(xr + (lane + 64 * j) * 4); v[j] = (f32x4){bflo(w.x), bfhi(w.x), bflo(w.y), bfhi(w.y)}; s += (v[j][0] * v[j][0] + v[j][1] * v[j][1]) + (v[j][2] * v[j][2] + v[j][3] * v[j][3]); }
        const float rstd = rsqrtf(wave_sum(s, lane) * (1.f / DM) + EPSV);
#pragma unroll
        for (int j = 0; j < 8; ++j) { const f32x4 y = v[j] * rstd * gv[j];
            if (F32OUT) *(f32x4*)(OF + (size_t)r * DM + (lane + 64 * j) * 4) = y;
            else { u32x2 w; w.x = pk2(y[0], y[1]); w.y = pk2(y[2], y[3]); *(u32x2*)(O + (size_t)r * DM + (lane + 64 * j) * 4) = w; } }
    }
}

__device__ __forceinline__ void rows_to_bf16_ss(const float* X, bf16_t* O, float* rss, int bx, int NGW) {
    const int tid = opaque_tid(), lane = tid & 63; const int gw = opq(bx) * 8 + __builtin_amdgcn_readfirstlane(tid >> 6);
    for (int r = gw; r < T_TOK; r += NGW) {
        const float* xr = X + (size_t)r * DM; f32x4 v[8]; float s = 0.f;
#pragma unroll
        for (int j = 0; j < 8; ++j) { v[j] = *(const f32x4*)(xr + (lane + 64 * j) * 4); s += (v[j][0] * v[j][0] + v[j][1] * v[j][1]) + (v[j][2] * v[j][2] + v[j][3] * v[j][3]); }
        s = wave_sum(s, lane); if (lane < 32) rss[(size_t)r * 32 + lane] = (lane == 0) ? s : 0.f;
#pragma unroll
        for (int j = 0; j < 8; ++j) { u32x2 w; w.x = pk2(v[j][0], v[j][1]); w.y = pk2(v[j][2], v[j][3]); *(u32x2*)(O + (size_t)r * DM + (lane + 64 * j) * 4) = w; }
    }
}
__device__ __forceinline__ void lru_item(LAS unsigned char* lds, int item, const bf16_t* ZE, const float* conv_w, const float* conv_b,
                                         const bf16_t* WrT, const bf16_t* WiT, const float* b_r, const float* b_i, const float* lam, bf16_t* YB) {
    const int tid = opaque_tid(), w = __builtin_amdgcn_readfirstlane(tid >> 6), lane = tid & 63, fr = lane & 15, fq = lane >> 4;
    const int b = item >> 6, hh = (item >> 2) & 15, qq = item & 3;
    LAS unsigned char* XC = lds;
    LAS float* SEGA = (LAS float*)(lds + 36864);
    LAS float* SEGB = SEGA + 1024;
    LAS float* HIN = SEGB + 1024;
    const int co = tid & 7, tr = tid >> 3;
    float cw[4][8], cb[8];
#pragma unroll
    for (int k = 0; k < 4; ++k)
#pragma unroll
        for (int e = 0; e < 8; ++e) cw[k][e] = conv_w[k * 1024 + hh * 64 + co * 8 + e];
#pragma unroll
    for (int e = 0; e < 8; ++e) cb[e] = conv_b[hh * 64 + co * 8 + e];
    bf16x8 wrf[2], wif[2];
#pragma unroll
    for (int kk = 0; kk < 2; ++kk) { wrf[kk] = *(const bf16x8*)(WrT + ((size_t)hh * 64 + qq * 16 + fr) * 64 + kk * 32 + fq * 8); wif[kk] = *(const bf16x8*)(WiT + ((size_t)hh * 64 + qq * 16 + fr) * 64 + kk * 32 + fq * 8); }
    const int ch = hh * 64 + qq * 16 + fr;
    const float br = b_r[ch], bi = b_i[ch];
    const float lm = lam[ch]; float sp8; { const float e = __expf(-lm); const float ser = e * (1.f - e * (0.5f - e * (0.33333333f - e * 0.25f)));
        sp8 = 8.0f * ((-lm > 20.f) ? -lm : (e < 0.03f ? ser : __logf(1.0f + e))); }
    float carry = 0.f;
    const bf16_t* zb = ZE + (size_t)b * SEQ * AB_IN;
    u32x4 xr[7];
#pragma unroll
    for (int r = 0; r < 7; ++r) { const int t = tr * 4 - 3 + r; xr[r] = (t >= 0) ? *(const u32x4*)(zb + (size_t)t * AB_IN + hh * 64 + co * 8) : (u32x4){0u, 0u, 0u, 0u}; }
    for (int sc = 0; sc < 16; ++sc) {
        const int t0 = sc * 256;
        unsigned short gr[2][4];
#pragma unroll
        for (int ml = 0; ml < 2; ++ml)
#pragma unroll
            for (int r = 0; r < 4; ++r) gr[ml][r] = zb[(size_t)(t0 + (w * 2 + ml) * 16 + fq * 4 + r) * AB_IN + 1024 + ch];
        {
            float xin[7][8];
#pragma unroll
            for (int r = 0; r < 7; ++r) { const u32x4 v = xr[r];
                xin[r][0] = bflo(v.x); xin[r][1] = bfhi(v.x); xin[r][2] = bflo(v.y); xin[r][3] = bfhi(v.y); xin[r][4] = bflo(v.z); xin[r][5] = bfhi(v.z); xin[r][6] = bflo(v.w); xin[r][7] = bfhi(v.w); }
#pragma unroll
            for (int q = 0; q < 4; ++q) { float o[8];
#pragma unroll
                for (int e = 0; e < 8; ++e) o[e] = cb[e] + cw[0][e] * xin[q][e] + cw[1][e] * xin[q + 1][e] + cw[2][e] * xin[q + 2][e] + cw[3][e] * xin[q + 3][e];
                u32x4 wv; wv.x = pk2(o[0], o[1]); wv.y = pk2(o[2], o[3]); wv.z = pk2(o[4], o[5]); wv.w = pk2(o[6], o[7]);
                *(LAS u32x4*)(XC + (tr * 4 + q) * 144 + co * 16) = wv; }
            if (sc < 15) {
#pragma unroll
                for (int r = 0; r < 7; ++r) xr[r] = *(const u32x4*)(zb + (size_t)(t0 + 256 + tr * 4 - 3 + r) * AB_IN + hh * 64 + co * 8); }
        }
        __syncthreads();
        float av[2][4], bv[2][4];
#pragma unroll
        for (int ml = 0; ml < 2; ++ml) { const int mt = w * 2 + ml;
            f32x4 ar = (f32x4){0.f, 0.f, 0.f, 0.f}, ai = ar;
#pragma unroll
            for (int kk = 0; kk < 2; ++kk) { const bf16x8 xa = *(const LAS bf16x8*)(XC + (mt * 16 + fr) * 144 + kk * 64 + fq * 16);
                ar = __builtin_amdgcn_mfma_f32_16x16x32_bf16(xa, wrf[kk], ar, 0, 0, 0); ai = __builtin_amdgcn_mfma_f32_16x16x32_bf16(xa, wif[kk], ai, 0, 0, 0); }
            float A = 1.f, Bc = 0.f;
#pragma unroll
            for (int r = 0; r < 4; ++r) { const int tok = mt * 16 + fq * 4 + r;
                const float xcv = bf2f(*(const LAS unsigned short*)(XC + tok * 144 + (qq * 16 + fr) * 2));
                const float rg = sigmoidf_(ar[r] + br), ig = sigmoidf_(ai[r] + bi);
                const float la = -rg * sp8; const float a = __expf(la); const float x2 = 2.f * la; const float em = (x2 > -0.3f) ? -x2 * (1.f + x2 * 0.5f * (1.f + x2 * 0.33333333f * (1.f + x2 * 0.25f * (1.f + x2 * 0.2f * (1.f + x2 * 0.16666667f))))) : 1.f - __expf(x2);
                const float mult = __builtin_amdgcn_sqrtf(fmaxf(em, 0.f));
                av[ml][r] = a; bv[ml][r] = mult * ig * xcv;
                Bc = a * Bc + bv[ml][r]; A = A * a; }
            const int sg = mt * 4 + fq; SEGA[sg * 16 + fr] = A; SEGB[sg * 16 + fr] = Bc; }
        __syncthreads();
        if (w == 0 && lane < 16) { float h = carry;
#pragma unroll 8
            for (int sg = 0; sg < 64; ++sg) { HIN[sg * 16 + lane] = h; h = SEGA[sg * 16 + lane] * h + SEGB[sg * 16 + lane]; }
            carry = h; }
        __syncthreads();
#pragma unroll
        for (int ml = 0; ml < 2; ++ml) { const int mt = w * 2 + ml; float h = HIN[(mt * 4 + fq) * 16 + fr];
#pragma unroll
            for (int r = 0; r < 4; ++r) { const int t = t0 + mt * 16 + fq * 4 + r; h = av[ml][r] * h + bv[ml][r];
                const float gt = bf2f(gr[ml][r]);
                YB[((size_t)b * SEQ + t) * DM + ch] = (bf16_t)f2bf(h * gelu_tanh(gt)); } }
    }
    __syncthreads();
}
__device__ __forceinline__ void pool_item(int item, const bf16_t* ZE, const float* scale, bf16_t* YB) {
    const int tid = opaque_tid(), b = item >> 6, tch = item & 63, co = tid & 127, seg = tid >> 7;
    const int win = 2 << (co >> 5);
    float sc[8];
#pragma unroll
    for (int e = 0; e < 8; ++e) sc[e] = scale[co * 8 + e];
    const bf16_t* zb = ZE + (size_t)b * SEQ * AB_IN + 2048 + co * 8;
    const int ts = tch * 64 + seg * 16;
    float sum[8];
#pragma unroll
    for (int e = 0; e < 8; ++e) sum[e] = 0.f;
    for (int s = ts - win + 1; s < ts; ++s) if (s >= 0) { const u32x4 v = *(const u32x4*)(zb + (size_t)s * AB_IN);
        sum[0] += bflo(v.x); sum[1] += bfhi(v.x); sum[2] += bflo(v.y); sum[3] += bfhi(v.y); sum[4] += bflo(v.z); sum[5] += bfhi(v.z); sum[6] += bflo(v.w); sum[7] += bfhi(v.w); }
    for (int t = ts; t < ts + 16; ++t) {
        const u32x4 v = *(const u32x4*)(zb + (size_t)t * AB_IN);
        float x[8] = {bflo(v.x), bfhi(v.x), bflo(v.y), bfhi(v.y), bflo(v.z), bfhi(v.z), bflo(v.w), bfhi(v.w)};
        const float inv = __builtin_amdgcn_rcpf((float)((t + 1) < win ? (t + 1) : win));
        float o[8];
#pragma unroll
        for (int e = 0; e < 8; ++e) { sum[e] += x[e]; o[e] = (sum[e] * inv - x[e]) * sc[e]; }
        u32x4 wv; wv.x = pk2(o[0], o[1]); wv.y = pk2(o[2], o[3]); wv.z = pk2(o[4], o[5]); wv.w = pk2(o[6], o[7]);
        *(u32x4*)(YB + ((size_t)b * SEQ + t) * DM + 1024 + co * 8) = wv;
        const int so = t - win + 1;
        if (so >= 0) { const u32x4 q = *(const u32x4*)(zb + (size_t)so * AB_IN);
            sum[0] -= bflo(q.x); sum[1] -= bfhi(q.x); sum[2] -= bflo(q.y); sum[3] -= bfhi(q.y); sum[4] -= bflo(q.z); sum[5] -= bfhi(q.z); sum[6] -= bflo(q.w); sum[7] -= bfhi(q.w); }
    }
}

constexpr int KT_PITCH = 272, VT_PITCH = 144;
constexpr int AL_KT = 0, AL_VT = 64 * KT_PITCH, AL_BUF = 36864  , AL_IMPA = 2 * 36864, AL_IMPB = AL_IMPA + 64 * 65 * 4, AL_SEL = AL_IMPB + 64 * 65 * 4, AL_UNI = AL_SEL + 512, AL_Q = 73728, Q_WAVE = 32 * KT_PITCH;
constexpr float QSCALE2 = 0.08838834764831845f * LOG2E;
constexpr float NEGB = -1e30f;

struct StageRegs { u32x4 k[2], v[2]; };
__device__ __forceinline__ void stage_load(StageRegs& R, const bf16_t* kbase, const bf16_t* vbase, int vpitch, int tid) {
    const int kr = tid >> 3, kc = tid & 7, vr = tid >> 2, vc = tid & 3;
    R.k[0] = *(const u32x4*)(kbase + kr * 128 + kc * 8); R.k[1] = *(const u32x4*)(kbase + kr * 128 + 64 + kc * 8);
    R.v[0] = *(const u32x4*)(vbase + (size_t)vr * vpitch + vc * 8); R.v[1] = *(const u32x4*)(vbase + (size_t)vr * vpitch + 32 + vc * 8);
}
__device__ __forceinline__ void stage_store(const StageRegs& R, LAS unsigned char* lds, int tid) {
    const int kr = tid >> 3, kc = tid & 7, vr = tid >> 2, vc = tid & 3;
    *(LAS u32x4*)(lds + AL_KT + kr * KT_PITCH + kc * 16) = R.k[0]; *(LAS u32x4*)(lds + AL_KT + kr * KT_PITCH + 128 + kc * 16) = R.k[1];
    *(LAS u32x4*)(lds + AL_VT + vr * VT_PITCH + vc * 16) = R.v[0]; *(LAS u32x4*)(lds + AL_VT + vr * VT_PITCH + 64 + vc * 16) = R.v[1];
}
template <int MODE>
__device__ __forceinline__ void attn_tile(bool MASK, LAS unsigned char* lds, LAS unsigned char* ldsi, const bf16x8 (&qf)[2][4], f32x4 (&O)[2][8], float (&m)[2], float (&l)[2], const int (&tpos)[2], float slope2,
                                          int kp0, const bool (&selbit)[2], int fr, int fq, int wv, int tile64, int lane) {
    constexpr int KS = (MODE <= 1) ? 16 : 1;
    f32x4 s[2][4];
#pragma unroll
    for (int ci = 0; ci < 2; ++ci)
#pragma unroll
        for (int k4 = 0; k4 < 4; ++k4) s[ci][k4] = (f32x4){0.f, 0.f, 0.f, 0.f};
#pragma unroll
    for (int kk = 0; kk < 4; ++kk) {
        const bf16x8 q0 = qf[0][kk], q1 = qf[1][kk];
#pragma unroll
        for (int k4 = 0; k4 < 4; ++k4) { const bf16x8 kf = *(const LAS bf16x8*)(lds + AL_KT + (k4 * 16 + fr) * KT_PITCH + kk * 64 + fq * 16);
            s[0][k4] = __builtin_amdgcn_mfma_f32_16x16x32_bf16(kf, q0, s[0][k4], 0, 0, 0);
            s[1][k4] = __builtin_amdgcn_mfma_f32_16x16x32_bf16(kf, q1, s[1][k4], 0, 0, 0); } }
    const float sk = slope2 * (float)KS;
    float alpha[2] = {1.f, 1.f};
#pragma unroll
    for (int ci = 0; ci < 2; ++ci) {
        const int base = tpos[ci] - kp0 - KS * (fq * 4);
        const float bb = -slope2 * (float)base;
        float mx = NEGB;
#pragma unroll
        for (int k4 = 0; k4 < 4; ++k4)
#pragma unroll
            for (int j = 0; j < 4; ++j) {
                s[ci][k4][j] = __builtin_fmaf(s[ci][k4][j], QSCALE2, __builtin_fmaf(sk, (float)(k4 * 16 + j), bb)); }
        if (MASK) {
#pragma unroll
            for (int k4 = 0; k4 < 4; ++k4)
#pragma unroll
                for (int j = 0; j < 4; ++j) { const int c = KS * (k4 * 16 + j); bool ok = c <= base; if (MODE == 3) ok = ok && (base - c < 512); s[ci][k4][j] = ok ? s[ci][k4][j] : 2.0f * NEGB; } }
#pragma unroll
        for (int k4 = 0; k4 < 4; ++k4)
#pragma unroll
            for (int j = 0; j < 4; ++j) mx = fmaxf(mx, s[ci][k4][j]);
        if (MODE == 2) mx = selbit[ci] ? mx : NEGB;
        if (MODE != 1) {
            mx = fmaxf(mx, shx(mx, lane, 16)); mx = fmaxf(mx, shx(mx, lane, 32));
            const float mn = fmaxf(m[ci], mx); alpha[ci] = __builtin_amdgcn_exp2f(m[ci] - mn); m[ci] = mn;
            float ps = 0.f;
#pragma unroll
            for (int k4 = 0; k4 < 4; ++k4)
#pragma unroll
                for (int j = 0; j < 4; ++j) { const float p = __builtin_amdgcn_exp2f(s[ci][k4][j] - mn); s[ci][k4][j] = p; ps += p; }
            if (MODE == 2) ps = selbit[ci] ? ps : 0.f;
            l[ci] = l[ci] * alpha[ci] + ps;
        } else {
#pragma unroll
            for (int k4 = 0; k4 < 4; ++k4) {
#pragma unroll
                for (int j = 0; j < 4; ++j) s[ci][k4][j] = __builtin_amdgcn_exp2f(s[ci][k4][j] - m[ci]) * l[ci];
                float a = (s[ci][k4][0] + s[ci][k4][1]) + (s[ci][k4][2] + s[ci][k4][3]); float b3 = s[ci][k4][3];
                a += shx(a, lane, 1); a += shx(a, lane, 2); b3 += shx(b3, lane, 1); b3 += shx(b3, lane, 2);
                if ((fr & 3) == 0) { const int tl = wv * 8 + ci * 4 + (fr >> 2); const int ms = tile64 * 16 + k4 * 4 + fq;
                    ((LAS float*)(ldsi + AL_IMPA))[tl * 65 + ms] = a; ((LAS float*)(ldsi + AL_IMPB))[tl * 65 + ms + 1] = b3; } }
        }
    }
    if (MODE >= 2) {
        if (__builtin_amdgcn_ballot_w64(alpha[0] != 1.f || alpha[1] != 1.f) != 0ull) {
#pragma unroll
            for (int ci = 0; ci < 2; ++ci)
#pragma unroll
                for (int dt = 0; dt < 8; ++dt) O[ci][dt] = O[ci][dt] * alpha[ci]; }
    }
    if (MODE != 0) {
#pragma unroll
        for (int ks = 0; ks < 2; ++ks) {
            bf16x8 pf[2];
#pragma unroll
            for (int ci = 0; ci < 2; ++ci) { u32x4 w; w.x = pk2(s[ci][2 * ks][0], s[ci][2 * ks][1]); w.y = pk2(s[ci][2 * ks][2], s[ci][2 * ks][3]); w.z = pk2(s[ci][2 * ks + 1][0], s[ci][2 * ks + 1][1]); w.w = pk2(s[ci][2 * ks + 1][2], s[ci][2 * ks + 1][3]);
                if (MODE == 2) { w.x = selbit[ci] ? w.x : 0u; w.y = selbit[ci] ? w.y : 0u; w.z = selbit[ci] ? w.z : 0u; w.w = selbit[ci] ? w.w : 0u; }
                pf[ci] = __builtin_bit_cast(bf16x8, w); }
#pragma unroll
            for (int dt = 0; dt < 8; ++dt) { const LAS unsigned char* vp = lds + AL_VT + (dt * 16 + fr) * VT_PITCH + (ks * 32 + fq * 4) * 2;
                const u32x2 lo = *(const LAS u32x2*)vp, hi = *(const LAS u32x2*)(vp + 32);
                const bf16x8 vf = __builtin_bit_cast(bf16x8, (u32x4){lo.x, lo.y, hi.x, hi.y});
                O[0][dt] = __builtin_amdgcn_mfma_f32_16x16x32_bf16(vf, pf[0], O[0][dt], 0, 0, 0);
                O[1][dt] = __builtin_amdgcn_mfma_f32_16x16x32_bf16(vf, pf[1], O[1][dt], 0, 0, 0); }
        }
    }
}

__device__ __forceinline__ void nsa_item(LAS unsigned char* lds, int b, int g, int tq, const bf16_t* Q, const bf16_t* KS, const bf16_t* VST, const bf16_t* KW, const bf16_t* VWT,
                                         const bf16_t* KCMP, const bf16_t* VCMPT, const float* GL, bf16_t* YB) {
    const int tid = opaque_tid(), wv = __builtin_amdgcn_readfirstlane(tid >> 6), lane = tid & 63, fr = lane & 15, fq = lane >> 4;
    const int t0 = tq * 64, bg = b * 4 + g, head = g * 4 + (fr & 3);
    LAS float* IMPA = (LAS float*)(lds + AL_IMPA);
    LAS unsigned long long* SEL = (LAS unsigned long long*)(lds + AL_SEL);
    LAS unsigned long long* UNI = (LAS unsigned long long*)(lds + AL_UNI);
    __syncthreads();
    for (int i = tid; i < 2 * 64 * 65; i += 512) IMPA[i] = 0.f;
    int tpos[2]; bf16x8 qf[2][4]; int tc = 0;
#pragma unroll
    for (int ci = 0; ci < 2; ++ci) { tpos[ci] = t0 + wv * 8 + ci * 4 + (fr >> 2);
        const bf16_t* qp = Q + ((size_t)(b * SEQ + tpos[ci])) * DM + head * 128 + fq * 8;
#pragma unroll
        for (int kk = 0; kk < 4; ++kk) qf[ci][kk] = *(const bf16x8*)(qp + kk * 32);
    }
    const float slope2 = exp2f(-0.5f * (float)(head + 1)) * LOG2E;
    f32x4 O[2][8]; float m[2], l[2]; bool selbit[2] = {true, true};
#pragma unroll
    for (int ci = 0; ci < 2; ++ci)
#pragma unroll
        for (int dt = 0; dt < 8; ++dt) { O[ci][dt] = (f32x4){0.f, 0.f, 0.f, 0.f}; }
    StageRegs R;
    const int ncmp = ((t0 + 32) >> 4) + 1, nct = (ncmp + 63) >> 6;
    const bf16_t* kcb = KCMP + (size_t)bg * 256 * 128; const bf16_t* vcb = VCMPT + (size_t)bg * 128 * 256;
    m[0] = m[1] = NEGB; l[0] = l[1] = 0.f;
    stage_load(R, kcb, vcb, 256, tid);
    for (int ct = 0; ct < nct; ++ct) {
        LAS unsigned char* kvb = lds + (tc & 1) * AL_BUF; ++tc; stage_store(R, kvb, tid); __syncthreads();
        if (ct + 1 < nct) stage_load(R, kcb + (size_t)(ct + 1) * 64 * 128, vcb + (ct + 1) * 64, 256, tid);
        attn_tile<0>(1024 * ct + 1039 > t0, kvb, lds, qf, O, m, l, tpos, slope2, 16 * (ct * 64) + 31, selbit, fr, fq, wv, ct, lane);
    }
#pragma unroll
    for (int ci = 0; ci < 2; ++ci) { float lt = l[ci]; lt += shx(lt, lane, 16); lt += shx(lt, lane, 32); l[ci] = lt > 0.f ? 1.0f / lt : 0.f; }
    stage_load(R, kcb, vcb, 256, tid);
    for (int ct = 0; ct < nct; ++ct) {
        LAS unsigned char* kvb = lds + (tc & 1) * AL_BUF; ++tc; stage_store(R, kvb, tid); __syncthreads();
        if (ct + 1 < nct) stage_load(R, kcb + (size_t)(ct + 1) * 64 * 128, vcb + (ct + 1) * 64, 256, tid);
        attn_tile<1>(1024 * ct + 1039 > t0, kvb, lds, qf, O, m, l, tpos, slope2, 16 * (ct * 64) + 31, selbit, fr, fq, wv, ct, lane);
    }
#pragma unroll
    for (int ci = 0; ci < 2; ++ci) { const float gc = GL[((size_t)(b * SEQ + tpos[ci])) * 48 + head];
        bf16_t* op = YB + ((size_t)(b * SEQ + tpos[ci])) * DM + head * 128 + fq * 4;
#pragma unroll
        for (int dt = 0; dt < 8; ++dt) { const f32x4 o = O[ci][dt] * gc; u32x2 w; w.x = pk2(o[0], o[1]); w.y = pk2(o[2], o[3]); *(u32x2*)(op + dt * 16) = w; O[ci][dt] = (f32x4){0.f, 0.f, 0.f, 0.f}; } }
    __syncthreads();
    {
        const int cur = tq; unsigned long long wun = 0ull;
#pragma unroll 1
        for (int tk = 0; tk < 8; ++tk) { const int tl = wv * 8 + tk;
            float v = IMPA[tl * 65 + lane] + IMPA[64 * 65 + tl * 65 + lane];
            if (lane == 0 || lane == cur || lane == cur - 1) v += 1e6f;
            if (lane > cur) v = NEGB;
            int rank = 0; const int vi = __builtin_bit_cast(int, v);
#pragma unroll
            for (int mm = 0; mm < 64; ++mm) { const float vm = __builtin_bit_cast(float, __builtin_amdgcn_readlane(vi, mm)); rank += ((vm > v) || (vm == v && mm < lane)) ? 1 : 0; }
            const unsigned long long mk = __ballot(rank < 16 && lane <= cur);
            wun |= mk;
            if (lane == 0) SEL[tl] = mk; }
        if (lane == 0) UNI[wv] = wun;
    }
    __syncthreads();
    unsigned long long selm[2], wun, bun = 0ull;
#pragma unroll
    for (int ci = 0; ci < 2; ++ci) selm[ci] = SEL[wv * 8 + ci * 4 + (fr >> 2)];
    wun = UNI[wv];
#pragma unroll
    for (int i = 0; i < 8; ++i) bun |= UNI[i];
    { const unsigned lo = __builtin_amdgcn_readfirstlane((unsigned)bun), hi = __builtin_amdgcn_readfirstlane((unsigned)(bun >> 32)); bun = ((unsigned long long)hi << 32) | lo;
      const unsigned lo2 = __builtin_amdgcn_readfirstlane((unsigned)wun), hi2 = __builtin_amdgcn_readfirstlane((unsigned)(wun >> 32)); wun = ((unsigned long long)hi2 << 32) | lo2; }
    const bf16_t* ksb = KS + (size_t)bg * SEQ * 128; const bf16_t* vsb = VST + (size_t)bg * 128 * SEQ;
    m[0] = m[1] = NEGB; l[0] = l[1] = 0.f;
    {
        unsigned long long rem = bun; int j = 63 - __builtin_clzll(rem); rem &= ~(1ull << j);
        stage_load(R, ksb + (size_t)j * 64 * 128, vsb + j * 64, SEQ, tid);
        for (;;) {
            LAS unsigned char* kvb = lds + (tc & 1) * AL_BUF; ++tc; stage_store(R, kvb, tid); __syncthreads();
            const int jn = rem ? 63 - __builtin_clzll(rem) : -1; if (jn >= 0) { rem &= ~(1ull << jn); stage_load(R, ksb + (size_t)jn * 64 * 128, vsb + jn * 64, SEQ, tid); }
            if ((wun >> j) & 1ull) { selbit[0] = (selm[0] >> j) & 1ull; selbit[1] = (selm[1] >> j) & 1ull;
                attn_tile<2>(j == tq, kvb, lds, qf, O, m, l, tpos, slope2, j * 64, selbit, fr, fq, wv, 0, lane); }
            if (jn < 0) break; j = jn;
        }
    }
#pragma unroll
    for (int ci = 0; ci < 2; ++ci) { float lt = l[ci]; lt += shx(lt, lane, 16); lt += shx(lt, lane, 32); const float gs = GL[((size_t)(b * SEQ + tpos[ci])) * 48 + 16 + head]; const float sc = lt > 0.f ? gs / lt : 0.f;
        bf16_t* op = YB + ((size_t)(b * SEQ + tpos[ci])) * DM + head * 128 + fq * 4;
#pragma unroll
        for (int dt = 0; dt < 8; ++dt) { const f32x4 o = O[ci][dt] * sc; const u32x2 pv = *(const u32x2*)(op + dt * 16); u32x2 w; w.x = pk2(bflo(pv.x) + o[0], bfhi(pv.x) + o[1]); w.y = pk2(bflo(pv.y) + o[2], bfhi(pv.y) + o[3]); *(u32x2*)(op + dt * 16) = w; O[ci][dt] = (f32x4){0.f, 0.f, 0.f, 0.f}; } }
    const bf16_t* kwb = KW + (size_t)bg * SEQ * 128; const bf16_t* vwb = VWT + (size_t)bg * 128 * SEQ;
    m[0] = m[1] = NEGB; l[0] = l[1] = 0.f; selbit[0] = selbit[1] = true;
    {
        const int j0 = tq >= 8 ? tq - 8 : 0;
        stage_load(R, kwb + (size_t)tq * 64 * 128, vwb + tq * 64, SEQ, tid);
        for (int j = tq; j >= j0; --j) {
            LAS unsigned char* kvb = lds + (tc & 1) * AL_BUF; ++tc; stage_store(R, kvb, tid); __syncthreads();
            if (j > j0) stage_load(R, kwb + (size_t)(j - 1) * 64 * 128, vwb + (j - 1) * 64, SEQ, tid);
            attn_tile<3>(j == tq || j == tq - 8, kvb, lds, qf, O, m, l, tpos, slope2, j * 64, selbit, fr, fq, wv, 0, lane);
        }
    }
#pragma unroll
    for (int ci = 0; ci < 2; ++ci) { float lt = l[ci]; lt += shx(lt, lane, 16); lt += shx(lt, lane, 32); const float gwv = GL[((size_t)(b * SEQ + tpos[ci])) * 48 + 32 + head]; const float sc = lt > 0.f ? gwv / lt : 0.f;
        bf16_t* op = YB + ((size_t)(b * SEQ + tpos[ci])) * DM + head * 128 + fq * 4;
#pragma unroll
        for (int dt = 0; dt < 8; ++dt) { const f32x4 o = O[ci][dt] * sc; const u32x2 pv = *(const u32x2*)(op + dt * 16); u32x2 w; w.x = pk2(bflo(pv.x) + o[0], bfhi(pv.x) + o[1]); w.y = pk2(bflo(pv.y) + o[2], bfhi(pv.y) + o[3]); *(u32x2*)(op + dt * 16) = w; } }
}

__global__ void __launch_bounds__(512) fwd_kernel(Args a) {
    extern __shared__ __attribute__((aligned(16))) unsigned char lds_raw[];
    LAS unsigned char* lds = (LAS unsigned char*)lds_raw;
    const int G = gridDim.x, bx = blockIdx.x;
    const int NGW = G * 8, NGT = G * 512;
#define GW() (opq(bx) * 8 + __builtin_amdgcn_readfirstlane(opaque_tid() >> 6))
    unsigned char* ws = a.ws;
    int ph = 0;
    { volatile LAS unsigned* MISC = (volatile LAS unsigned*)(lds + LDS_BYTES - 64); if (threadIdx.x < 16) MISC[threadIdx.x] = 0u; }
    __syncthreads();
    (void)xcd_barrier_post((unsigned*)(ws + WS_BAR), (volatile LAS unsigned*)(lds + LDS_BYTES - 64));
#ifndef ONLY
#define ONLY -1
#endif
#define EN(id) (ONLY < 0 || ONLY == (id))
#define ON() (ph >= a.lo && ph < a.hi)
#define SEAM() do { ++ph; if (a.one) { if (ph == 1) cg::this_grid().sync(); else { XcdBarrier bar; bar.bar = (unsigned*)(opqp(ws) + WS_BAR); bar.x = xb_xcc_id(); bar.st = (volatile LAS unsigned*)(lds + LDS_BYTES - 64); xcd_barrier(bar); } } } while (0)

    bf16_t* XN = (bf16_t*)(ws + WS_XN); bf16_t* YB = (bf16_t*)(ws + WS_YB); unsigned char* Z = ws + WS_Z;
    float* posb = (float*)(ws + WS_POSB);

    if (EN(0) && ON())
#pragma unroll 1
    for (int rp0 = 0; rp0 < REP_P0; ++rp0) {
        const int tid = opaque_tid(), lane = tid & 63, wave = __builtin_amdgcn_readfirstlane(tid >> 6), gw = bx * 8 + wave, gt = bx * 512 + tid;
        LAS float* scr = (LAS float*)(lds + wave * 16640);
        int rot = 0;
        for (int i = 0; i < 4; ++i) {
            conv_mat(a.in[23] + (size_t)i * DM * DFF, DM, DFF, DFF, (bf16_t*)(ws + WS_WUP + i * SZ_UP), DM, scr, gw, NGW, lane, rot, a.in[22] + i * DM);
            conv_mat(a.in[24] + (size_t)i * DFF * DM, DFF, DM, DM, (bf16_t*)(ws + WS_WDN + i * SZ_UP), DFF, scr, gw, NGW, lane, rot);
            conv_mat(a.in[26] + (size_t)i * DM * DM, DM, DM, DM, (bf16_t*)(ws + WS_WG + i * SZ_SQ), DM, scr, gw, NGW, lane, rot, a.in[25] + i * DM);
            conv_mat(a.in[27] + (size_t)i * PLE * DM, PLE, DM, DM, (bf16_t*)(ws + WS_WP + i * SZ_WP), PLE, scr, gw, NGW, lane, rot);
        }
        for (int j = 0; j < 2; ++j) {
            conv_mat(a.in[3] + (size_t)j * DM * AB_IN, DM, 2048, AB_IN, (bf16_t*)(ws + WS_WIN + j * SZ_WIN), DM, scr, gw, NGW, lane, rot, a.in[2] + (2 * j) * DM);
            conv_mat(a.in[13] + (size_t)j * DM * DM, DM, DM, DM, (bf16_t*)(ws + WS_WOUT + j * SZ_SQ), DM, scr, gw, NGW, lane, rot);
            conv_mat(a.in[14] + (size_t)j * DM * C_IN, DM, C_INP, C_IN, (bf16_t*)(ws + WS_CIN + j * SZ_CIN), DM, scr, gw, NGW, lane, rot, a.in[2] + (2 * j + 1) * DM);
            conv_mat(a.in[14] + (size_t)j * DM * C_IN + C_INP, DM, 48, C_IN, (bf16_t*)(ws + WS_WGL + (size_t)j * 256 * DM * 2), DM, scr, gw, NGW, lane, rot, a.in[2] + (2 * j + 1) * DM);
            conv_mat(a.in[21] + (size_t)j * DM * DM, DM, DM, DM, (bf16_t*)(ws + WS_COUT + j * SZ_SQ), DM, scr, gw, NGW, lane, rot);
            conv_mat(a.in[16] + (size_t)j * 4096 * 512, 4096, 512, 512, (bf16_t*)(ws + WS_W1K + j * SZ_W1), 4096, scr, gw, NGW, lane, rot);
            conv_mat(a.in[19] + (size_t)j * 4096 * 512, 4096, 512, 512, (bf16_t*)(ws + WS_W1V + j * SZ_W1), 4096, scr, gw, NGW, lane, rot);
            conv_mat(a.in[17] + (size_t)j * 512 * 128, 512, 128, 128, (bf16_t*)(ws + WS_W2K + j * SZ_W2), 512, scr, gw, NGW, lane, rot);
            conv_mat(a.in[20] + (size_t)j * 512 * 128, 512, 128, 128, (bf16_t*)(ws + WS_W2V + j * SZ_W2), 512, scr, gw, NGW, lane, rot);
            for (int h = 0; h < 16; ++h) {
                conv_mat(a.in[6] + ((size_t)j * 16 + h) * 4096, 64, 64, 64, (bf16_t*)(ws + WS_WR + j * SZ_WRI) + h * 4096, 64, scr, gw, NGW, lane, rot);
                conv_mat(a.in[8] + ((size_t)j * 16 + h) * 4096, 64, 64, 64, (bf16_t*)(ws + WS_WI + j * SZ_WRI) + h * 4096, 64, scr, gw, NGW, lane, rot);
            }
            for (int gI = 0; gI < 4; ++gI)
                conv_mat(a.in[11] + ((size_t)j * 4 + gI) * 65536, 256, 256, 256, (bf16_t*)(ws + WS_POOLT + j * SZ_POOLT) + gI * 65536, 256, scr, gw, NGW, lane, rot);
            conv_plain(a.in[3] + (size_t)j * DM * AB_IN + 2048, DM, 1024, AB_IN, (bf16_t*)(ws + WS_WU + j * SZ_WU), 1024, gt, NGT, a.in[2] + (2 * j) * DM);
            zero_fill16(ws + WS_WGL + (size_t)j * 256 * DM * 2 + (size_t)48 * DM * 2, (size_t)208 * DM * 2, gt, NGT);
            zero_fill16(ws + WS_W2K + j * SZ_W2 + (size_t)128 * 512 * 2, (size_t)128 * 512 * 2, gt, NGT);
            zero_fill16(ws + WS_W2V + j * SZ_W2 + (size_t)128 * 512 * 2, (size_t)128 * 512 * 2, gt, NGT);
        }
        conv_plain(a.in[1], 4 * T_TOK, PLE, PLE, (bf16_t*)(ws + WS_PB), PLE, gt, NGT);
        rows_to_bf16_ss(a.in[0], XN, (float*)(ws + WS_ROWSS), bx, NGW);
        for (int it = gw; it < 4 * 8 * 64; it += NGW) { const int q = it >> 9, fc = (it >> 6) & 7, kc = it & 63, j = q >> 1;
            const float* pos = a.in[(q & 1) ? 18 : 15] + (size_t)j * 4096 + kc * 64; const float* w1 = a.in[(q & 1) ? 19 : 16] + (size_t)j * 4096 * 512 + (size_t)kc * 64 * 512 + fc * 64 + lane;
            float acc0 = 0.f, acc1 = 0.f, acc2 = 0.f, acc3 = 0.f;
#pragma unroll 4
            for (int k = 0; k < 64; k += 4) { acc0 += pos[k] * w1[(size_t)k * 512]; acc1 += pos[k + 1] * w1[(size_t)(k + 1) * 512]; acc2 += pos[k + 2] * w1[(size_t)(k + 2) * 512]; acc3 += pos[k + 3] * w1[(size_t)(k + 3) * 512]; }
            ((float*)(ws + WS_POSP))[((size_t)q * 64 + kc) * 512 + fc * 64 + lane] = (acc0 + acc1) + (acc2 + acc3); }
    }
    SEAM();
    if (EN(1) && ON()) {
        if (bx < 64) { const int j = bx >> 5, gI = (bx >> 3) & 3, pn = bx & 7;
            pg8::Gemm gm{(const bf16_t*)(ws + WS_POOLT + j * SZ_POOLT) + gI * 65536, (const bf16_t*)(ws + WS_WU + j * SZ_WU) + gI * 256, 256, 2048, 256, 256, 1024};
            pg8::StaticOrder S; S.init(256, 2048, G, pn);
            EpiBf16<0> E{(bf16_t*)(ws + WS_WIN + j * SZ_WIN) + (size_t)(2048 + gI * 256) * DM, DM, nullptr, nullptr};
            pg8::gemm_phase(lds, gm, S, E); }
        else { const int tid = opaque_tid(); const float* pp = (const float*)(ws + WS_POSP);
            for (int o = (bx - 64) * 512 + tid; o < 2048; o += (G - 64) * 512) { const int q = o >> 9, f = o & 511; float acc = 0.f;
                for (int kc = 0; kc < 64; ++kc) acc += pp[((size_t)q * 64 + kc) * 512 + f];
                posb[o] = acc; } }
    }
    SEAM();
#pragma unroll 1
    for (int layer = 0; layer < 4; ++layer) {
        const int j = layer >> 1; const bool even = (layer & 1) == 0;
        unsigned char* wsl = opqp(ws); unsigned char* Zl = wsl + WS_Z; bf16_t* XNl = (bf16_t*)(wsl + WS_XN); bf16_t* YBl = (bf16_t*)(wsl + WS_YB); float* posbl = (float*)(wsl + WS_POSB);
        const float* hin = (layer == 0) ? a.in[0] : a.out;
        float* RSS = (float*)(wsl + WS_ROWSS); bf16_t* PPl = (bf16_t*)(wsl + WS_PP);
        bf16_t* hc = (layer & 1) ? (bf16_t*)(wsl + WS_H2) : XNl;
        bf16_t* hn = (layer & 1) ? XNl : (bf16_t*)(wsl + WS_H2);
        const bf16_t* Ain = hc;
        if (EN(3) && ON()) {
            if (even) { pg8::Gemm gm{Ain, (const bf16_t*)(wsl + WS_WIN + j * SZ_WIN), T_TOK, AB_IN, DM, DM, DM};
                pg8::StaticOrder S; S.init(T_TOK, AB_IN, opq(G), opq(bx)); EpiBf16<0> E{(bf16_t*)Zl, AB_IN, nullptr, RSS + (size_t)(layer * 3) * T_TOK * 32}; pg8::gemm_phase(lds, gm, S, E); }
            else { pg8::Gemm gm{Ain, (const bf16_t*)(wsl + WS_CIN + j * SZ_CIN), T_TOK, C_INP, DM, DM, DM};
                pg8::StaticOrder S; S.init(T_TOK, C_INP, opq(G), opq(bx));
                EpiNsa E{(bf16_t*)(Zl + Z_Q), (bf16_t*)(Zl + Z_KC), (bf16_t*)(Zl + Z_VC), (bf16_t*)(Zl + Z_KS), (bf16_t*)(Zl + Z_VST), (bf16_t*)(Zl + Z_KW), (bf16_t*)(Zl + Z_VWT), (float*)(Zl + Z_GL), RSS + (size_t)(layer * 3) * T_TOK * 32};
                pg8::gemm_phase(lds, gm, S, E); }
        }
        SEAM();
        if (even) {
            if (EN(4) && ON()) {
#ifndef NO_LRU
#pragma unroll 1
                for (int rp = 0; rp < REP_LRU; ++rp)
                for (int it = opq(bx); it < 256; it += G)
                    lru_item(lds, it, (const bf16_t*)Zl, a.in[4] + (size_t)j * 4096, a.in[5] + j * 1024, (const bf16_t*)(wsl + WS_WR + j * SZ_WRI), (const bf16_t*)(wsl + WS_WI + j * SZ_WRI),
                             a.in[7] + j * 1024, a.in[9] + j * 1024, a.in[10] + j * 1024, YBl);
#endif
                for (int it = opq(bx); it < 256; it += G) pool_item(it, (const bf16_t*)Zl, a.in[12] + j * 1024, YBl);
            }
            SEAM();
        } else {
            if (EN(5) && ON()) {
                if (bx < 64) { const int kv = bx >> 5;
                    pg8::Gemm gm{(const bf16_t*)(Zl + (kv ? Z_VC : Z_KC)), (const bf16_t*)(wsl + (kv ? WS_W1V : WS_W1K) + j * SZ_W1), 4096, 512, 4096, 2048, 4096};
                    pg8::StaticOrder S; S.init(4096, 512, opq(G), opq(bx) & 31);
                    EpiBf16<2> E{(bf16_t*)(Zl + (kv ? Z_HIDV : Z_HIDK)), 512, posbl + (j * 2 + kv) * 512, nullptr}; pg8::gemm_phase(lds, gm, S, E); }
                else if (bx < 128) { pg8::Gemm gm{Ain, (const bf16_t*)(wsl + WS_WGL + (size_t)j * 256 * DM * 2), T_TOK, 256, DM, DM, DM};
                    pg8::StaticOrder S; S.init(T_TOK, 256, opq(G), opq(bx) - 64); EpiGates E{(float*)(Zl + Z_GL), RSS + (size_t)(layer * 3) * T_TOK * 32}; pg8::gemm_phase(lds, gm, S, E); }
                else { pg8::Gemm gp{(const bf16_t*)(wsl + WS_PB) + (size_t)layer * T_TOK * PLE, (const bf16_t*)(wsl + WS_WP + layer * SZ_WP), T_TOK, DM, PLE, PLE, PLE};
                    pg8::StaticOrder S2; S2.init(T_TOK, DM, 128, opq(bx) - 128); EpiBf16<0> E2{PPl, DM, nullptr, nullptr}; pg8::gemm_phase(lds, gp, S2, E2); }
            }
            SEAM();
            if (EN(6) && ON()) {
                if (bx < 16) { pg8::Gemm gm{(const bf16_t*)(Zl + Z_HIDK), (const bf16_t*)(wsl + WS_W2K + j * SZ_W2), 4096, 256, 512, 512, 512};
                    pg8::StaticOrder S; S.init(4096, 256, opq(G), opq(bx)); EpiCmp2<0> E{(bf16_t*)(Zl + Z_KCMP)}; pg8::gemm_phase(lds, gm, S, E); }
                else if (bx < 32) { pg8::Gemm gm{(const bf16_t*)(Zl + Z_HIDV), (const bf16_t*)(wsl + WS_W2V + j * SZ_W2), 4096, 256, 512, 512, 512};
                    pg8::StaticOrder S; S.init(4096, 256, opq(G), opq(bx) - 16); EpiCmp2<1> E{(bf16_t*)(Zl + Z_VCMPT)}; pg8::gemm_phase(lds, gm, S, E); }
            }
            SEAM();
            if (EN(7) && ON()) {
#pragma unroll 1
                for (int rp = 0; rp < REP_ATTN; ++rp)
                for (int it = opq(bx), r = 0; it < 1024; it += G, ++r) { const int c = it % 256, rr = it / 256; const int cp = (rr & 1) ? 255 - c : c;
                    const int tq = 63 - (rr * 16 + (cp >> 4)), bgi = cp & 15;
#ifndef NO_ATTN
                    nsa_item(lds, bgi >> 2, bgi & 3, tq, (const bf16_t*)(Zl + Z_Q), (const bf16_t*)(Zl + Z_KS), (const bf16_t*)(Zl + Z_VST), (const bf16_t*)(Zl + Z_KW), (const bf16_t*)(Zl + Z_VWT),
                             (const bf16_t*)(Zl + Z_KCMP), (const bf16_t*)(Zl + Z_VCMPT), (const float*)(Zl + Z_GL), YBl);
#endif
                }
                __syncthreads();
            }
            SEAM();
        }
        if (EN(8) && ON()) { pg8::Gemm gm{YBl, (const bf16_t*)(wsl + (even ? WS_WOUT : WS_COUT) + j * SZ_SQ), T_TOK, DM, DM, DM, DM};
            pg8::StaticOrder S; S.init(T_TOK, DM, opq(G), opq(bx)); EpiRes<0> E{hc, hc, nullptr, DM, RSS + (size_t)(layer * 3 + 1) * T_TOK * 32, nullptr}; pg8::gemm_phase(lds, gm, S, E);
            if (even) { pg8::Gemm gp{(const bf16_t*)(wsl + WS_PB) + (size_t)layer * T_TOK * PLE, (const bf16_t*)(wsl + WS_WP + layer * SZ_WP), T_TOK, DM, PLE, PLE, PLE};
              pg8::StaticOrder S2; S2.init(T_TOK, DM, opq(G), opq(bx)); EpiBf16<0> E2{PPl, DM, nullptr, nullptr}; pg8::gemm_phase(lds, gp, S2, E2); } }
        SEAM();
        if (EN(10) && ON())
#pragma unroll 1
        for (int rpu = 0; rpu < REP_UP; ++rpu) { pg8::Gemm gm{hc, (const bf16_t*)(wsl + WS_WUP + layer * SZ_UP), T_TOK, DFF, DM, DM, DM};
            pg8::StaticOrder S; S.init(T_TOK, DFF, opq(G), opq(bx)); EpiBf16<1> E{(bf16_t*)Zl, DFF, nullptr, RSS + (size_t)(layer * 3 + 1) * T_TOK * 32}; pg8::gemm_phase(lds, gm, S, E); }
        SEAM();
        if (EN(11) && ON()) { pg8::Gemm gm{(const bf16_t*)Zl, (const bf16_t*)(wsl + WS_WDN + layer * SZ_UP), T_TOK, DM, DFF, DFF, DFF};
            pg8::StaticOrder S; S.init(T_TOK, DM, opq(G), opq(bx)); EpiRes<0> E{hc, hc, nullptr, DM, RSS + (size_t)(layer * 3 + 2) * T_TOK * 32, nullptr}; pg8::gemm_phase(lds, gm, S, E); }
        SEAM();
        if (EN(13) && ON()) { pg8::Gemm gm{hc, (const bf16_t*)(wsl + WS_WG + layer * SZ_SQ), T_TOK, DM, DM, DM, DM};
            pg8::StaticOrder S; S.init(T_TOK, DM, opq(G), opq(bx)); EpiRes<1> E{hc, hn, PPl, DM, RSS + (size_t)(layer * 3 + 3) * T_TOK * 32, RSS + (size_t)(layer * 3 + 2) * T_TOK * 32}; pg8::gemm_phase(lds, gm, S, E); }
        SEAM();
    }
    if (EN(14) && ON()) rmsnorm_rows<true>((const float*)XN, a.in[28], nullptr, a.out, bx, NGW);
#undef ON
#undef SEAM
}
constexpr int N_PHASES = 1 + 2 * 9 + 2 * 11 + 1;

extern "C" void kernel_launch(void* const* d_in, const int* in_sizes, int n_in, void* d_out, int out_size, void* d_ws, size_t ws_size, hipStream_t stream) {
    static int grid = 0;
    if (grid == 0) {
        if (n_in != 29 || ws_size < WS_END) { fprintf(stderr, "kernel_launch: unexpected n_in %d / ws %zu (need %zu)\n", n_in, ws_size, (size_t)WS_END); grid = -1; return; }
        int dev = 0, cus = 0, per_cu = 0;
        hipGetDevice(&dev); hipDeviceGetAttribute(&cus, hipDeviceAttributeMultiprocessorCount, dev);
        if (hipFuncSetAttribute((const void*)fwd_kernel, hipFuncAttributeMaxDynamicSharedMemorySize, LDS_BYTES) != hipSuccess) { fprintf(stderr, "hipFuncSetAttribute failed\n"); grid = -1; return; }
        if (hipOccupancyMaxActiveBlocksPerMultiprocessor(&per_cu, (const void*)fwd_kernel, 512, LDS_BYTES) != hipSuccess || per_cu < 1) { fprintf(stderr, "occupancy query: %d\n", per_cu); per_cu = 1; }
        (void)hipGetLastError();
        grid = cus;
    }
    if (grid < 0) return;
    Args a{};
    for (int i = 0; i < 29; ++i) a.in[i] = (const float*)d_in[i];
    a.out = (float*)d_out; a.ws = (unsigned char*)d_ws;
#if MK_ONE_LAUNCH
    (void)hipMemsetAsync((unsigned char*)d_ws + WS_BAR, 0, XCD_BAR_WORDS * 4, stream);
    a.lo = 0; a.hi = 1 << 30; a.one = 1; a.pad = 0;
    void* args[] = {&a};
    hipError_t e = hipLaunchCooperativeKernel((const void*)fwd_kernel, dim3(grid), dim3(512), args, LDS_BYTES, stream);
    if (e != hipSuccess) fprintf(stderr, "cooperative launch failed: %s (grid %d)\n", hipGetErrorString(e), grid);
#else
    for (int p = 0; p < N_PHASES; ++p) { a.lo = p; a.hi = p + 1; a.one = 0; a.pad = 0;
        hipLaunchKernelGGL(fwd_kernel, dim3(grid), dim3(512), LDS_BYTES, stream, a); }
#endif
}
```

```cpp
#include <hip/hip_runtime.h>
#include <hip/hip_cooperative_groups.h>
#include <cstdio>
namespace cg = cooperative_groups;

#ifndef REP_ATTN
#define REP_ATTN 1
#endif
#ifndef REP_LRU
#define REP_LRU 1
#endif
#ifndef REP_P0
#define REP_P0 1
#endif
#ifndef REP_UP
#define REP_UP 1
#endif
#ifndef MK_ONE_LAUNCH
#define MK_ONE_LAUNCH 1
#endif

#define LAS __attribute__((address_space(3)))
typedef unsigned short bf16_t;
typedef short bf16x8 __attribute__((ext_vector_type(8)));
typedef float f32x4 __attribute__((ext_vector_type(4)));
typedef float f32x2 __attribute__((ext_vector_type(2)));
typedef unsigned u32x4 __attribute__((ext_vector_type(4)));
typedef unsigned u32x2 __attribute__((ext_vector_type(2)));

constexpr int T_TOK = 16384, DM = 2048, SEQ = 4096, NB = 4, DFF = 8192, PLE = 256;
constexpr int AB_IN = 3072, C_IN = 5168, C_INP = 5120;
constexpr float EPSV = 1e-6f;
constexpr float LOG2E = 1.4426950408889634f;

__device__ __forceinline__ unsigned f2bf(float f) { unsigned u = __builtin_bit_cast(unsigned, f); return (u + 0x7fffu + ((u >> 16) & 1u)) >> 16; }
__device__ __forceinline__ unsigned pk2(float lo, float hi) { unsigned r; asm volatile("v_cvt_pk_bf16_f32 %0, %1, %2" : "=v"(r) : "v"(lo), "v"(hi)); return r; }
__device__ __forceinline__ float bf2f(unsigned short b) { return __builtin_bit_cast(float, ((unsigned)b) << 16); }
__device__ __forceinline__ float bflo(unsigned w) { return __builtin_bit_cast(float, w << 16); }
__device__ __forceinline__ float bfhi(unsigned w) { return __builtin_bit_cast(float, w & 0xffff0000u); }
__device__ __forceinline__ float shx(float v, int lane, int o) { return __builtin_bit_cast(float, __builtin_amdgcn_ds_bpermute((lane ^ o) << 2, __builtin_bit_cast(int, v))); }
__device__ __forceinline__ float wave_sum(float v, int lane) {
#pragma unroll
    for (int o = 1; o < 64; o <<= 1) v += shx(v, lane, o);
    return v;
}
__device__ __forceinline__ float sigmoidf_(float x) { return __builtin_amdgcn_rcpf(1.0f + __expf(-x)); }
__device__ __forceinline__ float gelu_tanh(float x) {
    const float u = 0.7978845608028654f * (x + 0.044715f * x * x * x);
    const float e = __expf(2.0f * u);
    const float th = 1.0f - 2.0f * __builtin_amdgcn_rcpf(e + 1.0f);
    return 0.5f * x * (1.0f + th);
}

__device__ __forceinline__ unsigned char* opqp(unsigned char* p) { size_t z = 0; asm volatile("" : "+s"(z)); return p + z; }
__device__ __forceinline__ int opq(int v) { asm volatile("" : "+s"(v)); return v; }
__device__ __forceinline__ int opaque_tid() { int t = threadIdx.x; asm volatile("" : "+v"(t)); return t; }
namespace pg8 {
constexpr int BM = 256, BK = 64, HALF = 128, HTB = HALF * BK * 2, STAGE_BYTES = 8 * HTB, NXCD = 8, WGM = 8;
__host__ __device__ __forceinline__ int lds_byte(int r, int c) { const int st = (r >> 4) * 2 + (c >> 5), rr = r & 15, cc = c & 31, ob = rr * 64 + cc * 2; return st * 1024 + (ob ^ (((ob >> 9) & 1) << 5)); }
__host__ __device__ __forceinline__ void stage_rc(int b, int& R, int& C) { const int st = b / 1024, sb = b % 1024, swz = sb ^ (((sb >> 9) & 1) << 5); R = (st >> 1) * 16 + swz / 64; C = (st & 1) * 32 + (swz % 64) / 2; }
__host__ __device__ __forceinline__ int perm32(int rho) { const int n = rho >> 4, i = rho & 15; return 8 * (i >> 2) + 4 * n + (i & 3); }

struct Unit { int pm, pn; };
struct Gemm { const bf16_t* A; const bf16_t* Bt; int M, N, K, lda, ldb; };

struct StaticOrder {
    int nM, nN, nwg, G, c;
    __device__ void init(int M, int N, int G_, int c_) { nM = M / BM; nN = N / BM; nwg = nM * nN; G = G_; c = c_; }
    __device__ bool next(int i, Unit& u) const {
        const long L = (long)i * G + c; if (L >= nwg || c < 0) return false;
        int wgid = (int)L; { const int q = nwg / NXCD, r = nwg % NXCD, xcd = wgid % NXCD, off = wgid / NXCD; wgid = (xcd < r ? xcd * (q + 1) : r * (q + 1) + (xcd - r) * q) + off; }
        const int nig = WGM * nN, gid = wgid / nig, fm = gid * WGM, gsz = (nM - fm) < WGM ? (nM - fm) : WGM;
        u.pm = fm + ((wgid % nig) % gsz); u.pn = (wgid % nig) / gsz; return true;
    }
};

template <class Epi, class Sched>
__device__ __forceinline__ void gemm_phase(LAS unsigned char* lds, const Gemm g, const Sched& S, const Epi& E) {
    const int tid = opaque_tid(), wid = __builtin_amdgcn_readfirstlane(tid >> 6), lane = tid & 63, wr = wid >> 2, wc = wid & 3, fr = lane & 15, fq = lane >> 4;
    const int K = g.K, nt = K / BK;
    unsigned voffA[2], voffB[2];
#pragma unroll
    for (int i = 0; i < 2; ++i) { int R, C; stage_rc(tid * 16 + i * 8192, R, C); const int Rb = Epi::PERM ? ((R & ~31) + perm32(R & 31)) : R;
        voffA[i] = (unsigned)(R * g.lda + C) * 2u; voffB[i] = (unsigned)(Rb * g.ldb + C) * 2u; }
    const size_t kstep = (size_t)(BK * 2);
    const size_t hstepA = (size_t)HALF * g.lda * 2, hstepB = (size_t)HALF * g.ldb * 2;
    const size_t tstepA = 2 * hstepA, tstepB = 2 * hstepB;
    const unsigned ldsw = (unsigned)wid * 1024u;
    const int aoff = lds_byte(wr * 64 + fr, fq * 8), boff = lds_byte(wc * 32 + fr, fq * 8);
#define PG8_SA(b, h) (((b) * 2 + (h)) * HTB)
#define PG8_SB(b, h) ((4 + (b) * 2 + (h)) * HTB)
#define PG8_STAGE(bufoff, gbase, voff) do { _Pragma("unroll") for (int _i = 0; _i < 2; ++_i) \
        __builtin_amdgcn_global_load_lds((const unsigned*)((const char*)(gbase) + (voff)[_i]), (LAS unsigned*)(lds + (bufoff) + ldsw + _i * 8192), 16, 0, 0); } while (0)
#define PG8_LDA(dst, b, h) do { _Pragma("unroll") for (int m = 0; m < 4; ++m) _Pragma("unroll") for (int k = 0; k < 2; ++k) dst[m][k] = *(const LAS bf16x8*)(lds + PG8_SA(b, h) + aoff + m * 2048 + k * 1024); } while (0)
#define PG8_LDB(dst, b, h) do { _Pragma("unroll") for (int n = 0; n < 2; ++n) _Pragma("unroll") for (int k = 0; k < 2; ++k) dst[n][k] = *(const LAS bf16x8*)(lds + PG8_SB(b, h) + boff + n * 2048 + k * 1024); } while (0)
#define PG8_MMA(ai, bj, At, Bt) do { __builtin_amdgcn_s_setprio(1); _Pragma("unroll") for (int m = 0; m < 4; ++m) _Pragma("unroll") for (int n = 0; n < 2; ++n) _Pragma("unroll") for (int k = 0; k < 2; ++k) \
        acc[ai][bj][m][n] = __builtin_amdgcn_mfma_f32_16x16x32_bf16(Bt[n][k], At[m][k], acc[ai][bj][m][n], 0, 0, 0); __builtin_amdgcn_s_setprio(0); } while (0)
#define PG8_WAIT_V(n) asm volatile("s_waitcnt vmcnt(" #n ")" ::: "memory")
#define PG8_WAIT_L(n) asm volatile("s_waitcnt lgkmcnt(" #n ")" ::: "memory")
#define PG8_BAR __builtin_amdgcn_s_barrier()
#define PG8_SCHED __builtin_amdgcn_sched_barrier(0)
    Unit cur, nxt; int ui = 0;
    if (!S.next(0, cur)) return;
    f32x4 acc[2][2][4][2];
#pragma unroll
    for (int a = 0; a < 2; ++a)
#pragma unroll
        for (int b = 0; b < 2; ++b)
#pragma unroll
            for (int m = 0; m < 4; ++m)
#pragma unroll
                for (int n = 0; n < 2; ++n) acc[a][b][m][n] = (f32x4){0.f, 0.f, 0.f, 0.f};
    bf16x8 At[4][2], B0[2][2], B1[2][2];
    const char* cA = (const char*)g.A + (size_t)cur.pm * tstepA; const char* cB = (const char*)g.Bt + (size_t)cur.pn * tstepB;
    PG8_STAGE(PG8_SB(0, 0), cB, voffB); PG8_STAGE(PG8_SB(0, 1), cB + hstepB, voffB); PG8_STAGE(PG8_SA(0, 0), cA, voffA); PG8_STAGE(PG8_SA(0, 1), cA + hstepA, voffA);
    if (wr == 1) PG8_BAR;
    PG8_WAIT_V(2); PG8_BAR;
    PG8_STAGE(PG8_SB(1, 0), cB + kstep, voffB); PG8_STAGE(PG8_SA(1, 0), cA + kstep, voffA); PG8_STAGE(PG8_SB(1, 1), cB + hstepB + kstep, voffB);
    PG8_WAIT_V(6); PG8_BAR;
    for (;;) {
        const bool has_next = S.next(ui + 1, nxt);
        const char* nA = has_next ? (const char*)g.A + (size_t)nxt.pm * tstepA : cA; const char* nB = has_next ? (const char*)g.Bt + (size_t)nxt.pn * tstepB : cB;
        for (int t = 0; t < nt; t += 2) {
            const bool last = (t == nt - 2);
            const char* a1 = cA + (size_t)(t + 1) * kstep;
            const char* a2 = last ? nA : cA + (size_t)(t + 2) * kstep; const char* b2 = last ? nB : cB + (size_t)(t + 2) * kstep;
            const char* a3 = a2 + kstep; const char* b3 = b2 + kstep;
            PG8_LDB(B0, 0, 0); PG8_LDB(B1, 0, 1); PG8_SCHED; PG8_LDA(At, 0, 0); PG8_STAGE(PG8_SA(1, 1), a1 + hstepA, voffA);
            PG8_WAIT_V(8); PG8_WAIT_L(0); PG8_BAR; PG8_MMA(0, 0, At, B0); PG8_MMA(0, 1, At, B1); PG8_BAR; PG8_SCHED;
            PG8_LDA(At, 0, 1); PG8_STAGE(PG8_SB(0, 0), b2, voffB); PG8_STAGE(PG8_SB(0, 1), b2 + hstepB, voffB); PG8_STAGE(PG8_SA(0, 0), a2, voffA);
            PG8_WAIT_V(8); PG8_WAIT_L(0); PG8_BAR; PG8_MMA(1, 0, At, B0); PG8_MMA(1, 1, At, B1); PG8_BAR; PG8_SCHED;
            PG8_LDB(B0, 1, 0); PG8_LDB(B1, 1, 1); PG8_SCHED; PG8_LDA(At, 1, 0); PG8_STAGE(PG8_SA(0, 1), a2 + hstepA, voffA);
            PG8_WAIT_V(8); PG8_WAIT_L(0); PG8_BAR; PG8_MMA(0, 0, At, B0); PG8_MMA(0, 1, At, B1); PG8_BAR; PG8_SCHED;
            PG8_LDA(At, 1, 1); PG8_STAGE(PG8_SB(1, 0), b3, voffB); PG8_STAGE(PG8_SB(1, 1), b3 + hstepB, voffB); PG8_STAGE(PG8_SA(1, 0), a3, voffA);
            PG8_WAIT_V(8); PG8_WAIT_L(0); PG8_BAR; PG8_MMA(1, 0, At, B0); PG8_MMA(1, 1, At, B1); PG8_BAR; PG8_SCHED;
        }
        if (wr == 0) PG8_BAR;
        { const int tl = opaque_tid() & 63; E(acc, cur, wr, wc, tl & 15, tl >> 4); }
        if (!has_next) break;
#pragma unroll
        for (int a = 0; a < 2; ++a)
#pragma unroll
            for (int b = 0; b < 2; ++b)
#pragma unroll
                for (int m = 0; m < 4; ++m)
#pragma unroll
                    for (int n = 0; n < 2; ++n) acc[a][b][m][n] = (f32x4){0.f, 0.f, 0.f, 0.f};
        cur = nxt; cA = nA; cB = nB; ++ui;
        if (wr == 1) PG8_BAR;
    }
    PG8_WAIT_V(0);
    PG8_BAR;
#undef PG8_SA
#undef PG8_SB
#undef PG8_STAGE
#undef PG8_LDA
#undef PG8_LDB
#undef PG8_MMA
#undef PG8_WAIT_V
#undef PG8_WAIT_L
#undef PG8_BAR
#undef PG8_SCHED
}
}
using pg8::Unit; using pg8::HALF; using pg8::BM;


#define XB_TMO      128
#define XB_XCNT(j)  (256  + 64 * (j))
#define XB_XSUB(j)  (1280 + 64 * (j))
#define XB_XGEN(j)  (2304 + 64 * (j))
#define XB_TOP      3328
#define XB_TOPGEN   3392
#define XCD_BAR_WORDS 3456
#define XB_SPIN_CAP (1u << 18)
__device__ __forceinline__ unsigned xb_ld(unsigned* p)              { return __hip_atomic_load(p, __ATOMIC_RELAXED, __HIP_MEMORY_SCOPE_AGENT); }
__device__ __forceinline__ unsigned xb_add(unsigned* p, unsigned v) { return __hip_atomic_fetch_add(p, v, __ATOMIC_RELAXED, __HIP_MEMORY_SCOPE_AGENT); }
__device__ __forceinline__ unsigned xb_xcc_id() { return (unsigned)__builtin_amdgcn_s_getreg((3 << 11) | 20) & 0xFu; }
#define XB_SPIN(cond, bar) do { unsigned _sp = 0; while (cond) { __builtin_amdgcn_s_sleep(1); \
    if ((++_sp & 255u) == 0u) { if (xb_ld(&(bar)[XB_TMO])) break; if (_sp > XB_SPIN_CAP) { atomicAdd(&(bar)[XB_TMO], 1u); break; } } } } while (0)
struct XcdBarrier { unsigned* bar; unsigned x; volatile LAS unsigned* st; };
__device__ __forceinline__ XcdBarrier xcd_barrier_post(unsigned* bar, volatile LAS unsigned* st) {
    XcdBarrier b; b.bar = bar; b.x = xb_xcc_id(); b.st = st;
    if (threadIdx.x == 0) (void)xb_add(&bar[XB_XCNT(b.x)], 1u);
    return b;
}
__device__ __forceinline__ void xcd_barrier_complete(unsigned* bar, unsigned x, unsigned& nloc, unsigned& nx) {
    const unsigned G = gridDim.x * gridDim.y * gridDim.z;
    unsigned sum, cnt, mine, sp = 0u;
    for (;;) {
        sum = 0u; cnt = 0u; mine = 0u;
#pragma unroll
        for (unsigned j = 0; j < 16; ++j) { const unsigned c = xb_ld(&bar[XB_XCNT(j)]); sum += c; cnt += (c > 0u) ? 1u : 0u; mine = (j == x) ? c : mine; }
        if (sum == G) break;
        __builtin_amdgcn_s_sleep(1);
        if ((++sp & 255u) == 0u) { if (xb_ld(&bar[XB_TMO])) break; if (sp > XB_SPIN_CAP) { atomicAdd(&bar[XB_TMO], 1u); break; } }
    }
    nloc = mine > 0u ? mine : 1u; nx = cnt > 0u ? cnt : 1u;
}
__device__ __forceinline__ void xcd_barrier(const XcdBarrier& b) {
    asm volatile("s_waitcnt vmcnt(0)" ::: "memory");
    __syncthreads();
    if (threadIdx.x == 0) {
        unsigned* bar = b.bar;
        __builtin_amdgcn_s_waitcnt(0);
        unsigned nloc = b.st[0], nx = b.st[1];
        if (nloc == 0u) { xcd_barrier_complete(bar, b.x, nloc, nx); b.st[0] = nloc; b.st[1] = nx; }
        const unsigned old = xb_add(&bar[XB_XSUB(b.x)], 1u);
        const unsigned gen = old / nloc;
        if (old + 1u == (gen + 1u) * nloc) {
            __builtin_amdgcn_fence(__ATOMIC_RELEASE, "agent");
            asm volatile("s_waitcnt vmcnt(0)" ::: "memory");
            const unsigned og = xb_add(&bar[XB_TOP], 1u);
            const unsigned tg = og / nx;
            if (og + 1u == (tg + 1u) * nx) xb_add(&bar[XB_TOPGEN], 1u);
            else XB_SPIN(xb_ld(&bar[XB_TOPGEN]) == tg, bar);
            __builtin_amdgcn_fence(__ATOMIC_ACQUIRE, "agent");
            xb_add(&bar[XB_XGEN(b.x)], 1u);
            asm volatile("s_waitcnt vmcnt(0)" ::: "memory");
        } else {
            XB_SPIN(xb_ld(&bar[XB_XGEN(b.x)]) == gen, bar);
            __builtin_amdgcn_fence(__ATOMIC_ACQUIRE, "agent");
            asm volatile("s_waitcnt vmcnt(0)" ::: "memory");
        }
    }
    __syncthreads();
}

__device__ __forceinline__ float row_rstd(const float* rp, int row, int fq, int lane) {
    const f32x4 a = *(const f32x4*)(rp + (size_t)row * 32 + fq * 8), b = *(const f32x4*)(rp + (size_t)row * 32 + fq * 8 + 4);
    float s = ((a[0] + a[1]) + (a[2] + a[3])) + ((b[0] + b[1]) + (b[2] + b[3]));
    s += shx(s, lane, 16); s += shx(s, lane, 32);
    return rsqrtf(s * (1.f / DM) + EPSV);
}
constexpr int RTAB_OFF = pg8::STAGE_BYTES;
__device__ __forceinline__ void fill_rstd_tab(LAS unsigned char* lds, const float* slots, int bx) {
    const int tid = opaque_tid(); const int panel = 8 * (bx & 7) + ((bx >> 3) & 7);
    if (tid < 256) { const float* rp = slots + ((size_t)panel * 256 + tid) * 32; float S[4];
#pragma unroll
        for (int k = 0; k < 4; ++k) { const f32x4 a = *(const f32x4*)(rp + k * 8), b = *(const f32x4*)(rp + k * 8 + 4); S[k] = ((a[0] + a[1]) + (a[2] + a[3])) + ((b[0] + b[1]) + (b[2] + b[3])); }
        ((LAS float*)(lds + RTAB_OFF))[tid] = rsqrtf(((S[0] + S[1]) + (S[2] + S[3])) * (1.f / DM) + EPSV); }
    __syncthreads();
}
template <int ACT  > struct EpiBf16 {
    static constexpr bool PERM = true;
    bf16_t* O; int ldc; const float* bias; LAS const float* tab;
    __device__ __forceinline__ void operator()(const f32x4 (&acc)[2][2][4][2], const Unit& u, int wr, int wc, int fr, int fq) const {
        const int row0 = u.pm * BM + wr * 64 + fr, col0 = u.pn * BM + wc * 32 + 8 * fq;
        f32x4 bv[2][2];
#pragma unroll
        for (int bj = 0; bj < 2; ++bj)
#pragma unroll
            for (int n = 0; n < 2; ++n) bv[bj][n] = (ACT == 2) ? *(const f32x4*)(bias + col0 + bj * HALF + 4 * n) : (f32x4){0.f, 0.f, 0.f, 0.f};
        float rsv[2][4];
#pragma unroll
        for (int ai = 0; ai < 2; ++ai)
#pragma unroll
            for (int m = 0; m < 4; ++m) rsv[ai][m] = tab ? tab[wr * 64 + fr + ai * HALF + m * 16] : 1.f;
        asm volatile("" ::: "memory");
#pragma unroll
        for (int ai = 0; ai < 2; ++ai)
#pragma unroll
            for (int m = 0; m < 4; ++m) { bf16_t* rowp = O + (size_t)(row0 + ai * HALF + m * 16) * ldc + col0;
                const float rs = rsv[ai][m];
#pragma unroll
                for (int bj = 0; bj < 2; ++bj) { f32x4 v0 = acc[ai][bj][m][0] * rs + bv[bj][0], v1 = acc[ai][bj][m][1] * rs + bv[bj][1];
                    if (ACT == 1) {
#pragma unroll
                        for (int j = 0; j < 4; ++j) { const float a = fmaxf(v0[j], 0.f), b = fmaxf(v1[j], 0.f); v0[j] = a * a; v1[j] = b * b; } }
                    if (ACT == 2) {
#pragma unroll
                        for (int j = 0; j < 4; ++j) { v0[j] = gelu_tanh(v0[j]); v1[j] = gelu_tanh(v1[j]); } }
                    u32x4 w; w.x = pk2(v0[0], v0[1]); w.y = pk2(v0[2], v0[3]); w.z = pk2(v1[0], v1[1]); w.w = pk2(v1[2], v1[3]);
                    *(u32x4*)(rowp + bj * HALF) = w; } }
    }
};
template <int MODE> struct EpiRes {
    static constexpr bool PERM = true;
    const bf16_t* base; bf16_t* out; const bf16_t* pp; int ldc; float* rss_out; LAS const float* tab_in;
    __device__ __forceinline__ void operator()(const f32x4 (&acc)[2][2][4][2], const Unit& u, int wr, int wc, int fr, int fq) const {
        const int row0 = u.pm * BM + wr * 64 + fr, col0 = u.pn * BM + wc * 32 + 8 * fq; const int lane = fq * 16 + fr;
        float rinv[8];
#pragma unroll
        for (int g = 0; g < 8; ++g) rinv[g] = (MODE == 1) ? tab_in[wr * 64 + fr + (g >> 2) * HALF + (g & 3) * 16] : 1.f;
        u32x4 bc[2], pc[2];
#pragma unroll
        for (int bj = 0; bj < 2; ++bj) { const size_t o2 = (size_t)row0 * ldc + col0 + bj * HALF; bc[bj] = *(const u32x4*)(base + o2); if (MODE == 1) pc[bj] = *(const u32x4*)(pp + o2); }
#pragma unroll
        for (int g = 0; g < 8; ++g) { const int ai = g >> 2, m = g & 3; const int row = row0 + ai * HALF + m * 16; const size_t off = (size_t)row * ldc + col0;
            f32x4 av[2][2];
#pragma unroll
            for (int bj = 0; bj < 2; ++bj) { f32x4 a0 = acc[ai][bj][m][0], a1 = acc[ai][bj][m][1];
                const f32x4 b0 = (f32x4){bflo(bc[bj].x), bfhi(bc[bj].x), bflo(bc[bj].y), bfhi(bc[bj].y)}, b1 = (f32x4){bflo(bc[bj].z), bfhi(bc[bj].z), bflo(bc[bj].w), bfhi(bc[bj].w)};
                if (MODE == 0) { a0 = a0 + b0; a1 = a1 + b1; }
                if (MODE == 1) { const f32x4 p0 = (f32x4){bflo(pc[bj].x), bfhi(pc[bj].x), bflo(pc[bj].y), bfhi(pc[bj].y)}, p1 = (f32x4){bflo(pc[bj].z), bfhi(pc[bj].z), bflo(pc[bj].w), bfhi(pc[bj].w)};
#pragma unroll
                    for (int j = 0; j < 4; ++j) { a0[j] = b0[j] + sigmoidf_(a0[j] * rinv[g]) * p0[j]; a1[j] = b1[j] + sigmoidf_(a1[j] * rinv[g]) * p1[j]; } }
                av[bj][0] = a0; av[bj][1] = a1; }
            asm volatile("" : "+v"(av[0][0]), "+v"(av[0][1]), "+v"(av[1][0]), "+v"(av[1][1]));
            if (g < 7) { const int rown = row0 + ((g + 1) >> 2) * HALF + ((g + 1) & 3) * 16;
#pragma unroll
                for (int bj = 0; bj < 2; ++bj) { const size_t o2 = (size_t)rown * ldc + col0 + bj * HALF; bc[bj] = *(const u32x4*)(base + o2); if (MODE == 1) pc[bj] = *(const u32x4*)(pp + o2); } }
            asm volatile("" ::: "memory");
            float ss = 0.f;
#pragma unroll
            for (int bj = 0; bj < 2; ++bj) { const f32x4 a0 = av[bj][0], a1 = av[bj][1];
                ss += ((a0[0] * a0[0] + a0[1] * a0[1]) + (a0[2] * a0[2] + a0[3] * a0[3])) + ((a1[0] * a1[0] + a1[1] * a1[1]) + (a1[2] * a1[2] + a1[3] * a1[3]));
                u32x4 w; w.x = pk2(a0[0], a0[1]); w.y = pk2(a0[2], a0[3]); w.z = pk2(a1[0], a1[1]); w.w = pk2(a1[2], a1[3]); *(u32x4*)(out + off + bj * HALF) = w; }
            ss += shx(ss, lane, 16); ss += shx(ss, lane, 32); if (fq == 0) rss_out[(size_t)row * 32 + u.pn * 4 + wc] = ss;
        }
    }
};
struct EpiNsa {
    static constexpr bool PERM = true;
    bf16_t *Q, *KC, *VC, *KS, *VST, *KW, *VWT; float* GL; LAS const float* tab;
    __device__ __forceinline__ void operator()(const f32x4 (&acc)[2][2][4][2], const Unit& u, int wr, int wc, int fr, int fq) const {
        const int row0 = u.pm * BM + wr * 64 + fr; const int pn = u.pn;
        float rsv[2][4];
#pragma unroll
        for (int ai = 0; ai < 2; ++ai)
#pragma unroll
            for (int m = 0; m < 4; ++m) rsv[ai][m] = tab[wr * 64 + fr + ai * HALF + m * 16];
        asm volatile("" ::: "memory");
#pragma unroll
        for (int ai = 0; ai < 2; ++ai)
#pragma unroll
            for (int m = 0; m < 4; ++m) { const int row = row0 + ai * HALF + m * 16; const int b = row >> 12, s = row & 4095;
                const float rs = rsv[ai][m];
#pragma unroll
                for (int bj = 0; bj < 2; ++bj) { const f32x4 v0 = acc[ai][bj][m][0] * rs, v1 = acc[ai][bj][m][1] * rs;
                    const int cl = bj * HALF + wc * 32 + 8 * fq;
                    if (pn < 8) { u32x4 w; w.x = pk2(v0[0], v0[1]); w.y = pk2(v0[2], v0[3]); w.z = pk2(v1[0], v1[1]); w.w = pk2(v1[2], v1[3]);
                        *(u32x4*)(Q + (size_t)row * 2048 + pn * 256 + cl) = w; }
                    else { const int k = (pn - 8) >> 1; const int c = ((pn - 8) & 1) * 256 + cl; const int g = c >> 7, d = c & 127;
                        if (k == 3 || k == 5) { bf16_t* dst = (k == 3 ? VST : VWT) + ((size_t)((b * 4 + g) * 128 + d)) * 4096 + s;
#pragma unroll
                            for (int j = 0; j < 4; ++j) { dst[(size_t)j * 4096] = (bf16_t)f2bf(v0[j]); dst[(size_t)(4 + j) * 4096] = (bf16_t)f2bf(v1[j]); } }
                        else { bf16_t* dst = (k == 0 ? KC : k == 1 ? VC : k == 2 ? KS : KW) + ((size_t)((b * 4 + g) * 4096 + s)) * 128 + d;
                            u32x4 w; w.x = pk2(v0[0], v0[1]); w.y = pk2(v0[2], v0[3]); w.z = pk2(v1[0], v1[1]); w.w = pk2(v1[2], v1[3]);
                            *(u32x4*)dst = w; } }
 } }
    }
};
struct EpiGates {
    static constexpr bool PERM = true;
    float* GL; LAS const float* tab;
    __device__ __forceinline__ void operator()(const f32x4 (&acc)[2][2][4][2], const Unit& u, int wr, int wc, int fr, int fq) const {
        const int row0 = u.pm * BM + wr * 64 + fr; const int cl = wc * 32 + 8 * fq;
        float rsv[2][4];
#pragma unroll
        for (int ai = 0; ai < 2; ++ai)
#pragma unroll
            for (int m = 0; m < 4; ++m) rsv[ai][m] = tab[wr * 64 + fr + ai * HALF + m * 16];
        if (cl < 48) {
#pragma unroll
            for (int ai = 0; ai < 2; ++ai)
#pragma unroll
                for (int m = 0; m < 4; ++m) { const int row = row0 + ai * HALF + m * 16; const float rs = rsv[ai][m];
                    const f32x4 v0 = acc[ai][0][m][0] * rs, v1 = acc[ai][0][m][1] * rs; f32x4 a, c2;
#pragma unroll
                    for (int j = 0; j < 4; ++j) { a[j] = sigmoidf_(v0[j]); c2[j] = sigmoidf_(v1[j]); }
                    float* dst = GL + (size_t)row * 48 + cl; *(f32x4*)dst = a; *(f32x4*)(dst + 4) = c2; } }
    }
};
template <int TR> struct EpiCmp2 {
    static constexpr bool PERM = true;
    bf16_t* O;
    __device__ __forceinline__ void operator()(const f32x4 (&acc)[2][2][4][2], const Unit& u, int wr, int wc, int fr, int fq) const {
        const int row0 = u.pm * BM + wr * 64 + fr; const int cl = wc * 32 + 8 * fq;
#pragma unroll
        for (int ai = 0; ai < 2; ++ai)
#pragma unroll
            for (int m = 0; m < 4; ++m) { const int row = row0 + ai * HALF + m * 16; const f32x4 v0 = acc[ai][0][m][0], v1 = acc[ai][0][m][1];
                if (TR == 0) { u32x4 w; w.x = pk2(v0[0], v0[1]); w.y = pk2(v0[2], v0[3]); w.z = pk2(v1[0], v1[1]); w.w = pk2(v1[2], v1[3]);
                    *(u32x4*)(O + (size_t)row * 128 + cl) = w; }
                else { bf16_t* dst = O + ((size_t)((row >> 8) * 128 + cl)) * 256 + (row & 255);
#pragma unroll
                    for (int j = 0; j < 4; ++j) { dst[(size_t)j * 256] = (bf16_t)f2bf(v0[j]); dst[(size_t)(4 + j) * 256] = (bf16_t)f2bf(v1[j]); } } }
    }
};

constexpr size_t al256(size_t x) { return (x + 255) & ~(size_t)255; }
constexpr size_t SZ_WIN = (size_t)AB_IN * DM * 2, SZ_SQ = (size_t)DM * DM * 2, SZ_CIN = (size_t)C_INP * DM * 2, SZ_W1 = (size_t)512 * 4096 * 2, SZ_W2 = (size_t)256 * 512 * 2;
constexpr size_t SZ_UP = (size_t)DFF * DM * 2, SZ_WP = (size_t)DM * PLE * 2, SZ_WRI = (size_t)16 * 64 * 64 * 2, SZ_POOLT = (size_t)4 * 256 * 256 * 2, SZ_WU = (size_t)DM * 1024 * 2;
constexpr size_t WS_WIN = 0;
constexpr size_t WS_WOUT = WS_WIN + 2 * SZ_WIN;
constexpr size_t WS_CIN = WS_WOUT + 2 * SZ_SQ;
constexpr size_t WS_COUT = WS_CIN + 2 * SZ_CIN;
constexpr size_t WS_W1K = WS_COUT + 2 * SZ_SQ;
constexpr size_t WS_W1V = WS_W1K + 2 * SZ_W1;
constexpr size_t WS_W2K = WS_W1V + 2 * SZ_W1;
constexpr size_t WS_W2V = WS_W2K + 2 * SZ_W2;
constexpr size_t WS_WUP = WS_W2V + 2 * SZ_W2;
constexpr size_t WS_WDN = WS_WUP + 4 * SZ_UP;
constexpr size_t WS_WG = WS_WDN + 4 * SZ_UP;
constexpr size_t WS_WP = WS_WG + 4 * SZ_SQ;
constexpr size_t WS_WR = WS_WP + 4 * SZ_WP;
constexpr size_t WS_WI = WS_WR + 2 * SZ_WRI;
constexpr size_t WS_POOLT = WS_WI + 2 * SZ_WRI;
constexpr size_t WS_WU = WS_POOLT + 2 * SZ_POOLT;
constexpr size_t WS_PB = WS_WU + 2 * SZ_WU;
constexpr size_t WS_POSB = WS_PB + (size_t)4 * T_TOK * PLE * 2;
constexpr size_t WS_XN = WS_POSB + 8192;
constexpr size_t WS_YB = WS_XN + (size_t)T_TOK * DM * 2;
constexpr size_t WS_Z = WS_YB + (size_t)T_TOK * DM * 2;
constexpr size_t SZ_KV = (size_t)16 * 4096 * 128 * 2;
constexpr size_t Z_Q = 0, Z_KC = (size_t)T_TOK * DM * 2, Z_VC = Z_KC + SZ_KV, Z_KS = Z_VC + SZ_KV, Z_VST = Z_KS + SZ_KV, Z_KW = Z_VST + SZ_KV, Z_VWT = Z_KW + SZ_KV;
constexpr size_t Z_GL = Z_VWT + SZ_KV, Z_HIDK = Z_GL + (size_t)T_TOK * 48 * 4, Z_HIDV = Z_HIDK + (size_t)4096 * 512 * 2, Z_KCMP = Z_HIDV + (size_t)4096 * 512 * 2, Z_VCMPT = Z_KCMP + (size_t)4096 * 128 * 2;
constexpr size_t WS_BAR = WS_Z + (size_t)T_TOK * DFF * 2;
constexpr size_t WS_ROWSS = WS_BAR + XCD_BAR_WORDS * 4 + 256;
constexpr size_t WS_PP = WS_ROWSS + (size_t)13 * T_TOK * 32 * 4;
constexpr size_t WS_POSP = WS_PP + (size_t)T_TOK * DM * 2;
constexpr size_t WS_WGL = WS_POSP + (size_t)4 * 64 * 512 * 4;
constexpr size_t WS_H2 = WS_WGL + (size_t)2 * 256 * DM * 2;
constexpr size_t WS_END = WS_H2 + (size_t)T_TOK * DM * 2;
static_assert(Z_VCMPT + 4096 * 128 * 2 <= (size_t)T_TOK * DFF * 2, "z region");
static_assert(WS_END <= (size_t)1 << 30, "workspace");
constexpr int LDS_BYTES = 147456;

struct Args { const float* in[29]; float* out; unsigned char* ws; int lo, hi, one, pad; };

__device__ __forceinline__ void titem_load(float (&v)[64], const float* W, int N, int ldw, int item, int lane) {
    const int nblk = (N + 63) / 64, kb = item / nblk, nb = item % nblk, k0 = 64 * kb, n0 = 64 * nb;
    const int nn = n0 + lane; const bool ok = nn < N;
    const float* p = W + (size_t)k0 * ldw + nn;
#pragma unroll
    for (int i = 0; i < 64; ++i) v[i] = ok ? p[(size_t)i * ldw] : 0.f;
}
__device__ __forceinline__ void titem_store(const float (&v)[64], int N, bf16_t* WT, int ldt, LAS float* scr, int item, int lane, const float* gk) {
    const int nblk = (N + 63) / 64, kb = item / nblk, nb = item % nblk, k0 = 64 * kb, n0 = 64 * nb;
#pragma unroll
    for (int i = 0; i < 64; ++i) scr[i * 65 + lane] = v[i];
    asm volatile("s_waitcnt lgkmcnt(0)" ::: "memory");
    const int c = lane & 7;
    f32x4 g0 = (f32x4){1.f, 1.f, 1.f, 1.f}, g1 = g0; if (gk) { g0 = *(const f32x4*)(gk + k0 + 8 * c); g1 = *(const f32x4*)(gk + k0 + 8 * c + 4); }
#pragma unroll
    for (int j = 0; j < 8; ++j) { const int n = (lane >> 3) + 8 * j; const LAS float* s = scr + (8 * c) * 65 + n;
        u32x4 o; o.x = pk2(s[0 * 65] * g0[0], s[1 * 65] * g0[1]); o.y = pk2(s[2 * 65] * g0[2], s[3 * 65] * g0[3]); o.z = pk2(s[4 * 65] * g1[0], s[5 * 65] * g1[1]); o.w = pk2(s[6 * 65] * g1[2], s[7 * 65] * g1[3]);
        if (n0 + n < N) *(u32x4*)(WT + (size_t)(n0 + n) * ldt + k0 + 8 * c) = o; }
    asm volatile("s_waitcnt lgkmcnt(0)" ::: "memory");
}
__device__ __forceinline__ void conv_mat(const float* W, int K, int N, int ldw, bf16_t* WT, int ldt, LAS float* scr, int gw, int NGW, int lane, int& rot, const float* gk = nullptr) {
    const int nitems = (K / 64) * ((N + 63) / 64);
    int it = gw - rot; if (it < 0) it += NGW;
    rot = (rot + nitems) % NGW;
    if (it >= nitems) return;
    float va[64], vb[64];
    titem_load(va, W, N, ldw, it, lane);
    for (;;) {
        const int n1 = it + NGW; if (n1 < nitems) titem_load(vb, W, N, ldw, n1, lane);
        titem_store(va, N, WT, ldt, scr, it, lane, gk);
        if (n1 >= nitems) break;
        const int n2 = n1 + NGW; if (n2 < nitems) titem_load(va, W, N, ldw, n2, lane);
        titem_store(vb, N, WT, ldt, scr, n1, lane, gk);
        if (n2 >= nitems) break;
        it = n2;
    }
}
__device__ __forceinline__ void conv_plain(const float* src, int rows, int ncols, int lds_, bf16_t* dst, int ldd, int gt, int NGT, const float* gk = nullptr) {
    const unsigned cpr = (unsigned)ncols / 8u; const unsigned total = (unsigned)rows * cpr;
    for (unsigned i = (unsigned)gt; i < total; i += (unsigned)NGT) { const int r = (int)(i / cpr), c = (int)(i % cpr) * 8;
        f32x4 a = *(const f32x4*)(src + (size_t)r * lds_ + c), b = *(const f32x4*)(src + (size_t)r * lds_ + c + 4);
        if (gk) { const float gg = gk[r]; a = a * gg; b = b * gg; }
        u32x4 o; o.x = f2bf(a[0]) | (f2bf(a[1]) << 16); o.y = f2bf(a[2]) | (f2bf(a[3]) << 16); o.z = f2bf(b[0]) | (f2bf(b[1]) << 16); o.w = f2bf(b[2]) | (f2bf(b[3]) << 16);
        *(u32x4*)(dst + (size_t)r * ldd + c) = o; }
}
__device__ __forceinline__ void zero_fill16(unsigned char* p, size_t bytes, int gt, int NGT) {
    const u32x4 z = (u32x4){0u, 0u, 0u, 0u};
    for (size_t i = (size_t)gt * 16; i < bytes; i += (size_t)NGT * 16) *(u32x4*)(p + i) = z;
}

template <bool F32OUT>
__device__ __forceinline__ void rmsnorm_rows(const float* X, const float* g, bf16_t* O, float* OF, int bx, int NGW) {
    asm volatile("" ::: "memory"); const int tid = opaque_tid(), lane = tid & 63; const int gw = opq(bx) * 8 + __builtin_amdgcn_readfirstlane(tid >> 6);
    f32x4 gv[8];
#pragma unroll
    for (int j = 0; j < 8; ++j) gv[j] = *(const f32x4*)(g + (lane + 64 * j) * 4);
    for (int r = gw; r < T_TOK; r += NGW) {
        const bf16_t* xr = (const bf16_t*)X + (size_t)r * DM; f32x4 v[8]; float s = 0.f;
#pragma unroll
        for (int j = 0; j < 8; ++j) { const u32x2 w = *(const u32x2*)(xr + (lane + 64 * j) * 4); v[j] = (f32x4){bflo(w.x), bfhi(w.x), bflo(w.y), bfhi(w.y)}; s += (v[j][0] * v[j][0] + v[j][1] * v[j][1]) + (v[j][2] * v[j][2] + v[j][3] * v[j][3]); }
        const float rstd = rsqrtf(wave_sum(s, lane) * (1.f / DM) + EPSV);
#pragma unroll
        for (int j = 0; j < 8; ++j) { const f32x4 y = v[j] * rstd * gv[j];
            if (F32OUT) *(f32x4*)(OF + (size_t)r * DM + (lane + 64 * j) * 4) = y;
            else { u32x2 w; w.x = pk2(y[0], y[1]); w.y = pk2(y[2], y[3]); *(u32x2*)(O + (size_t)r * DM + (lane + 64 * j) * 4) = w; } }
    }
}

__device__ __forceinline__ void rows_to_bf16_ss(const float* X, bf16_t* O, float* rss, int bx, int NGW) {
    const int tid = opaque_tid(), lane = tid & 63; const int gw = opq(bx) * 8 + __builtin_amdgcn_readfirstlane(tid >> 6);
    for (int r = gw; r < T_TOK; r += NGW) {
        const float* xr = X + (size_t)r * DM; f32x4 v[8]; float s = 0.f;
#pragma unroll
        for (int j = 0; j < 8; ++j) { v[j] = *(const f32x4*)(xr + (lane + 64 * j) * 4); s += (v[j][0] * v[j][0] + v[j][1] * v[j][1]) + (v[j][2] * v[j][2] + v[j][3] * v[j][3]); }
        s = wave_sum(s, lane); if (lane < 32) rss[(size_t)r * 32 + lane] = (lane == 0) ? s : 0.f;
#pragma unroll
        for (int j = 0; j < 8; ++j) { u32x2 w; w.x = pk2(v[j][0], v[j][1]); w.y = pk2(v[j][2], v[j][3]); *(u32x2*)(O + (size_t)r * DM + (lane + 64 * j) * 4) = w; }
    }
}
__device__ __forceinline__ void lru_item(LAS unsigned char* lds, int item, const bf16_t* ZE, const float* conv_w, const float* conv_b,
                                         const bf16_t* WrT, const bf16_t* WiT, const float* b_r, const float* b_i, const float* lam, bf16_t* YB) {
    const int tid = opaque_tid(), w = __builtin_amdgcn_readfirstlane(tid >> 6), lane = tid & 63, fr = lane & 15, fq = lane >> 4;
    const int b = item >> 6, hh = (item >> 2) & 15, qq = item & 3;
    LAS unsigned char* XC = lds;
    LAS float* SEGA = (LAS float*)(lds + 36864);
    LAS float* SEGB = SEGA + 1024;
    LAS float* HIN = SEGB + 1024;
    const int co = tid & 7, tr = tid >> 3;
    float cw[4][8], cb[8];
#pragma unroll
    for (int k = 0; k < 4; ++k)
#pragma unroll
        for (int e = 0; e < 8; ++e) cw[k][e] = conv_w[k * 1024 + hh * 64 + co * 8 + e];
#pragma unroll
    for (int e = 0; e < 8; ++e) cb[e] = conv_b[hh * 64 + co * 8 + e];
    bf16x8 wrf[2], wif[2];
#pragma unroll
    for (int kk = 0; kk < 2; ++kk) { wrf[kk] = *(const bf16x8*)(WrT + ((size_t)hh * 64 + qq * 16 + fr) * 64 + kk * 32 + fq * 8); wif[kk] = *(const bf16x8*)(WiT + ((size_t)hh * 64 + qq * 16 + fr) * 64 + kk * 32 + fq * 8); }
    const int ch = hh * 64 + qq * 16 + fr;
    const float br = b_r[ch], bi = b_i[ch];
    const float lm = lam[ch]; float sp8; { const float e = __expf(-lm); const float ser = e * (1.f - e * (0.5f - e * (0.33333333f - e * 0.25f)));
        sp8 = 8.0f * ((-lm > 20.f) ? -lm : (e < 0.03f ? ser : __logf(1.0f + e))); }
    float carry = 0.f;
    const bf16_t* zb = ZE + (size_t)b * SEQ * AB_IN;
    u32x4 xr[7];
#pragma unroll
    for (int r = 0; r < 7; ++r) { const int t = tr * 4 - 3 + r; xr[r] = (t >= 0) ? *(const u32x4*)(zb + (size_t)t * AB_IN + hh * 64 + co * 8) : (u32x4){0u, 0u, 0u, 0u}; }
    for (int sc = 0; sc < 16; ++sc) {
        const int t0 = sc * 256;
        unsigned short gr[2][4];
#pragma unroll
        for (int ml = 0; ml < 2; ++ml)
#pragma unroll
            for (int r = 0; r < 4; ++r) gr[ml][r] = zb[(size_t)(t0 + (w * 2 + ml) * 16 + fq * 4 + r) * AB_IN + 1024 + ch];
        {
            float xin[7][8];
#pragma unroll
            for (int r = 0; r < 7; ++r) { const u32x4 v = xr[r];
                xin[r][0] = bflo(v.x); xin[r][1] = bfhi(v.x); xin[r][2] = bflo(v.y); xin[r][3] = bfhi(v.y); xin[r][4] = bflo(v.z); xin[r][5] = bfhi(v.z); xin[r][6] = bflo(v.w); xin[r][7] = bfhi(v.w); }
#pragma unroll
            for (int q = 0; q < 4; ++q) { float o[8];
#pragma unroll
                for (int e = 0; e < 8; ++e) o[e] = cb[e] + cw[0][e] * xin[q][e] + cw[1][e] * xin[q + 1][e] + cw[2][e] * xin[q + 2][e] + cw[3][e] * xin[q + 3][e];
                u32x4 wv; wv.x = pk2(o[0], o[1]); wv.y = pk2(o[2], o[3]); wv.z = pk2(o[4], o[5]); wv.w = pk2(o[6], o[7]);
                *(LAS u32x4*)(XC + (tr * 4 + q) * 144 + co * 16) = wv; }
            if (sc < 15) {
#pragma unroll
                for (int r = 0; r < 7; ++r) xr[r] = *(const u32x4*)(zb + (size_t)(t0 + 256 + tr * 4 - 3 + r) * AB_IN + hh * 64 + co * 8); }
        }
        __syncthreads();
        float av[2][4], bv[2][4];
#pragma unroll
        for (int ml = 0; ml < 2; ++ml) { const int mt = w * 2 + ml;
            f32x4 ar = (f32x4){0.f, 0.f, 0.f, 0.f}, ai = ar;
#pragma unroll
            for (int kk = 0; kk < 2; ++kk) { const bf16x8 xa = *(const LAS bf16x8*)(XC + (mt * 16 + fr) * 144 + kk * 64 + fq * 16);
                ar = __builtin_amdgcn_mfma_f32_16x16x32_bf16(xa, wrf[kk], ar, 0, 0, 0); ai = __builtin_amdgcn_mfma_f32_16x16x32_bf16(xa, wif[kk], ai, 0, 0, 0); }
            float A = 1.f, Bc = 0.f;
#pragma unroll
            for (int r = 0; r < 4; ++r) { const int tok = mt * 16 + fq * 4 + r;
                const float xcv = bf2f(*(const LAS unsigned short*)(XC + tok * 144 + (qq * 16 + fr) * 2));
                const float rg = sigmoidf_(ar[r] + br), ig = sigmoidf_(ai[r] + bi);
                const float la = -rg * sp8; const float a = __expf(la); const float x2 = 2.f * la; const float em = (x2 > -0.3f) ? -x2 * (1.f + x2 * 0.5f * (1.f + x2 * 0.33333333f * (1.f + x2 * 0.25f * (1.f + x2 * 0.2f * (1.f + x2 * 0.16666667f))))) : 1.f - __expf(x2);
                const float mult = __builtin_amdgcn_sqrtf(fmaxf(em, 0.f));
                av[ml][r] = a; bv[ml][r] = mult * ig * xcv;
                Bc = a * Bc + bv[ml][r]; A = A * a; }
            const int sg = mt * 4 + fq; SEGA[sg * 16 + fr] = A; SEGB[sg * 16 + fr] = Bc; }
        __syncthreads();
        if (w == 0 && lane < 16) { float h = carry;
#pragma unroll 8
            for (int sg = 0; sg < 64; ++sg) { HIN[sg * 16 + lane] = h; h = SEGA[sg * 16 + lane] * h + SEGB[sg * 16 + lane]; }
            carry = h; }
        __syncthreads();
#pragma unroll
        for (int ml = 0; ml < 2; ++ml) { const int mt = w * 2 + ml; float h = HIN[(mt * 4 + fq) * 16 + fr];
#pragma unroll
            for (int r = 0; r < 4; ++r) { const int t = t0 + mt * 16 + fq * 4 + r; h = av[ml][r] * h + bv[ml][r];
                const float gt = bf2f(gr[ml][r]);
                YB[((size_t)b * SEQ + t) * DM + ch] = (bf16_t)f2bf(h * gelu_tanh(gt)); } }
    }
    __syncthreads();
}
__device__ __forceinline__ void pool_item(int item, const bf16_t* ZE, const float* scale, bf16_t* YB) {
    const int tid = opaque_tid(), b = item >> 6, tch = item & 63, co = tid & 127, seg = tid >> 7;
    const int win = 2 << (co >> 5);
    float sc[8];
#pragma unroll
    for (int e = 0; e < 8; ++e) sc[e] = scale[co * 8 + e];
    const bf16_t* zb = ZE + (size_t)b * SEQ * AB_IN + 2048 + co * 8;
    const int ts = tch * 64 + seg * 16;
    float sum[8];
#pragma unroll
    for (int e = 0; e < 8; ++e) sum[e] = 0.f;
    for (int s = ts - win + 1; s < ts; ++s) if (s >= 0) { const u32x4 v = *(const u32x4*)(zb + (size_t)s * AB_IN);
        sum[0] += bflo(v.x); sum[1] += bfhi(v.x); sum[2] += bflo(v.y); sum[3] += bfhi(v.y); sum[4] += bflo(v.z); sum[5] += bfhi(v.z); sum[6] += bflo(v.w); sum[7] += bfhi(v.w); }
    for (int t = ts; t < ts + 16; ++t) {
        const u32x4 v = *(const u32x4*)(zb + (size_t)t * AB_IN);
        float x[8] = {bflo(v.x), bfhi(v.x), bflo(v.y), bfhi(v.y), bflo(v.z), bfhi(v.z), bflo(v.w), bfhi(v.w)};
        const float inv = __builtin_amdgcn_rcpf((float)((t + 1) < win ? (t + 1) : win));
        float o[8];
#pragma unroll
        for (int e = 0; e < 8; ++e) { sum[e] += x[e]; o[e] = (sum[e] * inv - x[e]) * sc[e]; }
        u32x4 wv; wv.x = pk2(o[0], o[1]); wv.y = pk2(o[2], o[3]); wv.z = pk2(o[4], o[5]); wv.w = pk2(o[6], o[7]);
        *(u32x4*)(YB + ((size_t)b * SEQ + t) * DM + 1024 + co * 8) = wv;
        const int so = t - win + 1;
        if (so >= 0) { const u32x4 q = *(const u32x4*)(zb + (size_t)so * AB_IN);
            sum[0] -= bflo(q.x); sum[1] -= bfhi(q.x); sum[2] -= bflo(q.y); sum[3] -= bfhi(q.y); sum[4] -= bflo(q.z); sum[5] -= bfhi(q.z); sum[6] -= bflo(q.w); sum[7] -= bfhi(q.w); }
    }
}

constexpr int KT_PITCH = 272, VT_PITCH = 144;
constexpr int AL_KT = 0, AL_VT = 64 * KT_PITCH, AL_BUF = 36864  , AL_IMPA = 2 * 36864, AL_IMPB = AL_IMPA + 64 * 65 * 4, AL_SEL = AL_IMPB + 64 * 65 * 4, AL_UNI = AL_SEL + 512, AL_Q = 73728, Q_WAVE = 32 * KT_PITCH;
constexpr float QSCALE2 = 0.08838834764831845f * LOG2E;
constexpr float NEGB = -1e30f;

struct StageRegs { u32x4 k[2], v[2]; };
__device__ __forceinline__ void stage_load(StageRegs& R, const bf16_t* kbase, const bf16_t* vbase, int vpitch, int tid) {
    const int kr = tid >> 3, kc = tid & 7, vr = tid >> 2, vc = tid & 3;
    R.k[0] = *(const u32x4*)(kbase + kr * 128 + kc * 8); R.k[1] = *(const u32x4*)(kbase + kr * 128 + 64 + kc * 8);
    R.v[0] = *(const u32x4*)(vbase + (size_t)vr * vpitch + vc * 8); R.v[1] = *(const u32x4*)(vbase + (size_t)vr * vpitch + 32 + vc * 8);
}
__device__ __forceinline__ void stage_store(const StageRegs& R, LAS unsigned char* lds, int tid) {
    const int kr = tid >> 3, kc = tid & 7, vr = tid >> 2, vc = tid & 3;
    *(LAS u32x4*)(lds + AL_KT + kr * KT_PITCH + kc * 16) = R.k[0]; *(LAS u32x4*)(lds + AL_KT + kr * KT_PITCH + 128 + kc * 16) = R.k[1];
    *(LAS u32x4*)(lds + AL_VT + vr * VT_PITCH + vc * 16) = R.v[0]; *(LAS u32x4*)(lds + AL_VT + vr * VT_PITCH + 64 + vc * 16) = R.v[1];
}
template <int MODE>
__device__ __forceinline__ void attn_tile(bool MASK, LAS unsigned char* lds, LAS unsigned char* ldsi, const bf16x8 (&qf)[2][4], f32x4 (&O)[2][8], float (&m)[2], float (&l)[2], const int (&tpos)[2], float slope2,
                                          int kp0, const bool (&selbit)[2], int fr, int fq, int wv, int tile64, int lane) {
    constexpr int KS = (MODE <= 1) ? 16 : 1;
    f32x4 s[2][4];
#pragma unroll
    for (int ci = 0; ci < 2; ++ci)
#pragma unroll
        for (int k4 = 0; k4 < 4; ++k4) s[ci][k4] = (f32x4){0.f, 0.f, 0.f, 0.f};
#pragma unroll
    for (int kk = 0; kk < 4; ++kk) {
        const bf16x8 q0 = qf[0][kk], q1 = qf[1][kk];
#pragma unroll
        for (int k4 = 0; k4 < 4; ++k4) { const bf16x8 kf = *(const LAS bf16x8*)(lds + AL_KT + (k4 * 16 + fr) * KT_PITCH + kk * 64 + fq * 16);
            s[0][k4] = __builtin_amdgcn_mfma_f32_16x16x32_bf16(kf, q0, s[0][k4], 0, 0, 0);
            s[1][k4] = __builtin_amdgcn_mfma_f32_16x16x32_bf16(kf, q1, s[1][k4], 0, 0, 0); } }
    const float sk = slope2 * (float)KS;
    float alpha[2] = {1.f, 1.f};
#pragma unroll
    for (int ci = 0; ci < 2; ++ci) {
        const int base = tpos[ci] - kp0 - KS * (fq * 4);
        const float bb = -slope2 * (float)base;
        float mx = NEGB;
#pragma unroll
        for (int k4 = 0; k4 < 4; ++k4)
#pragma unroll
            for (int j = 0; j < 4; ++j) {
                s[ci][k4][j] = __builtin_fmaf(s[ci][k4][j], QSCALE2, __builtin_fmaf(sk, (float)(k4 * 16 + j), bb)); }
        if (MASK) {
#pragma unroll
            for (int k4 = 0; k4 < 4; ++k4)
#pragma unroll
                for (int j = 0; j < 4; ++j) { const int c = KS * (k4 * 16 + j); bool ok = c <= base; if (MODE == 3) ok = ok && (base - c < 512); s[ci][k4][j] = ok ? s[ci][k4][j] : 2.0f * NEGB; } }
#pragma unroll
        for (int k4 = 0; k4 < 4; ++k4)
#pragma unroll
            for (int j = 0; j < 4; ++j) mx = fmaxf(mx, s[ci][k4][j]);
        if (MODE == 2) mx = selbit[ci] ? mx : NEGB;
        if (MODE != 1) {
            mx = fmaxf(mx, shx(mx, lane, 16)); mx = fmaxf(mx, shx(mx, lane, 32));
            const float mn = fmaxf(m[ci], mx); alpha[ci] = __builtin_amdgcn_exp2f(m[ci] - mn); m[ci] = mn;
            float ps = 0.f;
#pragma unroll
            for (int k4 = 0; k4 < 4; ++k4)
#pragma unroll
                for (int j = 0; j < 4; ++j) { const float p = __builtin_amdgcn_exp2f(s[ci][k4][j] - mn); s[ci][k4][j] = p; ps += p; }
            if (MODE == 2) ps = selbit[ci] ? ps : 0.f;
            l[ci] = l[ci] * alpha[ci] + ps;
        } else {
#pragma unroll
            for (int k4 = 0; k4 < 4; ++k4) {
#pragma unroll
                for (int j = 0; j < 4; ++j) s[ci][k4][j] = __builtin_amdgcn_exp2f(s[ci][k4][j] - m[ci]) * l[ci];
                float a = (s[ci][k4][0] + s[ci][k4][1]) + (s[ci][k4][2] + s[ci][k4][3]); float b3 = s[ci][k4][3];
                a += shx(a, lane, 1); a += shx(a, lane, 2); b3 += shx(b3, lane, 1); b3 += shx(b3, lane, 2);
                if ((fr & 3) == 0) { const int tl = wv * 8 + ci * 4 + (fr >> 2); const int ms = tile64 * 16 + k4 * 4 + fq;
                    ((LAS float*)(ldsi + AL_IMPA))[tl * 65 + ms] = a; ((LAS float*)(ldsi + AL_IMPB))[tl * 65 + ms + 1] = b3; } }
        }
    }
    if (MODE >= 2) {
        if (__builtin_amdgcn_ballot_w64(alpha[0] != 1.f || alpha[1] != 1.f) != 0ull) {
#pragma unroll
            for (int ci = 0; ci < 2; ++ci)
#pragma unroll
                for (int dt = 0; dt < 8; ++dt) O[ci][dt] = O[ci][dt] * alpha[ci]; }
    }
    if (MODE != 0) {
#pragma unroll
        for (int ks = 0; ks < 2; ++ks) {
            bf16x8 pf[2];
#pragma unroll
            for (int ci = 0; ci < 2; ++ci) { u32x4 w; w.x = pk2(s[ci][2 * ks][0], s[ci][2 * ks][1]); w.y = pk2(s[ci][2 * ks][2], s[ci][2 * ks][3]); w.z = pk2(s[ci][2 * ks + 1][0], s[ci][2 * ks + 1][1]); w.w = pk2(s[ci][2 * ks + 1][2], s[ci][2 * ks + 1][3]);
                if (MODE == 2) { w.x = selbit[ci] ? w.x : 0u; w.y = selbit[ci] ? w.y : 0u; w.z = selbit[ci] ? w.z : 0u; w.w = selbit[ci] ? w.w : 0u; }
                pf[ci] = __builtin_bit_cast(bf16x8, w); }
#pragma unroll
            for (int dt = 0; dt < 8; ++dt) { const LAS unsigned char* vp = lds + AL_VT + (dt * 16 + fr) * VT_PITCH + (ks * 32 + fq * 4) * 2;
                const u32x2 lo = *(const LAS u32x2*)vp, hi = *(const LAS u32x2*)(vp + 32);
                const bf16x8 vf = __builtin_bit_cast(bf16x8, (u32x4){lo.x, lo.y, hi.x, hi.y});
                O[0][dt] = __builtin_amdgcn_mfma_f32_16x16x32_bf16(vf, pf[0], O[0][dt], 0, 0, 0);
                O[1][dt] = __builtin_amdgcn_mfma_f32_16x16x32_bf16(vf, pf[1], O[1][dt], 0, 0, 0); }
        }
    }
}

__device__ __forceinline__ void nsa_item(LAS unsigned char* lds, int b, int g, int tq, const bf16_t* Q, const bf16_t* KS, const bf16_t* VST, const bf16_t* KW, const bf16_t* VWT,
                                         const bf16_t* KCMP, const bf16_t* VCMPT, const float* GL, bf16_t* YB) {
    const int tid = opaque_tid(), wv = __builtin_amdgcn_readfirstlane(tid >> 6), lane = tid & 63, fr = lane & 15, fq = lane >> 4;
    const int t0 = tq * 64, bg = b * 4 + g, head = g * 4 + (fr & 3);
    LAS float* IMPA = (LAS float*)(lds + AL_IMPA);
    LAS unsigned long long* SEL = (LAS unsigned long long*)(lds + AL_SEL);
    LAS unsigned long long* UNI = (LAS unsigned long long*)(lds + AL_UNI);
    __syncthreads();
    for (int i = tid; i < 2 * 64 * 65; i += 512) IMPA[i] = 0.f;
    int tpos[2]; bf16x8 qf[2][4]; int tc = 0;
#pragma unroll
    for (int ci = 0; ci < 2; ++ci) { tpos[ci] = t0 + wv * 8 + ci * 4 + (fr >> 2);
        const bf16_t* qp = Q + ((size_t)(b * SEQ + tpos[ci])) * DM + head * 128 + fq * 8;
#pragma unroll
        for (int kk = 0; kk < 4; ++kk) qf[ci][kk] = *(const bf16x8*)(qp + kk * 32);
    }
    const float slope2 = exp2f(-0.5f * (float)(head + 1)) * LOG2E;
    f32x4 O[2][8]; float m[2], l[2]; bool selbit[2] = {true, true};
#pragma unroll
    for (int ci = 0; ci < 2; ++ci)
#pragma unroll
        for (int dt = 0; dt < 8; ++dt) { O[ci][dt] = (f32x4){0.f, 0.f, 0.f, 0.f}; }
    StageRegs R;
    const int ncmp = ((t0 + 32) >> 4) + 1, nct = (ncmp + 63) >> 6;
    const bf16_t* kcb = KCMP + (size_t)bg * 256 * 128; const bf16_t* vcb = VCMPT + (size_t)bg * 128 * 256;
    m[0] = m[1] = NEGB; l[0] = l[1] = 0.f;
    stage_load(R, kcb, vcb, 256, tid);
    for (int ct = 0; ct < nct; ++ct) {
        LAS unsigned char* kvb = lds + (tc & 1) * AL_BUF; ++tc; stage_store(R, kvb, tid); __syncthreads();
        if (ct + 1 < nct) stage_load(R, kcb + (size_t)(ct + 1) * 64 * 128, vcb + (ct + 1) * 64, 256, tid);
        attn_tile<0>(1024 * ct + 1039 > t0, kvb, lds, qf, O, m, l, tpos, slope2, 16 * (ct * 64) + 31, selbit, fr, fq, wv, ct, lane);
    }
#pragma unroll
    for (int ci = 0; ci < 2; ++ci) { float lt = l[ci]; lt += shx(lt, lane, 16); lt += shx(lt, lane, 32); l[ci] = lt > 0.f ? 1.0f / lt : 0.f; }
    stage_load(R, kcb, vcb, 256, tid);
    for (int ct = 0; ct < nct; ++ct) {
        LAS unsigned char* kvb = lds + (tc & 1) * AL_BUF; ++tc; stage_store(R, kvb, tid); __syncthreads();
        if (ct + 1 < nct) stage_load(R, kcb + (size_t)(ct + 1) * 64 * 128, vcb + (ct + 1) * 64, 256, tid);
        attn_tile<1>(1024 * ct + 1039 > t0, kvb, lds, qf, O, m, l, tpos, slope2, 16 * (ct * 64) + 31, selbit, fr, fq, wv, ct, lane);
    }
#pragma unroll
    for (int ci = 0; ci < 2; ++ci) { const float gc = GL[((size_t)(b * SEQ + tpos[ci])) * 48 + head];
        bf16_t* op = YB + ((size_t)(b * SEQ + tpos[ci])) * DM + head * 128 + fq * 4;
#pragma unroll
        for (int dt = 0; dt < 8; ++dt) { const f32x4 o = O[ci][dt] * gc; u32x2 w; w.x = pk2(o[0], o[1]); w.y = pk2(o[2], o[3]); *(u32x2*)(op + dt * 16) = w; O[ci][dt] = (f32x4){0.f, 0.f, 0.f, 0.f}; } }
    __syncthreads();
    {
        const int cur = tq; unsigned long long wun = 0ull;
#pragma unroll 1
        for (int tk = 0; tk < 8; ++tk) { const int tl = wv * 8 + tk;
            float v = IMPA[tl * 65 + lane] + IMPA[64 * 65 + tl * 65 + lane];
            if (lane == 0 || lane == cur || lane == cur - 1) v += 1e6f;
            if (lane > cur) v = NEGB;
            int rank = 0; const int vi = __builtin_bit_cast(int, v);
#pragma unroll
            for (int mm = 0; mm < 64; ++mm) { const float vm = __builtin_bit_cast(float, __builtin_amdgcn_readlane(vi, mm)); rank += ((vm > v) || (vm == v && mm < lane)) ? 1 : 0; }
            const unsigned long long mk = __ballot(rank < 16 && lane <= cur);
            wun |= mk;
            if (lane == 0) SEL[tl] = mk; }
        if (lane == 0) UNI[wv] = wun;
    }
    __syncthreads();
    unsigned long long selm[2], wun, bun = 0ull;
#pragma unroll
    for (int ci = 0; ci < 2; ++ci) selm[ci] = SEL[wv * 8 + ci * 4 + (fr >> 2)];
    wun = UNI[wv];
#pragma unroll
    for (int i = 0; i < 8; ++i) bun |= UNI[i];
    { const unsigned lo = __builtin_amdgcn_readfirstlane((unsigned)bun), hi = __builtin_amdgcn_readfirstlane((unsigned)(bun >> 32)); bun = ((unsigned long long)hi << 32) | lo;
      const unsigned lo2 = __builtin_amdgcn_readfirstlane((unsigned)wun), hi2 = __builtin_amdgcn_readfirstlane((unsigned)(wun >> 32)); wun = ((unsigned long long)hi2 << 32) | lo2; }
    const bf16_t* ksb = KS + (size_t)bg * SEQ * 128; const bf16_t* vsb = VST + (size_t)bg * 128 * SEQ;
    m[0] = m[1] = NEGB; l[0] = l[1] = 0.f;
    {
        unsigned long long rem = bun; int j = 63 - __builtin_clzll(rem); rem &= ~(1ull << j);
        stage_load(R, ksb + (size_t)j * 64 * 128, vsb + j * 64, SEQ, tid);
        for (;;) {
            LAS unsigned char* kvb = lds + (tc & 1) * AL_BUF; ++tc; stage_store(R, kvb, tid); __syncthreads();
            const int jn = rem ? 63 - __builtin_clzll(rem) : -1; if (jn >= 0) { rem &= ~(1ull << jn); stage_load(R, ksb + (size_t)jn * 64 * 128, vsb + jn * 64, SEQ, tid); }
            if ((wun >> j) & 1ull) { selbit[0] = (selm[0] >> j) & 1ull; selbit[1] = (selm[1] >> j) & 1ull;
                attn_tile<2>(j == tq, kvb, lds, qf, O, m, l, tpos, slope2, j * 64, selbit, fr, fq, wv, 0, lane); }
            if (jn < 0) break; j = jn;
        }
    }
#pragma unroll
    for (int ci = 0; ci < 2; ++ci) { float lt = l[ci]; lt += shx(lt, lane, 16); lt += shx(lt, lane, 32); const float gs = GL[((size_t)(b * SEQ + tpos[ci])) * 48 + 16 + head]; const float sc = lt > 0.f ? gs / lt : 0.f;
        bf16_t* op = YB + ((size_t)(b * SEQ + tpos[ci])) * DM + head * 128 + fq * 4;
#pragma unroll
        for (int dt = 0; dt < 8; ++dt) { const f32x4 o = O[ci][dt] * sc; const u32x2 pv = *(const u32x2*)(op + dt * 16); u32x2 w; w.x = pk2(bflo(pv.x) + o[0], bfhi(pv.x) + o[1]); w.y = pk2(bflo(pv.y) + o[2], bfhi(pv.y) + o[3]); *(u32x2*)(op + dt * 16) = w; O[ci][dt] = (f32x4){0.f, 0.f, 0.f, 0.f}; } }
    const bf16_t* kwb = KW + (size_t)bg * SEQ * 128; const bf16_t* vwb = VWT + (size_t)bg * 128 * SEQ;
    m[0] = m[1] = NEGB; l[0] = l[1] = 0.f; selbit[0] = selbit[1] = true;
    {
        const int j0 = tq >= 8 ? tq - 8 : 0;
        stage_load(R, kwb + (size_t)tq * 64 * 128, vwb + tq * 64, SEQ, tid);
        for (int j = tq; j >= j0; --j) {
            LAS unsigned char* kvb = lds + (tc & 1) * AL_BUF; ++tc; stage_store(R, kvb, tid); __syncthreads();
            if (j > j0) stage_load(R, kwb + (size_t)(j - 1) * 64 * 128, vwb + (j - 1) * 64, SEQ, tid);
            attn_tile<3>(j == tq || j == tq - 8, kvb, lds, qf, O, m, l, tpos, slope2, j * 64, selbit, fr, fq, wv, 0, lane);
        }
    }
#pragma unroll
    for (int ci = 0; ci < 2; ++ci) { float lt = l[ci]; lt += shx(lt, lane, 16); lt += shx(lt, lane, 32); const float gwv = GL[((size_t)(b * SEQ + tpos[ci])) * 48 + 32 + head]; const float sc = lt > 0.f ? gwv / lt : 0.f;
        bf16_t* op = YB + ((size_t)(b * SEQ + tpos[ci])) * DM + head * 128 + fq * 4;
#pragma unroll
        for (int dt = 0; dt < 8; ++dt) { const f32x4 o = O[ci][dt] * sc; const u32x2 pv = *(const u32x2*)(op + dt * 16); u32x2 w; w.x = pk2(bflo(pv.x) + o[0], bfhi(pv.x) + o[1]); w.y = pk2(bflo(pv.y) + o[2], bfhi(pv.y) + o[3]); *(u32x2*)(op + dt * 16) = w; } }
}

__global__ void __launch_bounds__(512) fwd_kernel(Args a) {
    extern __shared__ __attribute__((aligned(16))) unsigned char lds_raw[];
    LAS unsigned char* lds = (LAS unsigned char*)lds_raw;
    const int G = gridDim.x, bx = blockIdx.x;
    const int NGW = G * 8, NGT = G * 512;
#define GW() (opq(bx) * 8 + __builtin_amdgcn_readfirstlane(opaque_tid() >> 6))
    unsigned char* ws = a.ws;
    int ph = 0;
    { volatile LAS unsigned* MISC = (volatile LAS unsigned*)(lds + LDS_BYTES - 64); if (threadIdx.x < 16) MISC[threadIdx.x] = 0u; }
    __syncthreads();
    (void)xcd_barrier_post((unsigned*)(ws + WS_BAR), (volatile LAS unsigned*)(lds + LDS_BYTES - 64));
#ifndef ONLY
#define ONLY -1
#endif
#define EN(id) (ONLY < 0 || ONLY == (id))
#define ON() (ph >= a.lo && ph < a.hi)
#define SEAM() do { ++ph; if (a.one) { if (ph == 1) cg::this_grid().sync(); else { XcdBarrier bar; bar.bar = (unsigned*)(opqp(ws) + WS_BAR); bar.x = xb_xcc_id(); bar.st = (volatile LAS unsigned*)(lds + LDS_BYTES - 64); xcd_barrier(bar); } } } while (0)

    bf16_t* XN = (bf16_t*)(ws + WS_XN); bf16_t* YB = (bf16_t*)(ws + WS_YB); unsigned char* Z = ws + WS_Z;
    float* posb = (float*)(ws + WS_POSB);

    if (EN(0) && ON())
#pragma unroll 1
    for (int rp0 = 0; rp0 < REP_P0; ++rp0) {
        const int tid = opaque_tid(), lane = tid & 63, wave = __builtin_amdgcn_readfirstlane(tid >> 6), gw = bx * 8 + wave, gt = bx * 512 + tid;
        LAS float* scr = (LAS float*)(lds + wave * 16640);
        int rot = 0;
        for (int i = 0; i < 4; ++i) {
            conv_mat(a.in[23] + (size_t)i * DM * DFF, DM, DFF, DFF, (bf16_t*)(ws + WS_WUP + i * SZ_UP), DM, scr, gw, NGW, lane, rot, a.in[22] + i * DM);
            conv_mat(a.in[24] + (size_t)i * DFF * DM, DFF, DM, DM, (bf16_t*)(ws + WS_WDN + i * SZ_UP), DFF, scr, gw, NGW, lane, rot);
            conv_mat(a.in[26] + (size_t)i * DM * DM, DM, DM, DM, (bf16_t*)(ws + WS_WG + i * SZ_SQ), DM, scr, gw, NGW, lane, rot, a.in[25] + i * DM);
            conv_mat(a.in[27] + (size_t)i * PLE * DM, PLE, DM, DM, (bf16_t*)(ws + WS_WP + i * SZ_WP), PLE, scr, gw, NGW, lane, rot);
        }
        for (int j = 0; j < 2; ++j) {
            conv_mat(a.in[3] + (size_t)j * DM * AB_IN, DM, 2048, AB_IN, (bf16_t*)(ws + WS_WIN + j * SZ_WIN), DM, scr, gw, NGW, lane, rot, a.in[2] + (2 * j) * DM);
            conv_mat(a.in[13] + (size_t)j * DM * DM, DM, DM, DM, (bf16_t*)(ws + WS_WOUT + j * SZ_SQ), DM, scr, gw, NGW, lane, rot);
            conv_mat(a.in[14] + (size_t)j * DM * C_IN, DM, C_INP, C_IN, (bf16_t*)(ws + WS_CIN + j * SZ_CIN), DM, scr, gw, NGW, lane, rot, a.in[2] + (2 * j + 1) * DM);
            conv_mat(a.in[14] + (size_t)j * DM * C_IN + C_INP, DM, 48, C_IN, (bf16_t*)(ws + WS_WGL + (size_t)j * 256 * DM * 2), DM, scr, gw, NGW, lane, rot, a.in[2] + (2 * j + 1) * DM);
            conv_mat(a.in[21] + (size_t)j * DM * DM, DM, DM, DM, (bf16_t*)(ws + WS_COUT + j * SZ_SQ), DM, scr, gw, NGW, lane, rot);
            conv_mat(a.in[16] + (size_t)j * 4096 * 512, 4096, 512, 512, (bf16_t*)(ws + WS_W1K + j * SZ_W1), 4096, scr, gw, NGW, lane, rot);
            conv_mat(a.in[19] + (size_t)j * 4096 * 512, 4096, 512, 512, (bf16_t*)(ws + WS_W1V + j * SZ_W1), 4096, scr, gw, NGW, lane, rot);
            conv_mat(a.in[17] + (size_t)j * 512 * 128, 512, 128, 128, (bf16_t*)(ws + WS_W2K + j * SZ_W2), 512, scr, gw, NGW, lane, rot);
            conv_mat(a.in[20] + (size_t)j * 512 * 128, 512, 128, 128, (bf16_t*)(ws + WS_W2V + j * SZ_W2), 512, scr, gw, NGW, lane, rot);
            for (int h = 0; h < 16; ++h) {
                conv_mat(a.in[6] + ((size_t)j * 16 + h) * 4096, 64, 64, 64, (bf16_t*)(ws + WS_WR + j * SZ_WRI) + h * 4096, 64, scr, gw, NGW, lane, rot);
                conv_mat(a.in[8] + ((size_t)j * 16 + h) * 4096, 64, 64, 64, (bf16_t*)(ws + WS_WI + j * SZ_WRI) + h * 4096, 64, scr, gw, NGW, lane, rot);
            }
            for (int gI = 0; gI < 4; ++gI)
                conv_mat(a.in[11] + ((size_t)j * 4 + gI) * 65536, 256, 256, 256, (bf16_t*)(ws + WS_POOLT + j * SZ_POOLT) + gI * 65536, 256, scr, gw, NGW, lane, rot);
            conv_plain(a.in[3] + (size_t)j * DM * AB_IN + 2048, DM, 1024, AB_IN, (bf16_t*)(ws + WS_WU + j * SZ_WU), 1024, gt, NGT, a.in[2] + (2 * j) * DM);
            zero_fill16(ws + WS_WGL + (size_t)j * 256 * DM * 2 + (size_t)48 * DM * 2, (size_t)208 * DM * 2, gt, NGT);
            zero_fill16(ws + WS_W2K + j * SZ_W2 + (size_t)128 * 512 * 2, (size_t)128 * 512 * 2, gt, NGT);
            zero_fill16(ws + WS_W2V + j * SZ_W2 + (size_t)128 * 512 * 2, (size_t)128 * 512 * 2, gt, NGT);
        }
        conv_plain(a.in[1], 4 * T_TOK, PLE, PLE, (bf16_t*)(ws + WS_PB), PLE, gt, NGT);
        rows_to_bf16_ss(a.in[0], XN, (float*)(ws + WS_ROWSS), bx, NGW);
        for (int it = gw; it < 4 * 8 * 64; it += NGW) { const int q = it >> 9, fc = (it >> 6) & 7, kc = it & 63, j = q >> 1;
            const float* pos = a.in[(q & 1) ? 18 : 15] + (size_t)j * 4096 + kc * 64; const float* w1 = a.in[(q & 1) ? 19 : 16] + (size_t)j * 4096 * 512 + (size_t)kc * 64 * 512 + fc * 64 + lane;
            float acc0 = 0.f, acc1 = 0.f, acc2 = 0.f, acc3 = 0.f;
#pragma unroll 4
            for (int k = 0; k < 64; k += 4) { acc0 += pos[k] * w1[(size_t)k * 512]; acc1 += pos[k + 1] * w1[(size_t)(k + 1) * 512]; acc2 += pos[k + 2] * w1[(size_t)(k + 2) * 512]; acc3 += pos[k + 3] * w1[(size_t)(k + 3) * 512]; }
            ((float*)(ws + WS_POSP))[((size_t)q * 64 + kc) * 512 + fc * 64 + lane] = (acc0 + acc1) + (acc2 + acc3); }
    }
    SEAM();
    if (EN(1) && ON()) {
        if (bx < 64) { const int j = bx >> 5, gI = (bx >> 3) & 3, pn = bx & 7;
            pg8::Gemm gm{(const bf16_t*)(ws + WS_POOLT + j * SZ_POOLT) + gI * 65536, (const bf16_t*)(ws + WS_WU + j * SZ_WU) + gI * 256, 256, 2048, 256, 256, 1024};
            pg8::StaticOrder S; S.init(256, 2048, G, pn);
            EpiBf16<0> E{(bf16_t*)(ws + WS_WIN + j * SZ_WIN) + (size_t)(2048 + gI * 256) * DM, DM, nullptr, nullptr};
            pg8::gemm_phase(lds, gm, S, E); }
        else { const int tid = opaque_tid(); const float* pp = (const float*)(ws + WS_POSP);
            for (int o = (bx - 64) * 512 + tid; o < 2048; o += (G - 64) * 512) { const int q = o >> 9, f = o & 511; float acc = 0.f;
                for (int kc = 0; kc < 64; ++kc) acc += pp[((size_t)q * 64 + kc) * 512 + f];
                posb[o] = acc; } }
    }
    SEAM();
#pragma unroll 1
    for (int layer = 0; layer < 4; ++layer) {
        const int j = layer >> 1; const bool even = (layer & 1) == 0;
        unsigned char* wsl = opqp(ws); unsigned char* Zl = wsl + WS_Z; bf16_t* XNl = (bf16_t*)(wsl + WS_XN); bf16_t* YBl = (bf16_t*)(wsl + WS_YB); float* posbl = (float*)(wsl + WS_POSB);
        const float* hin = (layer == 0) ? a.in[0] : a.out;
        float* RSS = (float*)(wsl + WS_ROWSS); bf16_t* PPl = (bf16_t*)(wsl + WS_PP);
        bf16_t* hc = (layer & 1) ? (bf16_t*)(wsl + WS_H2) : XNl;
        bf16_t* hn = (layer & 1) ? XNl : (bf16_t*)(wsl + WS_H2);
        const bf16_t* Ain = hc;
        LAS const float* RT = (LAS const float*)(lds + RTAB_OFF);
        if (EN(3) && ON()) {
            fill_rstd_tab(lds, RSS + (size_t)(layer * 3) * T_TOK * 32, opq(bx));
            if (even) { pg8::Gemm gm{Ain, (const bf16_t*)(wsl + WS_WIN + j * SZ_WIN), T_TOK, AB_IN, DM, DM, DM};
                pg8::StaticOrder S; S.init(T_TOK, AB_IN, opq(G), opq(bx)); EpiBf16<0> E{(bf16_t*)Zl, AB_IN, nullptr, RT}; pg8::gemm_phase(lds, gm, S, E); }
            else { pg8::Gemm gm{Ain, (const bf16_t*)(wsl + WS_CIN + j * SZ_CIN), T_TOK, C_INP, DM, DM, DM};
                pg8::StaticOrder S; S.init(T_TOK, C_INP, opq(G), opq(bx));
                EpiNsa E{(bf16_t*)(Zl + Z_Q), (bf16_t*)(Zl + Z_KC), (bf16_t*)(Zl + Z_VC), (bf16_t*)(Zl + Z_KS), (bf16_t*)(Zl + Z_VST), (bf16_t*)(Zl + Z_KW), (bf16_t*)(Zl + Z_VWT), (float*)(Zl + Z_GL), RT};
                pg8::gemm_phase(lds, gm, S, E); }
        }
        SEAM();
        if (even) {
            if (EN(4) && ON()) {
#ifndef NO_LRU
#pragma unroll 1
                for (int rp = 0; rp < REP_LRU; ++rp)
                for (int it = opq(bx); it < 256; it += G)
                    lru_item(lds, it, (const bf16_t*)Zl, a.in[4] + (size_t)j * 4096, a.in[5] + j * 1024, (const bf16_t*)(wsl + WS_WR + j * SZ_WRI), (const bf16_t*)(wsl + WS_WI + j * SZ_WRI),
                             a.in[7] + j * 1024, a.in[9] + j * 1024, a.in[10] + j * 1024, YBl);
#endif
                for (int it = opq(bx); it < 256; it += G) pool_item(it, (const bf16_t*)Zl, a.in[12] + j * 1024, YBl);
            }
            SEAM();
        } else {
            if (EN(5) && ON()) {
                if (bx < 64) { const int kv = bx >> 5;
                    pg8::Gemm gm{(const bf16_t*)(Zl + (kv ? Z_VC : Z_KC)), (const bf16_t*)(wsl + (kv ? WS_W1V : WS_W1K) + j * SZ_W1), 4096, 512, 4096, 2048, 4096};
                    pg8::StaticOrder S; S.init(4096, 512, opq(G), opq(bx) & 31);
                    EpiBf16<2> E{(bf16_t*)(Zl + (kv ? Z_HIDV : Z_HIDK)), 512, posbl + (j * 2 + kv) * 512, nullptr}; pg8::gemm_phase(lds, gm, S, E); }
                else if (bx < 128) { pg8::Gemm gm{Ain, (const bf16_t*)(wsl + WS_WGL + (size_t)j * 256 * DM * 2), T_TOK, 256, DM, DM, DM};
                    fill_rstd_tab(lds, RSS + (size_t)(layer * 3) * T_TOK * 32, opq(bx));
                    pg8::StaticOrder S; S.init(T_TOK, 256, opq(G), opq(bx) - 64); EpiGates E{(float*)(Zl + Z_GL), RT}; pg8::gemm_phase(lds, gm, S, E); }
                else { pg8::Gemm gp{(const bf16_t*)(wsl + WS_PB) + (size_t)layer * T_TOK * PLE, (const bf16_t*)(wsl + WS_WP + layer * SZ_WP), T_TOK, DM, PLE, PLE, PLE};
                    pg8::StaticOrder S2; S2.init(T_TOK, DM, 128, opq(bx) - 128); EpiBf16<0> E2{PPl, DM, nullptr, nullptr}; pg8::gemm_phase(lds, gp, S2, E2); }
            }
            SEAM();
            if (EN(6) && ON()) {
                if (bx < 16) { pg8::Gemm gm{(const bf16_t*)(Zl + Z_HIDK), (const bf16_t*)(wsl + WS_W2K + j * SZ_W2), 4096, 256, 512, 512, 512};
                    pg8::StaticOrder S; S.init(4096, 256, opq(G), opq(bx)); EpiCmp2<0> E{(bf16_t*)(Zl + Z_KCMP)}; pg8::gemm_phase(lds, gm, S, E); }
                else if (bx < 32) { pg8::Gemm gm{(const bf16_t*)(Zl + Z_HIDV), (const bf16_t*)(wsl + WS_W2V + j * SZ_W2), 4096, 256, 512, 512, 512};
                    pg8::StaticOrder S; S.init(4096, 256, opq(G), opq(bx) - 16); EpiCmp2<1> E{(bf16_t*)(Zl + Z_VCMPT)}; pg8::gemm_phase(lds, gm, S, E); }
            }
            SEAM();
            if (EN(7) && ON()) {
#pragma unroll 1
                for (int rp = 0; rp < REP_ATTN; ++rp)
                for (int it = opq(bx), r = 0; it < 1024; it += G, ++r) { const int c = it % 256, rr = it / 256; const int cp = (rr & 1) ? 255 - c : c;
                    const int tq = 63 - (rr * 16 + (cp >> 4)), bgi = cp & 15;
#ifndef NO_ATTN
                    nsa_item(lds, bgi >> 2, bgi & 3, tq, (const bf16_t*)(Zl + Z_Q), (const bf16_t*)(Zl + Z_KS), (const bf16_t*)(Zl + Z_VST), (const bf16_t*)(Zl + Z_KW), (const bf16_t*)(Zl + Z_VWT),
                             (const bf16_t*)(Zl + Z_KCMP), (const bf16_t*)(Zl + Z_VCMPT), (const float*)(Zl + Z_GL), YBl);
#endif
                }
                __syncthreads();
            }
            SEAM();
        }
        if (EN(8) && ON()) { pg8::Gemm gm{YBl, (const bf16_t*)(wsl + (even ? WS_WOUT : WS_COUT) + j * SZ_SQ), T_TOK, DM, DM, DM, DM};
            pg8::StaticOrder S; S.init(T_TOK, DM, opq(G), opq(bx)); EpiRes<0> E{hc, hc, nullptr, DM, RSS + (size_t)(layer * 3 + 1) * T_TOK * 32, nullptr}; pg8::gemm_phase(lds, gm, S, E);
            if (even) { pg8::Gemm gp{(const bf16_t*)(wsl + WS_PB) + (size_t)layer * T_TOK * PLE, (const bf16_t*)(wsl + WS_WP + layer * SZ_WP), T_TOK, DM, PLE, PLE, PLE};
              pg8::StaticOrder S2; S2.init(T_TOK, DM, opq(G), opq(bx)); EpiBf16<0> E2{PPl, DM, nullptr, nullptr}; pg8::gemm_phase(lds, gp, S2, E2); } }
        SEAM();
        if (EN(10) && ON())
#pragma unroll 1
        for (int rpu = 0; rpu < REP_UP; ++rpu) { fill_rstd_tab(lds, RSS + (size_t)(layer * 3 + 1) * T_TOK * 32, opq(bx));
            pg8::Gemm gm{hc, (const bf16_t*)(wsl + WS_WUP + layer * SZ_UP), T_TOK, DFF, DM, DM, DM};
            pg8::StaticOrder S; S.init(T_TOK, DFF, opq(G), opq(bx)); EpiBf16<1> E{(bf16_t*)Zl, DFF, nullptr, RT}; pg8::gemm_phase(lds, gm, S, E); }
        SEAM();
        if (EN(11) && ON()) { pg8::Gemm gm{(const bf16_t*)Zl, (const bf16_t*)(wsl + WS_WDN + layer * SZ_UP), T_TOK, DM, DFF, DFF, DFF};
            pg8::StaticOrder S; S.init(T_TOK, DM, opq(G), opq(bx)); EpiRes<0> E{hc, hc, nullptr, DM, RSS + (size_t)(layer * 3 + 2) * T_TOK * 32, nullptr}; pg8::gemm_phase(lds, gm, S, E); }
        SEAM();
        if (EN(13) && ON()) { fill_rstd_tab(lds, RSS + (size_t)(layer * 3 + 2) * T_TOK * 32, opq(bx));
            pg8::Gemm gm{hc, (const bf16_t*)(wsl + WS_WG + layer * SZ_SQ), T_TOK, DM, DM, DM, DM};
            pg8::StaticOrder S; S.init(T_TOK, DM, opq(G), opq(bx)); EpiRes<1> E{hc, hn, PPl, DM, RSS + (size_t)(layer * 3 + 3) * T_TOK * 32, RT}; pg8::gemm_phase(lds, gm, S, E); }
        SEAM();
    }
    if (EN(14) && ON()) rmsnorm_rows<true>((const float*)XN, a.in[28], nullptr, a.out, bx, NGW);
#undef ON
#undef SEAM
}
constexpr int N_PHASES = 1 + 2 * 9 + 2 * 11 + 1;

extern "C" void kernel_launch(void* const* d_in, const int* in_sizes, int n_in, void* d_out, int out_size, void* d_ws, size_t ws_size, hipStream_t stream) {
    static int grid = 0;
    if (grid == 0) {
        if (n_in != 29 || ws_size < WS_END) { fprintf(stderr, "kernel_launch: unexpected n_in %d / ws %zu (need %zu)\n", n_in, ws_size, (size_t)WS_END); grid = -1; return; }
        int dev = 0, cus = 0, per_cu = 0;
        hipGetDevice(&dev); hipDeviceGetAttribute(&cus, hipDeviceAttributeMultiprocessorCount, dev);
        if (hipFuncSetAttribute((const void*)fwd_kernel, hipFuncAttributeMaxDynamicSharedMemorySize, LDS_BYTES) != hipSuccess) { fprintf(stderr, "hipFuncSetAttribute failed\n"); grid = -1; return; }
        if (hipOccupancyMaxActiveBlocksPerMultiprocessor(&per_cu, (const void*)fwd_kernel, 512, LDS_BYTES) != hipSuccess || per_cu < 1) { fprintf(stderr, "occupancy query: %d\n", per_cu); per_cu = 1; }
        (void)hipGetLastError();
        grid = cus;
        if (grid != 256) { fprintf(stderr, "kernel_launch: this build needs a 256-CU device (fixed row panel per workgroup); got %d\n", cus); grid = -1; return; }
    }
    if (grid < 0) return;
    Args a{};
    for (int i = 0; i < 29; ++i) a.in[i] = (const float*)d_in[i];
    a.out = (float*)d_out; a.ws = (unsigned char*)d_ws;
#if MK_ONE_LAUNCH
    (void)hipMemsetAsync((unsigned char*)d_ws + WS_BAR, 0, XCD_BAR_WORDS * 4, stream);
    a.lo = 0; a.hi = 1 << 30; a.one = 1; a.pad = 0;
    void* args[] = {&a};
    hipError_t e = hipLaunchCooperativeKernel((const void*)fwd_kernel, dim3(grid), dim3(512), args, LDS_BYTES, stream);
    if (e != hipSuccess) fprintf(stderr, "cooperative launch failed: %s (grid %d)\n", hipGetErrorString(e), grid);
#else
    for (int p = 0; p < N_PHASES; ++p) { a.lo = p; a.hi = p + 1; a.one = 0; a.pad = 0;
        hipLaunchKernelGGL(fwd_kernel, dim3(grid), dim3(512), LDS_BYTES, stream, a); }
#endif
}
```

```cpp
#include <hip/hip_runtime.h>
#include <hip/hip_cooperative_groups.h>
#include <cstdio>
namespace cg = cooperative_groups;

#ifndef REP_ATTN
#define REP_ATTN 1
#endif
#ifndef REP_LRU
#define REP_LRU 1
#endif
#ifndef REP_P0
#define REP_P0 1
#endif
#ifndef REP_UP
#define REP_UP 1
#endif
#ifndef MK_ONE_LAUNCH
#define MK_ONE_LAUNCH 1
#endif

#define LAS __attribute__((address_space(3)))
typedef unsigned short bf16_t;
typedef short bf16x8 __attribute__((ext_vector_type(8)));
typedef float f32x4 __attribute__((ext_vector_type(4)));
typedef float f32x2 __attribute__((ext_vector_type(2)));
typedef unsigned u32x4 __attribute__((ext_vector_type(4)));
typedef unsigned u32x2 __attribute__((ext_vector_type(2)));

constexpr int T_TOK = 16384, DM = 2048, SEQ = 4096, NB = 4, DFF = 8192, PLE = 256;
constexpr int AB_IN = 3072, C_IN = 5168, C_INP = 5120;
constexpr float EPSV = 1e-6f;
constexpr float LOG2E = 1.4426950408889634f;

__device__ __forceinline__ unsigned f2bf(float f) { unsigned u = __builtin_bit_cast(unsigned, f); return (u + 0x7fffu + ((u >> 16) & 1u)) >> 16; }
__device__ __forceinline__ unsigned pk2(float lo, float hi) { unsigned r; asm volatile("v_cvt_pk_bf16_f32 %0, %1, %2" : "=v"(r) : "v"(lo), "v"(hi)); return r; }
__device__ __forceinline__ float bf2f(unsigned short b) { return __builtin_bit_cast(float, ((unsigned)b) << 16); }
__device__ __forceinline__ float bflo(unsigned w) { return __builtin_bit_cast(float, w << 16); }
__device__ __forceinline__ float bfhi(unsigned w) { return __builtin_bit_cast(float, w & 0xffff0000u); }
__device__ __forceinline__ float shx(float v, int lane, int o) { return __builtin_bit_cast(float, __builtin_amdgcn_ds_bpermute((lane ^ o) << 2, __builtin_bit_cast(int, v))); }
__device__ __forceinline__ float wave_sum(float v, int lane) {
#pragma unroll
    for (int o = 1; o < 64; o <<= 1) v += shx(v, lane, o);
    return v;
}
__device__ __forceinline__ float sigmoidf_(float x) { return __builtin_amdgcn_rcpf(1.0f + __expf(-x)); }
__device__ __forceinline__ float gelu_tanh(float x) {
    const float u = 0.7978845608028654f * (x + 0.044715f * x * x * x);
    const float e = __expf(2.0f * u);
    const float th = 1.0f - 2.0f * __builtin_amdgcn_rcpf(e + 1.0f);
    return 0.5f * x * (1.0f + th);
}

__device__ __forceinline__ unsigned char* opqp(unsigned char* p) { size_t z = 0; asm volatile("" : "+s"(z)); return p + z; }
__device__ __forceinline__ int opq(int v) { asm volatile("" : "+s"(v)); return v; }
__device__ __forceinline__ int opaque_tid() { int t = threadIdx.x; asm volatile("" : "+v"(t)); return t; }
namespace pg8 {
constexpr int BM = 256, BK = 64, HALF = 128, HTB = HALF * BK * 2, STAGE_BYTES = 8 * HTB, NXCD = 8, WGM = 8;
__host__ __device__ __forceinline__ int lds_byte(int r, int c) { const int st = (r >> 4) * 2 + (c >> 5), rr = r & 15, cc = c & 31, ob = rr * 64 + cc * 2; return st * 1024 + (ob ^ (((ob >> 9) & 1) << 5)); }
__host__ __device__ __forceinline__ void stage_rc(int b, int& R, int& C) { const int st = b / 1024, sb = b % 1024, swz = sb ^ (((sb >> 9) & 1) << 5); R = (st >> 1) * 16 + swz / 64; C = (st & 1) * 32 + (swz % 64) / 2; }
__host__ __device__ __forceinline__ int perm32(int rho) { const int n = rho >> 4, i = rho & 15; return 8 * (i >> 2) + 4 * n + (i & 3); }

struct Unit { int pm, pn; };
struct Gemm { const bf16_t* A; const bf16_t* Bt; int M, N, K, lda, ldb; };

struct StaticOrder {
    int nM, nN, nwg, G, c;
    __device__ void init(int M, int N, int G_, int c_) { nM = M / BM; nN = N / BM; nwg = nM * nN; G = G_; c = c_; }
    __device__ bool next(int i, Unit& u) const {
        const long L = (long)i * G + c; if (L >= nwg || c < 0) return false;
        int wgid = (int)L; { const int q = nwg / NXCD, r = nwg % NXCD, xcd = wgid % NXCD, off = wgid / NXCD; wgid = (xcd < r ? xcd * (q + 1) : r * (q + 1) + (xcd - r) * q) + off; }
        const int nig = WGM * nN, gid = wgid / nig, fm = gid * WGM, gsz = (nM - fm) < WGM ? (nM - fm) : WGM;
        u.pm = fm + ((wgid % nig) % gsz); u.pn = (wgid % nig) / gsz; return true;
    }
};

template <class Epi, class Sched>
__device__ __forceinline__ void gemm_phase(LAS unsigned char* lds, const Gemm g, const Sched& S, const Epi& E) {
    const int tid = opaque_tid(), wid = __builtin_amdgcn_readfirstlane(tid >> 6), lane = tid & 63, wr = wid >> 2, wc = wid & 3, fr = lane & 15, fq = lane >> 4;
    const int K = g.K, nt = K / BK;
    unsigned voffA[2], voffB[2];
#pragma unroll
    for (int i = 0; i < 2; ++i) { int R, C; stage_rc(tid * 16 + i * 8192, R, C); const int Rb = Epi::PERM ? ((R & ~31) + perm32(R & 31)) : R;
        voffA[i] = (unsigned)(R * g.lda + C) * 2u; voffB[i] = (unsigned)(Rb * g.ldb + C) * 2u; }
    const size_t kstep = (size_t)(BK * 2);
    const size_t hstepA = (size_t)HALF * g.lda * 2, hstepB = (size_t)HALF * g.ldb * 2;
    const size_t tstepA = 2 * hstepA, tstepB = 2 * hstepB;
    const unsigned ldsw = (unsigned)wid * 1024u;
    const int aoff = lds_byte(wr * 64 + fr, fq * 8), boff = lds_byte(wc * 32 + fr, fq * 8);
#define PG8_SA(b, h) (((b) * 2 + (h)) * HTB)
#define PG8_SB(b, h) ((4 + (b) * 2 + (h)) * HTB)
#define PG8_STAGE(bufoff, gbase, voff) do { _Pragma("unroll") for (int _i = 0; _i < 2; ++_i) \
        __builtin_amdgcn_global_load_lds((const unsigned*)((const char*)(gbase) + (voff)[_i]), (LAS unsigned*)(lds + (bufoff) + ldsw + _i * 8192), 16, 0, 0); } while (0)
#define PG8_LDA(dst, b, h) do { _Pragma("unroll") for (int m = 0; m < 4; ++m) _Pragma("unroll") for (int k = 0; k < 2; ++k) dst[m][k] = *(const LAS bf16x8*)(lds + PG8_SA(b, h) + aoff + m * 2048 + k * 1024); } while (0)
#define PG8_LDB(dst, b, h) do { _Pragma("unroll") for (int n = 0; n < 2; ++n) _Pragma("unroll") for (int k = 0; k < 2; ++k) dst[n][k] = *(const LAS bf16x8*)(lds + PG8_SB(b, h) + boff + n * 2048 + k * 1024); } while (0)
#define PG8_MMA(ai, bj, At, Bt) do { __builtin_amdgcn_s_setprio(1); _Pragma("unroll") for (int m = 0; m < 4; ++m) _Pragma("unroll") for (int n = 0; n < 2; ++n) _Pragma("unroll") for (int k = 0; k < 2; ++k) \
        acc[ai][bj][m][n] = __builtin_amdgcn_mfma_f32_16x16x32_bf16(Bt[n][k], At[m][k], acc[ai][bj][m][n], 0, 0, 0); __builtin_amdgcn_s_setprio(0); } while (0)
#define PG8_WAIT_V(n) asm volatile("s_waitcnt vmcnt(" #n ")" ::: "memory")
#define PG8_WAIT_L(n) asm volatile("s_waitcnt lgkmcnt(" #n ")" ::: "memory")
#define PG8_BAR __builtin_amdgcn_s_barrier()
#define PG8_SCHED __builtin_amdgcn_sched_barrier(0)
    Unit cur, nxt; int ui = 0;
    if (!S.next(0, cur)) return;
    f32x4 acc[2][2][4][2];
#pragma unroll
    for (int a = 0; a < 2; ++a)
#pragma unroll
        for (int b = 0; b < 2; ++b)
#pragma unroll
            for (int m = 0; m < 4; ++m)
#pragma unroll
                for (int n = 0; n < 2; ++n) acc[a][b][m][n] = (f32x4){0.f, 0.f, 0.f, 0.f};
    bf16x8 At[4][2], B0[2][2], B1[2][2];
    const char* cA = (const char*)g.A + (size_t)cur.pm * tstepA; const char* cB = (const char*)g.Bt + (size_t)cur.pn * tstepB;
    PG8_STAGE(PG8_SB(0, 0), cB, voffB); PG8_STAGE(PG8_SB(0, 1), cB + hstepB, voffB); PG8_STAGE(PG8_SA(0, 0), cA, voffA); PG8_STAGE(PG8_SA(0, 1), cA + hstepA, voffA);
    if (wr == 1) PG8_BAR;
    PG8_WAIT_V(2); PG8_BAR;
    PG8_STAGE(PG8_SB(1, 0), cB + kstep, voffB); PG8_STAGE(PG8_SA(1, 0), cA + kstep, voffA); PG8_STAGE(PG8_SB(1, 1), cB + hstepB + kstep, voffB);
    PG8_WAIT_V(6); PG8_BAR;
    for (;;) {
        const bool has_next = S.next(ui + 1, nxt);
        const char* nA = has_next ? (const char*)g.A + (size_t)nxt.pm * tstepA : cA; const char* nB = has_next ? (const char*)g.Bt + (size_t)nxt.pn * tstepB : cB;
        for (int t = 0; t < nt; t += 2) {
            const bool last = (t == nt - 2);
            const char* a1 = cA + (size_t)(t + 1) * kstep;
            const char* a2 = last ? nA : cA + (size_t)(t + 2) * kstep; const char* b2 = last ? nB : cB + (size_t)(t + 2) * kstep;
            const char* a3 = a2 + kstep; const char* b3 = b2 + kstep;
            PG8_LDB(B0, 0, 0); PG8_LDB(B1, 0, 1); PG8_SCHED; PG8_LDA(At, 0, 0); PG8_STAGE(PG8_SA(1, 1), a1 + hstepA, voffA);
            PG8_WAIT_V(8); PG8_WAIT_L(0); PG8_BAR; PG8_MMA(0, 0, At, B0); PG8_MMA(0, 1, At, B1); PG8_BAR; PG8_SCHED;
            PG8_LDA(At, 0, 1); PG8_STAGE(PG8_SB(0, 0), b2, voffB); PG8_STAGE(PG8_SB(0, 1), b2 + hstepB, voffB); PG8_STAGE(PG8_SA(0, 0), a2, voffA);
            PG8_WAIT_V(8); PG8_WAIT_L(0); PG8_BAR; PG8_MMA(1, 0, At, B0); PG8_MMA(1, 1, At, B1); PG8_BAR; PG8_SCHED;
            PG8_LDB(B0, 1, 0); PG8_LDB(B1, 1, 1); PG8_SCHED; PG8_LDA(At, 1, 0); PG8_STAGE(PG8_SA(0, 1), a2 + hstepA, voffA);
            PG8_WAIT_V(8); PG8_WAIT_L(0); PG8_BAR; PG8_MMA(0, 0, At, B0); PG8_MMA(0, 1, At, B1); PG8_BAR; PG8_SCHED;
            PG8_LDA(At, 1, 1); PG8_STAGE(PG8_SB(1, 0), b3, voffB); PG8_STAGE(PG8_SB(1, 1), b3 + hstepB, voffB); PG8_STAGE(PG8_SA(1, 0), a3, voffA);
            PG8_WAIT_V(8); PG8_WAIT_L(0); PG8_BAR; PG8_MMA(1, 0, At, B0); PG8_MMA(1, 1, At, B1); PG8_BAR; PG8_SCHED;
        }
        if (wr == 0) PG8_BAR;
        { const int tl = opaque_tid() & 63; E(acc, cur, wr, wc, tl & 15, tl >> 4); }
        if (!has_next) break;
#pragma unroll
        for (int a = 0; a < 2; ++a)
#pragma unroll
            for (int b = 0; b < 2; ++b)
#pragma unroll
                for (int m = 0; m < 4; ++m)
#pragma unroll
                    for (int n = 0; n < 2; ++n) acc[a][b][m][n] = (f32x4){0.f, 0.f, 0.f, 0.f};
        cur = nxt; cA = nA; cB = nB; ++ui;
        if (wr == 1) PG8_BAR;
    }
    PG8_WAIT_V(0);
    PG8_BAR;
#undef PG8_SA
#undef PG8_SB
#undef PG8_STAGE
#undef PG8_LDA
#undef PG8_LDB
#undef PG8_MMA
#undef PG8_WAIT_V
#undef PG8_WAIT_L
#undef PG8_BAR
#undef PG8_SCHED
}
}
using pg8::Unit; using pg8::HALF; using pg8::BM;


#define XB_TMO      128
#define XB_XCNT(j)  (256  + 64 * (j))
#define XB_XSUB(j)  (1280 + 64 * (j))
#define XB_XGEN(j)  (2304 + 64 * (j))
#define XB_TOP      3328
#define XB_TOPGEN   3392
#define XCD_BAR_WORDS 3456
#define XB_SPIN_CAP (1u << 18)
__device__ __forceinline__ unsigned xb_ld(unsigned* p)              { return __hip_atomic_load(p, __ATOMIC_RELAXED, __HIP_MEMORY_SCOPE_AGENT); }
__device__ __forceinline__ unsigned xb_add(unsigned* p, unsigned v) { return __hip_atomic_fetch_add(p, v, __ATOMIC_RELAXED, __HIP_MEMORY_SCOPE_AGENT); }
__device__ __forceinline__ unsigned xb_xcc_id() { return (unsigned)__builtin_amdgcn_s_getreg((3 << 11) | 20) & 0xFu; }
#define XB_SPIN(cond, bar) do { unsigned _sp = 0; while (cond) { __builtin_amdgcn_s_sleep(1); \
    if ((++_sp & 255u) == 0u) { if (xb_ld(&(bar)[XB_TMO])) break; if (_sp > XB_SPIN_CAP) { atomicAdd(&(bar)[XB_TMO], 1u); break; } } } } while (0)
struct XcdBarrier { unsigned* bar; unsigned x; volatile LAS unsigned* st; };
__device__ __forceinline__ XcdBarrier xcd_barrier_post(unsigned* bar, volatile LAS unsigned* st) {
    XcdBarrier b; b.bar = bar; b.x = xb_xcc_id(); b.st = st;
    if (threadIdx.x == 0) (void)xb_add(&bar[XB_XCNT(b.x)], 1u);
    return b;
}
__device__ __forceinline__ void xcd_barrier_complete(unsigned* bar, unsigned x, unsigned& nloc, unsigned& nx) {
    const unsigned G = gridDim.x * gridDim.y * gridDim.z;
    unsigned sum, cnt, mine, sp = 0u;
    for (;;) {
        sum = 0u; cnt = 0u; mine = 0u;
#pragma unroll
        for (unsigned j = 0; j < 16; ++j) { const unsigned c = xb_ld(&bar[XB_XCNT(j)]); sum += c; cnt += (c > 0u) ? 1u : 0u; mine = (j == x) ? c : mine; }
        if (sum == G) break;
        __builtin_amdgcn_s_sleep(1);
        if ((++sp & 255u) == 0u) { if (xb_ld(&bar[XB_TMO])) break; if (sp > XB_SPIN_CAP) { atomicAdd(&bar[XB_TMO], 1u); break; } }
    }
    nloc = mine > 0u ? mine : 1u; nx = cnt > 0u ? cnt : 1u;
}
__device__ __forceinline__ void xcd_barrier(const XcdBarrier& b) {
    asm volatile("s_waitcnt vmcnt(0)" ::: "memory");
    __syncthreads();
    if (threadIdx.x == 0) {
        unsigned* bar = b.bar;
        __builtin_amdgcn_s_waitcnt(0);
        unsigned nloc = b.st[0], nx = b.st[1];
        if (nloc == 0u) { xcd_barrier_complete(bar, b.x, nloc, nx); b.st[0] = nloc; b.st[1] = nx; }
        const unsigned old = xb_add(&bar[XB_XSUB(b.x)], 1u);
        const unsigned gen = old / nloc;
        if (old + 1u == (gen + 1u) * nloc) {
            __builtin_amdgcn_fence(__ATOMIC_RELEASE, "agent");
            asm volatile("s_waitcnt vmcnt(0)" ::: "memory");
            const unsigned og = xb_add(&bar[XB_TOP], 1u);
            const unsigned tg = og / nx;
            if (og + 1u == (tg + 1u) * nx) xb_add(&bar[XB_TOPGEN], 1u);
            else XB_SPIN(xb_ld(&bar[XB_TOPGEN]) == tg, bar);
            __builtin_amdgcn_fence(__ATOMIC_ACQUIRE, "agent");
            xb_add(&bar[XB_XGEN(b.x)], 1u);
            asm volatile("s_waitcnt vmcnt(0)" ::: "memory");
        } else {
            XB_SPIN(xb_ld(&bar[XB_XGEN(b.x)]) == gen, bar);
            __builtin_amdgcn_fence(__ATOMIC_ACQUIRE, "agent");
            asm volatile("s_waitcnt vmcnt(0)" ::: "memory");
        }
    }
    __syncthreads();
}

__device__ __forceinline__ float row_rstd(const float* rp, int row, int fq, int lane) {
    const f32x4 a = *(const f32x4*)(rp + (size_t)row * 32 + fq * 8), b = *(const f32x4*)(rp + (size_t)row * 32 + fq * 8 + 4);
    float s = ((a[0] + a[1]) + (a[2] + a[3])) + ((b[0] + b[1]) + (b[2] + b[3]));
    s += shx(s, lane, 16); s += shx(s, lane, 32);
    return rsqrtf(s * (1.f / DM) + EPSV);
}
constexpr int RTAB_OFF = pg8::STAGE_BYTES;
__device__ __forceinline__ void fill_rstd_tab(LAS unsigned char* lds, const float* slots, int bx) {
    const int tid = opaque_tid(); const int panel = 8 * (bx & 7) + ((bx >> 3) & 7);
    if (tid < 256) { const float* rp = slots + ((size_t)panel * 256 + tid) * 32; float S[4];
#pragma unroll
        for (int k = 0; k < 4; ++k) { const f32x4 a = *(const f32x4*)(rp + k * 8), b = *(const f32x4*)(rp + k * 8 + 4); S[k] = ((a[0] + a[1]) + (a[2] + a[3])) + ((b[0] + b[1]) + (b[2] + b[3])); }
        ((LAS float*)(lds + RTAB_OFF))[tid] = rsqrtf(((S[0] + S[1]) + (S[2] + S[3])) * (1.f / DM) + EPSV); }
    __syncthreads();
}
template <int ACT  > struct EpiBf16 {
    static constexpr bool PERM = true;
    bf16_t* O; int ldc; const float* bias; LAS const float* tab;
    __device__ __forceinline__ void operator()(const f32x4 (&acc)[2][2][4][2], const Unit& u, int wr, int wc, int fr, int fq) const {
        const int row0 = u.pm * BM + wr * 64 + fr, col0 = u.pn * BM + wc * 32 + 8 * fq;
        f32x4 bv[2][2];
#pragma unroll
        for (int bj = 0; bj < 2; ++bj)
#pragma unroll
            for (int n = 0; n < 2; ++n) bv[bj][n] = (ACT == 2) ? *(const f32x4*)(bias + col0 + bj * HALF + 4 * n) : (f32x4){0.f, 0.f, 0.f, 0.f};
        float rsv[2][4];
#pragma unroll
        for (int ai = 0; ai < 2; ++ai)
#pragma unroll
            for (int m = 0; m < 4; ++m) rsv[ai][m] = tab ? tab[wr * 64 + fr + ai * HALF + m * 16] : 1.f;
        asm volatile("" ::: "memory");
#pragma unroll
        for (int ai = 0; ai < 2; ++ai)
#pragma unroll
            for (int m = 0; m < 4; ++m) { bf16_t* rowp = O + (size_t)(row0 + ai * HALF + m * 16) * ldc + col0;
                const float rs = rsv[ai][m];
#pragma unroll
                for (int bj = 0; bj < 2; ++bj) { f32x4 v0 = acc[ai][bj][m][0] * rs + bv[bj][0], v1 = acc[ai][bj][m][1] * rs + bv[bj][1];
                    if (ACT == 1) {
#pragma unroll
                        for (int j = 0; j < 4; ++j) { const float a = fmaxf(v0[j], 0.f), b = fmaxf(v1[j], 0.f); v0[j] = a * a; v1[j] = b * b; } }
                    if (ACT == 2) {
#pragma unroll
                        for (int j = 0; j < 4; ++j) { v0[j] = gelu_tanh(v0[j]); v1[j] = gelu_tanh(v1[j]); } }
                    u32x4 w; w.x = pk2(v0[0], v0[1]); w.y = pk2(v0[2], v0[3]); w.z = pk2(v1[0], v1[1]); w.w = pk2(v1[2], v1[3]);
                    *(u32x4*)(rowp + bj * HALF) = w; } }
    }
};
template <int MODE> struct EpiRes {
    static constexpr bool PERM = true;
    const bf16_t* base; bf16_t* out; const bf16_t* pp; int ldc; float* rss_out; LAS const float* tab_in;
    __device__ __forceinline__ void operator()(const f32x4 (&acc)[2][2][4][2], const Unit& u, int wr, int wc, int fr, int fq) const {
        const int row0 = u.pm * BM + wr * 64 + fr, col0 = u.pn * BM + wc * 32 + 8 * fq; const int lane = fq * 16 + fr;
        float rinv[8];
#pragma unroll
        for (int g = 0; g < 8; ++g) rinv[g] = (MODE == 1) ? tab_in[wr * 64 + fr + (g >> 2) * HALF + (g & 3) * 16] : 1.f;
        u32x4 bc[2], pc[2];
#pragma unroll
        for (int bj = 0; bj < 2; ++bj) { const size_t o2 = (size_t)row0 * ldc + col0 + bj * HALF; bc[bj] = *(const u32x4*)(base + o2); if (MODE == 1) pc[bj] = *(const u32x4*)(pp + o2); }
#pragma unroll
        for (int g = 0; g < 8; ++g) { const int ai = g >> 2, m = g & 3; const int row = row0 + ai * HALF + m * 16; const size_t off = (size_t)row * ldc + col0;
            f32x4 av[2][2];
#pragma unroll
            for (int bj = 0; bj < 2; ++bj) { f32x4 a0 = acc[ai][bj][m][0], a1 = acc[ai][bj][m][1];
                const f32x4 b0 = (f32x4){bflo(bc[bj].x), bfhi(bc[bj].x), bflo(bc[bj].y), bfhi(bc[bj].y)}, b1 = (f32x4){bflo(bc[bj].z), bfhi(bc[bj].z), bflo(bc[bj].w), bfhi(bc[bj].w)};
                if (MODE == 0) { a0 = a0 + b0; a1 = a1 + b1; }
                if (MODE == 1) { const f32x4 p0 = (f32x4){bflo(pc[bj].x), bfhi(pc[bj].x), bflo(pc[bj].y), bfhi(pc[bj].y)}, p1 = (f32x4){bflo(pc[bj].z), bfhi(pc[bj].z), bflo(pc[bj].w), bfhi(pc[bj].w)};
#pragma unroll
                    for (int j = 0; j < 4; ++j) { a0[j] = b0[j] + sigmoidf_(a0[j] * rinv[g]) * p0[j]; a1[j] = b1[j] + sigmoidf_(a1[j] * rinv[g]) * p1[j]; } }
                av[bj][0] = a0; av[bj][1] = a1; }
            asm volatile("" : "+v"(av[0][0]), "+v"(av[0][1]), "+v"(av[1][0]), "+v"(av[1][1]));
            if (g < 7) { const int rown = row0 + ((g + 1) >> 2) * HALF + ((g + 1) & 3) * 16;
#pragma unroll
                for (int bj = 0; bj < 2; ++bj) { const size_t o2 = (size_t)rown * ldc + col0 + bj * HALF; bc[bj] = *(const u32x4*)(base + o2); if (MODE == 1) pc[bj] = *(const u32x4*)(pp + o2); } }
            asm volatile("" ::: "memory");
            float ss = 0.f;
#pragma unroll
            for (int bj = 0; bj < 2; ++bj) { const f32x4 a0 = av[bj][0], a1 = av[bj][1];
                ss += ((a0[0] * a0[0] + a0[1] * a0[1]) + (a0[2] * a0[2] + a0[3] * a0[3])) + ((a1[0] * a1[0] + a1[1] * a1[1]) + (a1[2] * a1[2] + a1[3] * a1[3]));
                u32x4 w; w.x = pk2(a0[0], a0[1]); w.y = pk2(a0[2], a0[3]); w.z = pk2(a1[0], a1[1]); w.w = pk2(a1[2], a1[3]); *(u32x4*)(out + off + bj * HALF) = w; }
            ss += shx(ss, lane, 16); ss += shx(ss, lane, 32); if (fq == 0) rss_out[(size_t)row * 32 + u.pn * 4 + wc] = ss;
        }
    }
};
struct EpiNsa {
    static constexpr bool PERM = true; static constexpr size_t KVELEMS = (size_t)16 * 4096 * 128;
    bf16_t *Q, *KC, *VC, *KS, *VST, *KW, *VWT; float* GL; LAS const float* tab;
    __device__ __forceinline__ void operator()(const f32x4 (&acc)[2][2][4][2], const Unit& u, int wr, int wc, int fr, int fq) const {
        const int lr0 = wr * 64 + fr;
        const int pn = u.pn, d0 = wc * 32 + 8 * fq;
        float rsv[2][4];
#pragma unroll
        for (int ai = 0; ai < 2; ++ai)
#pragma unroll
            for (int m = 0; m < 4; ++m) rsv[ai][m] = tab[lr0 + ai * HALF + m * 16];
        const unsigned b4 = (unsigned)(u.pm >> 4) * 4u, s0 = (unsigned)(u.pm & 15) * 256u + (unsigned)lr0;
        const int k = (pn - 8) >> 1; const unsigned g0 = (unsigned)((pn - 8) & 1) * 2u;
        if (pn >= 8 && (k == 3 || k == 5)) {
            bf16_t* base = KC + (size_t)k * KVELEMS + (((b4 + g0) * 128u + (unsigned)d0) * 4096u + s0);
#pragma unroll
            for (int ai = 0; ai < 2; ++ai)
#pragma unroll
                for (int m = 0; m < 4; ++m) { const float rs = rsv[ai][m];
#pragma unroll
                    for (int bj = 0; bj < 2; ++bj) { const f32x4 v0 = acc[ai][bj][m][0] * rs, v1 = acc[ai][bj][m][1] * rs;
                        bf16_t* dst = base + (unsigned)(bj * 128 * 4096 + ai * HALF + m * 16);
#pragma unroll
                        for (int j = 0; j < 4; ++j) { dst[j * 4096] = (bf16_t)f2bf(v0[j]); dst[(4 + j) * 4096] = (bf16_t)f2bf(v1[j]); } } }
        } else {
            bf16_t* base; unsigned rowmul, bjstride;
            if (pn < 8) { base = Q + (size_t)u.pm * 256 * 2048 + pn * 256 + d0 + (unsigned)lr0 * 2048u; rowmul = 2048u; bjstride = 128u; }
            else { base = KC + (size_t)k * KVELEMS + d0 + ((b4 + g0) * 4096u + s0) * 128u; rowmul = 128u; bjstride = 4096u * 128u; }
#pragma unroll
            for (int ai = 0; ai < 2; ++ai)
#pragma unroll
                for (int m = 0; m < 4; ++m) { const unsigned ro = (unsigned)(ai * HALF + m * 16) * rowmul; const float rs = rsv[ai][m];
#pragma unroll
                    for (int bj = 0; bj < 2; ++bj) { const f32x4 v0 = acc[ai][bj][m][0] * rs, v1 = acc[ai][bj][m][1] * rs;
                        u32x4 w; w.x = pk2(v0[0], v0[1]); w.y = pk2(v0[2], v0[3]); w.z = pk2(v1[0], v1[1]); w.w = pk2(v1[2], v1[3]);
                        *(u32x4*)(base + ro + bj * bjstride) = w; } }
        }
    }
};
struct EpiGates {
    static constexpr bool PERM = true;
    float* GL; LAS const float* tab;
    __device__ __forceinline__ void operator()(const f32x4 (&acc)[2][2][4][2], const Unit& u, int wr, int wc, int fr, int fq) const {
        const int row0 = u.pm * BM + wr * 64 + fr; const int cl = wc * 32 + 8 * fq;
        float rsv[2][4];
#pragma unroll
        for (int ai = 0; ai < 2; ++ai)
#pragma unroll
            for (int m = 0; m < 4; ++m) rsv[ai][m] = tab[wr * 64 + fr + ai * HALF + m * 16];
        if (cl < 48) {
#pragma unroll
            for (int ai = 0; ai < 2; ++ai)
#pragma unroll
                for (int m = 0; m < 4; ++m) { const int row = row0 + ai * HALF + m * 16; const float rs = rsv[ai][m];
                    const f32x4 v0 = acc[ai][0][m][0] * rs, v1 = acc[ai][0][m][1] * rs; f32x4 a, c2;
#pragma unroll
                    for (int j = 0; j < 4; ++j) { a[j] = sigmoidf_(v0[j]); c2[j] = sigmoidf_(v1[j]); }
                    float* dst = GL + (size_t)row * 48 + cl; *(f32x4*)dst = a; *(f32x4*)(dst + 4) = c2; } }
    }
};
template <int TR> struct EpiCmp2 {
    static constexpr bool PERM = true;
    bf16_t* O;
    __device__ __forceinline__ void operator()(const f32x4 (&acc)[2][2][4][2], const Unit& u, int wr, int wc, int fr, int fq) const {
        const int row0 = u.pm * BM + wr * 64 + fr; const int cl = wc * 32 + 8 * fq;
#pragma unroll
        for (int ai = 0; ai < 2; ++ai)
#pragma unroll
            for (int m = 0; m < 4; ++m) { const int row = row0 + ai * HALF + m * 16; const f32x4 v0 = acc[ai][0][m][0], v1 = acc[ai][0][m][1];
                if (TR == 0) { u32x4 w; w.x = pk2(v0[0], v0[1]); w.y = pk2(v0[2], v0[3]); w.z = pk2(v1[0], v1[1]); w.w = pk2(v1[2], v1[3]);
                    *(u32x4*)(O + (size_t)row * 128 + cl) = w; }
                else { bf16_t* dst = O + ((size_t)((row >> 8) * 128 + cl)) * 256 + (row & 255);
#pragma unroll
                    for (int j = 0; j < 4; ++j) { dst[(size_t)j * 256] = (bf16_t)f2bf(v0[j]); dst[(size_t)(4 + j) * 256] = (bf16_t)f2bf(v1[j]); } } }
    }
};

constexpr size_t al256(size_t x) { return (x + 255) & ~(size_t)255; }
constexpr size_t SZ_WIN = (size_t)AB_IN * DM * 2, SZ_SQ = (size_t)DM * DM * 2, SZ_CIN = (size_t)C_INP * DM * 2, SZ_W1 = (size_t)512 * 4096 * 2, SZ_W2 = (size_t)256 * 512 * 2;
constexpr size_t SZ_UP = (size_t)DFF * DM * 2, SZ_WP = (size_t)DM * PLE * 2, SZ_WRI = (size_t)16 * 64 * 64 * 2, SZ_POOLT = (size_t)4 * 256 * 256 * 2, SZ_WU = (size_t)DM * 1024 * 2;
constexpr size_t WS_WIN = 0;
constexpr size_t WS_WOUT = WS_WIN + 2 * SZ_WIN;
constexpr size_t WS_CIN = WS_WOUT + 2 * SZ_SQ;
constexpr size_t WS_COUT = WS_CIN + 2 * SZ_CIN;
constexpr size_t WS_W1K = WS_COUT + 2 * SZ_SQ;
constexpr size_t WS_W1V = WS_W1K + 2 * SZ_W1;
constexpr size_t WS_W2K = WS_W1V + 2 * SZ_W1;
constexpr size_t WS_W2V = WS_W2K + 2 * SZ_W2;
constexpr size_t WS_WUP = WS_W2V + 2 * SZ_W2;
constexpr size_t WS_WDN = WS_WUP + 4 * SZ_UP;
constexpr size_t WS_WG = WS_WDN + 4 * SZ_UP;
constexpr size_t WS_WP = WS_WG + 4 * SZ_SQ;
constexpr size_t WS_WR = WS_WP + 4 * SZ_WP;
constexpr size_t WS_WI = WS_WR + 2 * SZ_WRI;
constexpr size_t WS_POOLT = WS_WI + 2 * SZ_WRI;
constexpr size_t WS_WU = WS_POOLT + 2 * SZ_POOLT;
constexpr size_t WS_PB = WS_WU + 2 * SZ_WU;
constexpr size_t WS_POSB = WS_PB + (size_t)4 * T_TOK * PLE * 2;
constexpr size_t WS_XN = WS_POSB + 8192;
constexpr size_t WS_YB = WS_XN + (size_t)T_TOK * DM * 2;
constexpr size_t WS_Z = WS_YB + (size_t)T_TOK * DM * 2;
constexpr size_t SZ_KV = (size_t)16 * 4096 * 128 * 2;
constexpr size_t Z_Q = 0, Z_KC = (size_t)T_TOK * DM * 2, Z_VC = Z_KC + SZ_KV, Z_KS = Z_VC + SZ_KV, Z_VST = Z_KS + SZ_KV, Z_KW = Z_VST + SZ_KV, Z_VWT = Z_KW + SZ_KV;
constexpr size_t Z_GL = Z_VWT + SZ_KV, Z_HIDK = Z_GL + (size_t)T_TOK * 48 * 4, Z_HIDV = Z_HIDK + (size_t)4096 * 512 * 2, Z_KCMP = Z_HIDV + (size_t)4096 * 512 * 2, Z_VCMPT = Z_KCMP + (size_t)4096 * 128 * 2;
constexpr size_t WS_BAR = WS_Z + (size_t)T_TOK * DFF * 2;
constexpr size_t WS_ROWSS = WS_BAR + XCD_BAR_WORDS * 4 + 256;
constexpr size_t WS_PP = WS_ROWSS + (size_t)13 * T_TOK * 32 * 4;
constexpr size_t WS_POSP = WS_PP + (size_t)T_TOK * DM * 2;
constexpr size_t WS_WGL = WS_POSP + (size_t)4 * 64 * 512 * 4;
constexpr size_t WS_H2 = WS_WGL + (size_t)2 * 256 * DM * 2;
constexpr size_t WS_END = WS_H2 + (size_t)T_TOK * DM * 2;
static_assert(Z_VCMPT + 4096 * 128 * 2 <= (size_t)T_TOK * DFF * 2, "z region");
static_assert(WS_END <= (size_t)1 << 30, "workspace");
constexpr int LDS_BYTES = 147456;

struct Args { const float* in[29]; float* out; unsigned char* ws; int lo, hi, one, pad; };

__device__ __forceinline__ void titem_load(float (&v)[64], const float* W, int N, int ldw, int item, int lane) {
    const int nblk = (N + 63) / 64, kb = item / nblk, nb = item % nblk, k0 = 64 * kb, n0 = 64 * nb;
    const int nn = n0 + lane; const bool ok = nn < N;
    const float* p = W + (size_t)k0 * ldw + nn;
#pragma unroll
    for (int i = 0; i < 64; ++i) v[i] = ok ? p[(size_t)i * ldw] : 0.f;
}
__device__ __forceinline__ void titem_store(const float (&v)[64], int N, bf16_t* WT, int ldt, LAS float* scr, int item, int lane, const float* gk) {
    const int nblk = (N + 63) / 64, kb = item / nblk, nb = item % nblk, k0 = 64 * kb, n0 = 64 * nb;
#pragma unroll
    for (int i = 0; i < 64; ++i) scr[i * 65 + lane] = v[i];
    asm volatile("s_waitcnt lgkmcnt(0)" ::: "memory");
    const int c = lane & 7;
    f32x4 g0 = (f32x4){1.f, 1.f, 1.f, 1.f}, g1 = g0; if (gk) { g0 = *(const f32x4*)(gk + k0 + 8 * c); g1 = *(const f32x4*)(gk + k0 + 8 * c + 4); }
#pragma unroll
    for (int j = 0; j < 8; ++j) { const int n = (lane >> 3) + 8 * j; const LAS float* s = scr + (8 * c) * 65 + n;
        u32x4 o; o.x = pk2(s[0 * 65] * g0[0], s[1 * 65] * g0[1]); o.y = pk2(s[2 * 65] * g0[2], s[3 * 65] * g0[3]); o.z = pk2(s[4 * 65] * g1[0], s[5 * 65] * g1[1]); o.w = pk2(s[6 * 65] * g1[2], s[7 * 65] * g1[3]);
        if (n0 + n < N) *(u32x4*)(WT + (size_t)(n0 + n) * ldt + k0 + 8 * c) = o; }
    asm volatile("s_waitcnt lgkmcnt(0)" ::: "memory");
}
__device__ __forceinline__ void conv_mat(const float* W, int K, int N, int ldw, bf16_t* WT, int ldt, LAS float* scr, int gw, int NGW, int lane, int& rot, const float* gk = nullptr) {
    const int nitems = (K / 64) * ((N + 63) / 64);
    int it = gw - rot; if (it < 0) it += NGW;
    rot = (rot + nitems) % NGW;
    if (it >= nitems) return;
    float va[64], vb[64];
    titem_load(va, W, N, ldw, it, lane);
    for (;;) {
        const int n1 = it + NGW; if (n1 < nitems) titem_load(vb, W, N, ldw, n1, lane);
        titem_store(va, N, WT, ldt, scr, it, lane, gk);
        if (n1 >= nitems) break;
        const int n2 = n1 + NGW; if (n2 < nitems) titem_load(va, W, N, ldw, n2, lane);
        titem_store(vb, N, WT, ldt, scr, n1, lane, gk);
        if (n2 >= nitems) break;
        it = n2;
    }
}
__device__ __forceinline__ void conv_plain(const float* src, int rows, int ncols, int lds_, bf16_t* dst, int ldd, int gt, int NGT, const float* gk = nullptr) {
    const unsigned cpr = (unsigned)ncols / 8u; const unsigned total = (unsigned)rows * cpr;
    for (unsigned i = (unsigned)gt; i < total; i += (unsigned)NGT) { const int r = (int)(i / cpr), c = (int)(i % cpr) * 8;
        f32x4 a = *(const f32x4*)(src + (size_t)r * lds_ + c), b = *(const f32x4*)(src + (size_t)r * lds_ + c + 4);
        if (gk) { const float gg = gk[r]; a = a * gg; b = b * gg; }
        u32x4 o; o.x = f2bf(a[0]) | (f2bf(a[1]) << 16); o.y = f2bf(a[2]) | (f2bf(a[3]) << 16); o.z = f2bf(b[0]) | (f2bf(b[1]) << 16); o.w = f2bf(b[2]) | (f2bf(b[3]) << 16);
        *(u32x4*)(dst + (size_t)r * ldd + c) = o; }
}
__device__ __forceinline__ void zero_fill16(unsigned char* p, size_t bytes, int gt, int NGT) {
    const u32x4 z = (u32x4){0u, 0u, 0u, 0u};
    for (size_t i = (size_t)gt * 16; i < bytes; i += (size_t)NGT * 16) *(u32x4*)(p + i) = z;
}

template <bool F32OUT>
__device__ __forceinline__ void rmsnorm_rows(const float* X, const float* g, bf16_t* O, float* OF, int bx, int NGW) {
    asm volatile("" ::: "memory"); const int tid = opaque_tid(), lane = tid & 63; const int gw = opq(bx) * 8 + __builtin_amdgcn_readfirstlane(tid >> 6);
    f32x4 gv[8];
#pragma unroll
    for (int j = 0; j < 8; ++j) gv[j] = *(const f32x4*)(g + (lane + 64 * j) * 4);
    for (int r = gw; r < T_TOK; r += NGW) {
        const bf16_t* xr = (const bf16_t*)X + (size_t)r * DM; f32x4 v[8]; float s = 0.f;
#pragma unroll
        for (int j = 0; j < 8; ++j) { const u32x2 w = *(const u32x2*)(xr + (lane + 64 * j) * 4); v[j] = (f32x4){bflo(w.x), bfhi(w.x), bflo(w.y), bfhi(w.y)}; s += (v[j][0] * v[j][0] + v[j][1] * v[j][1]) + (v[j][2] * v[j][2] + v[j][3] * v[j][3]); }
        const float rstd = rsqrtf(wave_sum(s, lane) * (1.f / DM) + EPSV);
#pragma unroll
        for (int j = 0; j < 8; ++j) { const f32x4 y = v[j] * rstd * gv[j];
            if (F32OUT) *(f32x4*)(OF + (size_t)r * DM + (lane + 64 * j) * 4) = y;
            else { u32x2 w; w.x = pk2(y[0], y[1]); w.y = pk2(y[2], y[3]); *(u32x2*)(O + (size_t)r * DM + (lane + 64 * j) * 4) = w; } }
    }
}

__device__ __forceinline__ void rows_to_bf16_ss(const float* X, bf16_t* O, float* rss, int bx, int NGW) {
    const int tid = opaque_tid(), lane = tid & 63; const int gw = opq(bx) * 8 + __builtin_amdgcn_readfirstlane(tid >> 6);
    for (int r = gw; r < T_TOK; r += NGW) {
        const float* xr = X + (size_t)r * DM; f32x4 v[8]; float s = 0.f;
#pragma unroll
        for (int j = 0; j < 8; ++j) { v[j] = *(const f32x4*)(xr + (lane + 64 * j) * 4); s += (v[j][0] * v[j][0] + v[j][1] * v[j][1]) + (v[j][2] * v[j][2] + v[j][3] * v[j][3]); }
        s = wave_sum(s, lane); if (lane < 32) rss[(size_t)r * 32 + lane] = (lane == 0) ? s : 0.f;
#pragma unroll
        for (int j = 0; j < 8; ++j) { u32x2 w; w.x = pk2(v[j][0], v[j][1]); w.y = pk2(v[j][2], v[j][3]); *(u32x2*)(O + (size_t)r * DM + (lane + 64 * j) * 4) = w; }
    }
}
__device__ __forceinline__ void lru_item(LAS unsigned char* lds, int item, const bf16_t* ZE, const float* conv_w, const float* conv_b,
                                         const bf16_t* WrT, const bf16_t* WiT, const float* b_r, const float* b_i, const float* lam, bf16_t* YB) {
    const int tid = opaque_tid(), w = __builtin_amdgcn_readfirstlane(tid >> 6), lane = tid & 63, fr = lane & 15, fq = lane >> 4;
    const int b = item >> 6, hh = (item >> 2) & 15, qq = item & 3;
    LAS unsigned char* XC = lds;
    LAS float* SEGA = (LAS float*)(lds + 36864);
    LAS float* SEGB = SEGA + 1024;
    LAS float* HIN = SEGB + 1024;
    const int co = tid & 7, tr = tid >> 3;
    float cw[4][8], cb[8];
#pragma unroll
    for (int k = 0; k < 4; ++k)
#pragma unroll
        for (int e = 0; e < 8; ++e) cw[k][e] = conv_w[k * 1024 + hh * 64 + co * 8 + e];
#pragma unroll
    for (int e = 0; e < 8; ++e) cb[e] = conv_b[hh * 64 + co * 8 + e];
    bf16x8 wrf[2], wif[2];
#pragma unroll
    for (int kk = 0; kk < 2; ++kk) { wrf[kk] = *(const bf16x8*)(WrT + ((size_t)hh * 64 + qq * 16 + fr) * 64 + kk * 32 + fq * 8); wif[kk] = *(const bf16x8*)(WiT + ((size_t)hh * 64 + qq * 16 + fr) * 64 + kk * 32 + fq * 8); }
    const int ch = hh * 64 + qq * 16 + fr;
    const float br = b_r[ch], bi = b_i[ch];
    const float lm = lam[ch]; float sp8; { const float e = __expf(-lm); const float ser = e * (1.f - e * (0.5f - e * (0.33333333f - e * 0.25f)));
        sp8 = 8.0f * ((-lm > 20.f) ? -lm : (e < 0.03f ? ser : __logf(1.0f + e))); }
    float carry = 0.f;
    const bf16_t* zb = ZE + (size_t)b * SEQ * AB_IN;
    u32x4 xr[7];
#pragma unroll
    for (int r = 0; r < 7; ++r) { const int t = tr * 4 - 3 + r; xr[r] = (t >= 0) ? *(const u32x4*)(zb + (size_t)t * AB_IN + hh * 64 + co * 8) : (u32x4){0u, 0u, 0u, 0u}; }
    for (int sc = 0; sc < 16; ++sc) {
        const int t0 = sc * 256;
        unsigned short gr[2][4];
#pragma unroll
        for (int ml = 0; ml < 2; ++ml)
#pragma unroll
            for (int r = 0; r < 4; ++r) gr[ml][r] = zb[(size_t)(t0 + (w * 2 + ml) * 16 + fq * 4 + r) * AB_IN + 1024 + ch];
        {
            float xin[7][8];
#pragma unroll
            for (int r = 0; r < 7; ++r) { const u32x4 v = xr[r];
                xin[r][0] = bflo(v.x); xin[r][1] = bfhi(v.x); xin[r][2] = bflo(v.y); xin[r][3] = bfhi(v.y); xin[r][4] = bflo(v.z); xin[r][5] = bfhi(v.z); xin[r][6] = bflo(v.w); xin[r][7] = bfhi(v.w); }
#pragma unroll
            for (int q = 0; q < 4; ++q) { float o[8];
#pragma unroll
                for (int e = 0; e < 8; ++e) o[e] = cb[e] + cw[0][e] * xin[q][e] + cw[1][e] * xin[q + 1][e] + cw[2][e] * xin[q + 2][e] + cw[3][e] * xin[q + 3][e];
                u32x4 wv; wv.x = pk2(o[0], o[1]); wv.y = pk2(o[2], o[3]); wv.z = pk2(o[4], o[5]); wv.w = pk2(o[6], o[7]);
                *(LAS u32x4*)(XC + (tr * 4 + q) * 144 + co * 16) = wv; }
            if (sc < 15) {
#pragma unroll
                for (int r = 0; r < 7; ++r) xr[r] = *(const u32x4*)(zb + (size_t)(t0 + 256 + tr * 4 - 3 + r) * AB_IN + hh * 64 + co * 8); }
        }
        __syncthreads();
        float av[2][4], bv[2][4];
#pragma unroll
        for (int ml = 0; ml < 2; ++ml) { const int mt = w * 2 + ml;
            f32x4 ar = (f32x4){0.f, 0.f, 0.f, 0.f}, ai = ar;
#pragma unroll
            for (int kk = 0; kk < 2; ++kk) { const bf16x8 xa = *(const LAS bf16x8*)(XC + (mt * 16 + fr) * 144 + kk * 64 + fq * 16);
                ar = __builtin_amdgcn_mfma_f32_16x16x32_bf16(xa, wrf[kk], ar, 0, 0, 0); ai = __builtin_amdgcn_mfma_f32_16x16x32_bf16(xa, wif[kk], ai, 0, 0, 0); }
            float A = 1.f, Bc = 0.f;
#pragma unroll
            for (int r = 0; r < 4; ++r) { const int tok = mt * 16 + fq * 4 + r;
                const float xcv = bf2f(*(const LAS unsigned short*)(XC + tok * 144 + (qq * 16 + fr) * 2));
                const float rg = sigmoidf_(ar[r] + br), ig = sigmoidf_(ai[r] + bi);
                const float la = -rg * sp8; const float a = __expf(la); const float x2 = 2.f * la; const float em = (x2 > -0.3f) ? -x2 * (1.f + x2 * 0.5f * (1.f + x2 * 0.33333333f * (1.f + x2 * 0.25f * (1.f + x2 * 0.2f * (1.f + x2 * 0.16666667f))))) : 1.f - __expf(x2);
                const float mult = __builtin_amdgcn_sqrtf(fmaxf(em, 0.f));
                av[ml][r] = a; bv[ml][r] = mult * ig * xcv;
                Bc = a * Bc + bv[ml][r]; A = A * a; }
            const int sg = mt * 4 + fq; SEGA[sg * 16 + fr] = A; SEGB[sg * 16 + fr] = Bc; }
        __syncthreads();
        if (w == 0 && lane < 16) { float h = carry;
#pragma unroll 8
            for (int sg = 0; sg < 64; ++sg) { HIN[sg * 16 + lane] = h; h = SEGA[sg * 16 + lane] * h + SEGB[sg * 16 + lane]; }
            carry = h; }
        __syncthreads();
#pragma unroll
        for (int ml = 0; ml < 2; ++ml) { const int mt = w * 2 + ml; float h = HIN[(mt * 4 + fq) * 16 + fr];
#pragma unroll
            for (int r = 0; r < 4; ++r) { const int t = t0 + mt * 16 + fq * 4 + r; h = av[ml][r] * h + bv[ml][r];
                const float gt = bf2f(gr[ml][r]);
                YB[((size_t)b * SEQ + t) * DM + ch] = (bf16_t)f2bf(h * gelu_tanh(gt)); } }
    }
    __syncthreads();
}
__device__ __forceinline__ void pool_item(int item, const bf16_t* ZE, const float* scale, bf16_t* YB) {
    const int tid = opaque_tid(), b = item >> 6, tch = item & 63, co = tid & 127, seg = tid >> 7;
    const int win = 2 << (co >> 5);
    float sc[8];
#pragma unroll
    for (int e = 0; e < 8; ++e) sc[e] = scale[co * 8 + e];
    const bf16_t* zb = ZE + (size_t)b * SEQ * AB_IN + 2048 + co * 8;
    const int ts = tch * 64 + seg * 16;
    float sum[8];
#pragma unroll
    for (int e = 0; e < 8; ++e) sum[e] = 0.f;
    for (int s = ts - win + 1; s < ts; ++s) if (s >= 0) { const u32x4 v = *(const u32x4*)(zb + (size_t)s * AB_IN);
        sum[0] += bflo(v.x); sum[1] += bfhi(v.x); sum[2] += bflo(v.y); sum[3] += bfhi(v.y); sum[4] += bflo(v.z); sum[5] += bfhi(v.z); sum[6] += bflo(v.w); sum[7] += bfhi(v.w); }
    for (int t = ts; t < ts + 16; ++t) {
        const u32x4 v = *(const u32x4*)(zb + (size_t)t * AB_IN);
        float x[8] = {bflo(v.x), bfhi(v.x), bflo(v.y), bfhi(v.y), bflo(v.z), bfhi(v.z), bflo(v.w), bfhi(v.w)};
        const float inv = __builtin_amdgcn_rcpf((float)((t + 1) < win ? (t + 1) : win));
        float o[8];
#pragma unroll
        for (int e = 0; e < 8; ++e) { sum[e] += x[e]; o[e] = (sum[e] * inv - x[e]) * sc[e]; }
        u32x4 wv; wv.x = pk2(o[0], o[1]); wv.y = pk2(o[2], o[3]); wv.z = pk2(o[4], o[5]); wv.w = pk2(o[6], o[7]);
        *(u32x4*)(YB + ((size_t)b * SEQ + t) * DM + 1024 + co * 8) = wv;
        const int so = t - win + 1;
        if (so >= 0) { const u32x4 q = *(const u32x4*)(zb + (size_t)so * AB_IN);
            sum[0] -= bflo(q.x); sum[1] -= bfhi(q.x); sum[2] -= bflo(q.y); sum[3] -= bfhi(q.y); sum[4] -= bflo(q.z); sum[5] -= bfhi(q.z); sum[6] -= bflo(q.w); sum[7] -= bfhi(q.w); }
    }
}

constexpr int KT_PITCH = 272, VT_PITCH = 144;
constexpr int AL_KT = 0, AL_VT = 64 * KT_PITCH, AL_BUF = 36864  , AL_IMPA = 2 * 36864, AL_IMPB = AL_IMPA + 64 * 65 * 4, AL_SEL = AL_IMPB + 64 * 65 * 4, AL_UNI = AL_SEL + 512, AL_Q = 73728, Q_WAVE = 32 * KT_PITCH;
constexpr float QSCALE2 = 0.08838834764831845f * LOG2E;
constexpr float NEGB = -1e30f;

struct StageRegs { u32x4 k[2], v[2]; };
__device__ __forceinline__ void stage_load(StageRegs& R, const bf16_t* kbase, const bf16_t* vbase, int vpitch, int tid) {
    const int kr = tid >> 3, kc = tid & 7, vr = tid >> 2, vc = tid & 3;
    R.k[0] = *(const u32x4*)(kbase + kr * 128 + kc * 8); R.k[1] = *(const u32x4*)(kbase + kr * 128 + 64 + kc * 8);
    R.v[0] = *(const u32x4*)(vbase + (size_t)vr * vpitch + vc * 8); R.v[1] = *(const u32x4*)(vbase + (size_t)vr * vpitch + 32 + vc * 8);
}
__device__ __forceinline__ void stage_store(const StageRegs& R, LAS unsigned char* lds, int tid) {
    const int kr = tid >> 3, kc = tid & 7, vr = tid >> 2, vc = tid & 3;
    *(LAS u32x4*)(lds + AL_KT + kr * KT_PITCH + kc * 16) = R.k[0]; *(LAS u32x4*)(lds + AL_KT + kr * KT_PITCH + 128 + kc * 16) = R.k[1];
    *(LAS u32x4*)(lds + AL_VT + vr * VT_PITCH + vc * 16) = R.v[0]; *(LAS u32x4*)(lds + AL_VT + vr * VT_PITCH + 64 + vc * 16) = R.v[1];
}
template <int MODE>
__device__ __forceinline__ void attn_tile(bool MASK, LAS unsigned char* lds, LAS unsigned char* ldsi, const bf16x8 (&qf)[2][4], f32x4 (&O)[2][8], float (&m)[2], float (&l)[2], const int (&tpos)[2], float slope2,
                                          int kp0, const bool (&selbit)[2], int fr, int fq, int wv, int tile64, int lane) {
    constexpr int KS = (MODE <= 1) ? 16 : 1;
    f32x4 s[2][4];
#pragma unroll
    for (int ci = 0; ci < 2; ++ci)
#pragma unroll
        for (int k4 = 0; k4 < 4; ++k4) s[ci][k4] = (f32x4){0.f, 0.f, 0.f, 0.f};
#pragma unroll
    for (int kk = 0; kk < 4; ++kk) {
        const bf16x8 q0 = qf[0][kk], q1 = qf[1][kk];
#pragma unroll
        for (int k4 = 0; k4 < 4; ++k4) { const bf16x8 kf = *(const LAS bf16x8*)(lds + AL_KT + (k4 * 16 + fr) * KT_PITCH + kk * 64 + fq * 16);
            s[0][k4] = __builtin_amdgcn_mfma_f32_16x16x32_bf16(kf, q0, s[0][k4], 0, 0, 0);
            s[1][k4] = __builtin_amdgcn_mfma_f32_16x16x32_bf16(kf, q1, s[1][k4], 0, 0, 0); } }
    const float sk = slope2 * (float)KS;
    float alpha[2] = {1.f, 1.f};
#pragma unroll
    for (int ci = 0; ci < 2; ++ci) {
        const int base = tpos[ci] - kp0 - KS * (fq * 4);
        const float bb = -slope2 * (float)base;
        float mx = NEGB;
#pragma unroll
        for (int k4 = 0; k4 < 4; ++k4)
#pragma unroll
            for (int j = 0; j < 4; ++j) {
                s[ci][k4][j] = __builtin_fmaf(s[ci][k4][j], QSCALE2, __builtin_fmaf(sk, (float)(k4 * 16 + j), bb)); }
        if (MASK) {
#pragma unroll
            for (int k4 = 0; k4 < 4; ++k4)
#pragma unroll
                for (int j = 0; j < 4; ++j) { const int c = KS * (k4 * 16 + j); bool ok = c <= base; if (MODE == 3) ok = ok && (base - c < 512); s[ci][k4][j] = ok ? s[ci][k4][j] : 2.0f * NEGB; } }
#pragma unroll
        for (int k4 = 0; k4 < 4; ++k4)
#pragma unroll
            for (int j = 0; j < 4; ++j) mx = fmaxf(mx, s[ci][k4][j]);
        if (MODE == 2) mx = selbit[ci] ? mx : NEGB;
        if (MODE != 1) {
            mx = fmaxf(mx, shx(mx, lane, 16)); mx = fmaxf(mx, shx(mx, lane, 32));
            const float mn = fmaxf(m[ci], mx); alpha[ci] = __builtin_amdgcn_exp2f(m[ci] - mn); m[ci] = mn;
            float ps = 0.f;
#pragma unroll
            for (int k4 = 0; k4 < 4; ++k4)
#pragma unroll
                for (int j = 0; j < 4; ++j) { const float p = __builtin_amdgcn_exp2f(s[ci][k4][j] - mn); s[ci][k4][j] = p; ps += p; }
            if (MODE == 2) ps = selbit[ci] ? ps : 0.f;
            l[ci] = l[ci] * alpha[ci] + ps;
        } else {
#pragma unroll
            for (int k4 = 0; k4 < 4; ++k4) {
#pragma unroll
                for (int j = 0; j < 4; ++j) s[ci][k4][j] = __builtin_amdgcn_exp2f(s[ci][k4][j] - m[ci]) * l[ci];
                float a = (s[ci][k4][0] + s[ci][k4][1]) + (s[ci][k4][2] + s[ci][k4][3]); float b3 = s[ci][k4][3];
                a += shx(a, lane, 1); a += shx(a, lane, 2); b3 += shx(b3, lane, 1); b3 += shx(b3, lane, 2);
                if ((fr & 3) == 0) { const int tl = wv * 8 + ci * 4 + (fr >> 2); const int ms = tile64 * 16 + k4 * 4 + fq;
                    ((LAS float*)(ldsi + AL_IMPA))[tl * 65 + ms] = a; ((LAS float*)(ldsi + AL_IMPB))[tl * 65 + ms + 1] = b3; } }
        }
    }
    if (MODE >= 2) {
        if (__builtin_amdgcn_ballot_w64(alpha[0] != 1.f || alpha[1] != 1.f) != 0ull) {
#pragma unroll
            for (int ci = 0; ci < 2; ++ci)
#pragma unroll
                for (int dt = 0; dt < 8; ++dt) O[ci][dt] = O[ci][dt] * alpha[ci]; }
    }
    if (MODE != 0) {
#pragma unroll
        for (int ks = 0; ks < 2; ++ks) {
            bf16x8 pf[2];
#pragma unroll
            for (int ci = 0; ci < 2; ++ci) { u32x4 w; w.x = pk2(s[ci][2 * ks][0], s[ci][2 * ks][1]); w.y = pk2(s[ci][2 * ks][2], s[ci][2 * ks][3]); w.z = pk2(s[ci][2 * ks + 1][0], s[ci][2 * ks + 1][1]); w.w = pk2(s[ci][2 * ks + 1][2], s[ci][2 * ks + 1][3]);
                if (MODE == 2) { w.x = selbit[ci] ? w.x : 0u; w.y = selbit[ci] ? w.y : 0u; w.z = selbit[ci] ? w.z : 0u; w.w = selbit[ci] ? w.w : 0u; }
                pf[ci] = __builtin_bit_cast(bf16x8, w); }
#pragma unroll
            for (int dt = 0; dt < 8; ++dt) { const LAS unsigned char* vp = lds + AL_VT + (dt * 16 + fr) * VT_PITCH + (ks * 32 + fq * 4) * 2;
                const u32x2 lo = *(const LAS u32x2*)vp, hi = *(const LAS u32x2*)(vp + 32);
                const bf16x8 vf = __builtin_bit_cast(bf16x8, (u32x4){lo.x, lo.y, hi.x, hi.y});
                O[0][dt] = __builtin_amdgcn_mfma_f32_16x16x32_bf16(vf, pf[0], O[0][dt], 0, 0, 0);
                O[1][dt] = __builtin_amdgcn_mfma_f32_16x16x32_bf16(vf, pf[1], O[1][dt], 0, 0, 0); }
        }
    }
}

__device__ __forceinline__ void nsa_item(LAS unsigned char* lds, int b, int g, int tq, const bf16_t* Q, const bf16_t* KS, const bf16_t* VST, const bf16_t* KW, const bf16_t* VWT,
                                         const bf16_t* KCMP, const bf16_t* VCMPT, const float* GL, bf16_t* YB) {
    const int tid = opaque_tid(), wv = __builtin_amdgcn_readfirstlane(tid >> 6), lane = tid & 63, fr = lane & 15, fq = lane >> 4;
    const int t0 = tq * 64, bg = b * 4 + g, head = g * 4 + (fr & 3);
    LAS float* IMPA = (LAS float*)(lds + AL_IMPA);
    LAS unsigned long long* SEL = (LAS unsigned long long*)(lds + AL_SEL);
    LAS unsigned long long* UNI = (LAS unsigned long long*)(lds + AL_UNI);
    __syncthreads();
    for (int i = tid; i < 2 * 64 * 65; i += 512) IMPA[i] = 0.f;
    int tpos[2]; bf16x8 qf[2][4]; int tc = 0;
#pragma unroll
    for (int ci = 0; ci < 2; ++ci) { tpos[ci] = t0 + wv * 8 + ci * 4 + (fr >> 2);
        const bf16_t* qp = Q + ((size_t)(b * SEQ + tpos[ci])) * DM + head * 128 + fq * 8;
#pragma unroll
        for (int kk = 0; kk < 4; ++kk) qf[ci][kk] = *(const bf16x8*)(qp + kk * 32);
    }
    const float slope2 = exp2f(-0.5f * (float)(head + 1)) * LOG2E;
    f32x4 O[2][8]; float m[2], l[2]; bool selbit[2] = {true, true};
#pragma unroll
    for (int ci = 0; ci < 2; ++ci)
#pragma unroll
        for (int dt = 0; dt < 8; ++dt) { O[ci][dt] = (f32x4){0.f, 0.f, 0.f, 0.f}; }
    StageRegs R;
    const int ncmp = ((t0 + 32) >> 4) + 1, nct = (ncmp + 63) >> 6;
    const bf16_t* kcb = KCMP + (size_t)bg * 256 * 128; const bf16_t* vcb = VCMPT + (size_t)bg * 128 * 256;
    m[0] = m[1] = NEGB; l[0] = l[1] = 0.f;
    stage_load(R, kcb, vcb, 256, tid);
    for (int ct = 0; ct < nct; ++ct) {
        LAS unsigned char* kvb = lds + (tc & 1) * AL_BUF; ++tc; stage_store(R, kvb, tid); __syncthreads();
        if (ct + 1 < nct) stage_load(R, kcb + (size_t)(ct + 1) * 64 * 128, vcb + (ct + 1) * 64, 256, tid);
        attn_tile<0>(1024 * ct + 1039 > t0, kvb, lds, qf, O, m, l, tpos, slope2, 16 * (ct * 64) + 31, selbit, fr, fq, wv, ct, lane);
    }
#pragma unroll
    for (int ci = 0; ci < 2; ++ci) { float lt = l[ci]; lt += shx(lt, lane, 16); lt += shx(lt, lane, 32); l[ci] = lt > 0.f ? 1.0f / lt : 0.f; }
    stage_load(R, kcb, vcb, 256, tid);
    for (int ct = 0; ct < nct; ++ct) {
        LAS unsigned char* kvb = lds + (tc & 1) * AL_BUF; ++tc; stage_store(R, kvb, tid); __syncthreads();
        if (ct + 1 < nct) stage_load(R, kcb + (size_t)(ct + 1) * 64 * 128, vcb + (ct + 1) * 64, 256, tid);
        attn_tile<1>(1024 * ct + 1039 > t0, kvb, lds, qf, O, m, l, tpos, slope2, 16 * (ct * 64) + 31, selbit, fr, fq, wv, ct, lane);
    }
#pragma unroll
    for (int ci = 0; ci < 2; ++ci) { const float gc = GL[((size_t)(b * SEQ + tpos[ci])) * 48 + head];
        bf16_t* op = YB + ((size_t)(b * SEQ + tpos[ci])) * DM + head * 128 + fq * 4;
#pragma unroll
        for (int dt = 0; dt < 8; ++dt) { const f32x4 o = O[ci][dt] * gc; u32x2 w; w.x = pk2(o[0], o[1]); w.y = pk2(o[2], o[3]); *(u32x2*)(op + dt * 16) = w; O[ci][dt] = (f32x4){0.f, 0.f, 0.f, 0.f}; } }
    __syncthreads();
    {
        const int cur = tq; unsigned long long wun = 0ull;
#pragma unroll 1
        for (int tk = 0; tk < 8; ++tk) { const int tl = wv * 8 + tk;
            float v = IMPA[tl * 65 + lane] + IMPA[64 * 65 + tl * 65 + lane];
            if (lane == 0 || lane == cur || lane == cur - 1) v += 1e6f;
            if (lane > cur) v = NEGB;
            int rank = 0; const int vi = __builtin_bit_cast(int, v);
#pragma unroll
            for (int mm = 0; mm < 64; ++mm) { const float vm = __builtin_bit_cast(float, __builtin_amdgcn_readlane(vi, mm)); rank += ((vm > v) || (vm == v && mm < lane)) ? 1 : 0; }
            const unsigned long long mk = __ballot(rank < 16 && lane <= cur);
            wun |= mk;
            if (lane == 0) SEL[tl] = mk; }
        if (lane == 0) UNI[wv] = wun;
    }
    __syncthreads();
    unsigned long long selm[2], wun, bun = 0ull;
#pragma unroll
    for (int ci = 0; ci < 2; ++ci) selm[ci] = SEL[wv * 8 + ci * 4 + (fr >> 2)];
    wun = UNI[wv];
#pragma unroll
    for (int i = 0; i < 8; ++i) bun |= UNI[i];
    { const unsigned lo = __builtin_amdgcn_readfirstlane((unsigned)bun), hi = __builtin_amdgcn_readfirstlane((unsigned)(bun >> 32)); bun = ((unsigned long long)hi << 32) | lo;
      const unsigned lo2 = __builtin_amdgcn_readfirstlane((unsigned)wun), hi2 = __builtin_amdgcn_readfirstlane((unsigned)(wun >> 32)); wun = ((unsigned long long)hi2 << 32) | lo2; }
    const bf16_t* ksb = KS + (size_t)bg * SEQ * 128; const bf16_t* vsb = VST + (size_t)bg * 128 * SEQ;
    m[0] = m[1] = NEGB; l[0] = l[1] = 0.f;
    {
        unsigned long long rem = bun; int j = 63 - __builtin_clzll(rem); rem &= ~(1ull << j);
        stage_load(R, ksb + (size_t)j * 64 * 128, vsb + j * 64, SEQ, tid);
        for (;;) {
            LAS unsigned char* kvb = lds + (tc & 1) * AL_BUF; ++tc; stage_store(R, kvb, tid); __syncthreads();
            const int jn = rem ? 63 - __builtin_clzll(rem) : -1; if (jn >= 0) { rem &= ~(1ull << jn); stage_load(R, ksb + (size_t)jn * 64 * 128, vsb + jn * 64, SEQ, tid); }
            if ((wun >> j) & 1ull) { selbit[0] = (selm[0] >> j) & 1ull; selbit[1] = (selm[1] >> j) & 1ull;
                attn_tile<2>(j == tq, kvb, lds, qf, O, m, l, tpos, slope2, j * 64, selbit, fr, fq, wv, 0, lane); }
            if (jn < 0) break; j = jn;
        }
    }
#pragma unroll
    for (int ci = 0; ci < 2; ++ci) { float lt = l[ci]; lt += shx(lt, lane, 16); lt += shx(lt, lane, 32); const float gs = GL[((size_t)(b * SEQ + tpos[ci])) * 48 + 16 + head]; const float sc = lt > 0.f ? gs / lt : 0.f;
        bf16_t* op = YB + ((size_t)(b * SEQ + tpos[ci])) * DM + head * 128 + fq * 4;
#pragma unroll
        for (int dt = 0; dt < 8; ++dt) { const f32x4 o = O[ci][dt] * sc; const u32x2 pv = *(const u32x2*)(op + dt * 16); u32x2 w; w.x = pk2(bflo(pv.x) + o[0], bfhi(pv.x) + o[1]); w.y = pk2(bflo(pv.y) + o[2], bfhi(pv.y) + o[3]); *(u32x2*)(op + dt * 16) = w; O[ci][dt] = (f32x4){0.f, 0.f, 0.f, 0.f}; } }
    const bf16_t* kwb = KW + (size_t)bg * SEQ * 128; const bf16_t* vwb = VWT + (size_t)bg * 128 * SEQ;
    m[0] = m[1] = NEGB; l[0] = l[1] = 0.f; selbit[0] = selbit[1] = true;
    {
        const int j0 = tq >= 8 ? tq - 8 : 0;
        stage_load(R, kwb + (size_t)tq * 64 * 128, vwb + tq * 64, SEQ, tid);
        for (int j = tq; j >= j0; --j) {
            LAS unsigned char* kvb = lds + (tc & 1) * AL_BUF; ++tc; stage_store(R, kvb, tid); __syncthreads();
            if (j > j0) stage_load(R, kwb + (size_t)(j - 1) * 64 * 128, vwb + (j - 1) * 64, SEQ, tid);
            attn_tile<3>(j == tq || j == tq - 8, kvb, lds, qf, O, m, l, tpos, slope2, j * 64, selbit, fr, fq, wv, 0, lane);
        }
    }
#pragma unroll
    for (int ci = 0; ci < 2; ++ci) { float lt = l[ci]; lt += shx(lt, lane, 16); lt += shx(lt, lane, 32); const float gwv = GL[((size_t)(b * SEQ + tpos[ci])) * 48 + 32 + head]; const float sc = lt > 0.f ? gwv / lt : 0.f;
        bf16_t* op = YB + ((size_t)(b * SEQ + tpos[ci])) * DM + head * 128 + fq * 4;
#pragma unroll
        for (int dt = 0; dt < 8; ++dt) { const f32x4 o = O[ci][dt] * sc; const u32x2 pv = *(const u32x2*)(op + dt * 16); u32x2 w; w.x = pk2(bflo(pv.x) + o[0], bfhi(pv.x) + o[1]); w.y = pk2(bflo(pv.y) + o[2], bfhi(pv.y) + o[3]); *(u32x2*)(op + dt * 16) = w; } }
}

__global__ void __launch_bounds__(512) fwd_kernel(Args a) {
    extern __shared__ __attribute__((aligned(16))) unsigned char lds_raw[];
    LAS unsigned char* lds = (LAS unsigned char*)lds_raw;
    const int G = gridDim.x, bx = blockIdx.x;
    const int NGW = G * 8, NGT = G * 512;
#define GW() (opq(bx) * 8 + __builtin_amdgcn_readfirstlane(opaque_tid() >> 6))
    unsigned char* ws = a.ws;
    int ph = 0;
    { volatile LAS unsigned* MISC = (volatile LAS unsigned*)(lds + LDS_BYTES - 64); if (threadIdx.x < 16) MISC[threadIdx.x] = 0u; }
    __syncthreads();
    (void)xcd_barrier_post((unsigned*)(ws + WS_BAR), (volatile LAS unsigned*)(lds + LDS_BYTES - 64));
#ifndef ONLY
#define ONLY -1
#endif
#define EN(id) (ONLY < 0 || ONLY == (id))
#define ON() (ph >= a.lo && ph < a.hi)
#define SEAM() do { ++ph; if (a.one) { if (ph == 1) cg::this_grid().sync(); else { XcdBarrier bar; bar.bar = (unsigned*)(opqp(ws) + WS_BAR); bar.x = xb_xcc_id(); bar.st = (volatile LAS unsigned*)(lds + LDS_BYTES - 64); xcd_barrier(bar); } } } while (0)

    bf16_t* XN = (bf16_t*)(ws + WS_XN); bf16_t* YB = (bf16_t*)(ws + WS_YB); unsigned char* Z = ws + WS_Z;
    float* posb = (float*)(ws + WS_POSB);

    if (EN(0) && ON())
#pragma unroll 1
    for (int rp0 = 0; rp0 < REP_P0; ++rp0) {
        const int tid = opaque_tid(), lane = tid & 63, wave = __builtin_amdgcn_readfirstlane(tid >> 6), gw = bx * 8 + wave, gt = bx * 512 + tid;
        LAS float* scr = (LAS float*)(lds + wave * 16640);
        int rot = 0;
        for (int i = 0; i < 4; ++i) {
            conv_mat(a.in[23] + (size_t)i * DM * DFF, DM, DFF, DFF, (bf16_t*)(ws + WS_WUP + i * SZ_UP), DM, scr, gw, NGW, lane, rot, a.in[22] + i * DM);
            conv_mat(a.in[24] + (size_t)i * DFF * DM, DFF, DM, DM, (bf16_t*)(ws + WS_WDN + i * SZ_UP), DFF, scr, gw, NGW, lane, rot);
            conv_mat(a.in[26] + (size_t)i * DM * DM, DM, DM, DM, (bf16_t*)(ws + WS_WG + i * SZ_SQ), DM, scr, gw, NGW, lane, rot, a.in[25] + i * DM);
            conv_mat(a.in[27] + (size_t)i * PLE * DM, PLE, DM, DM, (bf16_t*)(ws + WS_WP + i * SZ_WP), PLE, scr, gw, NGW, lane, rot);
        }
        for (int j = 0; j < 2; ++j) {
            conv_mat(a.in[3] + (size_t)j * DM * AB_IN, DM, 2048, AB_IN, (bf16_t*)(ws + WS_WIN + j * SZ_WIN), DM, scr, gw, NGW, lane, rot, a.in[2] + (2 * j) * DM);
            conv_mat(a.in[13] + (size_t)j * DM * DM, DM, DM, DM, (bf16_t*)(ws + WS_WOUT + j * SZ_SQ), DM, scr, gw, NGW, lane, rot);
            conv_mat(a.in[14] + (size_t)j * DM * C_IN, DM, C_INP, C_IN, (bf16_t*)(ws + WS_CIN + j * SZ_CIN), DM, scr, gw, NGW, lane, rot, a.in[2] + (2 * j + 1) * DM);
            conv_mat(a.in[14] + (size_t)j * DM * C_IN + C_INP, DM, 48, C_IN, (bf16_t*)(ws + WS_WGL + (size_t)j * 256 * DM * 2), DM, scr, gw, NGW, lane, rot, a.in[2] + (2 * j + 1) * DM);
            conv_mat(a.in[21] + (size_t)j * DM * DM, DM, DM, DM, (bf16_t*)(ws + WS_COUT + j * SZ_SQ), DM, scr, gw, NGW, lane, rot);
            conv_mat(a.in[16] + (size_t)j * 4096 * 512, 4096, 512, 512, (bf16_t*)(ws + WS_W1K + j * SZ_W1), 4096, scr, gw, NGW, lane, rot);
            conv_mat(a.in[19] + (size_t)j * 4096 * 512, 4096, 512, 512, (bf16_t*)(ws + WS_W1V + j * SZ_W1), 4096, scr, gw, NGW, lane, rot);
            conv_mat(a.in[17] + (size_t)j * 512 * 128, 512, 128, 128, (bf16_t*)(ws + WS_W2K + j * SZ_W2), 512, scr, gw, NGW, lane, rot);
            conv_mat(a.in[20] + (size_t)j * 512 * 128, 512, 128, 128, (bf16_t*)(ws + WS_W2V + j * SZ_W2), 512, scr, gw, NGW, lane, rot);
            for (int h = 0; h < 16; ++h) {
                conv_mat(a.in[6] + ((size_t)j * 16 + h) * 4096, 64, 64, 64, (bf16_t*)(ws + WS_WR + j * SZ_WRI) + h * 4096, 64, scr, gw, NGW, lane, rot);
                conv_mat(a.in[8] + ((size_t)j * 16 + h) * 4096, 64, 64, 64, (bf16_t*)(ws + WS_WI + j * SZ_WRI) + h * 4096, 64, scr, gw, NGW, lane, rot);
            }
            for (int gI = 0; gI < 4; ++gI)
                conv_mat(a.in[11] + ((size_t)j * 4 + gI) * 65536, 256, 256, 256, (bf16_t*)(ws + WS_POOLT + j * SZ_POOLT) + gI * 65536, 256, scr, gw, NGW, lane, rot);
            conv_plain(a.in[3] + (size_t)j * DM * AB_IN + 2048, DM, 1024, AB_IN, (bf16_t*)(ws + WS_WU + j * SZ_WU), 1024, gt, NGT, a.in[2] + (2 * j) * DM);
            zero_fill16(ws + WS_WGL + (size_t)j * 256 * DM * 2 + (size_t)48 * DM * 2, (size_t)208 * DM * 2, gt, NGT);
            zero_fill16(ws + WS_W2K + j * SZ_W2 + (size_t)128 * 512 * 2, (size_t)128 * 512 * 2, gt, NGT);
            zero_fill16(ws + WS_W2V + j * SZ_W2 + (size_t)128 * 512 * 2, (size_t)128 * 512 * 2, gt, NGT);
        }
        conv_plain(a.in[1], 4 * T_TOK, PLE, PLE, (bf16_t*)(ws + WS_PB), PLE, gt, NGT);
        rows_to_bf16_ss(a.in[0], XN, (float*)(ws + WS_ROWSS), bx, NGW);
        for (int it = gw; it < 4 * 8 * 64; it += NGW) { const int q = it >> 9, fc = (it >> 6) & 7, kc = it & 63, j = q >> 1;
            const float* pos = a.in[(q & 1) ? 18 : 15] + (size_t)j * 4096 + kc * 64; const float* w1 = a.in[(q & 1) ? 19 : 16] + (size_t)j * 4096 * 512 + (size_t)kc * 64 * 512 + fc * 64 + lane;
            float acc0 = 0.f, acc1 = 0.f, acc2 = 0.f, acc3 = 0.f;
#pragma unroll 4
            for (int k = 0; k < 64; k += 4) { acc0 += pos[k] * w1[(size_t)k * 512]; acc1 += pos[k + 1] * w1[(size_t)(k + 1) * 512]; acc2 += pos[k + 2] * w1[(size_t)(k + 2) * 512]; acc3 += pos[k + 3] * w1[(size_t)(k + 3) * 512]; }
            ((float*)(ws + WS_POSP))[((size_t)q * 64 + kc) * 512 + fc * 64 + lane] = (acc0 + acc1) + (acc2 + acc3); }
    }
    SEAM();
    if (EN(1) && ON()) {
        if (bx < 64) { const int j = bx >> 5, gI = (bx >> 3) & 3, pn = bx & 7;
            pg8::Gemm gm{(const bf16_t*)(ws + WS_POOLT + j * SZ_POOLT) + gI * 65536, (const bf16_t*)(ws + WS_WU + j * SZ_WU) + gI * 256, 256, 2048, 256, 256, 1024};
            pg8::StaticOrder S; S.init(256, 2048, G, pn);
            EpiBf16<0> E{(bf16_t*)(ws + WS_WIN + j * SZ_WIN) + (size_t)(2048 + gI * 256) * DM, DM, nullptr, nullptr};
            pg8::gemm_phase(lds, gm, S, E); }
        else { const int tid = opaque_tid(); const float* pp = (const float*)(ws + WS_POSP);
            for (int o = (bx - 64) * 512 + tid; o < 2048; o += (G - 64) * 512) { const int q = o >> 9, f = o & 511; float acc = 0.f;
                for (int kc = 0; kc < 64; ++kc) acc += pp[((size_t)q * 64 + kc) * 512 + f];
                posb[o] = acc; } }
    }
    SEAM();
#pragma unroll 1
    for (int layer = 0; layer < 4; ++layer) {
        const int j = layer >> 1; const bool even = (layer & 1) == 0;
        unsigned char* wsl = opqp(ws); unsigned char* Zl = wsl + WS_Z; bf16_t* XNl = (bf16_t*)(wsl + WS_XN); bf16_t* YBl = (bf16_t*)(wsl + WS_YB); float* posbl = (float*)(wsl + WS_POSB);
        const float* hin = (layer == 0) ? a.in[0] : a.out;
        float* RSS = (float*)(wsl + WS_ROWSS); bf16_t* PPl = (bf16_t*)(wsl + WS_PP);
        bf16_t* hc = (layer & 1) ? (bf16_t*)(wsl + WS_H2) : XNl;
        bf16_t* hn = (layer & 1) ? XNl : (bf16_t*)(wsl + WS_H2);
        const bf16_t* Ain = hc;
        LAS const float* RT = (LAS const float*)(lds + RTAB_OFF);
        if (EN(3) && ON()) {
            fill_rstd_tab(lds, RSS + (size_t)(layer * 3) * T_TOK * 32, opq(bx));
            if (even) { pg8::Gemm gm{Ain, (const bf16_t*)(wsl + WS_WIN + j * SZ_WIN), T_TOK, AB_IN, DM, DM, DM};
                pg8::StaticOrder S; S.init(T_TOK, AB_IN, opq(G), opq(bx)); EpiBf16<0> E{(bf16_t*)Zl, AB_IN, nullptr, RT}; pg8::gemm_phase(lds, gm, S, E); }
            else { pg8::Gemm gm{Ain, (const bf16_t*)(wsl + WS_CIN + j * SZ_CIN), T_TOK, C_INP, DM, DM, DM};
                pg8::StaticOrder S; S.init(T_TOK, C_INP, opq(G), opq(bx));
                EpiNsa E{(bf16_t*)(Zl + Z_Q), (bf16_t*)(Zl + Z_KC), (bf16_t*)(Zl + Z_VC), (bf16_t*)(Zl + Z_KS), (bf16_t*)(Zl + Z_VST), (bf16_t*)(Zl + Z_KW), (bf16_t*)(Zl + Z_VWT), (float*)(Zl + Z_GL), RT};
                pg8::gemm_phase(lds, gm, S, E); }
        }
        SEAM();
        if (even) {
            if (EN(4) && ON()) {
#ifndef NO_LRU
#pragma unroll 1
                for (int rp = 0; rp < REP_LRU; ++rp)
                for (int it = opq(bx); it < 256; it += G)
                    lru_item(lds, it, (const bf16_t*)Zl, a.in[4] + (size_t)j * 4096, a.in[5] + j * 1024, (const bf16_t*)(wsl + WS_WR + j * SZ_WRI), (const bf16_t*)(wsl + WS_WI + j * SZ_WRI),
                             a.in[7] + j * 1024, a.in[9] + j * 1024, a.in[10] + j * 1024, YBl);
#endif
                for (int it = opq(bx); it < 256; it += G) pool_item(it, (const bf16_t*)Zl, a.in[12] + j * 1024, YBl);
            }
            SEAM();
        } else {
            if (EN(5) && ON()) {
                if (bx < 64) { const int kv = bx >> 5;
                    pg8::Gemm gm{(const bf16_t*)(Zl + (kv ? Z_VC : Z_KC)), (const bf16_t*)(wsl + (kv ? WS_W1V : WS_W1K) + j * SZ_W1), 4096, 512, 4096, 2048, 4096};
                    pg8::StaticOrder S; S.init(4096, 512, opq(G), opq(bx) & 31);
                    EpiBf16<2> E{(bf16_t*)(Zl + (kv ? Z_HIDV : Z_HIDK)), 512, posbl + (j * 2 + kv) * 512, nullptr}; pg8::gemm_phase(lds, gm, S, E); }
                else if (bx < 128) { pg8::Gemm gm{Ain, (const bf16_t*)(wsl + WS_WGL + (size_t)j * 256 * DM * 2), T_TOK, 256, DM, DM, DM};
                    fill_rstd_tab(lds, RSS + (size_t)(layer * 3) * T_TOK * 32, opq(bx));
                    pg8::StaticOrder S; S.init(T_TOK, 256, opq(G), opq(bx) - 64); EpiGates E{(float*)(Zl + Z_GL), RT}; pg8::gemm_phase(lds, gm, S, E); }
                else { pg8::Gemm gp{(const bf16_t*)(wsl + WS_PB) + (size_t)layer * T_TOK * PLE, (const bf16_t*)(wsl + WS_WP + layer * SZ_WP), T_TOK, DM, PLE, PLE, PLE};
                    pg8::StaticOrder S2; S2.init(T_TOK, DM, 128, opq(bx) - 128); EpiBf16<0> E2{PPl, DM, nullptr, nullptr}; pg8::gemm_phase(lds, gp, S2, E2); }
            }
            SEAM();
            if (EN(6) && ON()) {
                if (bx < 16) { pg8::Gemm gm{(const bf16_t*)(Zl + Z_HIDK), (const bf16_t*)(wsl + WS_W2K + j * SZ_W2), 4096, 256, 512, 512, 512};
                    pg8::StaticOrder S; S.init(4096, 256, opq(G), opq(bx)); EpiCmp2<0> E{(bf16_t*)(Zl + Z_KCMP)}; pg8::gemm_phase(lds, gm, S, E); }
                else if (bx < 32) { pg8::Gemm gm{(const bf16_t*)(Zl + Z_HIDV), (const bf16_t*)(wsl + WS_W2V + j * SZ_W2), 4096, 256, 512, 512, 512};
                    pg8::StaticOrder S; S.init(4096, 256, opq(G), opq(bx) - 16); EpiCmp2<1> E{(bf16_t*)(Zl + Z_VCMPT)}; pg8::gemm_phase(lds, gm, S, E); }
            }
            SEAM();
            if (EN(7) && ON()) {
#pragma unroll 1
                for (int rp = 0; rp < REP_ATTN; ++rp)
                for (int it = opq(bx), r = 0; it < 1024; it += G, ++r) { const int c = it % 256, rr = it / 256; const int cp = (rr & 1) ? 255 - c : c;
                    const int tq = 63 - (rr * 16 + (cp >> 4)), bgi = cp & 15;
#ifndef NO_ATTN
                    nsa_item(lds, bgi >> 2, bgi & 3, tq, (const bf16_t*)(Zl + Z_Q), (const bf16_t*)(Zl + Z_KS), (const bf16_t*)(Zl + Z_VST), (const bf16_t*)(Zl + Z_KW), (const bf16_t*)(Zl + Z_VWT),
                             (const bf16_t*)(Zl + Z_KCMP), (const bf16_t*)(Zl + Z_VCMPT), (const float*)(Zl + Z_GL), YBl);
#endif
                }
                __syncthreads();
            }
            SEAM();
        }
        if (EN(8) && ON()) { pg8::Gemm gm{YBl, (const bf16_t*)(wsl + (even ? WS_WOUT : WS_COUT) + j * SZ_SQ), T_TOK, DM, DM, DM, DM};
            pg8::StaticOrder S; S.init(T_TOK, DM, opq(G), opq(bx)); EpiRes<0> E{hc, hc, nullptr, DM, RSS + (size_t)(layer * 3 + 1) * T_TOK * 32, nullptr}; pg8::gemm_phase(lds, gm, S, E);
            if (even) { pg8::Gemm gp{(const bf16_t*)(wsl + WS_PB) + (size_t)layer * T_TOK * PLE, (const bf16_t*)(wsl + WS_WP + layer * SZ_WP), T_TOK, DM, PLE, PLE, PLE};
              pg8::StaticOrder S2; S2.init(T_TOK, DM, opq(G), opq(bx)); EpiBf16<0> E2{PPl, DM, nullptr, nullptr}; pg8::gemm_phase(lds, gp, S2, E2); } }
        SEAM();
        if (EN(10) && ON())
#pragma unroll 1
        for (int rpu = 0; rpu < REP_UP; ++rpu) { fill_rstd_tab(lds, RSS + (size_t)(layer * 3 + 1) * T_TOK * 32, opq(bx));
            pg8::Gemm gm{hc, (const bf16_t*)(wsl + WS_WUP + layer * SZ_UP), T_TOK, DFF, DM, DM, DM};
            pg8::StaticOrder S; S.init(T_TOK, DFF, opq(G), opq(bx)); EpiBf16<1> E{(bf16_t*)Zl, DFF, nullptr, RT}; pg8::gemm_phase(lds, gm, S, E); }
        SEAM();
        if (EN(11) && ON()) { pg8::Gemm gm{(const bf16_t*)Zl, (const bf16_t*)(wsl + WS_WDN + layer * SZ_UP), T_TOK, DM, DFF, DFF, DFF};
            pg8::StaticOrder S; S.init(T_TOK, DM, opq(G), opq(bx)); EpiRes<0> E{hc, hc, nullptr, DM, RSS + (size_t)(layer * 3 + 2) * T_TOK * 32, nullptr}; pg8::gemm_phase(lds, gm, S, E); }
        SEAM();
        if (EN(13) && ON()) { fill_rstd_tab(lds, RSS + (size_t)(layer * 3 + 2) * T_TOK * 32, opq(bx));
            pg8::Gemm gm{hc, (const bf16_t*)(wsl + WS_WG + layer * SZ_SQ), T_TOK, DM, DM, DM, DM};
            pg8::StaticOrder S; S.init(T_TOK, DM, opq(G), opq(bx)); EpiRes<1> E{hc, hn, PPl, DM, RSS + (size_t)(layer * 3 + 3) * T_TOK * 32, RT}; pg8::gemm_phase(lds, gm, S, E); }
        SEAM();
    }
    if (EN(14) && ON()) rmsnorm_rows<true>((const float*)XN, a.in[28], nullptr, a.out, bx, NGW);
#undef ON
#undef SEAM
}
constexpr int N_PHASES = 1 + 2 * 9 + 2 * 11 + 1;

extern "C" void kernel_launch(void* const* d_in, const int* in_sizes, int n_in, void* d_out, int out_size, void* d_ws, size_t ws_size, hipStream_t stream) {
    static int grid = 0;
    if (grid == 0) {
        if (n_in != 29 || ws_size < WS_END) { fprintf(stderr, "kernel_launch: unexpected n_in %d / ws %zu (need %zu)\n", n_in, ws_size, (size_t)WS_END); grid = -1; return; }
        int dev = 0, cus = 0, per_cu = 0;
        hipGetDevice(&dev); hipDeviceGetAttribute(&cus, hipDeviceAttributeMultiprocessorCount, dev);
        if (hipFuncSetAttribute((const void*)fwd_kernel, hipFuncAttributeMaxDynamicSharedMemorySize, LDS_BYTES) != hipSuccess) { fprintf(stderr, "hipFuncSetAttribute failed\n"); grid = -1; return; }
        if (hipOccupancyMaxActiveBlocksPerMultiprocessor(&per_cu, (const void*)fwd_kernel, 512, LDS_BYTES) != hipSuccess || per_cu < 1) { fprintf(stderr, "occupancy query: %d\n", per_cu); per_cu = 1; }
        (void)hipGetLastError();
        grid = cus;
        if (grid != 256) { fprintf(stderr, "kernel_launch: this build needs a 256-CU device (fixed row panel per workgroup); got %d\n", cus); grid = -1; return; }
    }
    if (grid < 0) return;
    Args a{};
    for (int i = 0; i < 29; ++i) a.in[i] = (const float*)d_in[i];
    a.out = (float*)d_out; a.ws = (unsigned char*)d_ws;
#if MK_ONE_LAUNCH
    (void)hipMemsetAsync((unsigned char*)d_ws + WS_BAR, 0, XCD_BAR_WORDS * 4, stream);
    a.lo = 0; a.hi = 1 << 30; a.one = 1; a.pad = 0;
    void* args[] = {&a};
    hipError_t e = hipLaunchCooperativeKernel((const void*)fwd_kernel, dim3(grid), dim3(512), args, LDS_BYTES, stream);
    if (e != hipSuccess) fprintf(stderr, "cooperative launch failed: %s (grid %d)\n", hipGetErrorString(e), grid);
#else
    for (int p = 0; p < N_PHASES; ++p) { a.lo = p; a.hi = p + 1; a.one = 0; a.pad = 0;
        hipLaunchKernelGGL(fwd_kernel, dim3(grid), dim3(512), LDS_BYTES, stream, a); }
#endif
}
```

```cpp
#include <hip/hip_runtime.h>
#include <hip/hip_cooperative_groups.h>
#include <cstdio>
namespace cg = cooperative_groups;

#ifndef REP_ATTN
#define REP_ATTN 1
#endif
#ifndef REP_LRU
#define REP_LRU 1
#endif
#ifndef REP_P0
#define REP_P0 1
#endif
#ifndef REP_UP
#define REP_UP 1
#endif
#ifndef MK_ONE_LAUNCH
#define MK_ONE_LAUNCH 1
#endif

#define LAS __attribute__((address_space(3)))
typedef unsigned short bf16_t;
typedef short bf16x8 __attribute__((ext_vector_type(8)));
typedef float f32x4 __attribute__((ext_vector_type(4)));
typedef float f32x2 __attribute__((ext_vector_type(2)));
typedef unsigned u32x4 __attribute__((ext_vector_type(4)));
typedef unsigned u32x2 __attribute__((ext_vector_type(2)));

constexpr int T_TOK = 16384, DM = 2048, SEQ = 4096, NB = 4, DFF = 8192, PLE = 256;
constexpr int AB_IN = 3072, C_IN = 5168, C_INP = 5120;
constexpr float EPSV = 1e-6f;
constexpr float LOG2E = 1.4426950408889634f;

__device__ __forceinline__ unsigned f2bf(float f) { unsigned u = __builtin_bit_cast(unsigned, f); return (u + 0x7fffu + ((u >> 16) & 1u)) >> 16; }
__device__ __forceinline__ unsigned pk2(float lo, float hi) { unsigned r; asm volatile("v_cvt_pk_bf16_f32 %0, %1, %2" : "=v"(r) : "v"(lo), "v"(hi)); return r; }
__device__ __forceinline__ float bf2f(unsigned short b) { return __builtin_bit_cast(float, ((unsigned)b) << 16); }
__device__ __forceinline__ float bflo(unsigned w) { return __builtin_bit_cast(float, w << 16); }
__device__ __forceinline__ float bfhi(unsigned w) { return __builtin_bit_cast(float, w & 0xffff0000u); }
__device__ __forceinline__ float shx(float v, int lane, int o) { return __builtin_bit_cast(float, __builtin_amdgcn_ds_bpermute((lane ^ o) << 2, __builtin_bit_cast(int, v))); }
__device__ __forceinline__ float wave_sum(float v, int lane) {
#pragma unroll
    for (int o = 1; o < 64; o <<= 1) v += shx(v, lane, o);
    return v;
}
__device__ __forceinline__ float sigmoidf_(float x) { return __builtin_amdgcn_rcpf(1.0f + __expf(-x)); }
__device__ __forceinline__ float gelu_tanh(float x) {
    const float u = 0.7978845608028654f * (x + 0.044715f * x * x * x);
    const float e = __expf(2.0f * u);
    const float th = 1.0f - 2.0f * __builtin_amdgcn_rcpf(e + 1.0f);
    return 0.5f * x * (1.0f + th);
}

__device__ __forceinline__ unsigned char* opqp(unsigned char* p) { size_t z = 0; asm volatile("" : "+s"(z)); return p + z; }
__device__ __forceinline__ int opq(int v) { asm volatile("" : "+s"(v)); return v; }
__device__ __forceinline__ int opaque_tid() { int t = threadIdx.x; asm volatile("" : "+v"(t)); return t; }
namespace pg8 {
constexpr int BM = 256, BK = 64, HALF = 128, HTB = HALF * BK * 2, STAGE_BYTES = 8 * HTB, NXCD = 8, WGM = 8;
__host__ __device__ __forceinline__ int lds_byte(int r, int c) { const int st = (r >> 4) * 2 + (c >> 5), rr = r & 15, cc = c & 31, ob = rr * 64 + cc * 2; return st * 1024 + (ob ^ (((ob >> 9) & 1) << 5)); }
__host__ __device__ __forceinline__ void stage_rc(int b, int& R, int& C) { const int st = b / 1024, sb = b % 1024, swz = sb ^ (((sb >> 9) & 1) << 5); R = (st >> 1) * 16 + swz / 64; C = (st & 1) * 32 + (swz % 64) / 2; }
__host__ __device__ __forceinline__ int perm32(int rho) { const int n = rho >> 4, i = rho & 15; return 8 * (i >> 2) + 4 * n + (i & 3); }

struct Unit { int pm, pn; };
struct Gemm { const bf16_t* A; const bf16_t* Bt; int M, N, K, lda, ldb; };

struct StaticOrder {
    int nM, nN, nwg, G, c;
    __device__ void init(int M, int N, int G_, int c_) { nM = M / BM; nN = N / BM; nwg = nM * nN; G = G_; c = c_; }
    __device__ bool next(int i, Unit& u) const {
        const long L = (long)i * G + c; if (L >= nwg || c < 0) return false;
        int wgid = (int)L; { const int q = nwg / NXCD, r = nwg % NXCD, xcd = wgid % NXCD, off = wgid / NXCD; wgid = (xcd < r ? xcd * (q + 1) : r * (q + 1) + (xcd - r) * q) + off; }
        const int nig = WGM * nN, gid = wgid / nig, fm = gid * WGM, gsz = (nM - fm) < WGM ? (nM - fm) : WGM;
        u.pm = fm + ((wgid % nig) % gsz); u.pn = (wgid % nig) / gsz; return true;
    }
};

template <class Epi, class Sched>
__device__ __forceinline__ void gemm_phase(LAS unsigned char* lds, const Gemm g, const Sched& S, const Epi& E) {
    const int tid = opaque_tid(), wid = __builtin_amdgcn_readfirstlane(tid >> 6), lane = tid & 63, wr = wid >> 2, wc = wid & 3, fr = lane & 15, fq = lane >> 4;
    const int K = g.K, nt = K / BK;
    unsigned voffA[2], voffB[2];
#pragma unroll
    for (int i = 0; i < 2; ++i) { int R, C; stage_rc(tid * 16 + i * 8192, R, C); const int Rb = Epi::PERM ? ((R & ~31) + perm32(R & 31)) : R;
        voffA[i] = (unsigned)(R * g.lda + C) * 2u; voffB[i] = (unsigned)(Rb * g.ldb + C) * 2u; }
    const size_t kstep = (size_t)(BK * 2);
    const size_t hstepA = (size_t)HALF * g.lda * 2, hstepB = (size_t)HALF * g.ldb * 2;
    const size_t tstepA = 2 * hstepA, tstepB = 2 * hstepB;
    const unsigned ldsw = (unsigned)wid * 1024u;
    const int aoff = lds_byte(wr * 64 + fr, fq * 8), boff = lds_byte(wc * 32 + fr, fq * 8);
#define PG8_SA(b, h) (((b) * 2 + (h)) * HTB)
#define PG8_SB(b, h) ((4 + (b) * 2 + (h)) * HTB)
#define PG8_STAGE(bufoff, gbase, voff) do { _Pragma("unroll") for (int _i = 0; _i < 2; ++_i) \
        __builtin_amdgcn_global_load_lds((const unsigned*)((const char*)(gbase) + (voff)[_i]), (LAS unsigned*)(lds + (bufoff) + ldsw + _i * 8192), 16, 0, 0); } while (0)
#define PG8_LDA(dst, b, h) do { _Pragma("unroll") for (int m = 0; m < 4; ++m) _Pragma("unroll") for (int k = 0; k < 2; ++k) dst[m][k] = *(const LAS bf16x8*)(lds + PG8_SA(b, h) + aoff + m * 2048 + k * 1024); } while (0)
#define PG8_LDB(dst, b, h) do { _Pragma("unroll") for (int n = 0; n < 2; ++n) _Pragma("unroll") for (int k = 0; k < 2; ++k) dst[n][k] = *(const LAS bf16x8*)(lds + PG8_SB(b, h) + boff + n * 2048 + k * 1024); } while (0)
#define PG8_MMA(ai, bj, At, Bt) do { __builtin_amdgcn_s_setprio(1); _Pragma("unroll") for (int m = 0; m < 4; ++m) _Pragma("unroll") for (int n = 0; n < 2; ++n) _Pragma("unroll") for (int k = 0; k < 2; ++k) \
        acc[ai][bj][m][n] = __builtin_amdgcn_mfma_f32_16x16x32_bf16(Bt[n][k], At[m][k], acc[ai][bj][m][n], 0, 0, 0); __builtin_amdgcn_s_setprio(0); } while (0)
#define PG8_WAIT_V(n) asm volatile("s_waitcnt vmcnt(" #n ")" ::: "memory")
#define PG8_WAIT_L(n) asm volatile("s_waitcnt lgkmcnt(" #n ")" ::: "memory")
#define PG8_BAR __builtin_amdgcn_s_barrier()
#define PG8_SCHED __builtin_amdgcn_sched_barrier(0)
    Unit cur, nxt; int ui = 0;
    if (!S.next(0, cur)) return;
    f32x4 acc[2][2][4][2];
#pragma unroll
    for (int a = 0; a < 2; ++a)
#pragma unroll
        for (int b = 0; b < 2; ++b)
#pragma unroll
            for (int m = 0; m < 4; ++m)
#pragma unroll
                for (int n = 0; n < 2; ++n) acc[a][b][m][n] = (f32x4){0.f, 0.f, 0.f, 0.f};
    bf16x8 At[4][2], B0[2][2], B1[2][2];
    const char* cA = (const char*)g.A + (size_t)cur.pm * tstepA; const char* cB = (const char*)g.Bt + (size_t)cur.pn * tstepB;
    PG8_STAGE(PG8_SB(0, 0), cB, voffB); PG8_STAGE(PG8_SB(0, 1), cB + hstepB, voffB); PG8_STAGE(PG8_SA(0, 0), cA, voffA); PG8_STAGE(PG8_SA(0, 1), cA + hstepA, voffA);
    if (wr == 1) PG8_BAR;
    PG8_WAIT_V(2); PG8_BAR;
    PG8_STAGE(PG8_SB(1, 0), cB + kstep, voffB); PG8_STAGE(PG8_SA(1, 0), cA + kstep, voffA); PG8_STAGE(PG8_SB(1, 1), cB + hstepB + kstep, voffB);
    PG8_WAIT_V(6); PG8_BAR;
    for (;;) {
        const bool has_next = S.next(ui + 1, nxt);
        const char* nA = has_next ? (const char*)g.A + (size_t)nxt.pm * tstepA : cA; const char* nB = has_next ? (const char*)g.Bt + (size_t)nxt.pn * tstepB : cB;
        for (int t = 0; t < nt; t += 2) {
            const bool last = (t == nt - 2);
            const char* a1 = cA + (size_t)(t + 1) * kstep;
            const char* a2 = last ? nA : cA + (size_t)(t + 2) * kstep; const char* b2 = last ? nB : cB + (size_t)(t + 2) * kstep;
            const char* a3 = a2 + kstep; const char* b3 = b2 + kstep;
            PG8_LDB(B0, 0, 0); PG8_LDB(B1, 0, 1); PG8_SCHED; PG8_LDA(At, 0, 0); PG8_STAGE(PG8_SA(1, 1), a1 + hstepA, voffA);
            PG8_WAIT_V(8); PG8_WAIT_L(0); PG8_BAR; PG8_MMA(0, 0, At, B0); PG8_MMA(0, 1, At, B1); PG8_BAR; PG8_SCHED;
            PG8_LDA(At, 0, 1); PG8_STAGE(PG8_SB(0, 0), b2, voffB); PG8_STAGE(PG8_SB(0, 1), b2 + hstepB, voffB); PG8_STAGE(PG8_SA(0, 0), a2, voffA);
            PG8_WAIT_V(8); PG8_WAIT_L(0); PG8_BAR; PG8_MMA(1, 0, At, B0); PG8_MMA(1, 1, At, B1); PG8_BAR; PG8_SCHED;
            PG8_LDB(B0, 1, 0); PG8_LDB(B1, 1, 1); PG8_SCHED; PG8_LDA(At, 1, 0); PG8_STAGE(PG8_SA(0, 1), a2 + hstepA, voffA);
            PG8_WAIT_V(8); PG8_WAIT_L(0); PG8_BAR; PG8_MMA(0, 0, At, B0); PG8_MMA(0, 1, At, B1); PG8_BAR; PG8_SCHED;
            PG8_LDA(At, 1, 1); PG8_STAGE(PG8_SB(1, 0), b3, voffB); PG8_STAGE(PG8_SB(1, 1), b3 + hstepB, voffB); PG8_STAGE(PG8_SA(1, 0), a3, voffA);
            PG8_WAIT_V(8); PG8_WAIT_L(0); PG8_BAR; PG8_MMA(1, 0, At, B0); PG8_MMA(1, 1, At, B1); PG8_BAR; PG8_SCHED;
        }
        if (wr == 0) PG8_BAR;
        { const int tl = opaque_tid() & 63; E(acc, cur, wr, wc, tl & 15, tl >> 4); }
        if (!has_next) break;
#pragma unroll
        for (int a = 0; a < 2; ++a)
#pragma unroll
            for (int b = 0; b < 2; ++b)
#pragma unroll
                for (int m = 0; m < 4; ++m)
#pragma unroll
                    for (int n = 0; n < 2; ++n) acc[a][b][m][n] = (f32x4){0.f, 0.f, 0.f, 0.f};
        cur = nxt; cA = nA; cB = nB; ++ui;
        if (wr == 1) PG8_BAR;
    }
    PG8_WAIT_V(0);
    PG8_BAR;
#undef PG8_SA
#undef PG8_SB
#undef PG8_STAGE
#undef PG8_LDA
#undef PG8_LDB
#undef PG8_MMA
#undef PG8_WAIT_V
#undef PG8_WAIT_L
#undef PG8_BAR
#undef PG8_SCHED
}
}
using pg8::Unit; using pg8::HALF; using pg8::BM;


#define XB_TMO      128
#define XB_XCNT(j)  (256  + 64 * (j))
#define XB_XSUB(j)  (1280 + 64 * (j))
#define XB_XGEN(j)  (2304 + 64 * (j))
#define XB_TOP      3328
#define XB_TOPGEN   3392
#define XCD_BAR_WORDS 3456
#define XB_SPIN_CAP (1u << 18)
__device__ __forceinline__ unsigned xb_ld(unsigned* p)              { return __hip_atomic_load(p, __ATOMIC_RELAXED, __HIP_MEMORY_SCOPE_AGENT); }
__device__ __forceinline__ unsigned xb_add(unsigned* p, unsigned v) { return __hip_atomic_fetch_add(p, v, __ATOMIC_RELAXED, __HIP_MEMORY_SCOPE_AGENT); }
__device__ __forceinline__ unsigned xb_xcc_id() { return (unsigned)__builtin_amdgcn_s_getreg((3 << 11) | 20) & 0xFu; }
#define XB_SPIN(cond, bar) do { unsigned _sp = 0; while (cond) { __builtin_amdgcn_s_sleep(1); \
    if ((++_sp & 255u) == 0u) { if (xb_ld(&(bar)[XB_TMO])) break; if (_sp > XB_SPIN_CAP) { atomicAdd(&(bar)[XB_TMO], 1u); break; } } } } while (0)
struct XcdBarrier { unsigned* bar; unsigned x; volatile LAS unsigned* st; };
__device__ __forceinline__ XcdBarrier xcd_barrier_post(unsigned* bar, volatile LAS unsigned* st) {
    XcdBarrier b; b.bar = bar; b.x = xb_xcc_id(); b.st = st;
    if (threadIdx.x == 0) (void)xb_add(&bar[XB_XCNT(b.x)], 1u);
    return b;
}
__device__ __forceinline__ void xcd_barrier_complete(unsigned* bar, unsigned x, unsigned& nloc, unsigned& nx) {
    const unsigned G = gridDim.x * gridDim.y * gridDim.z;
    unsigned sum, cnt, mine, sp = 0u;
    for (;;) {
        sum = 0u; cnt = 0u; mine = 0u;
#pragma unroll
        for (unsigned j = 0; j < 16; ++j) { const unsigned c = xb_ld(&bar[XB_XCNT(j)]); sum += c; cnt += (c > 0u) ? 1u : 0u; mine = (j == x) ? c : mine; }
        if (sum == G) break;
        __builtin_amdgcn_s_sleep(1);
        if ((++sp & 255u) == 0u) { if (xb_ld(&bar[XB_TMO])) break; if (sp > XB_SPIN_CAP) { atomicAdd(&bar[XB_TMO], 1u); break; } }
    }
    nloc = mine > 0u ? mine : 1u; nx = cnt > 0u ? cnt : 1u;
}
__device__ __forceinline__ void xcd_barrier(const XcdBarrier& b) {
    asm volatile("s_waitcnt vmcnt(0)" ::: "memory");
    __syncthreads();
    if (threadIdx.x == 0) {
        unsigned* bar = b.bar;
        __builtin_amdgcn_s_waitcnt(0);
        unsigned nloc = b.st[0], nx = b.st[1];
        if (nloc == 0u) { xcd_barrier_complete(bar, b.x, nloc, nx); b.st[0] = nloc; b.st[1] = nx; }
        const unsigned old = xb_add(&bar[XB_XSUB(b.x)], 1u);
        const unsigned gen = old / nloc;
        if (old + 1u == (gen + 1u) * nloc) {
            __builtin_amdgcn_fence(__ATOMIC_RELEASE, "agent");
            asm volatile("s_waitcnt vmcnt(0)" ::: "memory");
            const unsigned og = xb_add(&bar[XB_TOP], 1u);
            const unsigned tg = og / nx;
            if (og + 1u == (tg + 1u) * nx) xb_add(&bar[XB_TOPGEN], 1u);
            else XB_SPIN(xb_ld(&bar[XB_TOPGEN]) == tg, bar);
            __builtin_amdgcn_fence(__ATOMIC_ACQUIRE, "agent");
            xb_add(&bar[XB_XGEN(b.x)], 1u);
            asm volatile("s_waitcnt vmcnt(0)" ::: "memory");
        } else {
            XB_SPIN(xb_ld(&bar[XB_XGEN(b.x)]) == gen, bar);
            __builtin_amdgcn_fence(__ATOMIC_ACQUIRE, "agent");
            asm volatile("s_waitcnt vmcnt(0)" ::: "memory");
        }
    }
    __syncthreads();
}

__device__ __forceinline__ float row_rstd(const float* rp, int row, int fq, int lane) {
    const f32x4 a = *(const f32x4*)(rp + (size_t)row * 32 + fq * 8), b = *(const f32x4*)(rp + (size_t)row * 32 + fq * 8 + 4);
    float s = ((a[0] + a[1]) + (a[2] + a[3])) + ((b[0] + b[1]) + (b[2] + b[3]));
    s += shx(s, lane, 16); s += shx(s, lane, 32);
    return rsqrtf(s * (1.f / DM) + EPSV);
}
constexpr int RTAB_OFF = pg8::STAGE_BYTES;
__device__ __forceinline__ void fill_rstd_tab(LAS unsigned char* lds, const float* slots, int bx) {
    const int tid = opaque_tid(); const int panel = 8 * (bx & 7) + ((bx >> 3) & 7);
    if (tid < 256) { const float* rp = slots + ((size_t)panel * 256 + tid) * 32; float S[4];
#pragma unroll
        for (int k = 0; k < 4; ++k) { const f32x4 a = *(const f32x4*)(rp + k * 8), b = *(const f32x4*)(rp + k * 8 + 4); S[k] = ((a[0] + a[1]) + (a[2] + a[3])) + ((b[0] + b[1]) + (b[2] + b[3])); }
        ((LAS float*)(lds + RTAB_OFF))[tid] = rsqrtf(((S[0] + S[1]) + (S[2] + S[3])) * (1.f / DM) + EPSV); }
    __syncthreads();
}
template <int ACT  > struct EpiBf16 {
    static constexpr bool PERM = true;
    bf16_t* O; int ldc; const float* bias; LAS const float* tab;
    __device__ __forceinline__ void operator()(const f32x4 (&acc)[2][2][4][2], const Unit& u, int wr, int wc, int fr, int fq) const {
        const int row0 = u.pm * BM + wr * 64 + fr, col0 = u.pn * BM + wc * 32 + 8 * fq;
        f32x4 bv[2][2];
#pragma unroll
        for (int bj = 0; bj < 2; ++bj)
#pragma unroll
            for (int n = 0; n < 2; ++n) bv[bj][n] = (ACT == 2) ? *(const f32x4*)(bias + col0 + bj * HALF + 4 * n) : (f32x4){0.f, 0.f, 0.f, 0.f};
        float rsv[2][4];
#pragma unroll
        for (int ai = 0; ai < 2; ++ai)
#pragma unroll
            for (int m = 0; m < 4; ++m) rsv[ai][m] = tab ? tab[wr * 64 + fr + ai * HALF + m * 16] : 1.f;
        asm volatile("" ::: "memory");
#pragma unroll
        for (int ai = 0; ai < 2; ++ai)
#pragma unroll
            for (int m = 0; m < 4; ++m) { bf16_t* rowp = O + (size_t)(row0 + ai * HALF + m * 16) * ldc + col0;
                const float rs = rsv[ai][m];
#pragma unroll
                for (int bj = 0; bj < 2; ++bj) { f32x4 v0 = acc[ai][bj][m][0] * rs + bv[bj][0], v1 = acc[ai][bj][m][1] * rs + bv[bj][1];
                    if (ACT == 1) {
#pragma unroll
                        for (int j = 0; j < 4; ++j) { const float a = fmaxf(v0[j], 0.f), b = fmaxf(v1[j], 0.f); v0[j] = a * a; v1[j] = b * b; } }
                    if (ACT == 2) {
#pragma unroll
                        for (int j = 0; j < 4; ++j) { v0[j] = gelu_tanh(v0[j]); v1[j] = gelu_tanh(v1[j]); } }
                    u32x4 w; w.x = pk2(v0[0], v0[1]); w.y = pk2(v0[2], v0[3]); w.z = pk2(v1[0], v1[1]); w.w = pk2(v1[2], v1[3]);
                    *(u32x4*)(rowp + bj * HALF) = w; } }
    }
};
template <int MODE> struct EpiRes {
    static constexpr bool PERM = true;
    const bf16_t* base; bf16_t* out; const bf16_t* pp; int ldc; float* rss_out; LAS const float* tab_in;
    __device__ __forceinline__ void operator()(const f32x4 (&acc)[2][2][4][2], const Unit& u, int wr, int wc, int fr, int fq) const {
        const int row0 = u.pm * BM + wr * 64 + fr, col0 = u.pn * BM + wc * 32 + 8 * fq; const int lane = fq * 16 + fr;
        float rinv[8];
#pragma unroll
        for (int g = 0; g < 8; ++g) rinv[g] = (MODE == 1) ? tab_in[wr * 64 + fr + (g >> 2) * HALF + (g & 3) * 16] : 1.f;
        u32x4 bc[2], pc[2];
#pragma unroll
        for (int bj = 0; bj < 2; ++bj) { const size_t o2 = (size_t)row0 * ldc + col0 + bj * HALF; bc[bj] = *(const u32x4*)(base + o2); if (MODE == 1) pc[bj] = *(const u32x4*)(pp + o2); }
#pragma unroll
        for (int g = 0; g < 8; ++g) { const int ai = g >> 2, m = g & 3; const int row = row0 + ai * HALF + m * 16; const size_t off = (size_t)row * ldc + col0;
            f32x4 av[2][2];
#pragma unroll
            for (int bj = 0; bj < 2; ++bj) { f32x4 a0 = acc[ai][bj][m][0], a1 = acc[ai][bj][m][1];
                const f32x4 b0 = (f32x4){bflo(bc[bj].x), bfhi(bc[bj].x), bflo(bc[bj].y), bfhi(bc[bj].y)}, b1 = (f32x4){bflo(bc[bj].z), bfhi(bc[bj].z), bflo(bc[bj].w), bfhi(bc[bj].w)};
                if (MODE == 0) { a0 = a0 + b0; a1 = a1 + b1; }
                if (MODE == 1) { const f32x4 p0 = (f32x4){bflo(pc[bj].x), bfhi(pc[bj].x), bflo(pc[bj].y), bfhi(pc[bj].y)}, p1 = (f32x4){bflo(pc[bj].z), bfhi(pc[bj].z), bflo(pc[bj].w), bfhi(pc[bj].w)};
#pragma unroll
                    for (int j = 0; j < 4; ++j) { a0[j] = b0[j] + sigmoidf_(a0[j] * rinv[g]) * p0[j]; a1[j] = b1[j] + sigmoidf_(a1[j] * rinv[g]) * p1[j]; } }
                av[bj][0] = a0; av[bj][1] = a1; }
            asm volatile("" : "+v"(av[0][0]), "+v"(av[0][1]), "+v"(av[1][0]), "+v"(av[1][1]));
            if (g < 7) { const int rown = row0 + ((g + 1) >> 2) * HALF + ((g + 1) & 3) * 16;
#pragma unroll
                for (int bj = 0; bj < 2; ++bj) { const size_t o2 = (size_t)rown * ldc + col0 + bj * HALF; bc[bj] = *(const u32x4*)(base + o2); if (MODE == 1) pc[bj] = *(const u32x4*)(pp + o2); } }
            asm volatile("" ::: "memory");
            float ss = 0.f;
#pragma unroll
            for (int bj = 0; bj < 2; ++bj) { const f32x4 a0 = av[bj][0], a1 = av[bj][1];
                ss += ((a0[0] * a0[0] + a0[1] * a0[1]) + (a0[2] * a0[2] + a0[3] * a0[3])) + ((a1[0] * a1[0] + a1[1] * a1[1]) + (a1[2] * a1[2] + a1[3] * a1[3]));
                u32x4 w; w.x = pk2(a0[0], a0[1]); w.y = pk2(a0[2], a0[3]); w.z = pk2(a1[0], a1[1]); w.w = pk2(a1[2], a1[3]); *(u32x4*)(out + off + bj * HALF) = w; }
            ss += shx(ss, lane, 16); ss += shx(ss, lane, 32); if (fq == 0) rss_out[(size_t)row * 32 + u.pn * 4 + wc] = ss;
        }
    }
};
struct EpiNsa {
    static constexpr bool PERM = true; static constexpr size_t KVELEMS = (size_t)16 * 4096 * 128;
    bf16_t *Q, *KC, *VC, *KS, *VST, *KW, *VWT; float* GL; LAS const float* tab;
    __device__ __forceinline__ void operator()(const f32x4 (&acc)[2][2][4][2], const Unit& u, int wr, int wc, int fr, int fq) const {
        const int lr0 = wr * 64 + fr;
        const int pn = u.pn, d0 = wc * 32 + 8 * fq;
        float rsv[2][4];
#pragma unroll
        for (int ai = 0; ai < 2; ++ai)
#pragma unroll
            for (int m = 0; m < 4; ++m) rsv[ai][m] = tab[lr0 + ai * HALF + m * 16];
        const unsigned b4 = (unsigned)(u.pm >> 4) * 4u, s0 = (unsigned)(u.pm & 15) * 256u + (unsigned)lr0;
        const int k = (pn - 8) >> 1; const unsigned g0 = (unsigned)((pn - 8) & 1) * 2u;
        if (pn >= 8 && (k == 3 || k == 5)) {
            bf16_t* base = KC + (size_t)k * KVELEMS + (((b4 + g0) * 128u + (unsigned)d0) * 4096u + s0);
#pragma unroll
            for (int ai = 0; ai < 2; ++ai)
#pragma unroll
                for (int m = 0; m < 4; ++m) { const float rs = rsv[ai][m];
#pragma unroll
                    for (int bj = 0; bj < 2; ++bj) { const f32x4 v0 = acc[ai][bj][m][0] * rs, v1 = acc[ai][bj][m][1] * rs;
                        bf16_t* dst = base + (unsigned)(bj * 128 * 4096 + ai * HALF + m * 16);
#pragma unroll
                        for (int j = 0; j < 4; ++j) { dst[j * 4096] = (bf16_t)f2bf(v0[j]); dst[(4 + j) * 4096] = (bf16_t)f2bf(v1[j]); } } }
        } else {
            bf16_t* base; unsigned rowmul, bjstride;
            if (pn < 8) { base = Q + (size_t)u.pm * 256 * 2048 + pn * 256 + d0 + (unsigned)lr0 * 2048u; rowmul = 2048u; bjstride = 128u; }
            else { base = KC + (size_t)k * KVELEMS + d0 + ((b4 + g0) * 4096u + s0) * 128u; rowmul = 128u; bjstride = 4096u * 128u; }
#pragma unroll
            for (int ai = 0; ai < 2; ++ai)
#pragma unroll
                for (int m = 0; m < 4; ++m) { const unsigned ro = (unsigned)(ai * HALF + m * 16) * rowmul; const float rs = rsv[ai][m];
#pragma unroll
                    for (int bj = 0; bj < 2; ++bj) { const f32x4 v0 = acc[ai][bj][m][0] * rs, v1 = acc[ai][bj][m][1] * rs;
                        u32x4 w; w.x = pk2(v0[0], v0[1]); w.y = pk2(v0[2], v0[3]); w.z = pk2(v1[0], v1[1]); w.w = pk2(v1[2], v1[3]);
                        *(u32x4*)(base + ro + bj * bjstride) = w; } }
        }
    }
};
struct EpiGates {
    static constexpr bool PERM = true;
    float* GL; LAS const float* tab;
    __device__ __forceinline__ void operator()(const f32x4 (&acc)[2][2][4][2], const Unit& u, int wr, int wc, int fr, int fq) const {
        const int row0 = u.pm * BM + wr * 64 + fr; const int cl = wc * 32 + 8 * fq;
        float rsv[2][4];
#pragma unroll
        for (int ai = 0; ai < 2; ++ai)
#pragma unroll
            for (int m = 0; m < 4; ++m) rsv[ai][m] = tab[wr * 64 + fr + ai * HALF + m * 16];
        if (cl < 48) {
#pragma unroll
            for (int ai = 0; ai < 2; ++ai)
#pragma unroll
                for (int m = 0; m < 4; ++m) { const int row = row0 + ai * HALF + m * 16; const float rs = rsv[ai][m];
                    const f32x4 v0 = acc[ai][0][m][0] * rs, v1 = acc[ai][0][m][1] * rs; f32x4 a, c2;
#pragma unroll
                    for (int j = 0; j < 4; ++j) { a[j] = sigmoidf_(v0[j]); c2[j] = sigmoidf_(v1[j]); }
                    float* dst = GL + (size_t)row * 48 + cl; *(f32x4*)dst = a; *(f32x4*)(dst + 4) = c2; } }
    }
};
template <int TR> struct EpiCmp2 {
    static constexpr bool PERM = true;
    bf16_t* O;
    __device__ __forceinline__ void operator()(const f32x4 (&acc)[2][2][4][2], const Unit& u, int wr, int wc, int fr, int fq) const {
        const int row0 = u.pm * BM + wr * 64 + fr; const int cl = wc * 32 + 8 * fq;
#pragma unroll
        for (int ai = 0; ai < 2; ++ai)
#pragma unroll
            for (int m = 0; m < 4; ++m) { const int row = row0 + ai * HALF + m * 16; const f32x4 v0 = acc[ai][0][m][0], v1 = acc[ai][0][m][1];
                if (TR == 0) { u32x4 w; w.x = pk2(v0[0], v0[1]); w.y = pk2(v0[2], v0[3]); w.z = pk2(v1[0], v1[1]); w.w = pk2(v1[2], v1[3]);
                    *(u32x4*)(O + (size_t)row * 128 + cl) = w; }
                else { bf16_t* dst = O + ((size_t)((row >> 8) * 128 + cl)) * 256 + (row & 255);
#pragma unroll
                    for (int j = 0; j < 4; ++j) { dst[(size_t)j * 256] = (bf16_t)f2bf(v0[j]); dst[(size_t)(4 + j) * 256] = (bf16_t)f2bf(v1[j]); } } }
    }
};

constexpr size_t al256(size_t x) { return (x + 255) & ~(size_t)255; }
constexpr size_t SZ_WIN = (size_t)AB_IN * DM * 2, SZ_SQ = (size_t)DM * DM * 2, SZ_CIN = (size_t)C_INP * DM * 2, SZ_W1 = (size_t)512 * 4096 * 2, SZ_W2 = (size_t)256 * 512 * 2;
constexpr size_t SZ_UP = (size_t)DFF * DM * 2, SZ_WP = (size_t)DM * PLE * 2, SZ_WRI = (size_t)16 * 64 * 64 * 2, SZ_POOLT = (size_t)4 * 256 * 256 * 2, SZ_WU = (size_t)DM * 1024 * 2;
constexpr size_t WS_WIN = 0;
constexpr size_t WS_WOUT = WS_WIN + 2 * SZ_WIN;
constexpr size_t WS_CIN = WS_WOUT + 2 * SZ_SQ;
constexpr size_t WS_COUT = WS_CIN + 2 * SZ_CIN;
constexpr size_t WS_W1K = WS_COUT + 2 * SZ_SQ;
constexpr size_t WS_W1V = WS_W1K + 2 * SZ_W1;
constexpr size_t WS_W2K = WS_W1V + 2 * SZ_W1;
constexpr size_t WS_W2V = WS_W2K + 2 * SZ_W2;
constexpr size_t WS_WUP = WS_W2V + 2 * SZ_W2;
constexpr size_t WS_WDN = WS_WUP + 4 * SZ_UP;
constexpr size_t WS_WG = WS_WDN + 4 * SZ_UP;
constexpr size_t WS_WP = WS_WG + 4 * SZ_SQ;
constexpr size_t WS_WR = WS_WP + 4 * SZ_WP;
constexpr size_t WS_WI = WS_WR + 2 * SZ_WRI;
constexpr size_t WS_POOLT = WS_WI + 2 * SZ_WRI;
constexpr size_t WS_WU = WS_POOLT + 2 * SZ_POOLT;
constexpr size_t WS_PB = WS_WU + 2 * SZ_WU;
constexpr size_t WS_POSB = WS_PB + (size_t)4 * T_TOK * PLE * 2;
constexpr size_t WS_XN = WS_POSB + 8192;
constexpr size_t WS_YB = WS_XN + (size_t)T_TOK * DM * 2;
constexpr size_t WS_Z = WS_YB + (size_t)T_TOK * DM * 2;
constexpr size_t SZ_KV = (size_t)16 * 4096 * 128 * 2;
constexpr size_t Z_Q = 0, Z_KC = (size_t)T_TOK * DM * 2, Z_VC = Z_KC + SZ_KV, Z_KS = Z_VC + SZ_KV, Z_VST = Z_KS + SZ_KV, Z_KW = Z_VST + SZ_KV, Z_VWT = Z_KW + SZ_KV;
constexpr size_t Z_GL = Z_VWT + SZ_KV, Z_HIDK = Z_GL + (size_t)T_TOK * 48 * 4, Z_HIDV = Z_HIDK + (size_t)4096 * 512 * 2, Z_KCMP = Z_HIDV + (size_t)4096 * 512 * 2, Z_VCMPT = Z_KCMP + (size_t)4096 * 128 * 2;
constexpr size_t WS_BAR = WS_Z + (size_t)T_TOK * DFF * 2;
constexpr size_t WS_ROWSS = WS_BAR + XCD_BAR_WORDS * 4 + 256;
constexpr size_t WS_PP = WS_ROWSS + (size_t)13 * T_TOK * 32 * 4;
constexpr size_t WS_POSP = WS_PP + (size_t)T_TOK * DM * 2;
constexpr size_t WS_WGL = WS_POSP + (size_t)4 * 64 * 512 * 4;
constexpr size_t WS_H2 = WS_WGL + (size_t)2 * 256 * DM * 2;
constexpr size_t WS_END = WS_H2 + (size_t)T_TOK * DM * 2;
static_assert(Z_VCMPT + 4096 * 128 * 2 <= (size_t)T_TOK * DFF * 2, "z region");
static_assert(WS_END <= (size_t)1 << 30, "workspace");
constexpr int LDS_BYTES = 147456;

struct Args { const float* in[29]; float* out; unsigned char* ws; int lo, hi, one, pad; };

__device__ __forceinline__ void titem_load(float (&v)[64], const float* W, int N, int ldw, int item, int lane) {
    const int nblk = (N + 63) / 64, kb = item / nblk, nb = item % nblk, k0 = 64 * kb, n0 = 64 * nb;
    const int nn = n0 + lane; const bool ok = nn < N;
    const float* p = W + (size_t)k0 * ldw + nn;
#pragma unroll
    for (int i = 0; i < 64; ++i) v[i] = ok ? p[(size_t)i * ldw] : 0.f;
}
__device__ __forceinline__ void titem_store(const float (&v)[64], int N, bf16_t* WT, int ldt, LAS float* scr, int item, int lane, const float* gk) {
    const int nblk = (N + 63) / 64, kb = item / nblk, nb = item % nblk, k0 = 64 * kb, n0 = 64 * nb;
#pragma unroll
    for (int i = 0; i < 64; ++i) scr[i * 65 + lane] = v[i];
    asm volatile("s_waitcnt lgkmcnt(0)" ::: "memory");
    const int c = lane & 7;
    f32x4 g0 = (f32x4){1.f, 1.f, 1.f, 1.f}, g1 = g0; if (gk) { g0 = *(const f32x4*)(gk + k0 + 8 * c); g1 = *(const f32x4*)(gk + k0 + 8 * c + 4); }
#pragma unroll
    for (int j = 0; j < 8; ++j) { const int n = (lane >> 3) + 8 * j; const LAS float* s = scr + (8 * c) * 65 + n;
        u32x4 o; o.x = pk2(s[0 * 65] * g0[0], s[1 * 65] * g0[1]); o.y = pk2(s[2 * 65] * g0[2], s[3 * 65] * g0[3]); o.z = pk2(s[4 * 65] * g1[0], s[5 * 65] * g1[1]); o.w = pk2(s[6 * 65] * g1[2], s[7 * 65] * g1[3]);
        if (n0 + n < N) *(u32x4*)(WT + (size_t)(n0 + n) * ldt + k0 + 8 * c) = o; }
    asm volatile("s_waitcnt lgkmcnt(0)" ::: "memory");
}
__device__ __forceinline__ void conv_mat(const float* W, int K, int N, int ldw, bf16_t* WT, int ldt, LAS float* scr, int gw, int NGW, int lane, int& rot, const float* gk = nullptr) {
    const int nitems = (K / 64) * ((N + 63) / 64);
    int it = gw - rot; if (it < 0) it += NGW;
    rot = (rot + nitems) % NGW;
    if (it >= nitems) return;
    float va[64], vb[64];
    titem_load(va, W, N, ldw, it, lane);
    for (;;) {
        const int n1 = it + NGW; if (n1 < nitems) titem_load(vb, W, N, ldw, n1, lane);
        titem_store(va, N, WT, ldt, scr, it, lane, gk);
        if (n1 >= nitems) break;
        const int n2 = n1 + NGW; if (n2 < nitems) titem_load(va, W, N, ldw, n2, lane);
        titem_store(vb, N, WT, ldt, scr, n1, lane, gk);
        if (n2 >= nitems) break;
        it = n2;
    }
}
__device__ __forceinline__ void conv_plain(const float* src, int rows, int ncols, int lds_, bf16_t* dst, int ldd, int gt, int NGT, const float* gk = nullptr) {
    const unsigned cpr = (unsigned)ncols / 8u; const unsigned total = (unsigned)rows * cpr;
    for (unsigned i = (unsigned)gt; i < total; i += (unsigned)NGT) { const int r = (int)(i / cpr), c = (int)(i % cpr) * 8;
        f32x4 a = *(const f32x4*)(src + (size_t)r * lds_ + c), b = *(const f32x4*)(src + (size_t)r * lds_ + c + 4);
        if (gk) { const float gg = gk[r]; a = a * gg; b = b * gg; }
        u32x4 o; o.x = f2bf(a[0]) | (f2bf(a[1]) << 16); o.y = f2bf(a[2]) | (f2bf(a[3]) << 16); o.z = f2bf(b[0]) | (f2bf(b[1]) << 16); o.w = f2bf(b[2]) | (f2bf(b[3]) << 16);
        *(u32x4*)(dst + (size_t)r * ldd + c) = o; }
}
__device__ __forceinline__ void zero_fill16(unsigned char* p, size_t bytes, int gt, int NGT) {
    const u32x4 z = (u32x4){0u, 0u, 0u, 0u};
    for (size_t i = (size_t)gt * 16; i < bytes; i += (size_t)NGT * 16) *(u32x4*)(p + i) = z;
}

template <bool F32OUT>
__device__ __forceinline__ void rmsnorm_rows(const float* X, const float* g, bf16_t* O, float* OF, int bx, int NGW) {
    asm volatile("" ::: "memory"); const int tid = opaque_tid(), lane = tid & 63; const int gw = opq(bx) * 8 + __builtin_amdgcn_readfirstlane(tid >> 6);
    f32x4 gv[8];
#pragma unroll
    for (int j = 0; j < 8; ++j) gv[j] = *(const f32x4*)(g + (lane + 64 * j) * 4);
    for (int r = gw; r < T_TOK; r += NGW) {
        const bf16_t* xr = (const bf16_t*)X + (size_t)r * DM; f32x4 v[8]; float s = 0.f;
#pragma unroll
        for (int j = 0; j < 8; ++j) { const u32x2 w = *(const u32x2*)(xr + (lane + 64 * j) * 4); v[j] = (f32x4){bflo(w.x), bfhi(w.x), bflo(w.y), bfhi(w.y)}; s += (v[j][0] * v[j][0] + v[j][1] * v[j][1]) + (v[j][2] * v[j][2] + v[j][3] * v[j][3]); }
        const float rstd = rsqrtf(wave_sum(s, lane) * (1.f / DM) + EPSV);
#pragma unroll
        for (int j = 0; j < 8; ++j) { const f32x4 y = v[j] * rstd * gv[j];
            if (F32OUT) *(f32x4*)(OF + (size_t)r * DM + (lane + 64 * j) * 4) = y;
            else { u32x2 w; w.x = pk2(y[0], y[1]); w.y = pk2(y[2], y[3]); *(u32x2*)(O + (size_t)r * DM + (lane + 64 * j) * 4) = w; } }
    }
}

__device__ __forceinline__ void rows_to_bf16_ss(const float* X, bf16_t* O, float* rss, int bx, int NGW) {
    const int tid = opaque_tid(), lane = tid & 63; const int gw = opq(bx) * 8 + __builtin_amdgcn_readfirstlane(tid >> 6);
    for (int r = gw; r < T_TOK; r += NGW) {
        const float* xr = X + (size_t)r * DM; f32x4 v[8]; float s = 0.f;
#pragma unroll
        for (int j = 0; j < 8; ++j) { v[j] = *(const f32x4*)(xr + (lane + 64 * j) * 4); s += (v[j][0] * v[j][0] + v[j][1] * v[j][1]) + (v[j][2] * v[j][2] + v[j][3] * v[j][3]); }
        s = wave_sum(s, lane); if (lane < 32) rss[(size_t)r * 32 + lane] = (lane == 0) ? s : 0.f;
#pragma unroll
        for (int j = 0; j < 8; ++j) { u32x2 w; w.x = pk2(v[j][0], v[j][1]); w.y = pk2(v[j][2], v[j][3]); *(u32x2*)(O + (size_t)r * DM + (lane + 64 * j) * 4) = w; }
    }
}
__device__ __forceinline__ void lru_item(LAS unsigned char* lds, int item, const bf16_t* ZE, const float* conv_w, const float* conv_b,
                                         const bf16_t* WrT, const bf16_t* WiT, const float* b_r, const float* b_i, const float* lam, bf16_t* YB) {
    const int tid = opaque_tid(), w = __builtin_amdgcn_readfirstlane(tid >> 6), lane = tid & 63, fr = lane & 15, fq = lane >> 4;
    const int b = item >> 6, hh = (item >> 2) & 15, qq = item & 3;
    LAS unsigned char* XC = lds;
    LAS float* SEGA = (LAS float*)(lds + 36864);
    LAS float* SEGB = SEGA + 1024;
    LAS float* HIN = SEGB + 1024;
    const int co = tid & 7, tr = tid >> 3;
    float cw[4][8], cb[8];
#pragma unroll
    for (int k = 0; k < 4; ++k)
#pragma unroll
        for (int e = 0; e < 8; ++e) cw[k][e] = conv_w[k * 1024 + hh * 64 + co * 8 + e];
#pragma unroll
    for (int e = 0; e < 8; ++e) cb[e] = conv_b[hh * 64 + co * 8 + e];
    bf16x8 wrf[2], wif[2];
#pragma unroll
    for (int kk = 0; kk < 2; ++kk) { wrf[kk] = *(const bf16x8*)(WrT + ((size_t)hh * 64 + qq * 16 + fr) * 64 + kk * 32 + fq * 8); wif[kk] = *(const bf16x8*)(WiT + ((size_t)hh * 64 + qq * 16 + fr) * 64 + kk * 32 + fq * 8); }
    const int ch = hh * 64 + qq * 16 + fr;
    const float br = b_r[ch], bi = b_i[ch];
    const float lm = lam[ch]; float sp8; { const float e = __expf(-lm); const float ser = e * (1.f - e * (0.5f - e * (0.33333333f - e * 0.25f)));
        sp8 = 8.0f * ((-lm > 20.f) ? -lm : (e < 0.03f ? ser : __logf(1.0f + e))); }
    float carry = 0.f;
    const bf16_t* zb = ZE + (size_t)b * SEQ * AB_IN;
    u32x4 xr[7];
#pragma unroll
    for (int r = 0; r < 7; ++r) { const int t = tr * 4 - 3 + r; xr[r] = (t >= 0) ? *(const u32x4*)(zb + (size_t)t * AB_IN + hh * 64 + co * 8) : (u32x4){0u, 0u, 0u, 0u}; }
    for (int sc = 0; sc < 16; ++sc) {
        const int t0 = sc * 256;
        unsigned short gr[2][4];
#pragma unroll
        for (int ml = 0; ml < 2; ++ml)
#pragma unroll
            for (int r = 0; r < 4; ++r) gr[ml][r] = zb[(size_t)(t0 + (w * 2 + ml) * 16 + fq * 4 + r) * AB_IN + 1024 + ch];
        {
            float xin[7][8];
#pragma unroll
            for (int r = 0; r < 7; ++r) { const u32x4 v = xr[r];
                xin[r][0] = bflo(v.x); xin[r][1] = bfhi(v.x); xin[r][2] = bflo(v.y); xin[r][3] = bfhi(v.y); xin[r][4] = bflo(v.z); xin[r][5] = bfhi(v.z); xin[r][6] = bflo(v.w); xin[r][7] = bfhi(v.w); }
#pragma unroll
            for (int q = 0; q < 4; ++q) { float o[8];
#pragma unroll
                for (int e = 0; e < 8; ++e) o[e] = cb[e] + cw[0][e] * xin[q][e] + cw[1][e] * xin[q + 1][e] + cw[2][e] * xin[q + 2][e] + cw[3][e] * xin[q + 3][e];
                u32x4 wv; wv.x = pk2(o[0], o[1]); wv.y = pk2(o[2], o[3]); wv.z = pk2(o[4], o[5]); wv.w = pk2(o[6], o[7]);
                *(LAS u32x4*)(XC + (tr * 4 + q) * 144 + co * 16) = wv; }
            if (sc < 15) {
#pragma unroll
                for (int r = 0; r < 7; ++r) xr[r] = *(const u32x4*)(zb + (size_t)(t0 + 256 + tr * 4 - 3 + r) * AB_IN + hh * 64 + co * 8); }
        }
        __syncthreads();
        float av[2][4], bv[2][4];
#pragma unroll
        for (int ml = 0; ml < 2; ++ml) { const int mt = w * 2 + ml;
            f32x4 ar = (f32x4){0.f, 0.f, 0.f, 0.f}, ai = ar;
#pragma unroll
            for (int kk = 0; kk < 2; ++kk) { const bf16x8 xa = *(const LAS bf16x8*)(XC + (mt * 16 + fr) * 144 + kk * 64 + fq * 16);
                ar = __builtin_amdgcn_mfma_f32_16x16x32_bf16(xa, wrf[kk], ar, 0, 0, 0); ai = __builtin_amdgcn_mfma_f32_16x16x32_bf16(xa, wif[kk], ai, 0, 0, 0); }
            float A = 1.f, Bc = 0.f;
#pragma unroll
            for (int r = 0; r < 4; ++r) { const int tok = mt * 16 + fq * 4 + r;
                const float xcv = bf2f(*(const LAS unsigned short*)(XC + tok * 144 + (qq * 16 + fr) * 2));
                const float rg = sigmoidf_(ar[r] + br), ig = sigmoidf_(ai[r] + bi);
                const float la = -rg * sp8; const float a = __expf(la); const float x2 = 2.f * la; const float em = (x2 > -0.3f) ? -x2 * (1.f + x2 * 0.5f * (1.f + x2 * 0.33333333f * (1.f + x2 * 0.25f * (1.f + x2 * 0.2f * (1.f + x2 * 0.16666667f))))) : 1.f - __expf(x2);
                const float mult = __builtin_amdgcn_sqrtf(fmaxf(em, 0.f));
                av[ml][r] = a; bv[ml][r] = mult * ig * xcv;
                Bc = a * Bc + bv[ml][r]; A = A * a; }
            const int sg = mt * 4 + fq; SEGA[sg * 16 + fr] = A; SEGB[sg * 16 + fr] = Bc; }
        __syncthreads();
        if (w == 0 && lane < 16) { float h = carry;
#pragma unroll 8
            for (int sg = 0; sg < 64; ++sg) { HIN[sg * 16 + lane] = h; h = SEGA[sg * 16 + lane] * h + SEGB[sg * 16 + lane]; }
            carry = h; }
        __syncthreads();
#pragma unroll
        for (int ml = 0; ml < 2; ++ml) { const int mt = w * 2 + ml; float h = HIN[(mt * 4 + fq) * 16 + fr];
#pragma unroll
            for (int r = 0; r < 4; ++r) { const int t = t0 + mt * 16 + fq * 4 + r; h = av[ml][r] * h + bv[ml][r];
                const float gt = bf2f(gr[ml][r]);
                YB[((size_t)b * SEQ + t) * DM + ch] = (bf16_t)f2bf(h * gelu_tanh(gt)); } }
    }
    __syncthreads();
}
__device__ __forceinline__ void pool_item(int item, const bf16_t* ZE, const float* scale, bf16_t* YB) {
    const int tid = opaque_tid(), b = item >> 6, tch = item & 63, co = tid & 127, seg = tid >> 7;
    const int win = 2 << (co >> 5);
    float sc[8];
#pragma unroll
    for (int e = 0; e < 8; ++e) sc[e] = scale[co * 8 + e];
    const bf16_t* zb = ZE + (size_t)b * SEQ * AB_IN + 2048 + co * 8;
    const int ts = tch * 64 + seg * 16;
    float sum[8];
#pragma unroll
    for (int e = 0; e < 8; ++e) sum[e] = 0.f;
    for (int s = ts - win + 1; s < ts; ++s) if (s >= 0) { const u32x4 v = *(const u32x4*)(zb + (size_t)s * AB_IN);
        sum[0] += bflo(v.x); sum[1] += bfhi(v.x); sum[2] += bflo(v.y); sum[3] += bfhi(v.y); sum[4] += bflo(v.z); sum[5] += bfhi(v.z); sum[6] += bflo(v.w); sum[7] += bfhi(v.w); }
    for (int t = ts; t < ts + 16; ++t) {
        const u32x4 v = *(const u32x4*)(zb + (size_t)t * AB_IN);
        float x[8] = {bflo(v.x), bfhi(v.x), bflo(v.y), bfhi(v.y), bflo(v.z), bfhi(v.z), bflo(v.w), bfhi(v.w)};
        const float inv = __builtin_amdgcn_rcpf((float)((t + 1) < win ? (t + 1) : win));
        float o[8];
#pragma unroll
        for (int e = 0; e < 8; ++e) { sum[e] += x[e]; o[e] = (sum[e] * inv - x[e]) * sc[e]; }
        u32x4 wv; wv.x = pk2(o[0], o[1]); wv.y = pk2(o[2], o[3]); wv.z = pk2(o[4], o[5]); wv.w = pk2(o[6], o[7]);
        *(u32x4*)(YB + ((size_t)b * SEQ + t) * DM + 1024 + co * 8) = wv;
        const int so = t - win + 1;
        if (so >= 0) { const u32x4 q = *(const u32x4*)(zb + (size_t)so * AB_IN);
            sum[0] -= bflo(q.x); sum[1] -= bfhi(q.x); sum[2] -= bflo(q.y); sum[3] -= bfhi(q.y); sum[4] -= bflo(q.z); sum[5] -= bfhi(q.z); sum[6] -= bflo(q.w); sum[7] -= bfhi(q.w); }
    }
}

constexpr int KT_PITCH = 272, VT_PITCH = 144;
constexpr int AL_KT = 0, AL_VT = 64 * KT_PITCH, AL_BUF = 36864  , AL_IMPA = 2 * 36864, AL_IMPB = AL_IMPA + 64 * 65 * 4, AL_SEL = AL_IMPB + 64 * 65 * 4, AL_UNI = AL_SEL + 512, AL_Q = 73728, Q_WAVE = 32 * KT_PITCH;
constexpr float QSCALE2 = 0.08838834764831845f * LOG2E;
constexpr float NEGB = -1e30f;

struct StageRegs { u32x4 k[2], v[2]; };
__device__ __forceinline__ void stage_load(StageRegs& R, const bf16_t* kbase, const bf16_t* vbase, int vpitch, int tid) {
    const int kr = tid >> 3, kc = tid & 7, vr = tid >> 2, vc = tid & 3;
    R.k[0] = *(const u32x4*)(kbase + kr * 128 + kc * 8); R.k[1] = *(const u32x4*)(kbase + kr * 128 + 64 + kc * 8);
    R.v[0] = *(const u32x4*)(vbase + (size_t)vr * vpitch + vc * 8); R.v[1] = *(const u32x4*)(vbase + (size_t)vr * vpitch + 32 + vc * 8);
}
__device__ __forceinline__ void stage_store(const StageRegs& R, LAS unsigned char* lds, int tid) {
    const int kr = tid >> 3, kc = tid & 7, vr = tid >> 2, vc = tid & 3;
    *(LAS u32x4*)(lds + AL_KT + kr * KT_PITCH + kc * 16) = R.k[0]; *(LAS u32x4*)(lds + AL_KT + kr * KT_PITCH + 128 + kc * 16) = R.k[1];
    *(LAS u32x4*)(lds + AL_VT + vr * VT_PITCH + vc * 16) = R.v[0]; *(LAS u32x4*)(lds + AL_VT + vr * VT_PITCH + 64 + vc * 16) = R.v[1];
}
template <int MODE>
__device__ __forceinline__ void attn_tile(bool MASK, LAS unsigned char* lds, LAS unsigned char* ldsi, const bf16x8 (&qf)[2][4], f32x4 (&O)[2][8], float (&m)[2], float (&l)[2], const int (&tpos)[2], float slope2,
                                          int kp0, const bool (&selbit)[2], int fr, int fq, int wv, int tile64, int lane) {
    constexpr int KS = (MODE <= 1) ? 16 : 1;
    f32x4 s[2][4];
#pragma unroll
    for (int ci = 0; ci < 2; ++ci)
#pragma unroll
        for (int k4 = 0; k4 < 4; ++k4) s[ci][k4] = (f32x4){0.f, 0.f, 0.f, 0.f};
    {
        const LAS unsigned char* kb = lds + AL_KT + fr * KT_PITCH + fq * 16;
#define KFRAG(i) (*(const LAS bf16x8*)(kb + ((i) & 3) * 16 * KT_PITCH + ((i) >> 2) * 64))
        bf16x8 kr[4]; kr[0] = KFRAG(0); kr[1] = KFRAG(1); kr[2] = KFRAG(2);
#pragma unroll
        for (int i = 0; i < 16; ++i) {
            if (i + 3 < 16) kr[(i + 3) & 3] = KFRAG(i + 3);
            __builtin_amdgcn_sched_barrier(0);
            s[0][i & 3] = __builtin_amdgcn_mfma_f32_16x16x32_bf16(kr[i & 3], qf[0][i >> 2], s[0][i & 3], 0, 0, 0);
            s[1][i & 3] = __builtin_amdgcn_mfma_f32_16x16x32_bf16(kr[i & 3], qf[1][i >> 2], s[1][i & 3], 0, 0, 0);
            __builtin_amdgcn_sched_barrier(0);
        }
#undef KFRAG
    }
    const float sk = slope2 * (float)KS;
    float alpha[2] = {1.f, 1.f};
#pragma unroll
    for (int ci = 0; ci < 2; ++ci) {
        const int base = tpos[ci] - kp0 - KS * (fq * 4);
        const float bb = -slope2 * (float)base;
        float mx = NEGB;
#pragma unroll
        for (int k4 = 0; k4 < 4; ++k4)
#pragma unroll
            for (int j = 0; j < 4; ++j) {
                s[ci][k4][j] = __builtin_fmaf(s[ci][k4][j], QSCALE2, __builtin_fmaf(sk, (float)(k4 * 16 + j), bb)); }
        if (MASK) {
#pragma unroll
            for (int k4 = 0; k4 < 4; ++k4)
#pragma unroll
                for (int j = 0; j < 4; ++j) { const int c = KS * (k4 * 16 + j); bool ok = c <= base; if (MODE == 3) ok = ok && (base - c < 512); s[ci][k4][j] = ok ? s[ci][k4][j] : 2.0f * NEGB; } }
#pragma unroll
        for (int k4 = 0; k4 < 4; ++k4)
#pragma unroll
            for (int j = 0; j < 4; ++j) mx = fmaxf(mx, s[ci][k4][j]);
        if (MODE == 2) mx = selbit[ci] ? mx : NEGB;
        if (MODE != 1) {
            mx = fmaxf(mx, shx(mx, lane, 16)); mx = fmaxf(mx, shx(mx, lane, 32));
            const float mn = fmaxf(m[ci], mx); alpha[ci] = __builtin_amdgcn_exp2f(m[ci] - mn); m[ci] = mn;
            float ps = 0.f;
#pragma unroll
            for (int k4 = 0; k4 < 4; ++k4)
#pragma unroll
                for (int j = 0; j < 4; ++j) { const float p = __builtin_amdgcn_exp2f(s[ci][k4][j] - mn); s[ci][k4][j] = p; ps += p; }
            if (MODE == 2) ps = selbit[ci] ? ps : 0.f;
            l[ci] = l[ci] * alpha[ci] + ps;
        } else {
#pragma unroll
            for (int k4 = 0; k4 < 4; ++k4) {
#pragma unroll
                for (int j = 0; j < 4; ++j) s[ci][k4][j] = __builtin_amdgcn_exp2f(s[ci][k4][j] - m[ci]) * l[ci];
                float a = (s[ci][k4][0] + s[ci][k4][1]) + (s[ci][k4][2] + s[ci][k4][3]); float b3 = s[ci][k4][3];
                a += shx(a, lane, 1); a += shx(a, lane, 2); b3 += shx(b3, lane, 1); b3 += shx(b3, lane, 2);
                if ((fr & 3) == 0) { const int tl = wv * 8 + ci * 4 + (fr >> 2); const int ms = tile64 * 16 + k4 * 4 + fq;
                    ((LAS float*)(ldsi + AL_IMPA))[tl * 65 + ms] = a; ((LAS float*)(ldsi + AL_IMPB))[tl * 65 + ms + 1] = b3; } }
        }
    }
    if (MODE >= 2) {
        if (__builtin_amdgcn_ballot_w64(alpha[0] != 1.f || alpha[1] != 1.f) != 0ull) {
#pragma unroll
            for (int ci = 0; ci < 2; ++ci)
#pragma unroll
                for (int dt = 0; dt < 8; ++dt) O[ci][dt] = O[ci][dt] * alpha[ci]; }
    }
    if (MODE != 0) {
        bf16x8 pf[2][2];
#pragma unroll
        for (int ks = 0; ks < 2; ++ks)
#pragma unroll
            for (int ci = 0; ci < 2; ++ci) { u32x4 w; w.x = pk2(s[ci][2 * ks][0], s[ci][2 * ks][1]); w.y = pk2(s[ci][2 * ks][2], s[ci][2 * ks][3]); w.z = pk2(s[ci][2 * ks + 1][0], s[ci][2 * ks + 1][1]); w.w = pk2(s[ci][2 * ks + 1][2], s[ci][2 * ks + 1][3]);
                if (MODE == 2) { w.x = selbit[ci] ? w.x : 0u; w.y = selbit[ci] ? w.y : 0u; w.z = selbit[ci] ? w.z : 0u; w.w = selbit[ci] ? w.w : 0u; }
                pf[ks][ci] = __builtin_bit_cast(bf16x8, w); }
        const LAS unsigned char* vb = lds + AL_VT + fr * VT_PITCH + fq * 8;
#define VLO(i) (*(const LAS u32x2*)(vb + ((i) & 7) * 16 * VT_PITCH + ((i) >> 3) * 64))
#define VHI(i) (*(const LAS u32x2*)(vb + ((i) & 7) * 16 * VT_PITCH + ((i) >> 3) * 64 + 32))
        u32x2 vl[4], vh[4]; vl[0] = VLO(0); vh[0] = VHI(0); vl[1] = VLO(1); vh[1] = VHI(1); vl[2] = VLO(2); vh[2] = VHI(2);
#pragma unroll
        for (int i = 0; i < 16; ++i) {
            if (i + 3 < 16) { vl[(i + 3) & 3] = VLO(i + 3); vh[(i + 3) & 3] = VHI(i + 3); }
            __builtin_amdgcn_sched_barrier(0);
            const bf16x8 vf = __builtin_bit_cast(bf16x8, (u32x4){vl[i & 3].x, vl[i & 3].y, vh[i & 3].x, vh[i & 3].y});
            O[0][i & 7] = __builtin_amdgcn_mfma_f32_16x16x32_bf16(vf, pf[i >> 3][0], O[0][i & 7], 0, 0, 0);
            O[1][i & 7] = __builtin_amdgcn_mfma_f32_16x16x32_bf16(vf, pf[i >> 3][1], O[1][i & 7], 0, 0, 0);
            __builtin_amdgcn_sched_barrier(0);
        }
#undef VLO
#undef VHI
    }
}

__device__ __forceinline__ void nsa_item(LAS unsigned char* lds, int b, int g, int tq, const bf16_t* Q, const bf16_t* KS, const bf16_t* VST, const bf16_t* KW, const bf16_t* VWT,
                                         const bf16_t* KCMP, const bf16_t* VCMPT, const float* GL, bf16_t* YB) {
    const int tid = opaque_tid(), wv = __builtin_amdgcn_readfirstlane(tid >> 6), lane = tid & 63, fr = lane & 15, fq = lane >> 4;
    const int t0 = tq * 64, bg = b * 4 + g, head = g * 4 + (fr & 3);
    LAS float* IMPA = (LAS float*)(lds + AL_IMPA);
    LAS unsigned long long* SEL = (LAS unsigned long long*)(lds + AL_SEL);
    LAS unsigned long long* UNI = (LAS unsigned long long*)(lds + AL_UNI);
    __syncthreads();
    for (int i = tid; i < 2 * 64 * 65; i += 512) IMPA[i] = 0.f;
    int tpos[2]; bf16x8 qf[2][4]; int tc = 0;
#pragma unroll
    for (int ci = 0; ci < 2; ++ci) { tpos[ci] = t0 + wv * 8 + ci * 4 + (fr >> 2);
        const bf16_t* qp = Q + ((size_t)(b * SEQ + tpos[ci])) * DM + head * 128 + fq * 8;
#pragma unroll
        for (int kk = 0; kk < 4; ++kk) qf[ci][kk] = *(const bf16x8*)(qp + kk * 32);
    }
    const float slope2 = exp2f(-0.5f * (float)(head + 1)) * LOG2E;
    f32x4 O[2][8]; float m[2], l[2]; bool selbit[2] = {true, true};
#pragma unroll
    for (int ci = 0; ci < 2; ++ci)
#pragma unroll
        for (int dt = 0; dt < 8; ++dt) { O[ci][dt] = (f32x4){0.f, 0.f, 0.f, 0.f}; }
    StageRegs R;
    const int ncmp = ((t0 + 32) >> 4) + 1, nct = (ncmp + 63) >> 6;
    const bf16_t* kcb = KCMP + (size_t)bg * 256 * 128; const bf16_t* vcb = VCMPT + (size_t)bg * 128 * 256;
    m[0] = m[1] = NEGB; l[0] = l[1] = 0.f;
    stage_load(R, kcb, vcb, 256, tid);
    for (int ct = 0; ct < nct; ++ct) {
        LAS unsigned char* kvb = lds + (tc & 1) * AL_BUF; ++tc; stage_store(R, kvb, tid); __syncthreads();
        if (ct + 1 < nct) stage_load(R, kcb + (size_t)(ct + 1) * 64 * 128, vcb + (ct + 1) * 64, 256, tid);
        attn_tile<0>(1024 * ct + 1039 > t0, kvb, lds, qf, O, m, l, tpos, slope2, 16 * (ct * 64) + 31, selbit, fr, fq, wv, ct, lane);
    }
#pragma unroll
    for (int ci = 0; ci < 2; ++ci) { float lt = l[ci]; lt += shx(lt, lane, 16); lt += shx(lt, lane, 32); l[ci] = lt > 0.f ? 1.0f / lt : 0.f; }
    stage_load(R, kcb, vcb, 256, tid);
    for (int ct = 0; ct < nct; ++ct) {
        LAS unsigned char* kvb = lds + (tc & 1) * AL_BUF; ++tc; stage_store(R, kvb, tid); __syncthreads();
        if (ct + 1 < nct) stage_load(R, kcb + (size_t)(ct + 1) * 64 * 128, vcb + (ct + 1) * 64, 256, tid);
        attn_tile<1>(1024 * ct + 1039 > t0, kvb, lds, qf, O, m, l, tpos, slope2, 16 * (ct * 64) + 31, selbit, fr, fq, wv, ct, lane);
    }
#pragma unroll
    for (int ci = 0; ci < 2; ++ci) { const float gc = GL[((size_t)(b * SEQ + tpos[ci])) * 48 + head];
        bf16_t* op = YB + ((size_t)(b * SEQ + tpos[ci])) * DM + head * 128 + fq * 4;
#pragma unroll
        for (int dt = 0; dt < 8; ++dt) { const f32x4 o = O[ci][dt] * gc; u32x2 w; w.x = pk2(o[0], o[1]); w.y = pk2(o[2], o[3]); *(u32x2*)(op + dt * 16) = w; O[ci][dt] = (f32x4){0.f, 0.f, 0.f, 0.f}; } }
    __syncthreads();
    {
        const int cur = tq; unsigned long long wun = 0ull;
#pragma unroll 1
        for (int tk = 0; tk < 8; ++tk) { const int tl = wv * 8 + tk;
            float v = IMPA[tl * 65 + lane] + IMPA[64 * 65 + tl * 65 + lane];
            if (lane == 0 || lane == cur || lane == cur - 1) v += 1e6f;
            if (lane > cur) v = NEGB;
            int rank = 0; const int vi = __builtin_bit_cast(int, v);
#pragma unroll
            for (int mm = 0; mm < 64; ++mm) { const float vm = __builtin_bit_cast(float, __builtin_amdgcn_readlane(vi, mm)); rank += ((vm > v) || (vm == v && mm < lane)) ? 1 : 0; }
            const unsigned long long mk = __ballot(rank < 16 && lane <= cur);
            wun |= mk;
            if (lane == 0) SEL[tl] = mk; }
        if (lane == 0) UNI[wv] = wun;
    }
    __syncthreads();
    unsigned long long selm[2], wun, bun = 0ull;
#pragma unroll
    for (int ci = 0; ci < 2; ++ci) selm[ci] = SEL[wv * 8 + ci * 4 + (fr >> 2)];
    wun = UNI[wv];
#pragma unroll
    for (int i = 0; i < 8; ++i) bun |= UNI[i];
    { const unsigned lo = __builtin_amdgcn_readfirstlane((unsigned)bun), hi = __builtin_amdgcn_readfirstlane((unsigned)(bun >> 32)); bun = ((unsigned long long)hi << 32) | lo;
      const unsigned lo2 = __builtin_amdgcn_readfirstlane((unsigned)wun), hi2 = __builtin_amdgcn_readfirstlane((unsigned)(wun >> 32)); wun = ((unsigned long long)hi2 << 32) | lo2; }
    const bf16_t* ksb = KS + (size_t)bg * SEQ * 128; const bf16_t* vsb = VST + (size_t)bg * 128 * SEQ;
    m[0] = m[1] = NEGB; l[0] = l[1] = 0.f;
    {
        unsigned long long rem = bun; int j = 63 - __builtin_clzll(rem); rem &= ~(1ull << j);
        stage_load(R, ksb + (size_t)j * 64 * 128, vsb + j * 64, SEQ, tid);
        for (;;) {
            LAS unsigned char* kvb = lds + (tc & 1) * AL_BUF; ++tc; stage_store(R, kvb, tid); __syncthreads();
            const int jn = rem ? 63 - __builtin_clzll(rem) : -1; if (jn >= 0) { rem &= ~(1ull << jn); stage_load(R, ksb + (size_t)jn * 64 * 128, vsb + jn * 64, SEQ, tid); }
            if ((wun >> j) & 1ull) { selbit[0] = (selm[0] >> j) & 1ull; selbit[1] = (selm[1] >> j) & 1ull;
                attn_tile<2>(j == tq, kvb, lds, qf, O, m, l, tpos, slope2, j * 64, selbit, fr, fq, wv, 0, lane); }
            if (jn < 0) break; j = jn;
        }
    }
#pragma unroll
    for (int ci = 0; ci < 2; ++ci) { float lt = l[ci]; lt += shx(lt, lane, 16); lt += shx(lt, lane, 32); const float gs = GL[((size_t)(b * SEQ + tpos[ci])) * 48 + 16 + head]; const float sc = lt > 0.f ? gs / lt : 0.f;
        bf16_t* op = YB + ((size_t)(b * SEQ + tpos[ci])) * DM + head * 128 + fq * 4;
#pragma unroll
        for (int dt = 0; dt < 8; ++dt) { const f32x4 o = O[ci][dt] * sc; const u32x2 pv = *(const u32x2*)(op + dt * 16); u32x2 w; w.x = pk2(bflo(pv.x) + o[0], bfhi(pv.x) + o[1]); w.y = pk2(bflo(pv.y) + o[2], bfhi(pv.y) + o[3]); *(u32x2*)(op + dt * 16) = w; O[ci][dt] = (f32x4){0.f, 0.f, 0.f, 0.f}; } }
    const bf16_t* kwb = KW + (size_t)bg * SEQ * 128; const bf16_t* vwb = VWT + (size_t)bg * 128 * SEQ;
    m[0] = m[1] = NEGB; l[0] = l[1] = 0.f; selbit[0] = selbit[1] = true;
    {
        const int j0 = tq >= 8 ? tq - 8 : 0;
        stage_load(R, kwb + (size_t)tq * 64 * 128, vwb + tq * 64, SEQ, tid);
        for (int j = tq; j >= j0; --j) {
            LAS unsigned char* kvb = lds + (tc & 1) * AL_BUF; ++tc; stage_store(R, kvb, tid); __syncthreads();
            if (j > j0) stage_load(R, kwb + (size_t)(j - 1) * 64 * 128, vwb + (j - 1) * 64, SEQ, tid);
            attn_tile<3>(j == tq || j == tq - 8, kvb, lds, qf, O, m, l, tpos, slope2, j * 64, selbit, fr, fq, wv, 0, lane);
        }
    }
#pragma unroll
    for (int ci = 0; ci < 2; ++ci) { float lt = l[ci]; lt += shx(lt, lane, 16); lt += shx(lt, lane, 32); const float gwv = GL[((size_t)(b * SEQ + tpos[ci])) * 48 + 32 + head]; const float sc = lt > 0.f ? gwv / lt : 0.f;
        bf16_t* op = YB + ((size_t)(b * SEQ + tpos[ci])) * DM + head * 128 + fq * 4;
#pragma unroll
        for (int dt = 0; dt < 8; ++dt) { const f32x4 o = O[ci][dt] * sc; const u32x2 pv = *(const u32x2*)(op + dt * 16); u32x2 w; w.x = pk2(bflo(pv.x) + o[0], bfhi(pv.x) + o[1]); w.y = pk2(bflo(pv.y) + o[2], bfhi(pv.y) + o[3]); *(u32x2*)(op + dt * 16) = w; } }
}

__global__ void __launch_bounds__(512) fwd_kernel(Args a) {
    extern __shared__ __attribute__((aligned(16))) unsigned char lds_raw[];
    LAS unsigned char* lds = (LAS unsigned char*)lds_raw;
    const int G = gridDim.x, bx = blockIdx.x;
    const int NGW = G * 8, NGT = G * 512;
#define GW() (opq(bx) * 8 + __builtin_amdgcn_readfirstlane(opaque_tid() >> 6))
    unsigned char* ws = a.ws;
    int ph = 0;
    { volatile LAS unsigned* MISC = (volatile LAS unsigned*)(lds + LDS_BYTES - 64); if (threadIdx.x < 16) MISC[threadIdx.x] = 0u; }
    __syncthreads();
    (void)xcd_barrier_post((unsigned*)(ws + WS_BAR), (volatile LAS unsigned*)(lds + LDS_BYTES - 64));
#ifndef ONLY
#define ONLY -1
#endif
#define EN(id) (ONLY < 0 || ONLY == (id))
#define ON() (ph >= a.lo && ph < a.hi)
#define SEAM() do { ++ph; if (a.one) { if (ph == 1) cg::this_grid().sync(); else { XcdBarrier bar; bar.bar = (unsigned*)(opqp(ws) + WS_BAR); bar.x = xb_xcc_id(); bar.st = (volatile LAS unsigned*)(lds + LDS_BYTES - 64); xcd_barrier(bar); } } } while (0)

    bf16_t* XN = (bf16_t*)(ws + WS_XN); bf16_t* YB = (bf16_t*)(ws + WS_YB); unsigned char* Z = ws + WS_Z;
    float* posb = (float*)(ws + WS_POSB);

    if (EN(0) && ON())
#pragma unroll 1
    for (int rp0 = 0; rp0 < REP_P0; ++rp0) {
        const int tid = opaque_tid(), lane = tid & 63, wave = __builtin_amdgcn_readfirstlane(tid >> 6), gw = bx * 8 + wave, gt = bx * 512 + tid;
        LAS float* scr = (LAS float*)(lds + wave * 16640);
        int rot = 0;
        for (int i = 0; i < 4; ++i) {
            conv_mat(a.in[23] + (size_t)i * DM * DFF, DM, DFF, DFF, (bf16_t*)(ws + WS_WUP + i * SZ_UP), DM, scr, gw, NGW, lane, rot, a.in[22] + i * DM);
            conv_mat(a.in[24] + (size_t)i * DFF * DM, DFF, DM, DM, (bf16_t*)(ws + WS_WDN + i * SZ_UP), DFF, scr, gw, NGW, lane, rot);
            conv_mat(a.in[26] + (size_t)i * DM * DM, DM, DM, DM, (bf16_t*)(ws + WS_WG + i * SZ_SQ), DM, scr, gw, NGW, lane, rot, a.in[25] + i * DM);
            conv_mat(a.in[27] + (size_t)i * PLE * DM, PLE, DM, DM, (bf16_t*)(ws + WS_WP + i * SZ_WP), PLE, scr, gw, NGW, lane, rot);
        }
        for (int j = 0; j < 2; ++j) {
            conv_mat(a.in[3] + (size_t)j * DM * AB_IN, DM, 2048, AB_IN, (bf16_t*)(ws + WS_WIN + j * SZ_WIN), DM, scr, gw, NGW, lane, rot, a.in[2] + (2 * j) * DM);
            conv_mat(a.in[13] + (size_t)j * DM * DM, DM, DM, DM, (bf16_t*)(ws + WS_WOUT + j * SZ_SQ), DM, scr, gw, NGW, lane, rot);
            conv_mat(a.in[14] + (size_t)j * DM * C_IN, DM, C_INP, C_IN, (bf16_t*)(ws + WS_CIN + j * SZ_CIN), DM, scr, gw, NGW, lane, rot, a.in[2] + (2 * j + 1) * DM);
            conv_mat(a.in[14] + (size_t)j * DM * C_IN + C_INP, DM, 48, C_IN, (bf16_t*)(ws + WS_WGL + (size_t)j * 256 * DM * 2), DM, scr, gw, NGW, lane, rot, a.in[2] + (2 * j + 1) * DM);
            conv_mat(a.in[21] + (size_t)j * DM * DM, DM, DM, DM, (bf16_t*)(ws + WS_COUT + j * SZ_SQ), DM, scr, gw, NGW, lane, rot);
            conv_mat(a.in[16] + (size_t)j * 4096 * 512, 4096, 512, 512, (bf16_t*)(ws + WS_W1K + j * SZ_W1), 4096, scr, gw, NGW, lane, rot);
            conv_mat(a.in[19] + (size_t)j * 4096 * 512, 4096, 512, 512, (bf16_t*)(ws + WS_W1V + j * SZ_W1), 4096, scr, gw, NGW, lane, rot);
            conv_mat(a.in[17] + (size_t)j * 512 * 128, 512, 128, 128, (bf16_t*)(ws + WS_W2K + j * SZ_W2), 512, scr, gw, NGW, lane, rot);
            conv_mat(a.in[20] + (size_t)j * 512 * 128, 512, 128, 128, (bf16_t*)(ws + WS_W2V + j * SZ_W2), 512, scr, gw, NGW, lane, rot);
            for (int h = 0; h < 16; ++h) {
                conv_mat(a.in[6] + ((size_t)j * 16 + h) * 4096, 64, 64, 64, (bf16_t*)(ws + WS_WR + j * SZ_WRI) + h * 4096, 64, scr, gw, NGW, lane, rot);
                conv_mat(a.in[8] + ((size_t)j * 16 + h) * 4096, 64, 64, 64, (bf16_t*)(ws + WS_WI + j * SZ_WRI) + h * 4096, 64, scr, gw, NGW, lane, rot);
            }
            for (int gI = 0; gI < 4; ++gI)
                conv_mat(a.in[11] + ((size_t)j * 4 + gI) * 65536, 256, 256, 256, (bf16_t*)(ws + WS_POOLT + j * SZ_POOLT) + gI * 65536, 256, scr, gw, NGW, lane, rot);
            conv_plain(a.in[3] + (size_t)j * DM * AB_IN + 2048, DM, 1024, AB_IN, (bf16_t*)(ws + WS_WU + j * SZ_WU), 1024, gt, NGT, a.in[2] + (2 * j) * DM);
            zero_fill16(ws + WS_WGL + (size_t)j * 256 * DM * 2 + (size_t)48 * DM * 2, (size_t)208 * DM * 2, gt, NGT);
            zero_fill16(ws + WS_W2K + j * SZ_W2 + (size_t)128 * 512 * 2, (size_t)128 * 512 * 2, gt, NGT);
            zero_fill16(ws + WS_W2V + j * SZ_W2 + (size_t)128 * 512 * 2, (size_t)128 * 512 * 2, gt, NGT);
        }
        conv_plain(a.in[1], 4 * T_TOK, PLE, PLE, (bf16_t*)(ws + WS_PB), PLE, gt, NGT);
        rows_to_bf16_ss(a.in[0], XN, (float*)(ws + WS_ROWSS), bx, NGW);
        for (int it = gw; it < 4 * 8 * 64; it += NGW) { const int q = it >> 9, fc = (it >> 6) & 7, kc = it & 63, j = q >> 1;
            const float* pos = a.in[(q & 1) ? 18 : 15] + (size_t)j * 4096 + kc * 64; const float* w1 = a.in[(q & 1) ? 19 : 16] + (size_t)j * 4096 * 512 + (size_t)kc * 64 * 512 + fc * 64 + lane;
            float acc0 = 0.f, acc1 = 0.f, acc2 = 0.f, acc3 = 0.f;
#pragma unroll 4
            for (int k = 0; k < 64; k += 4) { acc0 += pos[k] * w1[(size_t)k * 512]; acc1 += pos[k + 1] * w1[(size_t)(k + 1) * 512]; acc2 += pos[k + 2] * w1[(size_t)(k + 2) * 512]; acc3 += pos[k + 3] * w1[(size_t)(k + 3) * 512]; }
            ((float*)(ws + WS_POSP))[((size_t)q * 64 + kc) * 512 + fc * 64 + lane] = (acc0 + acc1) + (acc2 + acc3); }
    }
    SEAM();
    if (EN(1) && ON()) {
        if (bx < 64) { const int j = bx >> 5, gI = (bx >> 3) & 3, pn = bx & 7;
            pg8::Gemm gm{(const bf16_t*)(ws + WS_POOLT + j * SZ_POOLT) + gI * 65536, (const bf16_t*)(ws + WS_WU + j * SZ_WU) + gI * 256, 256, 2048, 256, 256, 1024};
            pg8::StaticOrder S; S.init(256, 2048, G, pn);
            EpiBf16<0> E{(bf16_t*)(ws + WS_WIN + j * SZ_WIN) + (size_t)(2048 + gI * 256) * DM, DM, nullptr, nullptr};
            pg8::gemm_phase(lds, gm, S, E); }
        else { const int tid = opaque_tid(); const float* pp = (const float*)(ws + WS_POSP);
            for (int o = (bx - 64) * 512 + tid; o < 2048; o += (G - 64) * 512) { const int q = o >> 9, f = o & 511; float acc = 0.f;
                for (int kc = 0; kc < 64; ++kc) acc += pp[((size_t)q * 64 + kc) * 512 + f];
                posb[o] = acc; } }
    }
    SEAM();
#pragma unroll 1
    for (int layer = 0; layer < 4; ++layer) {
        const int j = layer >> 1; const bool even = (layer & 1) == 0;
        unsigned char* wsl = opqp(ws); unsigned char* Zl = wsl + WS_Z; bf16_t* XNl = (bf16_t*)(wsl + WS_XN); bf16_t* YBl = (bf16_t*)(wsl + WS_YB); float* posbl = (float*)(wsl + WS_POSB);
        const float* hin = (layer == 0) ? a.in[0] : a.out;
        float* RSS = (float*)(wsl + WS_ROWSS); bf16_t* PPl = (bf16_t*)(wsl + WS_PP);
        bf16_t* hc = (layer & 1) ? (bf16_t*)(wsl + WS_H2) : XNl;
        bf16_t* hn = (layer & 1) ? XNl : (bf16_t*)(wsl + WS_H2);
        const bf16_t* Ain = hc;
        LAS const float* RT = (LAS const float*)(lds + RTAB_OFF);
        if (EN(3) && ON()) {
            fill_rstd_tab(lds, RSS + (size_t)(layer * 3) * T_TOK * 32, opq(bx));
            if (even) { pg8::Gemm gm{Ain, (const bf16_t*)(wsl + WS_WIN + j * SZ_WIN), T_TOK, AB_IN, DM, DM, DM};
                pg8::StaticOrder S; S.init(T_TOK, AB_IN, opq(G), opq(bx)); EpiBf16<0> E{(bf16_t*)Zl, AB_IN, nullptr, RT}; pg8::gemm_phase(lds, gm, S, E); }
            else { pg8::Gemm gm{Ain, (const bf16_t*)(wsl + WS_CIN + j * SZ_CIN), T_TOK, C_INP, DM, DM, DM};
                pg8::StaticOrder S; S.init(T_TOK, C_INP, opq(G), opq(bx));
                EpiNsa E{(bf16_t*)(Zl + Z_Q), (bf16_t*)(Zl + Z_KC), (bf16_t*)(Zl + Z_VC), (bf16_t*)(Zl + Z_KS), (bf16_t*)(Zl + Z_VST), (bf16_t*)(Zl + Z_KW), (bf16_t*)(Zl + Z_VWT), (float*)(Zl + Z_GL), RT};
                pg8::gemm_phase(lds, gm, S, E); }
        }
        SEAM();
        if (even) {
            if (EN(4) && ON()) {
#ifndef NO_LRU
#pragma unroll 1
                for (int rp = 0; rp < REP_LRU; ++rp)
                for (int it = opq(bx); it < 256; it += G)
                    lru_item(lds, it, (const bf16_t*)Zl, a.in[4] + (size_t)j * 4096, a.in[5] + j * 1024, (const bf16_t*)(wsl + WS_WR + j * SZ_WRI), (const bf16_t*)(wsl + WS_WI + j * SZ_WRI),
                             a.in[7] + j * 1024, a.in[9] + j * 1024, a.in[10] + j * 1024, YBl);
#endif
                for (int it = opq(bx); it < 256; it += G) pool_item(it, (const bf16_t*)Zl, a.in[12] + j * 1024, YBl);
            }
            SEAM();
        } else {
            if (EN(5) && ON()) {
                if (bx < 64) { const int kv = bx >> 5;
                    pg8::Gemm gm{(const bf16_t*)(Zl + (kv ? Z_VC : Z_KC)), (const bf16_t*)(wsl + (kv ? WS_W1V : WS_W1K) + j * SZ_W1), 4096, 512, 4096, 2048, 4096};
                    pg8::StaticOrder S; S.init(4096, 512, opq(G), opq(bx) & 31);
                    EpiBf16<2> E{(bf16_t*)(Zl + (kv ? Z_HIDV : Z_HIDK)), 512, posbl + (j * 2 + kv) * 512, nullptr}; pg8::gemm_phase(lds, gm, S, E); }
                else if (bx < 128) { pg8::Gemm gm{Ain, (const bf16_t*)(wsl + WS_WGL + (size_t)j * 256 * DM * 2), T_TOK, 256, DM, DM, DM};
                    fill_rstd_tab(lds, RSS + (size_t)(layer * 3) * T_TOK * 32, opq(bx));
                    pg8::StaticOrder S; S.init(T_TOK, 256, opq(G), opq(bx) - 64); EpiGates E{(float*)(Zl + Z_GL), RT}; pg8::gemm_phase(lds, gm, S, E); }
                else { pg8::Gemm gp{(const bf16_t*)(wsl + WS_PB) + (size_t)layer * T_TOK * PLE, (const bf16_t*)(wsl + WS_WP + layer * SZ_WP), T_TOK, DM, PLE, PLE, PLE};
                    pg8::StaticOrder S2; S2.init(T_TOK, DM, 128, opq(bx) - 128); EpiBf16<0> E2{PPl, DM, nullptr, nullptr}; pg8::gemm_phase(lds, gp, S2, E2); }
            }
            SEAM();
            if (EN(6) && ON()) {
                if (bx < 16) { pg8::Gemm gm{(const bf16_t*)(Zl + Z_HIDK), (const bf16_t*)(wsl + WS_W2K + j * SZ_W2), 4096, 256, 512, 512, 512};
                    pg8::StaticOrder S; S.init(4096, 256, opq(G), opq(bx)); EpiCmp2<0> E{(bf16_t*)(Zl + Z_KCMP)}; pg8::gemm_phase(lds, gm, S, E); }
                else if (bx < 32) { pg8::Gemm gm{(const bf16_t*)(Zl + Z_HIDV), (const bf16_t*)(wsl + WS_W2V + j * SZ_W2), 4096, 256, 512, 512, 512};
                    pg8::StaticOrder S; S.init(4096, 256, opq(G), opq(bx) - 16); EpiCmp2<1> E{(bf16_t*)(Zl + Z_VCMPT)}; pg8::gemm_phase(lds, gm, S, E); }
            }
            SEAM();
            if (EN(7) && ON()) {
#pragma unroll 1
                for (int rp = 0; rp < REP_ATTN; ++rp)
                for (int it = opq(bx), r = 0; it < 1024; it += G, ++r) { const int c = it % 256, rr = it / 256; const int cp = (rr & 1) ? 255 - c : c;
                    const int tq = 63 - (rr * 16 + (cp >> 4)), bgi = cp & 15;
#ifndef NO_ATTN
                    nsa_item(lds, bgi >> 2, bgi & 3, tq, (const bf16_t*)(Zl + Z_Q), (const bf16_t*)(Zl + Z_KS), (const bf16_t*)(Zl + Z_VST), (const bf16_t*)(Zl + Z_KW), (const bf16_t*)(Zl + Z_VWT),
                             (const bf16_t*)(Zl + Z_KCMP), (const bf16_t*)(Zl + Z_VCMPT), (const float*)(Zl + Z_GL), YBl);
#endif
                }
                __syncthreads();
            }
            SEAM();
        }
        if (EN(8) && ON()) { pg8::Gemm gm{YBl, (const bf16_t*)(wsl + (even ? WS_WOUT : WS_COUT) + j * SZ_SQ), T_TOK, DM, DM, DM, DM};
            pg8::StaticOrder S; S.init(T_TOK, DM, opq(G), opq(bx)); EpiRes<0> E{hc, hc, nullptr, DM, RSS + (size_t)(layer * 3 + 1) * T_TOK * 32, nullptr}; pg8::gemm_phase(lds, gm, S, E);
            if (even) { pg8::Gemm gp{(const bf16_t*)(wsl + WS_PB) + (size_t)layer * T_TOK * PLE, (const bf16_t*)(wsl + WS_WP + layer * SZ_WP), T_TOK, DM, PLE, PLE, PLE};
              pg8::StaticOrder S2; S2.init(T_TOK, DM, opq(G), opq(bx)); EpiBf16<0> E2{PPl, DM, nullptr, nullptr}; pg8::gemm_phase(lds, gp, S2, E2); } }
        SEAM();
        if (EN(10) && ON())
#pragma unroll 1
        for (int rpu = 0; rpu < REP_UP; ++rpu) { fill_rstd_tab(lds, RSS + (size_t)(layer * 3 + 1) * T_TOK * 32, opq(bx));
            pg8::Gemm gm{hc, (const bf16_t*)(wsl + WS_WUP + layer * SZ_UP), T_TOK, DFF, DM, DM, DM};
            pg8::StaticOrder S; S.init(T_TOK, DFF, opq(G), opq(bx)); EpiBf16<1> E{(bf16_t*)Zl, DFF, nullptr, RT}; pg8::gemm_phase(lds, gm, S, E); }
        SEAM();
        if (EN(11) && ON()) { pg8::Gemm gm{(const bf16_t*)Zl, (const bf16_t*)(wsl + WS_WDN + layer * SZ_UP), T_TOK, DM, DFF, DFF, DFF};
            pg8::StaticOrder S; S.init(T_TOK, DM, opq(G), opq(bx)); EpiRes<0> E{hc, hc, nullptr, DM, RSS + (size_t)(layer * 3 + 2) * T_TOK * 32, nullptr}; pg8::gemm_phase(lds, gm, S, E); }
        SEAM();
        if (EN(13) && ON()) { fill_rstd_tab(lds, RSS + (size_t)(layer * 3 + 2) * T_TOK * 32, opq(bx));
            pg8::Gemm gm{hc, (const bf16_t*)(wsl + WS_WG + layer * SZ_SQ), T_TOK, DM, DM, DM, DM};
            pg8::StaticOrder S; S.init(T_TOK, DM, opq(G), opq(bx)); EpiRes<1> E{hc, hn, PPl, DM, RSS + (size_t)(layer * 3 + 3) * T_TOK * 32, RT}; pg8::gemm_phase(lds, gm, S, E); }
        SEAM();
    }
    if (EN(14) && ON()) rmsnorm_rows<true>((const float*)XN, a.in[28], nullptr, a.out, bx, NGW);
#undef ON
#undef SEAM
}
constexpr int N_PHASES = 1 + 2 * 9 + 2 * 11 + 1;

extern "C" void kernel_launch(void* const* d_in, const int* in_sizes, int n_in, void* d_out, int out_size, void* d_ws, size_t ws_size, hipStream_t stream) {
    static int grid = 0;
    if (grid == 0) {
        if (n_in != 29 || ws_size < WS_END) { fprintf(stderr, "kernel_launch: unexpected n_in %d / ws %zu (need %zu)\n", n_in, ws_size, (size_t)WS_END); grid = -1; return; }
        int dev = 0, cus = 0, per_cu = 0;
        hipGetDevice(&dev); hipDeviceGetAttribute(&cus, hipDeviceAttributeMultiprocessorCount, dev);
        if (hipFuncSetAttribute((const void*)fwd_kernel, hipFuncAttributeMaxDynamicSharedMemorySize, LDS_BYTES) != hipSuccess) { fprintf(stderr, "hipFuncSetAttribute failed\n"); grid = -1; return; }
        if (hipOccupancyMaxActiveBlocksPerMultiprocessor(&per_cu, (const void*)fwd_kernel, 512, LDS_BYTES) != hipSuccess || per_cu < 1) { fprintf(stderr, "occupancy query: %d\n", per_cu); per_cu = 1; }
        (void)hipGetLastError();
        grid = cus;
        if (grid != 256) { fprintf(stderr, "kernel_launch: this build needs a 256-CU device (fixed row panel per workgroup); got %d\n", cus); grid = -1; return; }
    }
    if (grid < 0) return;
    Args a{};
    for (int i = 0; i < 29; ++i) a.in[i] = (const float*)d_in[i];
    a.out = (float*)d_out; a.ws = (unsigned char*)d_ws;
#if MK_ONE_LAUNCH
    (void)hipMemsetAsync((unsigned char*)d_ws + WS_BAR, 0, XCD_BAR_WORDS * 4, stream);
    a.lo = 0; a.hi = 1 << 30; a.one = 1; a.pad = 0;
    void* args[] = {&a};
    hipError_t e = hipLaunchCooperativeKernel((const void*)fwd_kernel, dim3(grid), dim3(512), args, LDS_BYTES, stream);
    if (e != hipSuccess) fprintf(stderr, "cooperative launch failed: %s (grid %d)\n", hipGetErrorString(e), grid);
#else
    for (int p = 0; p < N_PHASES; ++p) { a.lo = p; a.hi = p + 1; a.one = 0; a.pad = 0;
        hipLaunchKernelGGL(fwd_kernel, dim3(grid), dim3(512), LDS_BYTES, stream, a); }
#endif
}
```
